# Optimizing an MI355X kernel written in HIP

```python
import math
import jax, jax.numpy as jnp
from jax import lax
import numpy as np

D_MODEL = 1024
BATCH = 8
SEQ = 2048
DEPTH = 4

CTX_LEN = 256
GRID_W = 64
N_EVEN = (DEPTH + 1) // 2
N_ODD = DEPTH // 2

A_HEADS = 4
A_DQK = 64
A_DV = 2 * A_DQK
A_WIDTH = A_HEADS * A_DV
B_HEADS = 4
B_DK = 64
B_DV = 128
B_WIDTH = B_HEADS * B_DV
B_GATE_RANK = 16
B_GATE_NORM = 16.0
C_HEADS = 8
C_DH = D_MODEL // C_HEADS
C_WIDTH = C_HEADS * C_DH

CHUNK = 64
Q_BLOCK = 128
ROPE_BASE = 10000.0
EPS = 1e-6
D_FF = ((8 * D_MODEL + 3 * 256 - 1) // (3 * 256)) * 256

EVEN_SIZES = (2 * A_HEADS * A_DQK, 2 * A_HEADS * A_DQK, A_WIDTH,
              B_HEADS * B_DK, B_HEADS * B_DK, B_WIDTH, B_WIDTH, 2 * B_GATE_RANK)
EVEN_COLS = sum(EVEN_SIZES)
EVEN_SPLITS = tuple(int(s) for s in np.cumsum(EVEN_SIZES)[:-1])
ODD_COLS = 5 * C_WIDTH

kernel_name = "hybrid_diffattn_gla_hgrn2_prefix_dit"

F32 = jnp.float32


def rms_norm(x, gain):
    xf = x.astype(F32)
    y = xf * lax.rsqrt(jnp.mean(xf * xf, axis=-1, keepdims=True) + EPS)
    return (y * gain.astype(F32)).astype(x.dtype)


def axial_rope_tables(rows):
    row_ids = jnp.repeat(jnp.arange(rows), GRID_W).astype(F32)
    col_ids = jnp.tile(jnp.arange(GRID_W), rows).astype(F32)
    n_axis = A_DQK // 2
    inv = ROPE_BASE ** (-jnp.arange(0, n_axis, 2, dtype=F32) / n_axis)
    ang = jnp.concatenate([row_ids[:, None] * inv, col_ids[:, None] * inv], axis=-1)
    return jnp.cos(ang), jnp.sin(ang)


def apply_axial_rope(x, cos, sin):
    def rot(u, cs, sn):
        cs = cs[:, None, None, :]
        sn = sn[:, None, None, :]
        u1, u2 = jnp.split(u, 2, axis=-1)
        return jnp.concatenate([u1 * cs - u2 * sn, u2 * cs + u1 * sn], axis=-1)
    xr, xc = jnp.split(x, 2, axis=-1)
    cr, cc = jnp.split(cos, 2, axis=-1)
    sr, sc = jnp.split(sin, 2, axis=-1)
    return jnp.concatenate([rot(xr, cr, sr), rot(xc, cc, sc)], axis=-1).astype(x.dtype)


def diff_attend(q, k, v, lam):
    s = jnp.einsum('bqhcd,bkhcd->bhcqk', q, k).astype(F32) * (A_DQK ** -0.5)
    p = jax.nn.softmax(s, axis=-1)
    a = (p[:, :, 0] - lam * p[:, :, 1]).astype(v.dtype)
    return jnp.einsum('bhqk,bkhe->bqhe', a, v)


def chunked_gated_scan(q, k, v, logf, s0):
    Bn, L, H, _ = q.shape
    dv = v.shape[-1]
    n = L // CHUNK

    def to_chunks(a):
        return jnp.moveaxis(a.reshape(Bn, n, CHUNK, H, a.shape[-1]), 1, 0)

    mask = jnp.tril(jnp.ones((CHUNK, CHUNK), dtype=bool))[None, :, :, None, None]

    def step(S, inp):
        qc, kc, vc, gc = inp
        qf, kf, vf = qc.astype(F32), kc.astype(F32), vc.astype(F32)
        b = jnp.cumsum(gc.astype(F32), axis=1)
        o_inter = jnp.einsum('bthd,bhde->bthe', qf * jnp.exp(b), S)
        rel = b[:, :, None] - b[:, None, :]
        dec = jnp.exp(jnp.where(mask, rel, -jnp.inf))
        att = jnp.einsum('bthd,bshd,btshd->bhts', qf, kf, dec)
        o_intra = jnp.einsum('bhts,bshe->bthe', att, vf)
        b_last = b[:, -1]
        k_dec = kf * jnp.exp(b_last[:, None] - b)
        S_new = jnp.exp(b_last)[..., None] * S + jnp.einsum('bshd,bshe->bhde', k_dec, vf)
        return S_new, (o_inter + o_intra).astype(v.dtype)

    S, o = lax.scan(step, s0.astype(F32), (to_chunks(q), to_chunks(k), to_chunks(v), to_chunks(logf)))
    return jnp.moveaxis(o, 0, 1).reshape(Bn, L, H, dv), S


def bidir_scan(qc, kfc, gfc, kbc, gbc, vc, ql, kfl, gfl, kbl, gbl, vl, need_ctx):
    Bn, _, H, dk = qc.shape
    s0 = jnp.zeros((Bn, H, dk, vc.shape[-1]), F32)
    fl = lambda a: jnp.flip(a, axis=1)
    oc_f, sc_f = chunked_gated_scan(qc, kfc, vc, gfc, s0)
    ol_f, _ = chunked_gated_scan(ql, kfl, vl, gfl, sc_f)
    oc_b, sc_b = chunked_gated_scan(fl(qc), fl(kbc), fl(vc), fl(gbc), s0)
    ol_b, _ = chunked_gated_scan(fl(ql), fl(kbl), fl(vl), fl(gbl), sc_b)
    ol = ol_f + fl(ol_b)
    oc = oc_f + fl(oc_b) if need_ctx else None
    return oc, ol


def prep_even(p, qk_gain, w_gate_up, b_gate_up):
    Bn, L = p.shape[:2]
    aq, ak, av, bq, bk, bv, bg, blr = jnp.split(p, EVEN_SPLITS, axis=-1)
    aq = rms_norm(aq.reshape(Bn, L, A_HEADS, 2, A_DQK), qk_gain[0])
    ak = rms_norm(ak.reshape(Bn, L, A_HEADS, 2, A_DQK), qk_gain[1])
    av = av.reshape(Bn, L, A_HEADS, A_DV)
    bq = bq.reshape(Bn, L, B_HEADS, B_DK) * (B_DK ** -0.5)
    bk = bk.reshape(Bn, L, B_HEADS, B_DK)
    bv = bv.reshape(Bn, L, B_HEADS, B_DV)
    lr_f, lr_b = jnp.split(blr, 2, axis=-1)
    gk_f = (jax.nn.log_sigmoid((lr_f @ w_gate_up[0] + b_gate_up[0]).astype(F32)) / B_GATE_NORM).reshape(Bn, L, B_HEADS, B_DK)
    gk_b = (jax.nn.log_sigmoid((lr_b @ w_gate_up[1] + b_gate_up[1]).astype(F32)) / B_GATE_NORM).reshape(Bn, L, B_HEADS, B_DK)
    return aq, ak, av, (bq, bk, gk_f, bk, gk_b, bv), bg


def even_mixer(pc, pl, rope_cos, rope_sin, qk_gain, lam, sub_gain, lambda_init,
               w_gate_up, b_gate_up, gla_gain, need_ctx):
    qc, kc, vc, bc, bgc = prep_even(pc, qk_gain, w_gate_up, b_gate_up)
    ql, kl, vl, bl, bgl = prep_even(pl, qk_gain, w_gate_up, b_gate_up)
    ql = apply_axial_rope(ql, rope_cos, rope_sin)
    kl = apply_axial_rope(kl, rope_cos, rope_sin)
    k_all = jnp.concatenate([kc, kl], axis=1)
    v_all = jnp.concatenate([vc, vl], axis=1)
    Bn, T = ql.shape[:2]
    nb = T // Q_BLOCK
    q_blocks = jnp.moveaxis(ql.reshape(Bn, nb, Q_BLOCK, A_HEADS, 2, A_DQK), 1, 0)
    o_blocks = lax.map(lambda qb: diff_attend(qb, k_all, v_all, lam), q_blocks)
    oa_l = jnp.moveaxis(o_blocks, 0, 1).reshape(Bn, T, A_HEADS, A_DV)

    def post_a(o):
        return (rms_norm(o, sub_gain) * (1.0 - lambda_init)).reshape(o.shape[0], o.shape[1], A_WIDTH)

    def post_b(o, g):
        return (rms_norm(o, gla_gain) * jax.nn.silu(g).reshape(o.shape)).reshape(o.shape[0], o.shape[1], B_WIDTH)

    ob_c, ob_l = bidir_scan(*bc, *bl, need_ctx)
    ol = jnp.concatenate([post_a(oa_l), post_b(ob_l, bgl)], axis=-1)
    oc = None
    if need_ctx:
        oa_c = diff_attend(qc, kc, vc, lam)
        oc = jnp.concatenate([post_a(oa_c), post_b(ob_c, bgc)], axis=-1)
    return oc, ol


def prep_odd(p, lb_f, lb_b):
    Bn, L = p.shape[:2]
    hd = lambda a: a.reshape(Bn, L, C_HEADS, C_DH)
    q, ff, fb, i, g = jnp.split(p, 5, axis=-1)
    q = hd(jax.nn.silu(q)) * (C_DH ** -0.5)
    f_f = lb_f + (1.0 - lb_f) * jax.nn.sigmoid(ff.astype(F32))
    f_b = lb_b + (1.0 - lb_b) * jax.nn.sigmoid(fb.astype(F32))
    return (q, hd(1.0 - f_f), hd(jnp.log(f_f)), hd(1.0 - f_b), hd(jnp.log(f_b)), hd(i)), g


def odd_mixer(pc, pl, lb_f, lb_b, out_gain, need_ctx):
    sc, gc = prep_odd(pc, lb_f, lb_b)
    sl, gl = prep_odd(pl, lb_f, lb_b)
    oc, ol = bidir_scan(*sc, *sl, need_ctx)

    def post(o, g):
        return (rms_norm(o, out_gain) * jax.nn.silu(g).reshape(o.shape)).reshape(o.shape[0], o.shape[1], C_WIDTH)

    return (post(oc, gc) if need_ctx else None), post(ol, gl)


def swiglu(h, w_in, w_out):
    gate, up = jnp.split(h @ w_in, 2, axis=-1)
    return (jax.nn.silu(gate) * up) @ w_out


def setup_inputs(seed: int = 0) -> dict:
    key = jax.random.key(seed)
    ks = jax.random.split(key, 24)
    D = D_MODEL
    nrm = lambda k, shape, scale: jax.random.normal(k, shape, jnp.float32) * scale
    return {
        "x": nrm(ks[0], (BATCH, SEQ, D), 1.0),
        "c": nrm(ks[1], (BATCH, D), 1.0),
        "ctx": nrm(ks[2], (BATCH, CTX_LEN, D), 1.0),
        "c_ctx": nrm(ks[3], (D,), 1.0),
        "w_ada": nrm(ks[4], (DEPTH, D, 6 * D), 0.5 * D ** -0.5),
        "b_ada": nrm(ks[5], (DEPTH, 6 * D), 0.02),
        "norm1_gain": 1.0 + nrm(ks[6], (DEPTH, D), 0.02),
        "norm2_gain": 1.0 + nrm(ks[7], (DEPTH, D), 0.02),
        "w_in_even": nrm(ks[8], (N_EVEN, D, EVEN_COLS), D ** -0.5),
        "qk_gain_a": 1.0 + nrm(ks[9], (N_EVEN, 2, A_DQK), 0.02),
        "lambda_a": nrm(ks[10], (N_EVEN, 4, A_DQK), 0.1),
        "subln_gain_a": 1.0 + nrm(ks[11], (N_EVEN, A_DV), 0.02),
        "w_gate_up_b": nrm(ks[12], (N_EVEN, 2, B_GATE_RANK, B_HEADS * B_DK), B_GATE_RANK ** -0.5),
        "b_gate_up_b": nrm(ks[13], (N_EVEN, 2, B_HEADS * B_DK), 0.01),
        "onorm_gain_b": 1.0 + nrm(ks[14], (N_EVEN, B_DV), 0.02),
        "w_out_even": nrm(ks[15], (N_EVEN, A_WIDTH + B_WIDTH, D), (A_WIDTH + B_WIDTH) ** -0.5),
        "w_in_odd": nrm(ks[16], (N_ODD, D, ODD_COLS), D ** -0.5),
        "lb_raw_c": nrm(ks[17], (2, DEPTH, C_WIDTH), 0.5),
        "onorm_gain_c": 1.0 + nrm(ks[18], (N_ODD, C_DH), 0.02),
        "w_out_odd": nrm(ks[19], (N_ODD, C_WIDTH, D), C_WIDTH ** -0.5),
        "w_ffn_in": nrm(ks[20], (DEPTH, D, 2 * D_FF), D ** -0.5),
        "w_ffn_out": nrm(ks[21], (DEPTH, D_FF, D), D_FF ** -0.5),
    }


def reference(x, c, ctx, c_ctx, w_ada, b_ada, norm1_gain, norm2_gain, w_in_even, qk_gain_a,
              lambda_a, subln_gain_a, w_gate_up_b, b_gate_up_b, onorm_gain_b, w_out_even,
              w_in_odd, lb_raw_c, onorm_gain_c, w_out_odd, w_ffn_in, w_ffn_out):
    rows = x.shape[1] // GRID_W
    rope_cos, rope_sin = axial_rope_tables(rows)
    lb_p = jax.nn.softmax(lb_raw_c.astype(F32), axis=1)
    lower_bounds = jnp.cumsum(lb_p, axis=1) - lb_p[:, :1]
    z = ctx
    sc = jax.nn.silu(c)
    scc = jax.nn.silu(c_ctx)
    for l in range(DEPTH):
        need_ctx = l < DEPTH - 1
        mod_l = [m[..., None, :] for m in jnp.split(sc @ w_ada[l] + b_ada[l], 6, axis=-1)]
        mod_c = [m[..., None, :] for m in jnp.split(scc @ w_ada[l] + b_ada[l], 6, axis=-1)]
        hl = rms_norm(x, norm1_gain[l]) * (1.0 + mod_l[1]) + mod_l[0]
        hc = rms_norm(z, norm1_gain[l]) * (1.0 + mod_c[1]) + mod_c[0]
        if l % 2 == 0:
            j = l // 2
            lambda_init = 0.8 - 0.6 * math.exp(-0.3 * l)
            lq1, lk1, lq2, lk2 = lambda_a[j].astype(F32)
            lam = jnp.exp(jnp.sum(lq1 * lk1)) - jnp.exp(jnp.sum(lq2 * lk2)) + lambda_init
            oc, ol = even_mixer(hc @ w_in_even[j], hl @ w_in_even[j], rope_cos, rope_sin,
                                qk_gain_a[j], lam, subln_gain_a[j], lambda_init,
                                w_gate_up_b[j], b_gate_up_b[j], onorm_gain_b[j], need_ctx)
            w_out = w_out_even[j]
        else:
            j = l // 2
            oc, ol = odd_mixer(hc @ w_in_odd[j], hl @ w_in_odd[j], lower_bounds[0, l],
                               lower_bounds[1, l], onorm_gain_c[j], need_ctx)
            w_out = w_out_odd[j]
        x = x + mod_l[2] * (ol @ w_out)
        hl = rms_norm(x, norm2_gain[l]) * (1.0 + mod_l[4]) + mod_l[3]
        x = x + mod_l[5] * swiglu(hl, w_ffn_in[l], w_ffn_out[l])
        if need_ctx:
            z = z + mod_c[2] * (oc @ w_out)
            hc = rms_norm(z, norm2_gain[l]) * (1.0 + mod_c[4]) + mod_c[3]
            z = z + mod_c[5] * swiglu(hc, w_ffn_in[l], w_ffn_out[l])
    return x
```

```cpp
#include <hip/hip_runtime.h>
#include <hip/hip_cooperative_groups.h>
#include <cstdio>
namespace cg = cooperative_groups;

#ifndef ONE_LAUNCH
#define ONE_LAUNCH 1
#endif

typedef unsigned short bf16_t;
typedef short bf16x8 __attribute__((ext_vector_type(8)));
typedef short s16x4 __attribute__((ext_vector_type(4)));
typedef float f32x4 __attribute__((ext_vector_type(4)));
typedef float f32x16 __attribute__((ext_vector_type(16)));
#define DI __device__ __forceinline__

__device__ const float ROPE_CS[64][16] = {
  {1.00000000e+00f,1.00000000e+00f,1.00000000e+00f,1.00000000e+00f,1.00000000e+00f,1.00000000e+00f,1.00000000e+00f,1.00000000e+00f,1.00000000e+00f,1.00000000e+00f,1.00000000e+00f,1.00000000e+00f,1.00000000e+00f,1.00000000e+00f,1.00000000e+00f,1.00000000e+00f},
  {5.40302277e-01f,8.46009135e-01f,9.50415254e-01f,9.84230220e-01f,9.95004177e-01f,9.98419285e-01f,9.99500036e-01f,9.99841869e-01f,9.99949992e-01f,9.99984205e-01f,9.99994993e-01f,9.99998391e-01f,9.99999523e-01f,9.99999821e-01f,9.99999940e-01f,1.00000000e+00f},
  {-4.16146845e-01f,4.31462824e-01f,8.06578398e-01f,9.37418282e-01f,9.80066597e-01f,9.93682086e-01f,9.98000681e-01f,9.99367595e-01f,9.99800026e-01f,9.99936759e-01f,9.99979973e-01f,9.99993682e-01f,9.99997973e-01f,9.99999344e-01f,9.99999821e-01f,9.99999940e-01f},
  {-9.89992499e-01f,-1.15966164e-01f,5.82753658e-01f,8.61040652e-01f,9.55336511e-01f,9.85803485e-01f,9.95503366e-01f,9.98577297e-01f,9.99550045e-01f,9.99857724e-01f,9.99954998e-01f,9.99985754e-01f,9.99995530e-01f,9.99998569e-01f,9.99999523e-01f,9.99999881e-01f},
  {-6.53643608e-01f,-6.27679706e-01f,3.01137477e-01f,7.57506192e-01f,9.21060979e-01f,9.74808276e-01f,9.92010653e-01f,9.97471273e-01f,9.99200106e-01f,9.99747038e-01f,9.99920011e-01f,9.99974728e-01f,9.99992013e-01f,9.99997497e-01f,9.99999225e-01f,9.99999762e-01f},
  {2.83662200e-01f,-9.46079254e-01f,-1.03423381e-02f,6.30080283e-01f,8.77582550e-01f,9.60731268e-01f,9.87526000e-01f,9.96049762e-01f,9.98750269e-01f,9.99604762e-01f,9.99875009e-01f,9.99960482e-01f,9.99987483e-01f,9.99996066e-01f,9.99998748e-01f,9.99999583e-01f},
  {9.60170269e-01f,-9.73103702e-01f,-3.20796400e-01f,4.82782036e-01f,8.25335622e-01f,9.43616986e-01f,9.82053936e-01f,9.94313300e-01f,9.98200536e-01f,9.99430835e-01f,9.99819994e-01f,9.99943078e-01f,9.99981999e-01f,9.99994338e-01f,9.99998212e-01f,9.99999404e-01f},
  {7.53902256e-01f,-7.00429797e-01f,-5.99437475e-01f,3.20257008e-01f,7.64842212e-01f,9.23519433e-01f,9.75599885e-01f,9.92262423e-01f,9.97551024e-01f,9.99225318e-01f,9.99755025e-01f,9.99922514e-01f,9.99975502e-01f,9.99992251e-01f,9.99997556e-01f,9.99999225e-01f},
  {-1.45500034e-01f,-2.12036446e-01f,-8.18632424e-01f,1.47631213e-01f,6.96706712e-01f,9.00502324e-01f,9.68170285e-01f,9.89897788e-01f,9.96801734e-01f,9.98988271e-01f,9.99680042e-01f,9.99898791e-01f,9.99967992e-01f,9.99989867e-01f,9.99996781e-01f,9.99998987e-01f},
  {-9.11130250e-01f,3.41660261e-01f,-9.56644177e-01f,-2.96507962e-02f,6.21609926e-01f,8.74638259e-01f,9.59772646e-01f,9.87220109e-01f,9.95952725e-01f,9.98719573e-01f,9.99595046e-01f,9.99871910e-01f,9.99959528e-01f,9.99987185e-01f,9.99995947e-01f,9.99998748e-01f},
  {-8.39071512e-01f,7.90131867e-01f,-9.99786079e-01f,-2.05997631e-01f,5.40302277e-01f,8.46009135e-01f,9.50415313e-01f,9.84230220e-01f,9.95004177e-01f,9.98419285e-01f,9.99500036e-01f,9.99841869e-01f,9.99949992e-01f,9.99984205e-01f,9.99994993e-01f,9.99998391e-01f},
  {4.42569796e-03f,9.95257378e-01f,-9.43779767e-01f,-3.75847399e-01f,4.53596085e-01f,8.14705312e-01f,9.40107584e-01f,9.80929136e-01f,9.93956089e-01f,9.98087406e-01f,9.99395072e-01f,9.99808669e-01f,9.99939501e-01f,9.99980867e-01f,9.99993920e-01f,9.99998093e-01f},
  {8.43853951e-01f,8.93861592e-01f,-7.94179380e-01f,-5.33843040e-01f,3.62357706e-01f,7.80825913e-01f,9.28859890e-01f,9.77317870e-01f,9.92808640e-01f,9.97723997e-01f,9.99280095e-01f,9.99772310e-01f,9.99927998e-01f,9.99977231e-01f,9.99992788e-01f,9.99997735e-01f},
  {9.07446802e-01f,5.17172873e-01f,-5.65820515e-01f,-6.75001681e-01f,2.67498761e-01f,7.44477987e-01f,9.16683376e-01f,9.73397553e-01f,9.91561890e-01f,9.97329056e-01f,9.99155104e-01f,9.99732792e-01f,9.99915481e-01f,9.99973297e-01f,9.99991536e-01f,9.99997318e-01f},
  {1.36737213e-01f,-1.87961515e-02f,-2.81349480e-01f,-7.94870913e-01f,1.69967160e-01f,7.05776393e-01f,9.03590262e-01f,9.69169438e-01f,9.90216017e-01f,9.96902585e-01f,9.99020159e-01f,9.99690115e-01f,9.99902010e-01f,9.99969006e-01f,9.99990225e-01f,9.99996901e-01f},
  {-7.59687901e-01f,-5.48975468e-01f,3.10223512e-02f,-8.89670432e-01f,7.07371980e-02f,6.64843500e-01f,8.89593601e-01f,9.64634836e-01f,9.88771081e-01f,9.96444523e-01f,9.98875201e-01f,9.99644279e-01f,9.99887526e-01f,9.99964416e-01f,9.99988735e-01f,9.99996424e-01f},
  {-9.57659483e-01f,-9.10081089e-01f,3.40318173e-01f,-9.56410050e-01f,-2.91995462e-02f,6.21808827e-01f,8.74707460e-01f,9.59795177e-01f,9.87227261e-01f,9.95954990e-01f,9.98720288e-01f,9.99595284e-01f,9.99872029e-01f,9.99959528e-01f,9.99987185e-01f,9.99995947e-01f},
  {-2.75163352e-01f,-9.90897954e-01f,6.15864813e-01f,-9.92985010e-01f,-1.28844544e-01f,5.76808274e-01f,8.58946681e-01f,9.54652011e-01f,9.85584795e-01f,9.95433986e-01f,9.98555362e-01f,9.99543071e-01f,9.99855518e-01f,9.99954283e-01f,9.99985576e-01f,9.99995410e-01f},
  {6.60316706e-01f,-7.66536534e-01f,8.30336154e-01f,-9.98241663e-01f,-2.27202162e-01f,5.29984176e-01f,8.42327058e-01f,9.49207008e-01f,9.83843684e-01f,9.94881511e-01f,9.98380423e-01f,9.99487758e-01f,9.99837995e-01f,9.99948800e-01f,9.99983788e-01f,9.99994874e-01f},
  {9.88704622e-01f,-3.06095392e-01f,9.62463796e-01f,-9.72014248e-01f,-3.23289543e-01f,4.81484592e-01f,8.24865162e-01f,9.43461835e-01f,9.82004225e-01f,9.94297504e-01f,9.98195529e-01f,9.99429286e-01f,9.99819517e-01f,9.99942899e-01f,9.99981940e-01f,9.99994278e-01f},
  {4.08082068e-01f,2.48616725e-01f,9.99144375e-01f,-9.15129960e-01f,-4.16146845e-01f,4.31462824e-01f,8.06578457e-01f,9.37418282e-01f,9.80066597e-01f,9.93682086e-01f,9.98000681e-01f,9.99367595e-01f,9.99800026e-01f,9.99936759e-01f,9.99979973e-01f,9.99993682e-01f},
  {-5.47729254e-01f,7.26760268e-01f,9.36740458e-01f,-8.29382956e-01f,-5.04846215e-01f,3.80077004e-01f,7.87485182e-01f,9.31078374e-01f,9.78030920e-01f,9.93035257e-01f,9.97795820e-01f,9.99302804e-01f,9.99779522e-01f,9.99930263e-01f,9.99977946e-01f,9.99993026e-01f},
  {-9.99960840e-01f,9.81074572e-01f,7.81440377e-01f,-7.17477441e-01f,-5.88501155e-01f,3.27489585e-01f,7.67604589e-01f,9.24443960e-01f,9.75897431e-01f,9.92357016e-01f,9.97581005e-01f,9.99234855e-01f,9.99758005e-01f,9.99923468e-01f,9.99975801e-01f,9.99992371e-01f},
  {-5.32833040e-01f,9.33235765e-01f,5.48645258e-01f,-5.82943261e-01f,-6.66275978e-01f,2.73866832e-01f,7.46956408e-01f,9.17517304e-01f,9.73666370e-01f,9.91647422e-01f,9.97356176e-01f,9.99163687e-01f,9.99735534e-01f,9.99916375e-01f,9.99973536e-01f,9.99991655e-01f},
  {4.24179018e-01f,5.97977161e-01f,2.61441678e-01f,-4.30023283e-01f,-7.37393796e-01f,2.19378278e-01f,7.25561321e-01f,9.10300434e-01f,9.71337974e-01f,9.90906477e-01f,9.97121394e-01f,9.99089420e-01f,9.99711990e-01f,9.99908924e-01f,9.99971211e-01f,9.99990880e-01f},
  {9.91202831e-01f,7.85522610e-02f,-5.16893305e-02f,-2.63540596e-01f,-8.01143587e-01f,1.64196163e-01f,7.03440726e-01f,9.02795732e-01f,9.68912423e-01f,9.90134120e-01f,9.96876657e-01f,9.99011934e-01f,9.99687493e-01f,9.99901175e-01f,9.99968767e-01f,9.99990106e-01f},
  {6.46919310e-01f,-4.65064496e-01f,-3.59694332e-01f,-8.87455046e-02f,-8.56888831e-01f,1.08494945e-01f,6.80616796e-01f,8.95005584e-01f,9.66389954e-01f,9.89330530e-01f,9.96621907e-01f,9.98931348e-01f,9.99662042e-01f,9.99893129e-01f,9.99966204e-01f,9.99989331e-01f},
  {-2.92138815e-01f,-8.65450621e-01f,-6.32028639e-01f,8.88481140e-02f,-9.04072165e-01f,5.24506159e-02f,6.57112300e-01f,8.86932373e-01f,9.63770926e-01f,9.88495648e-01f,9.96357203e-01f,9.98847544e-01f,9.99635518e-01f,9.99884725e-01f,9.99963522e-01f,9.99988496e-01f},
  {-9.62605894e-01f,-9.99293387e-01f,-8.41684937e-01f,2.63639510e-01f,-9.42222297e-01f,-3.75941908e-03f,6.32950664e-01f,8.78578722e-01f,9.61055458e-01f,9.87629473e-01f,9.96082544e-01f,9.98760641e-01f,9.99608040e-01f,9.99876022e-01f,9.99960780e-01f,9.99987602e-01f},
  {-7.48057544e-01f,-8.25371623e-01f,-9.67871487e-01f,4.30115849e-01f,-9.70958173e-01f,-5.99575676e-02f,6.08156204e-01f,8.69947195e-01f,9.58243906e-01f,9.86732066e-01f,9.95797932e-01f,9.98670578e-01f,9.99579549e-01f,9.99867022e-01f,9.99957979e-01f,9.99986708e-01f},
  {1.54251456e-01f,-3.97251874e-01f,-9.98075247e-01f,5.83026946e-01f,-9.89992499e-01f,-1.15966164e-01f,5.82753658e-01f,8.61040652e-01f,9.55336511e-01f,9.85803485e-01f,9.95503366e-01f,9.98577297e-01f,9.99550045e-01f,9.99857724e-01f,9.99954998e-01f,9.99985754e-01f},
  {9.14742351e-01f,1.53215483e-01f,-9.29300308e-01f,7.17549205e-01f,-9.99135137e-01f,-1.71608135e-01f,5.56768358e-01f,8.51861775e-01f,9.52333570e-01f,9.84843671e-01f,9.95198846e-01f,9.98480916e-01f,9.99519527e-01f,9.99848068e-01f,9.99951959e-01f,9.99984801e-01f},
  {8.34223390e-01f,6.56495154e-01f,-7.68367112e-01f,8.29440355e-01f,-9.98294771e-01f,-2.26707578e-01f,5.30226350e-01f,8.42413545e-01f,9.49235439e-01f,9.83852804e-01f,9.94884372e-01f,9.98381376e-01f,9.99488056e-01f,9.99838114e-01f,9.99948800e-01f,9.99983788e-01f},
  {-1.32767474e-02f,9.57586050e-01f,-5.31235278e-01f,9.15171385e-01f,-9.87479806e-01f,-2.81090319e-01f,5.03154159e-01f,8.32698941e-01f,9.46042359e-01f,9.82830763e-01f,9.94559944e-01f,9.98278618e-01f,9.99455571e-01f,9.99827802e-01f,9.99945521e-01f,9.99982774e-01f},
  {-8.48570287e-01f,9.63757515e-01f,-2.41421118e-01f,9.72038329e-01f,-9.66798186e-01f,-3.34584385e-01f,4.75578904e-01f,8.22721004e-01f,9.42754686e-01f,9.81777668e-01f,9.94225562e-01f,9.98172760e-01f,9.99422073e-01f,9.99817252e-01f,9.99942183e-01f,9.99981701e-01f},
  {-9.03692186e-01f,6.73110247e-01f,7.23346695e-02f,9.98247743e-01f,-9.36456680e-01f,-3.87020677e-01f,4.47528064e-01f,8.12482953e-01f,9.39372718e-01f,9.80693519e-01f,9.93881226e-01f,9.98063743e-01f,9.99387562e-01f,9.99806345e-01f,9.99938726e-01f,9.99980628e-01f},
  {-1.27963692e-01f,1.75156534e-01f,3.78916174e-01f,9.92972851e-01f,-8.96758378e-01f,-4.38233554e-01f,4.19029742e-01f,8.01987886e-01f,9.35896814e-01f,9.79578316e-01f,9.93526995e-01f,9.97951567e-01f,9.99352098e-01f,9.99795079e-01f,9.99935210e-01f,9.99979496e-01f},
  {7.65414059e-01f,-3.76742303e-01f,6.47921681e-01f,9.56380010e-01f,-8.48100007e-01f,-4.88060862e-01f,3.90112430e-01f,7.91239262e-01f,9.32327330e-01f,9.78432178e-01f,9.93162811e-01f,9.97836173e-01f,9.99315560e-01f,9.99783576e-01f,9.99931574e-01f,9.99978364e-01f},
  {9.55073655e-01f,-8.12611222e-01f,8.52673113e-01f,8.89623463e-01f,-7.90967762e-01f,-5.36345184e-01f,3.60805035e-01f,7.80240417e-01f,9.28664625e-01f,9.77255106e-01f,9.92788672e-01f,9.97717679e-01f,9.99278069e-01f,9.99771714e-01f,9.99927819e-01f,9.99977171e-01f},
  {2.66642928e-01f,-9.98210371e-01f,9.72865343e-01f,7.94808388e-01f,-7.25932240e-01f,-5.82933903e-01f,3.31136853e-01f,7.68994927e-01f,9.24909055e-01f,9.76047099e-01f,9.92404640e-01f,9.97596025e-01f,9.99239624e-01f,9.99759495e-01f,9.99923944e-01f,9.99975979e-01f},
  {-6.66938066e-01f,-8.76379430e-01f,9.96578991e-01f,6.74925625e-01f,-6.53643608e-01f,-6.27679706e-01f,3.01137596e-01f,7.57506192e-01f,9.21060979e-01f,9.74808276e-01f,9.92010653e-01f,9.97471273e-01f,9.99200106e-01f,9.99747038e-01f,9.99920011e-01f,9.99974728e-01f},
  {-9.87339258e-01f,-4.84639406e-01f,9.21462357e-01f,5.33756077e-01f,-5.74824035e-01f,-6.70441091e-01f,2.70837069e-01f,7.45777905e-01f,9.17120814e-01f,9.73538578e-01f,9.91606772e-01f,9.97343302e-01f,9.99159634e-01f,9.99734223e-01f,9.99915957e-01f,9.99973416e-01f},
  {-3.99985313e-01f,5.63609414e-02f,7.54965365e-01f,3.75752151e-01f,-4.90260571e-01f,-7.11082935e-01f,2.40265876e-01f,7.33813822e-01f,9.13088918e-01f,9.72238123e-01f,9.91192937e-01f,9.97212172e-01f,9.99118149e-01f,9.99721110e-01f,9.99911785e-01f,9.99972105e-01f},
  {5.55113316e-01f,5.80003142e-01f,5.13598442e-01f,2.05897167e-01f,-4.00799006e-01f,-7.49476731e-01f,2.09454417e-01f,7.21617639e-01f,9.08965766e-01f,9.70906913e-01f,9.90769207e-01f,9.97077882e-01f,9.99075651e-01f,9.99707639e-01f,9.99907553e-01f,9.99970794e-01f},
  {9.99843299e-01f,9.25014675e-01f,2.21298173e-01f,2.95478199e-02f,-3.07332784e-01f,-7.85501122e-01f,1.78433523e-01f,7.09193349e-01f,9.04751658e-01f,9.69545007e-01f,9.90335584e-01f,9.96940494e-01f,9.99032140e-01f,9.99693930e-01f,9.99903202e-01f,9.99969363e-01f},
  {5.25321960e-01f,9.85138178e-01f,-9.29481089e-02f,-1.47732988e-01f,-2.10795805e-01f,-8.19042206e-01f,1.47234216e-01f,6.96544766e-01f,9.00447130e-01f,9.68152404e-01f,9.89892066e-01f,9.96799886e-01f,9.98987675e-01f,9.99679863e-01f,9.99898732e-01f,9.99967992e-01f},
  {-4.32177931e-01f,7.41858006e-01f,-3.97976756e-01f,-3.20354372e-01f,-1.12152621e-01f,-8.49993885e-01f,1.15887694e-01f,6.83675885e-01f,8.96052480e-01f,9.66729224e-01f,9.89438653e-01f,9.96656179e-01f,9.98942196e-01f,9.99665439e-01f,9.99894202e-01f,9.99966562e-01f},
  {-9.92335498e-01f,2.70098448e-01f,-6.63538277e-01f,-4.82871950e-01f,-1.23883775e-02f,-8.78258407e-01f,8.44252855e-02f,6.70590878e-01f,8.91568303e-01f,9.65275466e-01f,9.88975346e-01f,9.96509314e-01f,9.98895705e-01f,9.99650776e-01f,9.99889553e-01f,9.99965072e-01f},
  {-6.40144348e-01f,-2.84846604e-01f,-8.63296509e-01f,-6.30159974e-01f,8.74991715e-02f,-9.03746367e-01f,5.28784581e-02f,6.57293737e-01f,8.86994898e-01f,9.63791192e-01f,9.88502085e-01f,9.96359289e-01f,9.98848200e-01f,9.99635756e-01f,9.99884784e-01f,9.99963582e-01f},
  {3.00592542e-01f,-7.52063990e-01f,-9.77442741e-01f,-7.57573068e-01f,1.86512470e-01f,-9.26377118e-01f,2.12787576e-02f,6.43788815e-01f,8.82332861e-01f,9.62276459e-01f,9.88018990e-01f,9.96206105e-01f,9.98799741e-01f,9.99620378e-01f,9.99879956e-01f,9.99962032e-01f},
  {9.64965999e-01f,-9.87659097e-01f,-9.94656444e-01f,-8.61092687e-01f,2.83662200e-01f,-9.46079254e-01f,-1.03422189e-02f,6.30080283e-01f,8.77582550e-01f,9.60731268e-01f,9.87526000e-01f,9.96049762e-01f,9.98750269e-01f,9.99604762e-01f,9.99875009e-01f,9.99960482e-01f},
  {7.42154181e-01f,-9.19073522e-01f,-9.13230121e-01f,-9.37454224e-01f,3.77977669e-01f,-9.62790370e-01f,-4.19528559e-02f,6.16172493e-01f,8.72744501e-01f,9.59155679e-01f,9.87023175e-01f,9.95890260e-01f,9.98699784e-01f,9.99588788e-01f,9.99869943e-01f,9.99958873e-01f},
  {-1.62990779e-01f,-5.67430019e-01f,-7.41239965e-01f,-9.84248459e-01f,4.68516916e-01f,-9.76457715e-01f,-7.35215396e-02f,6.02069914e-01f,8.67819190e-01f,9.57549810e-01f,9.86510456e-01f,9.95727658e-01f,9.98648286e-01f,9.99572515e-01f,9.99864817e-01f,9.99957263e-01f},
  {-9.18282807e-01f,-4.10281904e-02f,-4.95741814e-01f,-1.00000000e+00f,5.54374516e-01f,-9.87038016e-01f,-1.05016708e-01f,5.87776959e-01f,8.62807095e-01f,9.55913603e-01f,9.85987842e-01f,9.95561838e-01f,9.98595834e-01f,9.99555886e-01f,9.99859571e-01f,9.99955595e-01f},
  {-8.29309821e-01f,4.98009592e-01f,-2.01079622e-01f,-9.84212041e-01f,6.34692967e-01f,-9.94497895e-01f,-1.36406869e-01f,5.73298037e-01f,8.57708693e-01f,9.54247177e-01f,9.85455394e-01f,9.95392919e-01f,9.98542368e-01f,9.99538958e-01f,9.99854207e-01f,9.99953866e-01f},
  {2.21267566e-02f,8.83669317e-01f,1.13521777e-01f,-9.37382519e-01f,7.08669782e-01f,-9.98813629e-01f,-1.67660639e-01f,5.58637917e-01f,8.52524519e-01f,9.52550590e-01f,9.84913111e-01f,9.95220840e-01f,9.98487890e-01f,9.99521732e-01f,9.99848783e-01f,9.99952197e-01f},
  {8.53220105e-01f,9.97174621e-01f,4.16867077e-01f,-8.60988438e-01f,7.75565803e-01f,-9.99971747e-01f,-1.98746875e-01f,5.43801069e-01f,8.47255111e-01f,9.50823903e-01f,9.84360933e-01f,9.95045662e-01f,9.98432398e-01f,9.99504209e-01f,9.99843180e-01f,9.99950409e-01f},
  {8.99866819e-01f,8.03569078e-01f,6.78870201e-01f,-7.57439196e-01f,8.34712923e-01f,-9.97968495e-01f,-2.29634270e-01f,5.28792322e-01f,8.41901004e-01f,9.49067116e-01f,9.83798921e-01f,9.94867265e-01f,9.98375952e-01f,9.99486327e-01f,9.99837577e-01f,9.99948621e-01f},
  {1.19180135e-01f,3.62476677e-01f,8.73550534e-01f,-6.30000710e-01f,8.85519624e-01f,-9.92810190e-01f,-2.60292053e-01f,5.13616323e-01f,8.36462677e-01f,9.47280347e-01f,9.83227074e-01f,9.94685769e-01f,9.98318493e-01f,9.99468148e-01f,9.99831796e-01f,9.99946833e-01f},
  {-7.71080196e-01f,-1.90249100e-01f,9.81602073e-01f,-4.82692331e-01f,9.27478492e-01f,-9.84513164e-01f,-2.90689558e-01f,4.98277903e-01f,8.30940723e-01f,9.45463598e-01f,9.82645452e-01f,9.94501114e-01f,9.98260021e-01f,9.99449670e-01f,9.99825954e-01f,9.99944985e-01f},
  {-9.52412963e-01f,-6.84381902e-01f,9.92308319e-01f,-3.20159167e-01f,9.60170269e-01f,-9.73103702e-01f,-3.20796400e-01f,4.82782036e-01f,8.25335622e-01f,9.43616986e-01f,9.82053936e-01f,9.94313300e-01f,9.98200536e-01f,9.99430835e-01f,9.99819994e-01f,9.99943078e-01f},
  {-2.58101642e-01f,-9.67739642e-01f,9.04607594e-01f,-1.47529200e-01f,9.83268440e-01f,-9.58617806e-01f,-3.50582451e-01f,4.67133403e-01f,8.19648027e-01f,9.41740453e-01f,9.81452644e-01f,9.94122326e-01f,9.98140097e-01f,9.99411702e-01f,9.99813974e-01f,9.99941170e-01f},
  {6.73507154e-01f,-9.53050017e-01f,7.27198064e-01f,2.97537707e-02f,9.96542096e-01f,-9.41101313e-01f,-3.80017966e-01f,4.51337039e-01f,8.13878477e-01f,9.39834237e-01f,9.80841517e-01f,9.93928254e-01f,9.98078644e-01f,9.99392271e-01f,9.99807835e-01f,9.99939203e-01f},
  {9.85896587e-01f,-6.44837022e-01f,4.77671444e-01f,2.06098333e-01f,9.99858618e-01f,-9.20609534e-01f,-4.09073502e-01f,4.35397953e-01f,8.08027506e-01f,9.37898219e-01f,9.80220556e-01f,9.93731022e-01f,9.98016179e-01f,9.99372482e-01f,9.99801576e-01f,9.99937236e-01f}
};
__device__ const float ROPE_SN[64][16] = {
  {0.00000000e+00f,0.00000000e+00f,0.00000000e+00f,0.00000000e+00f,0.00000000e+00f,0.00000000e+00f,0.00000000e+00f,0.00000000e+00f,0.00000000e+00f,0.00000000e+00f,0.00000000e+00f,0.00000000e+00f,0.00000000e+00f,0.00000000e+00f,0.00000000e+00f,0.00000000e+00f},
  {8.41470957e-01f,5.33168435e-01f,3.10983598e-01f,1.76892191e-01f,9.98334214e-02f,5.62044978e-02f,3.16175036e-02f,1.77818574e-02f,9.99983307e-03f,5.62338345e-03f,3.16227227e-03f,1.77827850e-03f,9.99999931e-04f,5.62341243e-04f,3.16227757e-04f,1.77827940e-04f},
  {9.09297407e-01f,9.02130723e-01f,5.91127098e-01f,3.48205268e-01f,1.98669329e-01f,1.12231314e-01f,6.32033944e-02f,3.55580896e-02f,1.99986659e-02f,1.12465890e-02f,6.32451288e-03f,3.55655141e-03f,1.99999870e-03f,1.12468237e-03f,6.32455456e-04f,3.55655880e-04f},
  {1.41120002e-01f,9.93253171e-01f,8.12648892e-01f,5.08536100e-01f,2.95520216e-01f,1.67903304e-01f,9.47260857e-02f,5.33230826e-02f,2.99954992e-02f,1.68694388e-02f,9.48669016e-03f,5.33481315e-03f,2.99999560e-03f,1.68702309e-03f,9.48683126e-04f,5.33483806e-04f},
  {-7.56802499e-01f,7.78471708e-01f,9.53580737e-01f,6.52827978e-01f,3.89418334e-01f,2.23044485e-01f,1.26154065e-01f,7.10712075e-02f,3.99893336e-02f,2.24917568e-02f,1.26487734e-02f,7.11305765e-03f,3.99998948e-03f,2.24936334e-03f,1.26491068e-03f,7.11311703e-04f},
  {-9.58924294e-01f,3.23935270e-01f,9.99946535e-01f,7.76529968e-01f,4.79425550e-01f,2.77480543e-01f,1.57455876e-01f,8.87968615e-02f,4.99791652e-02f,2.81133614e-02f,1.58107281e-02f,8.89127981e-03f,4.99997940e-03f,2.81170290e-03f,1.58113812e-03f,8.89139599e-04f},
  {-2.79415488e-01f,-2.30367512e-01f,9.47148204e-01f,8.75740528e-01f,5.64642489e-01f,3.31039310e-01f,1.88600272e-01f,1.06494442e-01f,5.99640049e-02f,3.37340795e-02f,1.89725272e-02f,1.06694745e-02f,5.99996420e-03f,3.37404152e-03f,1.89736532e-03f,1.06696738e-03f},
  {6.56986594e-01f,-7.13721275e-01f,8.00421596e-01f,9.47330713e-01f,6.44217670e-01f,3.83551568e-01f,2.19556093e-01f,1.24158338e-01f,6.99428469e-02f,3.93537246e-02f,2.21341345e-02f,1.24476347e-02f,6.99994294e-03f,3.93637875e-03f,2.21359241e-03f,1.24479528e-03f},
  {9.89358246e-01f,-9.77261782e-01f,5.74317753e-01f,9.89042461e-01f,7.17356086e-01f,4.34851229e-01f,2.50292331e-01f,1.41782969e-01f,7.99146891e-02f,4.49721329e-02f,2.52955221e-02f,1.42257558e-02f,7.99991470e-03f,4.49871505e-03f,2.52981926e-03f,1.42262306e-03f},
  {4.12118495e-01f,-9.39823508e-01f,2.91259229e-01f,9.99560297e-01f,7.83326924e-01f,4.84776139e-01f,2.80778319e-01f,1.59362778e-01f,8.98785442e-02f,5.05891182e-02f,2.84566563e-02f,1.60038304e-02f,8.99987947e-03f,5.06105041e-03f,2.84604589e-03f,1.60045072e-03f},
  {-5.44021130e-01f,-6.12936914e-01f,-2.06835698e-02f,9.78552461e-01f,8.41470957e-01f,5.33168435e-01f,3.10983568e-01f,1.76892191e-01f,9.98334140e-02f,5.62044978e-02f,3.16175036e-02f,1.77818574e-02f,9.99983400e-03f,5.62338345e-03f,3.16227227e-03f,1.77827850e-03f},
  {-9.99990225e-01f,-9.72764567e-02f,-3.30574960e-01f,9.26681578e-01f,8.91207397e-01f,5.79875171e-01f,3.40877861e-01f,1.94365650e-01f,1.09778300e-01f,6.18181042e-02f,3.47780399e-02f,1.95598267e-02f,1.09997792e-02f,6.18571462e-03f,3.47849843e-03f,1.95610616e-03f},
  {-5.36572933e-01f,4.48342979e-01f,-6.07683420e-01f,8.45583618e-01f,9.32039082e-01f,6.24748647e-01f,3.70431304e-01f,2.11777672e-01f,1.19712204e-01f,6.74297586e-02f,3.79382223e-02f,2.13377345e-02f,1.19997123e-02f,6.74804440e-03f,3.79472389e-03f,2.13393359e-03f},
  {4.20167029e-01f,8.55880976e-01f,-8.24528456e-01f,7.37816215e-01f,9.63558197e-01f,6.67647004e-01f,3.99614304e-01f,2.29122713e-01f,1.29634142e-01f,7.30392784e-02f,4.10980321e-02f,2.31155735e-02f,1.29996343e-02f,7.31037185e-03f,4.11094911e-03f,2.31176103e-03f},
  {9.90607381e-01f,9.99823332e-01f,-9.59605396e-01f,6.06778562e-01f,9.85449731e-01f,7.08434701e-01f,4.28397775e-01f,2.46395305e-01f,1.39543116e-01f,7.86464810e-02f,4.42574248e-02f,2.48933397e-02f,1.39995432e-02f,7.87269697e-03f,4.42717411e-03f,2.48958869e-03f},
  {6.50287867e-01f,8.35838437e-01f,-9.99518692e-01f,4.56603259e-01f,9.97494996e-01f,7.46982634e-01f,4.56752867e-01f,2.63589978e-01f,1.49438128e-01f,8.42512026e-02f,4.74163815e-02f,2.66710296e-02f,1.49994381e-02f,8.43502022e-03f,4.74339863e-03f,2.66741589e-03f},
  {-2.87903309e-01f,4.14430231e-01f,-9.40310359e-01f,2.92027086e-01f,9.99573588e-01f,7.83169091e-01f,4.84651238e-01f,2.80701309e-01f,1.59318209e-01f,8.98532644e-02f,5.05748577e-02f,2.84486320e-02f,1.59993190e-02f,8.99733976e-03f,5.05962269e-03f,2.84524332e-03f},
  {-9.61397469e-01f,-1.34615138e-01f,-7.87851870e-01f,1.18240520e-01f,9.91664827e-01f,8.16879570e-01f,5.12064993e-01f,2.97723860e-01f,1.69182345e-01f,9.54524800e-02f,5.37328273e-02f,3.02261449e-02f,1.69991814e-02f,9.55965649e-03f,5.37584582e-03f,3.02307028e-03f},
  {-7.50987232e-01f,-6.42200708e-01f,-5.57262897e-01f,-5.92755191e-02f,9.73847628e-01f,8.48007560e-01f,5.38966715e-01f,3.14652264e-01f,1.79029569e-01f,1.01048686e-01f,5.68902642e-02f,3.20035629e-02f,1.79990288e-02f,1.01219704e-02f,5.69206895e-03f,3.20089748e-03f},
  {1.49877205e-01f,-9.52000856e-01f,-2.71410108e-01f,-2.34921798e-01f,9.46300089e-01f,8.76454532e-01f,5.65329552e-01f,3.31481189e-01f,1.88858896e-01f,1.06641680e-01f,6.00471310e-02f,3.37808803e-02f,1.89988576e-02f,1.06842816e-02f,6.00829115e-03f,3.37872445e-03f},
  {9.12945271e-01f,-9.68601942e-01f,4.13582884e-02f,-4.03158993e-01f,9.09297407e-01f,9.02130723e-01f,5.91127038e-01f,3.48205268e-01f,1.98669314e-01f,1.12231314e-01f,6.32033944e-02f,3.55580896e-02f,1.99986678e-02f,1.12465890e-02f,6.32451288e-03f,3.55655141e-03f},
  {8.36655617e-01f,-6.86891198e-01f,3.50024760e-01f,-5.58680534e-01f,8.63209307e-01f,9.24954832e-01f,6.16333544e-01f,3.64819258e-01f,2.08459899e-01f,1.17817394e-01f,6.63590282e-02f,3.73351872e-02f,2.09984574e-02f,1.18088927e-02f,6.64073415e-03f,3.73437814e-03f},
  {-8.85130931e-03f,-1.93630233e-01f,6.23979926e-01f,-6.96581721e-01f,8.08496356e-01f,9.44854796e-01f,6.40923738e-01f,3.81317884e-01f,2.18229622e-01f,1.23399742e-01f,6.95140064e-02f,3.91121693e-02f,2.19982266e-02f,1.23711927e-02f,6.95695449e-03f,3.91220488e-03f},
  {-8.46220434e-01f,3.59264523e-01f,8.36055279e-01f,-8.12512875e-01f,7.45705247e-01f,9.61767614e-01f,6.64873064e-01f,3.97695929e-01f,2.27977514e-01f,1.28978193e-01f,7.26682767e-02f,4.08890247e-02f,2.29979735e-02f,1.29334899e-02f,7.27317436e-03f,4.09003161e-03f},
  {-9.05578375e-01f,8.01513135e-01f,9.65219259e-01f,-9.02817786e-01f,6.75463140e-01f,9.75639880e-01f,6.88157499e-01f,4.13948208e-01f,2.37702623e-01f,1.34552568e-01f,7.58218244e-02f,4.26657498e-02f,2.39976961e-02f,1.34957815e-02f,7.58939330e-03f,4.26785741e-03f},
  {-1.32351756e-01f,9.96909976e-01f,9.98663187e-01f,-9.64648306e-01f,5.98472118e-01f,9.86427724e-01f,7.10753918e-01f,4.30069596e-01f,2.47403964e-01f,1.40122697e-01f,7.89746121e-02f,4.44423407e-02f,2.49973964e-02f,1.40580693e-02f,7.90561177e-03f,4.44568414e-03f},
  {7.62558460e-01f,8.85276794e-01f,9.33070183e-01f,-9.96054351e-01f,5.15501261e-01f,9.94096994e-01f,7.32639611e-01f,4.46054995e-01f,2.57080555e-01f,1.45688385e-01f,8.21266174e-02f,4.62187938e-02f,2.59970706e-02f,1.46203535e-02f,8.22182931e-03f,4.62350994e-03f},
  {9.56375957e-01f,5.00994205e-01f,7.74945021e-01f,-9.96045172e-01f,4.27379847e-01f,9.98623490e-01f,7.53792703e-01f,4.61899310e-01f,2.66731411e-01f,1.51249468e-01f,8.52777958e-02f,4.79951017e-02f,2.69967206e-02f,1.51826320e-02f,8.53804592e-03f,4.80133574e-03f},
  {2.70905793e-01f,-3.75856608e-02f,5.39968967e-01f,-9.64621305e-01f,3.34988207e-01f,9.99992907e-01f,7.74192095e-01f,4.77597594e-01f,2.76355654e-01f,1.56805754e-01f,8.84281173e-02f,4.97712530e-02f,2.79963426e-02f,1.57449059e-02f,8.85426160e-03f,4.97916201e-03f},
  {-6.63633883e-01f,-5.64589798e-01f,2.51445323e-01f,-9.02773678e-01f,2.39249229e-01f,9.98200953e-01f,7.93817401e-01f,4.93144840e-01f,2.85952210e-01f,1.62357092e-01f,9.15775672e-02f,5.15472479e-02f,2.89959367e-02f,1.63071752e-02f,9.17047635e-03f,5.15698735e-03f},
  {-9.88031626e-01f,-9.17709649e-01f,-6.20148405e-02f,-8.12452853e-01f,1.41120002e-01f,9.93253171e-01f,8.12648892e-01f,5.08536100e-01f,2.95520186e-01f,1.67903304e-01f,9.47260931e-02f,5.33230826e-02f,2.99955010e-02f,1.68694388e-02f,9.48669016e-03f,5.33481315e-03f},
  {-4.04037654e-01f,-9.88192797e-01f,-3.69325012e-01f,-6.96507812e-01f,4.15805206e-02f,9.85165298e-01f,8.30667794e-01f,5.23766637e-01f,3.05058628e-01f,1.73444211e-01f,9.78736654e-02f,5.50987460e-02f,3.09950355e-02f,1.74316969e-02f,9.80290305e-03f,5.51263802e-03f},
  {5.51426709e-01f,-7.54330218e-01f,-6.40009403e-01f,-5.58595300e-01f,-5.83741926e-02f,9.73962843e-01f,8.47856104e-01f,5.38831532e-01f,3.14566553e-01f,1.78979620e-01f,1.01020269e-01f,5.68742342e-02f,3.19945402e-02f,1.79939512e-02f,1.01191159e-02f,5.69046335e-03f},
  {9.99911845e-01f,-2.88147390e-01f,-8.47224355e-01f,-4.03064936e-01f,-1.57745644e-01f,9.59681332e-01f,8.64196658e-01f,5.53726017e-01f,3.24043006e-01f,1.84509367e-01f,1.04165860e-01f,5.86495437e-02f,3.29940096e-02f,1.85561981e-02f,1.04353270e-02f,5.86828869e-03f},
  {5.29082716e-01f,2.66779721e-01f,-9.70420420e-01f,-2.34822124e-01f,-2.55541205e-01f,9.42365825e-01f,8.79673064e-01f,5.68445385e-01f,3.33487093e-01f,1.90033287e-01f,1.07310407e-01f,6.04246669e-02f,3.39934528e-02f,1.91184394e-02f,1.07515370e-02f,6.04611309e-03f},
  {-4.28182662e-01f,7.39542127e-01f,-9.97380435e-01f,-5.91726787e-02f,-3.50783229e-01f,9.22071040e-01f,8.94269884e-01f,5.82984984e-01f,3.42897803e-01f,1.95551202e-01f,1.10453881e-01f,6.21996038e-02f,3.49928550e-02f,1.96806751e-02f,1.10677453e-02f,6.22393796e-03f},
  {-9.91778851e-01f,9.84540582e-01f,-9.25431013e-01f,1.18342586e-01f,-4.42520559e-01f,8.98861170e-01f,9.07972515e-01f,5.97340286e-01f,3.52274209e-01f,2.01062918e-01f,1.13596253e-01f,6.39743358e-02f,3.59922275e-02f,2.02429052e-02f,1.13839535e-02f,6.40176190e-03f},
  {-6.43538117e-01f,9.26318109e-01f,-7.61706948e-01f,2.92125374e-01f,-5.29836178e-01f,8.72809589e-01f,9.20767248e-01f,6.11506701e-01f,3.61615449e-01f,2.06568271e-01f,1.16737492e-01f,6.57488778e-02f,3.69915590e-02f,2.08051261e-02f,1.17001599e-02f,6.57958630e-03f},
  {2.96368569e-01f,5.82806170e-01f,-5.22444785e-01f,4.56694692e-01f,-6.11857831e-01f,8.43998730e-01f,9.32641268e-01f,6.25479698e-01f,3.70920479e-01f,2.12067112e-01f,1.19877554e-01f,6.75232038e-02f,3.79908569e-02f,2.13673431e-02f,1.20163653e-02f,6.75741071e-03f},
  {9.63795364e-01f,5.98003156e-02f,-2.31372014e-01f,6.06860459e-01f,-6.87766254e-01f,8.12519610e-01f,9.43582714e-01f,6.39254928e-01f,3.80188406e-01f,2.17559248e-01f,1.23016424e-01f,6.92973137e-02f,3.89901139e-02f,2.19295528e-02f,1.23325698e-02f,6.93523418e-03f},
  {7.45113134e-01f,-4.81621295e-01f,8.26458037e-02f,7.37885714e-01f,-7.56802499e-01f,7.78471708e-01f,9.53580678e-01f,6.52827978e-01f,3.89418334e-01f,2.23044485e-01f,1.26154065e-01f,7.10712075e-02f,3.99893373e-02f,2.24917568e-02f,1.26487734e-02f,7.11305765e-03f},
  {-1.58622667e-01f,-8.74714017e-01f,3.88467699e-01f,8.45638454e-01f,-8.18277061e-01f,7.41962790e-01f,9.62625206e-01f,6.66194677e-01f,3.98609310e-01f,2.28522688e-01f,1.29290432e-01f,7.28448778e-02f,4.09885161e-02f,2.30539497e-02f,1.29649751e-02f,7.29088066e-03f},
  {-9.16521549e-01f,-9.98410463e-01f,6.55764699e-01f,9.26720202e-01f,-8.71575892e-01f,7.03108132e-01f,9.70707119e-01f,6.79350674e-01f,4.07760441e-01f,2.33993664e-01f,1.32425532e-01f,7.46183172e-02f,4.19876575e-02f,2.36161388e-02f,1.32811759e-02f,7.46870413e-03f},
  {-8.31774771e-01f,-8.14614236e-01f,8.58030677e-01f,9.78573620e-01f,-9.16166008e-01f,6.62030637e-01f,9.77818429e-01f,6.92291796e-01f,4.16870773e-01f,2.39457220e-01f,1.35559291e-01f,7.63915181e-02f,4.29867506e-02f,2.41783205e-02f,1.35973748e-02f,7.64652714e-03f},
  {1.77019257e-02f,-3.79931390e-01f,9.75206196e-01f,9.99563396e-01f,-9.51602101e-01f,6.18860185e-01f,9.83951986e-01f,7.05014050e-01f,4.25939471e-01f,2.44913206e-01f,1.38691694e-01f,7.81644881e-02f,4.39858064e-02f,2.47404929e-02f,1.39135728e-02f,7.82434922e-03f},
  {8.50903511e-01f,1.71763569e-01f,9.95670974e-01f,9.89027262e-01f,-9.77530122e-01f,5.73733270e-01f,9.89101648e-01f,7.17513323e-01f,4.34965521e-01f,2.50361472e-01f,1.41822711e-01f,7.99371973e-02f,4.49848175e-02f,2.53026579e-02f,1.42297689e-02f,8.00217129e-03f},
  {9.01788354e-01f,6.70557022e-01f,9.17395473e-01f,9.47297752e-01f,-9.93690968e-01f,5.26792526e-01f,9.93262351e-01f,7.29785740e-01f,4.43948090e-01f,2.55801797e-01f,1.44952312e-01f,8.17096606e-02f,4.59837839e-02f,2.58648153e-02f,1.45459641e-02f,8.17999430e-03f},
  {1.23573124e-01f,9.62832689e-01f,7.48142362e-01f,8.75690997e-01f,-9.99923289e-01f,4.78186339e-01f,9.96429801e-01f,7.41827428e-01f,4.52886283e-01f,2.61234075e-01f,1.48080453e-01f,8.34818557e-02f,4.69827019e-02f,2.64269635e-02f,1.48621574e-02f,8.35781638e-03f},
  {-7.68254638e-01f,9.58573103e-01f,5.04697084e-01f,7.76465356e-01f,-9.96164620e-01f,4.28068399e-01f,9.98600960e-01f,7.53634512e-01f,4.61779177e-01f,2.66658038e-01f,1.51207119e-01f,8.52537975e-02f,4.79815714e-02f,2.69891042e-02f,1.51783489e-02f,8.53563752e-03f},
  {-9.53752637e-01f,6.59090102e-01f,2.11200655e-01f,6.52750373e-01f,-9.82452571e-01f,3.76597136e-01f,9.99773562e-01f,7.65203178e-01f,4.70625877e-01f,2.72073567e-01f,1.54332280e-01f,8.70254710e-02f,4.89803962e-02f,2.75512375e-02f,1.54945394e-02f,8.71345960e-03f},
  {-2.62374848e-01f,1.56619072e-01f,-1.03240460e-01f,5.08447945e-01f,-9.58924294e-01f,3.23935270e-01f,9.99946535e-01f,7.76529968e-01f,4.79425550e-01f,2.77480543e-01f,1.57455891e-01f,8.87968615e-02f,4.99791689e-02f,2.81133596e-02f,1.58107281e-02f,8.89127981e-03f},
  {6.70229197e-01f,-3.94086063e-01f,-4.07444149e-01f,3.48108500e-01f,-9.25814748e-01f,2.70249337e-01f,9.99119580e-01f,7.87611187e-01f,4.88177240e-01f,2.82878697e-01f,1.60577938e-01f,9.05679762e-02f,5.09778969e-02f,2.86754742e-02f,1.61269177e-02f,9.06910095e-03f},
  {9.86627579e-01f,-8.23421597e-01f,-6.71240151e-01f,1.76790684e-01f,-8.83454502e-01f,2.15709001e-01f,9.97293651e-01f,7.98443377e-01f,4.96880114e-01f,2.88267940e-01f,1.63698375e-01f,9.23388004e-02f,5.19765690e-02f,2.92375814e-02f,1.64431017e-02f,9.24692024e-03f},
  {3.95925164e-01f,-9.99157965e-01f,-8.68469954e-01f,-1.03020677e-04f,-8.32267344e-01f,1.60486728e-01f,9.94470477e-01f,8.09023023e-01f,5.05533338e-01f,2.93648034e-01f,1.66817173e-01f,9.41093415e-02f,5.29751927e-02f,2.97996756e-02f,1.67592876e-02f,9.42474138e-03f},
  {-5.58789074e-01f,-8.67171526e-01f,-9.79574919e-01f,-1.76993474e-01f,-7.72764444e-01f,1.04756832e-01f,9.90652919e-01f,8.19346905e-01f,5.14135957e-01f,2.99018890e-01f,1.69934288e-01f,9.58795771e-02f,5.39737605e-02f,3.03617641e-02f,1.70754679e-02f,9.60256159e-03f},
  {-9.99755144e-01f,-4.68111664e-01f,-9.93535519e-01f,-3.48301649e-01f,-7.05540299e-01f,4.86960001e-02f,9.85844791e-01f,8.29411685e-01f,5.22687256e-01f,3.04380238e-01f,1.73049718e-01f,9.76495072e-02f,5.49722798e-02f,3.09238415e-02f,1.73916500e-02f,9.78038087e-03f},
  {-5.21551013e-01f,7.51182064e-02f,-9.08967435e-01f,-5.08624554e-01f,-6.31266713e-01f,-7.51878507e-03f,9.80050862e-01f,8.39214146e-01f,5.31186223e-01f,3.09731960e-01f,1.76163420e-01f,9.94191393e-02f,5.59707358e-02f,3.14859077e-02f,1.77078284e-02f,9.95820016e-03f},
  {4.36164767e-01f,5.95211506e-01f,-7.34258294e-01f,-6.52905703e-01f,-5.50685287e-01f,-6.37097955e-02f,9.73276973e-01f,8.48751247e-01f,5.39632022e-01f,3.15073937e-01f,1.79275364e-01f,1.01188451e-01f,5.69691435e-02f,3.20479684e-02f,1.80240069e-02f,1.01360194e-02f},
  {9.92872655e-01f,9.31992829e-01f,-4.86733496e-01f,-7.76594579e-01f,-4.64602023e-01f,-1.19699396e-01f,9.65529919e-01f,8.58020008e-01f,5.48023939e-01f,3.20405900e-01f,1.82385504e-01f,1.02957435e-01f,5.79674877e-02f,3.26100141e-02f,1.83401816e-02f,1.03138378e-02f},
  {6.36738002e-01f,9.81735826e-01f,-1.90938011e-01f,-8.75790000e-01f,-3.73876572e-01f,-1.75310582e-01f,9.56817448e-01f,8.67017388e-01f,5.56361020e-01f,3.25727791e-01f,1.85493827e-01f,1.04726106e-01f,5.89657798e-02f,3.31720486e-02f,1.86563563e-02f,1.04916561e-02f},
  {-3.04810613e-01f,7.29123712e-01f,1.23790950e-01f,-9.47363734e-01f,-2.79415488e-01f,-2.30367512e-01f,9.47148204e-01f,8.75740528e-01f,5.64642429e-01f,3.31039310e-01f,1.88600287e-01f,1.06494442e-01f,5.99640086e-02f,3.37340795e-02f,1.89725272e-02f,1.06694745e-02f},
  {-9.66117799e-01f,2.51952261e-01f,4.26245421e-01f,-9.89057720e-01f,-1.82162598e-01f,-2.84696162e-01f,9.36531842e-01f,8.84186864e-01f,5.72867453e-01f,3.36340427e-01f,1.91704854e-01f,1.08262435e-01f,6.09621815e-02f,3.42960916e-02f,1.92886982e-02f,1.08472919e-02f},
  {-7.39180684e-01f,-3.02812874e-01f,6.86427653e-01f,-9.99557257e-01f,-8.30891207e-02f,-3.38124752e-01f,9.24979091e-01f,8.92353535e-01f,5.81035137e-01f,3.41630876e-01f,1.94807529e-01f,1.10030092e-01f,6.19602874e-02f,3.48580964e-02f,1.96048655e-02f,1.10251084e-02f},
  {1.67355701e-01f,-7.64320076e-01f,8.78538549e-01f,-9.78531301e-01f,1.68140903e-02f,-3.90484393e-01f,9.12501454e-01f,9.00238097e-01f,5.89144766e-01f,3.46910536e-01f,1.97908238e-01f,1.11797392e-01f,6.29583374e-02f,3.54200937e-02f,1.99210308e-02f,1.12029258e-02f}
};


constexpr int D = 1024, ML = 16384, MC = 2048, MT = ML + MC, TL = 2048, TCX = 256, NB = 8;
constexpr int LDP_E = 3328, LDP_O = 5120, DFF = 2816, NKK = 2304;
constexpr int NTHR = 512;
constexpr float EPSN = 1e-6f;

struct Params {
  const float *x, *c, *ctx, *c_ctx, *w_ada, *b_ada, *n1g, *n2g, *w_in_even, *qk_gain, *lambda_a, *subln, *w_gate_up, *b_gate_up,
      *onorm_b, *w_out_even, *w_in_odd, *lb_raw, *onorm_c, *w_out_odd, *w_ffn_in, *w_ffn_out;
  float* out;
  bf16_t *wt_in_even, *wt_in_odd, *wt_out_even, *wt_out_odd, *wt_ffn_in, *wt_ffn_out;
  float* Z;
  float* mod;
  bf16_t *P, *R1, *R2, *Vt;
};

extern __shared__ __attribute__((aligned(16))) char smem_raw[];

DI bf16_t f2bf(float x) { unsigned u = __float_as_uint(x); u += 0x7fffu + ((u >> 16) & 1u); return (bf16_t)(u >> 16); }
DI float bf2f(bf16_t h) { return __uint_as_float(((unsigned)h) << 16); }
DI unsigned pack2(float a, float b) { return (unsigned)f2bf(a) | ((unsigned)f2bf(b) << 16); }
DI float wave_sum(float v) {
#pragma unroll
  for (int o = 32; o >= 1; o >>= 1) v += __shfl_xor(v, o, 64);
  return v;
}
DI int TID() { int t = threadIdx.x; asm volatile("" : "+v"(t)); return t; }
DI float siluf(float x) { return x / (1.f + __expf(-x)); }
DI float sigmoidf_(float x) { return 1.f / (1.f + __expf(-x)); }

DI void convert_tile(const float* __restrict__ src, int K, int N, bf16_t* __restrict__ dst, int mode, int tile) {
  float* ts = (float*)smem_raw;
  const int tid = TID();
  const int nkt = K >> 6;
  const int kt = tile % nkt, nt = tile / nkt;
  const int k0 = kt << 6, n0 = nt << 6;
#pragma unroll
  for (int i = 0; i < 2; ++i) {
    const int idx = tid + i * NTHR;
    const int kr = idx >> 4, c4 = idx & 15;
    const int n = n0 + 4 * c4;
    float4 v = make_float4(0.f, 0.f, 0.f, 0.f);
    if (n < N) v = *(const float4*)(src + (size_t)(k0 + kr) * N + n);
    float* t = ts + kr * 65 + 4 * c4;
    t[0] = v.x; t[1] = v.y; t[2] = v.z; t[3] = v.w;
  }
  __syncthreads();
  {
    const int nrow = tid >> 3, kq = tid & 7;
    float f[8];
#pragma unroll
    for (int j = 0; j < 8; ++j) f[j] = ts[(kq * 8 + j) * 65 + nrow];
    int n = n0 + nrow;
    int orow = n;
    if (mode == 1) { const int up = n >= DFF ? 1 : 0; const int j = n - up * DFF; orow = (j >> 7) * 256 + up * 128 + (j & 127); }
    uint4 o;
    o.x = pack2(f[0], f[1]); o.y = pack2(f[2], f[3]); o.z = pack2(f[4], f[5]); o.w = pack2(f[6], f[7]);
    *(uint4*)(dst + (size_t)orow * K + k0 + kq * 8) = o;
  }
  __syncthreads();
}

__device__ void phase_init(const Params& p) {
  const int tid = TID(), nb = gridDim.x, bid = blockIdx.x;
  {
    const float4* xs = (const float4*)p.x; float4* xo = (float4*)p.out;
    const size_t n4 = (size_t)ML * D / 4;
    for (size_t i = (size_t)bid * NTHR + tid; i < n4; i += (size_t)nb * NTHR) xo[i] = xs[i];
    const float4* cs = (const float4*)p.ctx; float4* zo = (float4*)p.Z;
    const size_t m4 = (size_t)MC * D / 4;
    for (size_t i = (size_t)bid * NTHR + tid; i < m4; i += (size_t)nb * NTHR) zo[i] = cs[i];
  }
  {
    const int T0 = 2 * 16 * 52, T1 = T0 + 2 * 16 * 80, T2 = T1 + 2 * 256, T3 = T2 + 2 * 256, T4 = T3 + 4 * 16 * 88, T5 = T4 + 4 * 44 * 16;
    for (int it = bid; it < T5; it += nb) {
      if (it < T0) { const int j = it / 832, t = it % 832; convert_tile(p.w_in_even + (size_t)j * 1024 * 3104, 1024, 3104, p.wt_in_even + (size_t)j * LDP_E * 1024, 0, t); }
      else if (it < T1) { const int q = it - T0; const int j = q / 1280, t = q % 1280; convert_tile(p.w_in_odd + (size_t)j * 1024 * 5120, 1024, 5120, p.wt_in_odd + (size_t)j * 5120 * 1024, 0, t); }
      else if (it < T2) { const int q = it - T1; const int j = q / 256, t = q % 256; convert_tile(p.w_out_even + (size_t)j * 1024 * 1024, 1024, 1024, p.wt_out_even + (size_t)j * 1024 * 1024, 0, t); }
      else if (it < T3) { const int q = it - T2; const int j = q / 256, t = q % 256; convert_tile(p.w_out_odd + (size_t)j * 1024 * 1024, 1024, 1024, p.wt_out_odd + (size_t)j * 1024 * 1024, 0, t); }
      else if (it < T4) { const int q = it - T3; const int j = q / 1408, t = q % 1408; convert_tile(p.w_ffn_in + (size_t)j * 1024 * 5632, 1024, 5632, p.wt_ffn_in + (size_t)j * 5632 * 1024, 1, t); }
      else { const int q = it - T4; const int j = q / 704, t = q % 704; convert_tile(p.w_ffn_out + (size_t)j * DFF * 1024, DFF, 1024, p.wt_ffn_out + (size_t)j * 1024 * DFF, 0, t); }
    }
  }
  {
    float* sc = (float*)smem_raw;
    float* part = sc + 9 * 1024;
    __syncthreads();
    for (int i = tid; i < 9 * 1024; i += NTHR) {
      const int m = i >> 10, k = i & 1023;
      const float v = m < 8 ? p.c[m * 1024 + k] : p.c_ctx[k];
      sc[i] = siluf(v);
    }
    __syncthreads();
    for (int it = bid; it < 4 * 96; it += nb) {
      const int l = it / 96, n0 = (it % 96) * 64;
      const int col4 = tid & 15, ks = tid >> 4;
      float acc[9][4];
#pragma unroll
      for (int m = 0; m < 9; ++m) { acc[m][0] = 0.f; acc[m][1] = 0.f; acc[m][2] = 0.f; acc[m][3] = 0.f; }
      const float* wp = p.w_ada + (size_t)l * 1024 * 6144 + n0 + 4 * col4;
      for (int kk = 0; kk < 32; ++kk) {
        const int k = ks * 32 + kk;
        const float4 w = *(const float4*)(wp + (size_t)k * 6144);
#pragma unroll
        for (int m = 0; m < 9; ++m) { const float s = sc[m * 1024 + k]; acc[m][0] += s * w.x; acc[m][1] += s * w.y; acc[m][2] += s * w.z; acc[m][3] += s * w.w; }
      }
#pragma unroll
      for (int m = 0; m < 9; ++m) {
        float* pp = part + (ks * 9 + m) * 64 + 4 * col4;
        pp[0] = acc[m][0]; pp[1] = acc[m][1]; pp[2] = acc[m][2]; pp[3] = acc[m][3];
      }
      __syncthreads();
      for (int i = tid; i < 9 * 64; i += NTHR) {
        const int m = i >> 6, cc = i & 63;
        float s = p.b_ada[l * 6144 + n0 + cc];
        for (int q = 0; q < 32; ++q) s += part[(q * 9 + m) * 64 + cc];
        p.mod[((size_t)l * 9 + m) * 6144 + n0 + cc] = s;
      }
      __syncthreads();
    }
  }
}

__device__ void phase_norm(const Params& p, int l, int which, int nrows, bf16_t* __restrict__ H) {
  const int wave = TID() >> 6, lane = TID() & 63;
  const float* gain = (which == 0 ? p.n1g : p.n2g) + l * 1024;
  const int sh_idx = which == 0 ? 0 : 3, sc_idx = which == 0 ? 1 : 4;
  for (int row = blockIdx.x * 8 + wave; row < nrows; row += gridDim.x * 8) {
    const float* xr = row < ML ? p.out + (size_t)row * D : p.Z + (size_t)(row - ML) * D;
    const int midx = row < ML ? (row >> 11) : 8;
    const float* md = p.mod + ((size_t)l * 9 + midx) * 6144;
    float4 v[4];
    float ss = 0.f;
#pragma unroll
    for (int i = 0; i < 4; ++i) { v[i] = *(const float4*)(xr + i * 256 + lane * 4); ss += v[i].x * v[i].x + v[i].y * v[i].y + v[i].z * v[i].z + v[i].w * v[i].w; }
    ss = wave_sum(ss);
    const float r = rsqrtf(ss * (1.f / 1024.f) + EPSN);
#pragma unroll
    for (int i = 0; i < 4; ++i) {
      const int col = i * 256 + lane * 4;
      const float4 g = *(const float4*)(gain + col);
      const float4 sh = *(const float4*)(md + sh_idx * 1024 + col);
      const float4 sc = *(const float4*)(md + sc_idx * 1024 + col);
      const float y0 = v[i].x * r * g.x * (1.f + sc.x) + sh.x;
      const float y1 = v[i].y * r * g.y * (1.f + sc.y) + sh.y;
      const float y2 = v[i].z * r * g.z * (1.f + sc.z) + sh.z;
      const float y3 = v[i].w * r * g.w * (1.f + sc.w) + sh.w;
      uint2 o; o.x = pack2(y0, y1); o.y = pack2(y2, y3);
      *(uint2*)(H + (size_t)row * D + col) = o;
    }
  }
}

#define LAS __attribute__((address_space(3)))
constexpr int BM = 256, BK = 64, HALF = 128, HTB = HALF * BK * 2, NXCD = 8, WGM = 8;
DI int lds_byte(int r, int c) { const int st = (r >> 4) * 2 + (c >> 5), rr = r & 15, cc = c & 31, ob = rr * 64 + cc * 2; return st * 1024 + (ob ^ (((ob >> 9) & 1) << 5)); }
DI void stage_rc(int b, int& R, int& C) { const int st = b / 1024, sb = b % 1024, swz = sb ^ (((sb >> 9) & 1) << 5); R = (st >> 1) * 16 + swz / 64; C = (st & 1) * 32 + (swz % 64) / 2; }

struct Unit { int pm, pn; };
struct TileOrder {
  int nM, nN, nwg, G, c;
  DI void init(int M, int N) { nM = M / BM; nN = N / BM; nwg = nM * nN; G = gridDim.x; c = blockIdx.x; }
  DI bool next(int i, Unit& u) const {
    const long L = (long)i * G + c; if (L >= nwg) return false;
    int wgid = (int)L; { const int q = nwg / NXCD, r = nwg % NXCD, xcd = wgid % NXCD, off = wgid / NXCD; wgid = (xcd < r ? xcd * (q + 1) : r * (q + 1) + (xcd - r) * q) + off; }
    const int nig = WGM * nN, gid = wgid / nig, fm = gid * WGM, gsz = (nM - fm) < WGM ? (nM - fm) : WGM;
    u.pm = fm + ((wgid % nig) % gsz); u.pn = (wgid % nig) / gsz; return true;
  }
};

enum { EPI_P = 0, EPI_RES = 1, EPI_SWIGLU = 2 };
struct EpiArgs { bf16_t* outb; int ld; float* xl; float* xz; const float* gate; };

template <int EPI>
DI void gemm_epilogue(const f32x4 (&acc)[2][2][4][2], const Unit& u, int wr, int wc, int fr, int fq, const EpiArgs& ea) {
  const int brow = u.pm * BM, bcol = u.pn * BM;
#pragma unroll
  for (int ai = 0; ai < 2; ++ai)
#pragma unroll
    for (int m = 0; m < 4; ++m) {
      const int row = brow + ai * HALF + wr * 64 + m * 16 + fr;
      if (EPI == EPI_P) {
#pragma unroll
        for (int bj = 0; bj < 2; ++bj)
#pragma unroll
          for (int n = 0; n < 2; ++n) {
            const int col = bcol + bj * HALF + wc * 32 + n * 16 + 4 * fq;
            const f32x4 a = acc[ai][bj][m][n];
            uint2 o; o.x = pack2(a[0], a[1]); o.y = pack2(a[2], a[3]);
            *(uint2*)(ea.outb + (size_t)row * ea.ld + col) = o;
          }
      } else if (EPI == EPI_RES) {
        float* xr = row < ML ? ea.xl + (size_t)row * D : ea.xz + (size_t)(row - ML) * D;
        const int midx = row < ML ? (row >> 11) : 8;
        const float* g = ea.gate + (size_t)midx * 6144;
#pragma unroll
        for (int bj = 0; bj < 2; ++bj)
#pragma unroll
          for (int n = 0; n < 2; ++n) {
            const int col = bcol + bj * HALF + wc * 32 + n * 16 + 4 * fq;
            const f32x4 a = acc[ai][bj][m][n];
            float4 xv = *(float4*)(xr + col);
            const float4 gv = *(const float4*)(g + col);
            xv.x += gv.x * a[0]; xv.y += gv.y * a[1]; xv.z += gv.z * a[2]; xv.w += gv.w * a[3];
            *(float4*)(xr + col) = xv;
          }
      } else {
#pragma unroll
        for (int n = 0; n < 2; ++n) {
          const int col = u.pn * HALF + wc * 32 + n * 16 + 4 * fq;
          const f32x4 g = acc[ai][0][m][n], up = acc[ai][1][m][n];
          uint2 o; o.x = pack2(siluf(g[0]) * up[0], siluf(g[1]) * up[1]); o.y = pack2(siluf(g[2]) * up[2], siluf(g[3]) * up[3]);
          *(uint2*)(ea.outb + (size_t)row * ea.ld + col) = o;
        }
      }
    }
}

template <int EPI>
DI void gemm_phase(const bf16_t* __restrict__ Ag, const bf16_t* __restrict__ Btg, int M, int N, int K, const EpiArgs ea) {
  LAS unsigned char* lds = (LAS unsigned char*)smem_raw;
  TileOrder S; S.init(M, N);
  const int tid = TID(), wid = __builtin_amdgcn_readfirstlane(tid >> 6), lane = tid & 63, wr = wid >> 2, wc = wid & 3, fr = lane & 15, fq = lane >> 4;
  const int nt = K / BK;
  unsigned voffA[2];
#pragma unroll
  for (int i = 0; i < 2; ++i) { int R, C; stage_rc(tid * 16 + i * 8192, R, C); voffA[i] = (unsigned)(R * K + C) * 2u; }
  const size_t kstep = (size_t)(BK * 2);
  const size_t hstep = (size_t)HALF * K * 2;
  const size_t tstep = 2 * hstep;
  const unsigned ldsw = (unsigned)wid * 1024u;
  const int aoff = lds_byte(wr * 64 + fr, fq * 8), boff = lds_byte(wc * 32 + fr, fq * 8);
#define G_SA(b, h) (((b) * 2 + (h)) * HTB)
#define G_SB(b, h) ((4 + (b) * 2 + (h)) * HTB)
#define G_STAGE(bufoff, gbase) do { _Pragma("unroll") for (int _i = 0; _i < 2; ++_i) \
    __builtin_amdgcn_global_load_lds((const unsigned*)((const char*)(gbase) + voffA[_i]), (LAS unsigned*)(lds + (bufoff) + ldsw + _i * 8192), 16, 0, 0); } while (0)
#define G_LDA(dst, b, h) do { _Pragma("unroll") for (int m = 0; m < 4; ++m) _Pragma("unroll") for (int k = 0; k < 2; ++k) dst[m][k] = *(const LAS bf16x8*)(lds + G_SA(b, h) + aoff + m * 2048 + k * 1024); } while (0)
#define G_LDB(dst, b, h) do { _Pragma("unroll") for (int n = 0; n < 2; ++n) _Pragma("unroll") for (int k = 0; k < 2; ++k) dst[n][k] = *(const LAS bf16x8*)(lds + G_SB(b, h) + boff + n * 2048 + k * 1024); } while (0)
#define G_MMA(ai, bj, At_, Bt_) do { __builtin_amdgcn_s_setprio(1); _Pragma("unroll") for (int m = 0; m < 4; ++m) _Pragma("unroll") for (int n = 0; n < 2; ++n) _Pragma("unroll") for (int k = 0; k < 2; ++k) \
    acc[ai][bj][m][n] = __builtin_amdgcn_mfma_f32_16x16x32_bf16(Bt_[n][k], At_[m][k], acc[ai][bj][m][n], 0, 0, 0); __builtin_amdgcn_s_setprio(0); } while (0)
#define G_WAIT_V(n) asm volatile("s_waitcnt vmcnt(" #n ")" ::: "memory")
#define G_WAIT_L(n) asm volatile("s_waitcnt lgkmcnt(" #n ")" ::: "memory")
#define G_BAR __builtin_amdgcn_s_barrier()
#define G_SCHED __builtin_amdgcn_sched_barrier(0)
  Unit cur, nxt; int ui = 0;
  if (S.next(0, cur)) {
    f32x4 acc[2][2][4][2];
#pragma unroll
    for (int a = 0; a < 2; ++a)
#pragma unroll
      for (int b = 0; b < 2; ++b)
#pragma unroll
        for (int m = 0; m < 4; ++m)
#pragma unroll
          for (int n = 0; n < 2; ++n) acc[a][b][m][n] = (f32x4){0.f, 0.f, 0.f, 0.f};
    bf16x8 At[4][2], B0[2][2], B1[2][2];
    const char* cA = (const char*)Ag + (size_t)cur.pm * tstep; const char* cB = (const char*)Btg + (size_t)cur.pn * tstep;
    G_STAGE(G_SB(0, 0), cB); G_STAGE(G_SA(0, 0), cA); G_STAGE(G_SB(0, 1), cB + hstep); G_STAGE(G_SA(0, 1), cA + hstep);
    if (wr == 1) G_BAR;
    G_WAIT_V(4); G_BAR;
    G_STAGE(G_SB(1, 0), cB + kstep); G_STAGE(G_SA(1, 0), cA + kstep); G_STAGE(G_SB(1, 1), cB + hstep + kstep);
    G_WAIT_V(6); G_BAR;
    for (;;) {
      const bool has_next = S.next(ui + 1, nxt);
      const char* nA = has_next ? (const char*)Ag + (size_t)nxt.pm * tstep : cA; const char* nB = has_next ? (const char*)Btg + (size_t)nxt.pn * tstep : cB;
      for (int t = 0; t < nt; t += 2) {
        const bool last = (t == nt - 2);
        const char* a1 = cA + (size_t)(t + 1) * kstep;
        const char* a2 = last ? nA : cA + (size_t)(t + 2) * kstep; const char* b2 = last ? nB : cB + (size_t)(t + 2) * kstep;
        const char* a3 = a2 + kstep; const char* b3 = b2 + kstep;
        G_LDB(B0, 0, 0); G_SCHED; G_LDA(At, 0, 0); G_STAGE(G_SA(1, 1), a1 + hstep);
        G_WAIT_L(8); G_BAR; G_WAIT_L(0); G_MMA(0, 0, At, B0); G_BAR; G_SCHED;
        G_LDB(B1, 0, 1); G_STAGE(G_SB(0, 0), b2);
        G_BAR; G_WAIT_L(0); G_MMA(0, 1, At, B1); G_BAR;
        G_LDA(At, 0, 1); G_STAGE(G_SA(0, 0), a2);
        G_BAR; G_WAIT_L(0); G_MMA(1, 0, At, B0); G_BAR; G_SCHED;
        G_STAGE(G_SB(0, 1), b2 + hstep);
        G_WAIT_V(6); G_BAR; G_MMA(1, 1, At, B1); G_BAR;
        G_LDB(B0, 1, 0); G_SCHED; G_LDA(At, 1, 0); G_STAGE(G_SA(0, 1), a2 + hstep);
        G_WAIT_L(8); G_BAR; G_WAIT_L(0); G_MMA(0, 0, At, B0); G_BAR; G_SCHED;
        G_LDB(B1, 1, 1); G_STAGE(G_SB(1, 0), b3);
        G_BAR; G_WAIT_L(0); G_MMA(0, 1, At, B1); G_BAR;
        G_LDA(At, 1, 1); G_STAGE(G_SA(1, 0), a3);
        G_BAR; G_WAIT_L(0); G_MMA(1, 0, At, B0); G_BAR; G_SCHED;
        G_STAGE(G_SB(1, 1), b3 + hstep);
        G_WAIT_V(6); G_BAR; G_MMA(1, 1, At, B1); G_BAR;
      }
      gemm_epilogue<EPI>(acc, cur, wr, wc, fr, fq, ea);
      if (!has_next) break;
#pragma unroll
      for (int a = 0; a < 2; ++a)
#pragma unroll
        for (int b = 0; b < 2; ++b)
#pragma unroll
          for (int m = 0; m < 4; ++m)
#pragma unroll
            for (int n = 0; n < 2; ++n) acc[a][b][m][n] = (f32x4){0.f, 0.f, 0.f, 0.f};
      cur = nxt; cA = nA; cB = nB; ++ui;
    }
    G_WAIT_V(0);
    if (wr == 0) G_BAR;
    G_BAR;
  }
#undef G_SA
#undef G_SB
#undef G_STAGE
#undef G_LDA
#undef G_LDB
#undef G_MMA
}

__device__ void phase_prep_even(const Params& p, int j) {
  const int wave = TID() >> 6, lane = TID() & 63, tid = TID();
  const float qscale = 0.125f * 1.44269504088896f;
  const float gq = p.qk_gain[j * 128 + lane], gk = p.qk_gain[j * 128 + 64 + lane];
  for (int row = blockIdx.x * 8 + wave; row < MT; row += gridDim.x * 8) {
    bf16_t* pr = p.P + (size_t)row * LDP_E;
    const bool lat = row < ML;
    const int t = row & 2047;
    const int pos = (lane < 32) ? (t >> 6) : (t & 63);
    const float cs = ROPE_CS[pos][lane & 15], sn = ROPE_SN[pos][lane & 15];
    float vals[16];
#pragma unroll
    for (int g = 0; g < 16; ++g) vals[g] = bf2f(pr[g * 64 + lane]);
#pragma unroll
    for (int g = 0; g < 16; ++g) {
      const float v = vals[g];
      const float ss = wave_sum(v * v);
      float y = v * rsqrtf(ss * (1.f / 64.f) + EPSN) * (g < 8 ? gq : gk);
      if (lat) {
        const float o = __shfl_xor(y, 16, 64);
        y = (lane & 16) ? (y * cs + o * sn) : (y * cs - o * sn);
      }
      if (g < 8) y *= qscale;
      pr[g * 64 + lane] = f2bf(y);
    }
  }
  bf16_t* ts = (bf16_t*)smem_raw;
  for (int it = blockIdx.x; it < NB * 4 * 36; it += gridDim.x) {
    const int kb = it % 36, h = (it / 36) & 3, b = it / 144;
    __syncthreads();
    {
      const int r = tid >> 3, ch = tid & 7;
      const int kk = kb * 64 + r;
      const int row = kk < TCX ? ML + b * TCX + kk : b * TL + (kk - TCX);
      const bf16_t* src = p.P + (size_t)row * LDP_E + 1024 + h * 128;
#pragma unroll
      for (int i = 0; i < 2; ++i) {
        const int c8 = (ch + i * 8) * 8;
        const uint4 v = *(const uint4*)(src + c8);
        unsigned* d = (unsigned*)(ts + r * 130 + c8);
        d[0] = v.x; d[1] = v.y; d[2] = v.z; d[3] = v.w;
      }
    }
    __syncthreads();
    {
      const int e = tid >> 2, kq = tid & 3;
      unsigned w[8];
#pragma unroll
      for (int i = 0; i < 8; ++i) {
        const unsigned lo = ts[(kq * 16 + 2 * i) * 130 + e], hi = ts[(kq * 16 + 2 * i + 1) * 130 + e];
        w[i] = lo | (hi << 16);
      }
      bf16_t* dst = p.Vt + ((size_t)(b * 4 + h) * 128 + e) * NKK + kb * 64 + kq * 16;
      *(uint4*)(dst) = make_uint4(w[0], w[1], w[2], w[3]);
      *(uint4*)(dst + 8) = make_uint4(w[4], w[5], w[6], w[7]);
    }
  }
}

__device__ void attn_item(const Params& p, int item) {
  const int tid = TID(), wave = tid >> 6, lane = tid & 63, r = lane & 31, hh = lane >> 5;
  int b, hc, qrow0, krow_ctx, krow_lat, ntile;
  if (item < 512) { b = item >> 6; hc = (item >> 3) & 7; qrow0 = b * TL + (item & 7) * 256; ntile = 36; }
  else { const int i2 = item - 512; b = i2 >> 3; hc = i2 & 7; qrow0 = ML + b * TCX; ntile = 4; }
  krow_ctx = ML + b * TCX; krow_lat = b * TL;
  const int h = hc >> 1, c = hc & 1;
  bf16_t* Ksm = (bf16_t*)smem_raw;
  bf16_t* Vsm = (bf16_t*)(smem_raw + 2 * 9216);
  const int qrow = qrow0 + wave * 32 + r;
  bf16x8 qf[4];
#pragma unroll
  for (int s = 0; s < 4; ++s) qf[s] = *(const bf16x8*)(p.P + (size_t)qrow * LDP_E + hc * 64 + 16 * s + 8 * hh);
  f32x16 oacc[4];
#pragma unroll
  for (int eb = 0; eb < 4; ++eb)
#pragma unroll
    for (int i = 0; i < 16; ++i) oacc[eb][i] = 0.f;
  float mrun = -1e30f, lsum = 0.f;
  const int kkey = tid >> 3, kch = tid & 7;
  const int ve = tid >> 2, vch = tid & 3;
  const bf16_t* vbase = p.Vt + ((size_t)(b * 4 + h) * 128 + ve) * NKK + vch * 16;
  uint4 kreg, vreg0, vreg1;
  auto gload = [&](int t) {
    const int kk = t * 64 + kkey;
    const int row = kk < TCX ? krow_ctx + kk : krow_lat + (kk - TCX);
    kreg = *(const uint4*)(p.P + (size_t)row * LDP_E + 512 + hc * 64 + kch * 8);
    vreg0 = *(const uint4*)(vbase + t * 64);
    vreg1 = *(const uint4*)(vbase + t * 64 + 8);
  };
  auto sstore = [&](int buf) {
    *(uint4*)(Ksm + buf * 4608 + kkey * 72 + kch * 8) = kreg;
    uint2* d = (uint2*)(Vsm + buf * 8704 + ve * 68 + vch * 16);
    d[0] = make_uint2(vreg0.x, vreg0.y); d[1] = make_uint2(vreg0.z, vreg0.w);
    d[2] = make_uint2(vreg1.x, vreg1.y); d[3] = make_uint2(vreg1.z, vreg1.w);
  };
  __syncthreads();
  gload(0); sstore(0);
  __syncthreads();
  for (int t = 0; t < ntile; ++t) {
    const int buf = t & 1;
    if (t + 1 < ntile) gload(t + 1);
    const bf16_t* Kb = Ksm + buf * 4608;
    const bf16_t* Vb = Vsm + buf * 8704;
    f32x16 sacc[2];
#pragma unroll
    for (int kb = 0; kb < 2; ++kb) {
#pragma unroll
      for (int i = 0; i < 16; ++i) sacc[kb][i] = 0.f;
#pragma unroll
      for (int s = 0; s < 4; ++s) {
        const bf16x8 kf = *(const bf16x8*)(Kb + (32 * kb + r) * 72 + 16 * s + 8 * hh);
        sacc[kb] = __builtin_amdgcn_mfma_f32_32x32x16_bf16(kf, qf[s], sacc[kb], 0, 0, 0);
      }
    }
    float mx = sacc[0][0];
#pragma unroll
    for (int kb = 0; kb < 2; ++kb)
#pragma unroll
      for (int i = 0; i < 16; ++i) mx = fmaxf(mx, sacc[kb][i]);
    mx = fmaxf(mx, __shfl_xor(mx, 32, 64));
    const float mnew = fmaxf(mrun, mx);
    const float alpha = exp2f(mrun - mnew);
    mrun = mnew;
    float ps = 0.f;
#pragma unroll
    for (int kb = 0; kb < 2; ++kb)
#pragma unroll
      for (int i = 0; i < 16; ++i) { const float pv = exp2f(sacc[kb][i] - mnew); sacc[kb][i] = pv; ps += pv; }
    lsum = lsum * alpha + ps;
#pragma unroll
    for (int eb = 0; eb < 4; ++eb)
#pragma unroll
      for (int i = 0; i < 16; ++i) oacc[eb][i] *= alpha;
#pragma unroll
    for (int ks = 0; ks < 4; ++ks) {
      const int kb = ks >> 1, s2 = ks & 1;
      bf16x8 pf;
#pragma unroll
      for (int jj = 0; jj < 8; ++jj) pf[jj] = (short)f2bf(sacc[kb][8 * s2 + jj]);
#pragma unroll
      for (int eb = 0; eb < 4; ++eb) {
        const s16x4 lo = *(const s16x4*)(Vb + (32 * eb + r) * 68 + 16 * ks + 4 * hh);
        const s16x4 hi = *(const s16x4*)(Vb + (32 * eb + r) * 68 + 16 * ks + 8 + 4 * hh);
        const bf16x8 vf = __builtin_shufflevector(lo, hi, 0, 1, 2, 3, 4, 5, 6, 7);
        oacc[eb] = __builtin_amdgcn_mfma_f32_32x32x16_bf16(vf, pf, oacc[eb], 0, 0, 0);
      }
    }
    if (t + 1 < ntile) sstore(buf ^ 1);
    __syncthreads();
  }
  lsum += __shfl_xor(lsum, 32, 64);
  const float inv = 1.f / lsum;
  bf16_t* orow = p.R1 + (size_t)qrow * D + c * 512 + h * 128;
#pragma unroll
  for (int eb = 0; eb < 4; ++eb)
#pragma unroll
    for (int g = 0; g < 4; ++g) {
      const int e = 32 * eb + 8 * g + 4 * hh;
      uint2 o; o.x = pack2(oacc[eb][4 * g] * inv, oacc[eb][4 * g + 1] * inv); o.y = pack2(oacc[eb][4 * g + 2] * inv, oacc[eb][4 * g + 3] * inv);
      *(uint2*)(orow + e) = o;
    }
}

template <int MODE>
__device__ void scan_item(const Params& p, int l, int item) {
  constexpr int DK = MODE ? 128 : 64, DVS = MODE ? 64 : 32, DP = NTHR / DVS, DPT = DK / DP, TC = 32;
  constexpr int NH = MODE ? 8 : 4, NSL = 128 / DVS, LDP = MODE ? LDP_O : LDP_E;
  const int j = l >> 1;
  const int sl = item % NSL, dir = (item / NSL) & 1, h = (item / (NSL * 2)) % NH, b = item / (NSL * 2 * NH);
  float* Qs = (float*)smem_raw; float* Ks = Qs + TC * DK; float* Ds = Ks + TC * DK; float* Vs = Ds + TC * DK; float* Os = Vs + TC * DVS; float* LB = Os + TC * DVS;
  const int tid = TID(), dpart = tid % DP, e = tid / DP;
  float S[DPT];
#pragma unroll
  for (int i = 0; i < DPT; ++i) S[i] = 0.f;
  __syncthreads();
  if (MODE == 1) {
    if (tid < 128) {
      const float* lr = p.lb_raw + (size_t)dir * 4 * 1024 + h * 128 + tid;
      const float r0 = lr[0], r1 = lr[1024], r2 = lr[2048], r3 = lr[3072];
      const float mx = fmaxf(fmaxf(r0, r1), fmaxf(r2, r3));
      const float e0 = __expf(r0 - mx), e1 = __expf(r1 - mx), e2 = __expf(r2 - mx), e3 = __expf(r3 - mx);
      const float inv = 1.f / (e0 + e1 + e2 + e3);
      float acc = 0.f;
      if (l >= 1) acc += e1;
      if (l >= 2) acc += e2;
      if (l >= 3) acc += e3;
      LB[tid] = acc * inv;
    }
  }
  bf16_t* Ro;
  int ldo, ocol;
  if (MODE == 0) { Ro = p.R2 + (size_t)dir * MT * 512; ldo = 512; ocol = h * 128 + sl * DVS; }
  else { Ro = dir ? p.R2 : p.R1; ldo = 1024; ocol = h * 128 + sl * DVS; }
  for (int chunk = 0; chunk < NKK / TC; ++chunk) {
    __syncthreads();
    for (int idx = tid; idx < TC * DK; idx += NTHR) {
      const int tt = idx / DK, d = idx % DK;
      const int n = chunk * TC + tt;
      int row;
      if (n < TCX) row = ML + b * TCX + (dir ? (TCX - 1 - n) : n); else row = b * TL + (dir ? (TL - 1 - (n - TCX)) : (n - TCX));
      const bf16_t* pr = p.P + (size_t)row * LDP;
      float q, k, dec;
      if (MODE == 0) {
        q = bf2f(pr[1536 + h * 64 + d]) * 0.125f;
        k = bf2f(pr[1792 + h * 64 + d]);
        const float* w = p.w_gate_up + ((size_t)(j * 2 + dir) * 16) * 256 + h * 64 + d;
        float xg = p.b_gate_up[(j * 2 + dir) * 256 + h * 64 + d];
#pragma unroll
        for (int rr = 0; rr < 16; ++rr) xg += bf2f(pr[3072 + dir * 16 + rr]) * w[rr * 256];
        const float ls = fminf(xg, 0.f) - log1pf(__expf(-fabsf(xg)));
        dec = __expf(ls * (1.f / 16.f));
      } else {
        q = siluf(bf2f(pr[h * 128 + d])) * 0.08838834764831845f;
        const float lbv = LB[d];
        const float f = lbv + (1.f - lbv) * sigmoidf_(bf2f(pr[1024 + dir * 1024 + h * 128 + d]));
        k = 1.f - f; dec = f;
      }
      Qs[idx] = q; Ks[idx] = k; Ds[idx] = dec;
    }
    for (int idx = tid; idx < TC * DVS; idx += NTHR) {
      const int tt = idx / DVS, ee = idx % DVS;
      const int n = chunk * TC + tt;
      int row;
      if (n < TCX) row = ML + b * TCX + (dir ? (TCX - 1 - n) : n); else row = b * TL + (dir ? (TL - 1 - (n - TCX)) : (n - TCX));
      const bf16_t* pr = p.P + (size_t)row * LDP;
      Vs[idx] = bf2f(pr[(MODE ? 3072 : 2048) + h * 128 + sl * DVS + ee]);
    }
    __syncthreads();
    for (int tt = 0; tt < TC; ++tt) {
      const float v = Vs[tt * DVS + e];
      float part = 0.f;
#pragma unroll
      for (int i4 = 0; i4 < DPT / 4; ++i4) {
        const float4 q4 = *(const float4*)(Qs + tt * DK + dpart * DPT + i4 * 4);
        const float4 k4 = *(const float4*)(Ks + tt * DK + dpart * DPT + i4 * 4);
        const float4 d4 = *(const float4*)(Ds + tt * DK + dpart * DPT + i4 * 4);
        S[i4 * 4 + 0] = S[i4 * 4 + 0] * d4.x + k4.x * v; part += q4.x * S[i4 * 4 + 0];
        S[i4 * 4 + 1] = S[i4 * 4 + 1] * d4.y + k4.y * v; part += q4.y * S[i4 * 4 + 1];
        S[i4 * 4 + 2] = S[i4 * 4 + 2] * d4.z + k4.z * v; part += q4.z * S[i4 * 4 + 2];
        S[i4 * 4 + 3] = S[i4 * 4 + 3] * d4.w + k4.w * v; part += q4.w * S[i4 * 4 + 3];
      }
#pragma unroll
      for (int o = DP / 2; o >= 1; o >>= 1) part += __shfl_xor(part, o, 64);
      if (dpart == 0) Os[tt * DVS + e] = part;
    }
    __syncthreads();
    for (int idx = tid; idx < TC * DVS; idx += NTHR) {
      const int tt = idx / DVS, ee = idx % DVS;
      const int n = chunk * TC + tt;
      int row;
      if (n < TCX) row = ML + b * TCX + (dir ? (TCX - 1 - n) : n); else row = b * TL + (dir ? (TL - 1 - (n - TCX)) : (n - TCX));
      Ro[(size_t)row * ldo + ocol + ee] = f2bf(Os[idx]);
    }
  }
}

__device__ void phase_post_even(const Params& p, int l) {
  const int j = l >> 1;
  const int wave = TID() >> 6, lane = TID() & 63;
  const float lambda_init = 0.8f - 0.6f * expf(-0.3f * (float)l);
  const float* la = p.lambda_a + j * 256;
  const float s1 = wave_sum(la[lane] * la[64 + lane]);
  const float s2 = wave_sum(la[128 + lane] * la[192 + lane]);
  const float lam = expf(s1) - expf(s2) + lambda_init;
  const float ga0 = p.subln[j * 128 + 2 * lane] * (1.f - lambda_init), ga1 = p.subln[j * 128 + 2 * lane + 1] * (1.f - lambda_init);
  const float gb0 = p.onorm_b[j * 128 + 2 * lane], gb1 = p.onorm_b[j * 128 + 2 * lane + 1];
  for (int row = blockIdx.x * 8 + wave; row < MT; row += gridDim.x * 8) {
    bf16_t* r1 = p.R1 + (size_t)row * D;
    const bf16_t* r2f = p.R2 + (size_t)row * 512;
    const bf16_t* r2b = p.R2 + (size_t)MT * 512 + (size_t)row * 512;
    const bf16_t* pg = p.P + (size_t)row * LDP_E + 2560;
    unsigned a1[4], a2[4], bf_[4], bb_[4], gg[4];
#pragma unroll
    for (int h = 0; h < 4; ++h) {
      a1[h] = *(const unsigned*)(r1 + h * 128 + 2 * lane);
      a2[h] = *(const unsigned*)(r1 + 512 + h * 128 + 2 * lane);
      bf_[h] = *(const unsigned*)(r2f + h * 128 + 2 * lane);
      bb_[h] = *(const unsigned*)(r2b + h * 128 + 2 * lane);
      gg[h] = *(const unsigned*)(pg + h * 128 + 2 * lane);
    }
    unsigned oa[4], ob[4];
#pragma unroll
    for (int h = 0; h < 4; ++h) {
      const float x0 = bf2f((bf16_t)(a1[h] & 0xffff)) - lam * bf2f((bf16_t)(a2[h] & 0xffff));
      const float x1 = bf2f((bf16_t)(a1[h] >> 16)) - lam * bf2f((bf16_t)(a2[h] >> 16));
      const float ra = rsqrtf(wave_sum(x0 * x0 + x1 * x1) * (1.f / 128.f) + EPSN);
      oa[h] = pack2(x0 * ra * ga0, x1 * ra * ga1);
      const float y0 = bf2f((bf16_t)(bf_[h] & 0xffff)) + bf2f((bf16_t)(bb_[h] & 0xffff));
      const float y1 = bf2f((bf16_t)(bf_[h] >> 16)) + bf2f((bf16_t)(bb_[h] >> 16));
      const float rb = rsqrtf(wave_sum(y0 * y0 + y1 * y1) * (1.f / 128.f) + EPSN);
      const float g0 = bf2f((bf16_t)(gg[h] & 0xffff)), g1 = bf2f((bf16_t)(gg[h] >> 16));
      ob[h] = pack2(y0 * rb * gb0 * siluf(g0), y1 * rb * gb1 * siluf(g1));
    }
#pragma unroll
    for (int h = 0; h < 4; ++h) {
      *(unsigned*)(r1 + h * 128 + 2 * lane) = oa[h];
      *(unsigned*)(r1 + 512 + h * 128 + 2 * lane) = ob[h];
    }
  }
}

__device__ void phase_post_odd(const Params& p, int l) {
  const int j = l >> 1;
  const int wave = TID() >> 6, lane = TID() & 63;
  const float g0 = p.onorm_c[j * 128 + 2 * lane], g1 = p.onorm_c[j * 128 + 2 * lane + 1];
  for (int row = blockIdx.x * 8 + wave; row < MT; row += gridDim.x * 8) {
    bf16_t* r1 = p.R1 + (size_t)row * D;
    const bf16_t* r2 = p.R2 + (size_t)row * D;
    const bf16_t* pg = p.P + (size_t)row * LDP_O + 4096;
    unsigned a[8], bq[8], gg[8];
#pragma unroll
    for (int h = 0; h < 8; ++h) {
      a[h] = *(const unsigned*)(r1 + h * 128 + 2 * lane);
      bq[h] = *(const unsigned*)(r2 + h * 128 + 2 * lane);
      gg[h] = *(const unsigned*)(pg + h * 128 + 2 * lane);
    }
    unsigned o[8];
#pragma unroll
    for (int h = 0; h < 8; ++h) {
      const float y0 = bf2f((bf16_t)(a[h] & 0xffff)) + bf2f((bf16_t)(bq[h] & 0xffff));
      const float y1 = bf2f((bf16_t)(a[h] >> 16)) + bf2f((bf16_t)(bq[h] >> 16));
      const float rb = rsqrtf(wave_sum(y0 * y0 + y1 * y1) * (1.f / 128.f) + EPSN);
      const float q0 = bf2f((bf16_t)(gg[h] & 0xffff)), q1 = bf2f((bf16_t)(gg[h] >> 16));
      o[h] = pack2(y0 * rb * g0 * siluf(q0), y1 * rb * g1 * siluf(q1));
    }
#pragma unroll
    for (int h = 0; h < 8; ++h) *(unsigned*)(r1 + h * 128 + 2 * lane) = o[h];
  }
}

constexpr int NPHASE = 1 + 4 * 9;
#ifndef GEMM_INL
#define GEMM_INL
#endif
__device__ GEMM_INL void gemm_call_p(const bf16_t* A, const bf16_t* Bt, int M, int N, int K, EpiArgs ea) { gemm_phase<EPI_P>(A, Bt, M, N, K, ea); }
__device__ GEMM_INL void gemm_call_res(const bf16_t* A, const bf16_t* Bt, int M, int N, int K, EpiArgs ea) { gemm_phase<EPI_RES>(A, Bt, M, N, K, ea); }
__device__ GEMM_INL void gemm_call_sw(const bf16_t* A, const bf16_t* Bt, int M, int N, int K, EpiArgs ea) { gemm_phase<EPI_SWIGLU>(A, Bt, M, N, K, ea); }

__device__ void run_phase(const Params& p, int ph) {
  if (ph == 0) { phase_init(p); return; }
  const int l = (ph - 1) / 9, s = (ph - 1) % 9, j = l >> 1;
  const bool even = (l & 1) == 0;
  const int mrows = l < 3 ? MT : ML;
  const float* modl = p.mod + (size_t)l * 9 * 6144;
  if (s == 1 || s == 5 || s == 8) {
    if (s == 1) {
      EpiArgs ea{p.P, even ? LDP_E : LDP_O, nullptr, nullptr, nullptr};
      const bf16_t* Bt = even ? p.wt_in_even + (size_t)j * LDP_E * 1024 : p.wt_in_odd + (size_t)j * LDP_O * 1024;
      gemm_call_p(p.R1, Bt, MT, even ? LDP_E : LDP_O, 1024, ea);
    } else {
      EpiArgs ea{nullptr, 0, p.out, p.Z, modl + (s == 5 ? 2 : 5) * 1024};
      const bf16_t* A = s == 5 ? p.R1 : p.P;
      const bf16_t* Bt = s == 5 ? (even ? p.wt_out_even : p.wt_out_odd) + (size_t)j * 1024 * 1024 : p.wt_ffn_out + (size_t)l * 1024 * DFF;
      gemm_call_res(A, Bt, mrows, 1024, s == 5 ? 1024 : DFF, ea);
    }
    return;
  }
  switch (s) {
    case 0: phase_norm(p, l, 0, MT, p.R1); break;
    case 2: if (even) phase_prep_even(p, j); break;
    case 3: {
      if (even) {
        for (int it = blockIdx.x; it < 256 + 576; it += gridDim.x) { if (it < 256) scan_item<0>(p, l, it); else attn_item(p, it - 256); }
      } else {
        for (int it = blockIdx.x; it < 256; it += gridDim.x) scan_item<1>(p, l, it);
      }
    } break;
    case 4: if (even) phase_post_even(p, l); else phase_post_odd(p, l); break;
    case 6: phase_norm(p, l, 1, mrows, p.R2); break;
    case 7: {
      EpiArgs ea{p.P, DFF, nullptr, nullptr, nullptr};
      gemm_call_sw(p.R2, p.wt_ffn_in + (size_t)l * 5632 * 1024, mrows, 5632, 1024, ea);
    } break;
  }
}

__global__ void __launch_bounds__(NTHR, 2) mega_kernel(Params p, int ph0, int ph1) {
  cg::grid_group grid = cg::this_grid();
  for (int ph = ph0; ph < ph1; ++ph) {
    run_phase(p, ph);
    if (ph + 1 < ph1) grid.sync();
  }
}

extern "C" void kernel_launch(void* const* d_in, const int* in_sizes, int n_in, void* d_out, int out_size, void* d_ws, size_t ws_size, hipStream_t stream) {
  constexpr size_t kDynLds = 131072;
  static int grid_blocks = 0;
  if (!grid_blocks) {
    hipFuncSetAttribute((const void*)mega_kernel, hipFuncAttributeMaxDynamicSharedMemorySize, (int)kDynLds);
    int dev = 0, cus = 0, per_cu = 0;
    hipGetDevice(&dev);
    hipDeviceGetAttribute(&cus, hipDeviceAttributeMultiprocessorCount, dev);
    hipOccupancyMaxActiveBlocksPerMultiprocessor(&per_cu, mega_kernel, NTHR, kDynLds);
    if (per_cu < 1) per_cu = 1;
    grid_blocks = cus * per_cu;
  }
  Params p{};
  const float* const* in = (const float* const*)d_in;
  p.x = in[0]; p.c = in[1]; p.ctx = in[2]; p.c_ctx = in[3]; p.w_ada = in[4]; p.b_ada = in[5]; p.n1g = in[6]; p.n2g = in[7];
  p.w_in_even = in[8]; p.qk_gain = in[9]; p.lambda_a = in[10]; p.subln = in[11]; p.w_gate_up = in[12]; p.b_gate_up = in[13];
  p.onorm_b = in[14]; p.w_out_even = in[15]; p.w_in_odd = in[16]; p.lb_raw = in[17]; p.onorm_c = in[18]; p.w_out_odd = in[19];
  p.w_ffn_in = in[20]; p.w_ffn_out = in[21];
  p.out = (float*)d_out;
  char* w = (char*)d_ws;
  size_t off = 0;
  auto take = [&](size_t bytes) { char* r = w + off; off += (bytes + 255) & ~(size_t)255; return r; };
  p.wt_in_even = (bf16_t*)take((size_t)2 * LDP_E * 1024 * 2);
  p.wt_in_odd = (bf16_t*)take((size_t)2 * LDP_O * 1024 * 2);
  p.wt_out_even = (bf16_t*)take((size_t)2 * 1024 * 1024 * 2);
  p.wt_out_odd = (bf16_t*)take((size_t)2 * 1024 * 1024 * 2);
  p.wt_ffn_in = (bf16_t*)take((size_t)4 * 5632 * 1024 * 2);
  p.wt_ffn_out = (bf16_t*)take((size_t)4 * 1024 * DFF * 2);
  p.Z = (float*)take((size_t)MC * D * 4);
  p.mod = (float*)take((size_t)4 * 9 * 6144 * 4);
  p.P = (bf16_t*)take((size_t)MT * LDP_O * 2);
  p.R1 = (bf16_t*)take((size_t)MT * D * 2);
  p.R2 = (bf16_t*)take((size_t)MT * D * 2);
  p.Vt = p.P + (size_t)MT * LDP_E;
  if (off > ws_size) { fprintf(stderr, "workspace too small: need %zu have %zu\n", off, ws_size); return; }
#if ONE_LAUNCH
  int ph0 = 0, ph1 = NPHASE;
  void* args[] = {&p, &ph0, &ph1};
  hipError_t e = hipLaunchCooperativeKernel((const void*)mega_kernel, dim3(grid_blocks), dim3(NTHR), args, kDynLds, stream);
  if (e != hipSuccess) fprintf(stderr, "cooperative launch failed: %s (grid %d)\n", hipGetErrorString(e), grid_blocks);
#else
  for (int ph = 0; ph < NPHASE; ++ph) {
    const int l = (ph - 1) / 9, s = (ph - 1) % 9;
    if (ph > 0 && s == 2 && (l & 1)) continue;
    mega_kernel<<<grid_blocks, NTHR, kDynLds, stream>>>(p, ph, ph + 1);
  }
#endif
}
```

```cpp
#include <hip/hip_runtime.h>
#include <hip/hip_cooperative_groups.h>
#include <cstdio>
namespace cg = cooperative_groups;

#ifndef DYNQ
#define DYNQ 0
#endif
#ifndef EXP1
#define EXP1 0
#endif
#ifndef EXP2
#define EXP2 0
#endif
#ifndef DBL_MASK
#define DBL_MASK 0
#endif
#ifndef ONE_LAUNCH
#define ONE_LAUNCH 1
#endif

typedef unsigned short bf16_t;
typedef short bf16x8 __attribute__((ext_vector_type(8)));
typedef short s16x4 __attribute__((ext_vector_type(4)));
typedef float f32x4 __attribute__((ext_vector_type(4)));
typedef float f32x16 __attribute__((ext_vector_type(16)));
#define DI __device__ __forceinline__

__device__ const float ROPE_CS[64][16] = {
  {1.00000000e+00f,1.00000000e+00f,1.00000000e+00f,1.00000000e+00f,1.00000000e+00f,1.00000000e+00f,1.00000000e+00f,1.00000000e+00f,1.00000000e+00f,1.00000000e+00f,1.00000000e+00f,1.00000000e+00f,1.00000000e+00f,1.00000000e+00f,1.00000000e+00f,1.00000000e+00f},
  {5.40302277e-01f,8.46009135e-01f,9.50415254e-01f,9.84230220e-01f,9.95004177e-01f,9.98419285e-01f,9.99500036e-01f,9.99841869e-01f,9.99949992e-01f,9.99984205e-01f,9.99994993e-01f,9.99998391e-01f,9.99999523e-01f,9.99999821e-01f,9.99999940e-01f,1.00000000e+00f},
  {-4.16146845e-01f,4.31462824e-01f,8.06578398e-01f,9.37418282e-01f,9.80066597e-01f,9.93682086e-01f,9.98000681e-01f,9.99367595e-01f,9.99800026e-01f,9.99936759e-01f,9.99979973e-01f,9.99993682e-01f,9.99997973e-01f,9.99999344e-01f,9.99999821e-01f,9.99999940e-01f},
  {-9.89992499e-01f,-1.15966164e-01f,5.82753658e-01f,8.61040652e-01f,9.55336511e-01f,9.85803485e-01f,9.95503366e-01f,9.98577297e-01f,9.99550045e-01f,9.99857724e-01f,9.99954998e-01f,9.99985754e-01f,9.99995530e-01f,9.99998569e-01f,9.99999523e-01f,9.99999881e-01f},
  {-6.53643608e-01f,-6.27679706e-01f,3.01137477e-01f,7.57506192e-01f,9.21060979e-01f,9.74808276e-01f,9.92010653e-01f,9.97471273e-01f,9.99200106e-01f,9.99747038e-01f,9.99920011e-01f,9.99974728e-01f,9.99992013e-01f,9.99997497e-01f,9.99999225e-01f,9.99999762e-01f},
  {2.83662200e-01f,-9.46079254e-01f,-1.03423381e-02f,6.30080283e-01f,8.77582550e-01f,9.60731268e-01f,9.87526000e-01f,9.96049762e-01f,9.98750269e-01f,9.99604762e-01f,9.99875009e-01f,9.99960482e-01f,9.99987483e-01f,9.99996066e-01f,9.99998748e-01f,9.99999583e-01f},
  {9.60170269e-01f,-9.73103702e-01f,-3.20796400e-01f,4.82782036e-01f,8.25335622e-01f,9.43616986e-01f,9.82053936e-01f,9.94313300e-01f,9.98200536e-01f,9.99430835e-01f,9.99819994e-01f,9.99943078e-01f,9.99981999e-01f,9.99994338e-01f,9.99998212e-01f,9.99999404e-01f},
  {7.53902256e-01f,-7.00429797e-01f,-5.99437475e-01f,3.20257008e-01f,7.64842212e-01f,9.23519433e-01f,9.75599885e-01f,9.92262423e-01f,9.97551024e-01f,9.99225318e-01f,9.99755025e-01f,9.99922514e-01f,9.99975502e-01f,9.99992251e-01f,9.99997556e-01f,9.99999225e-01f},
  {-1.45500034e-01f,-2.12036446e-01f,-8.18632424e-01f,1.47631213e-01f,6.96706712e-01f,9.00502324e-01f,9.68170285e-01f,9.89897788e-01f,9.96801734e-01f,9.98988271e-01f,9.99680042e-01f,9.99898791e-01f,9.99967992e-01f,9.99989867e-01f,9.99996781e-01f,9.99998987e-01f},
  {-9.11130250e-01f,3.41660261e-01f,-9.56644177e-01f,-2.96507962e-02f,6.21609926e-01f,8.74638259e-01f,9.59772646e-01f,9.87220109e-01f,9.95952725e-01f,9.98719573e-01f,9.99595046e-01f,9.99871910e-01f,9.99959528e-01f,9.99987185e-01f,9.99995947e-01f,9.99998748e-01f},
  {-8.39071512e-01f,7.90131867e-01f,-9.99786079e-01f,-2.05997631e-01f,5.40302277e-01f,8.46009135e-01f,9.50415313e-01f,9.84230220e-01f,9.95004177e-01f,9.98419285e-01f,9.99500036e-01f,9.99841869e-01f,9.99949992e-01f,9.99984205e-01f,9.99994993e-01f,9.99998391e-01f},
  {4.42569796e-03f,9.95257378e-01f,-9.43779767e-01f,-3.75847399e-01f,4.53596085e-01f,8.14705312e-01f,9.40107584e-01f,9.80929136e-01f,9.93956089e-01f,9.98087406e-01f,9.99395072e-01f,9.99808669e-01f,9.99939501e-01f,9.99980867e-01f,9.99993920e-01f,9.99998093e-01f},
  {8.43853951e-01f,8.93861592e-01f,-7.94179380e-01f,-5.33843040e-01f,3.62357706e-01f,7.80825913e-01f,9.28859890e-01f,9.77317870e-01f,9.92808640e-01f,9.97723997e-01f,9.99280095e-01f,9.99772310e-01f,9.99927998e-01f,9.99977231e-01f,9.99992788e-01f,9.99997735e-01f},
  {9.07446802e-01f,5.17172873e-01f,-5.65820515e-01f,-6.75001681e-01f,2.67498761e-01f,7.44477987e-01f,9.16683376e-01f,9.73397553e-01f,9.91561890e-01f,9.97329056e-01f,9.99155104e-01f,9.99732792e-01f,9.99915481e-01f,9.99973297e-01f,9.99991536e-01f,9.99997318e-01f},
  {1.36737213e-01f,-1.87961515e-02f,-2.81349480e-01f,-7.94870913e-01f,1.69967160e-01f,7.05776393e-01f,9.03590262e-01f,9.69169438e-01f,9.90216017e-01f,9.96902585e-01f,9.99020159e-01f,9.99690115e-01f,9.99902010e-01f,9.99969006e-01f,9.99990225e-01f,9.99996901e-01f},
  {-7.59687901e-01f,-5.48975468e-01f,3.10223512e-02f,-8.89670432e-01f,7.07371980e-02f,6.64843500e-01f,8.89593601e-01f,9.64634836e-01f,9.88771081e-01f,9.96444523e-01f,9.98875201e-01f,9.99644279e-01f,9.99887526e-01f,9.99964416e-01f,9.99988735e-01f,9.99996424e-01f},
  {-9.57659483e-01f,-9.10081089e-01f,3.40318173e-01f,-9.56410050e-01f,-2.91995462e-02f,6.21808827e-01f,8.74707460e-01f,9.59795177e-01f,9.87227261e-01f,9.95954990e-01f,9.98720288e-01f,9.99595284e-01f,9.99872029e-01f,9.99959528e-01f,9.99987185e-01f,9.99995947e-01f},
  {-2.75163352e-01f,-9.90897954e-01f,6.15864813e-01f,-9.92985010e-01f,-1.28844544e-01f,5.76808274e-01f,8.58946681e-01f,9.54652011e-01f,9.85584795e-01f,9.95433986e-01f,9.98555362e-01f,9.99543071e-01f,9.99855518e-01f,9.99954283e-01f,9.99985576e-01f,9.99995410e-01f},
  {6.60316706e-01f,-7.66536534e-01f,8.30336154e-01f,-9.98241663e-01f,-2.27202162e-01f,5.29984176e-01f,8.42327058e-01f,9.49207008e-01f,9.83843684e-01f,9.94881511e-01f,9.98380423e-01f,9.99487758e-01f,9.99837995e-01f,9.99948800e-01f,9.99983788e-01f,9.99994874e-01f},
  {9.88704622e-01f,-3.06095392e-01f,9.62463796e-01f,-9.72014248e-01f,-3.23289543e-01f,4.81484592e-01f,8.24865162e-01f,9.43461835e-01f,9.82004225e-01f,9.94297504e-01f,9.98195529e-01f,9.99429286e-01f,9.99819517e-01f,9.99942899e-01f,9.99981940e-01f,9.99994278e-01f},
  {4.08082068e-01f,2.48616725e-01f,9.99144375e-01f,-9.15129960e-01f,-4.16146845e-01f,4.31462824e-01f,8.06578457e-01f,9.37418282e-01f,9.80066597e-01f,9.93682086e-01f,9.98000681e-01f,9.99367595e-01f,9.99800026e-01f,9.99936759e-01f,9.99979973e-01f,9.99993682e-01f},
  {-5.47729254e-01f,7.26760268e-01f,9.36740458e-01f,-8.29382956e-01f,-5.04846215e-01f,3.80077004e-01f,7.87485182e-01f,9.31078374e-01f,9.78030920e-01f,9.93035257e-01f,9.97795820e-01f,9.99302804e-01f,9.99779522e-01f,9.99930263e-01f,9.99977946e-01f,9.99993026e-01f},
  {-9.99960840e-01f,9.81074572e-01f,7.81440377e-01f,-7.17477441e-01f,-5.88501155e-01f,3.27489585e-01f,7.67604589e-01f,9.24443960e-01f,9.75897431e-01f,9.92357016e-01f,9.97581005e-01f,9.99234855e-01f,9.99758005e-01f,9.99923468e-01f,9.99975801e-01f,9.99992371e-01f},
  {-5.32833040e-01f,9.33235765e-01f,5.48645258e-01f,-5.82943261e-01f,-6.66275978e-01f,2.73866832e-01f,7.46956408e-01f,9.17517304e-01f,9.73666370e-01f,9.91647422e-01f,9.97356176e-01f,9.99163687e-01f,9.99735534e-01f,9.99916375e-01f,9.99973536e-01f,9.99991655e-01f},
  {4.24179018e-01f,5.97977161e-01f,2.61441678e-01f,-4.30023283e-01f,-7.37393796e-01f,2.19378278e-01f,7.25561321e-01f,9.10300434e-01f,9.71337974e-01f,9.90906477e-01f,9.97121394e-01f,9.99089420e-01f,9.99711990e-01f,9.99908924e-01f,9.99971211e-01f,9.99990880e-01f},
  {9.91202831e-01f,7.85522610e-02f,-5.16893305e-02f,-2.63540596e-01f,-8.01143587e-01f,1.64196163e-01f,7.03440726e-01f,9.02795732e-01f,9.68912423e-01f,9.90134120e-01f,9.96876657e-01f,9.99011934e-01f,9.99687493e-01f,9.99901175e-01f,9.99968767e-01f,9.99990106e-01f},
  {6.46919310e-01f,-4.65064496e-01f,-3.59694332e-01f,-8.87455046e-02f,-8.56888831e-01f,1.08494945e-01f,6.80616796e-01f,8.95005584e-01f,9.66389954e-01f,9.89330530e-01f,9.96621907e-01f,9.98931348e-01f,9.99662042e-01f,9.99893129e-01f,9.99966204e-01f,9.99989331e-01f},
  {-2.92138815e-01f,-8.65450621e-01f,-6.32028639e-01f,8.88481140e-02f,-9.04072165e-01f,5.24506159e-02f,6.57112300e-01f,8.86932373e-01f,9.63770926e-01f,9.88495648e-01f,9.96357203e-01f,9.98847544e-01f,9.99635518e-01f,9.99884725e-01f,9.99963522e-01f,9.99988496e-01f},
  {-9.62605894e-01f,-9.99293387e-01f,-8.41684937e-01f,2.63639510e-01f,-9.42222297e-01f,-3.75941908e-03f,6.32950664e-01f,8.78578722e-01f,9.61055458e-01f,9.87629473e-01f,9.96082544e-01f,9.98760641e-01f,9.99608040e-01f,9.99876022e-01f,9.99960780e-01f,9.99987602e-01f},
  {-7.48057544e-01f,-8.25371623e-01f,-9.67871487e-01f,4.30115849e-01f,-9.70958173e-01f,-5.99575676e-02f,6.08156204e-01f,8.69947195e-01f,9.58243906e-01f,9.86732066e-01f,9.95797932e-01f,9.98670578e-01f,9.99579549e-01f,9.99867022e-01f,9.99957979e-01f,9.99986708e-01f},
  {1.54251456e-01f,-3.97251874e-01f,-9.98075247e-01f,5.83026946e-01f,-9.89992499e-01f,-1.15966164e-01f,5.82753658e-01f,8.61040652e-01f,9.55336511e-01f,9.85803485e-01f,9.95503366e-01f,9.98577297e-01f,9.99550045e-01f,9.99857724e-01f,9.99954998e-01f,9.99985754e-01f},
  {9.14742351e-01f,1.53215483e-01f,-9.29300308e-01f,7.17549205e-01f,-9.99135137e-01f,-1.71608135e-01f,5.56768358e-01f,8.51861775e-01f,9.52333570e-01f,9.84843671e-01f,9.95198846e-01f,9.98480916e-01f,9.99519527e-01f,9.99848068e-01f,9.99951959e-01f,9.99984801e-01f},
  {8.34223390e-01f,6.56495154e-01f,-7.68367112e-01f,8.29440355e-01f,-9.98294771e-01f,-2.26707578e-01f,5.30226350e-01f,8.42413545e-01f,9.49235439e-01f,9.83852804e-01f,9.94884372e-01f,9.98381376e-01f,9.99488056e-01f,9.99838114e-01f,9.99948800e-01f,9.99983788e-01f},
  {-1.32767474e-02f,9.57586050e-01f,-5.31235278e-01f,9.15171385e-01f,-9.87479806e-01f,-2.81090319e-01f,5.03154159e-01f,8.32698941e-01f,9.46042359e-01f,9.82830763e-01f,9.94559944e-01f,9.98278618e-01f,9.99455571e-01f,9.99827802e-01f,9.99945521e-01f,9.99982774e-01f},
  {-8.48570287e-01f,9.63757515e-01f,-2.41421118e-01f,9.72038329e-01f,-9.66798186e-01f,-3.34584385e-01f,4.75578904e-01f,8.22721004e-01f,9.42754686e-01f,9.81777668e-01f,9.94225562e-01f,9.98172760e-01f,9.99422073e-01f,9.99817252e-01f,9.99942183e-01f,9.99981701e-01f},
  {-9.03692186e-01f,6.73110247e-01f,7.23346695e-02f,9.98247743e-01f,-9.36456680e-01f,-3.87020677e-01f,4.47528064e-01f,8.12482953e-01f,9.39372718e-01f,9.80693519e-01f,9.93881226e-01f,9.98063743e-01f,9.99387562e-01f,9.99806345e-01f,9.99938726e-01f,9.99980628e-01f},
  {-1.27963692e-01f,1.75156534e-01f,3.78916174e-01f,9.92972851e-01f,-8.96758378e-01f,-4.38233554e-01f,4.19029742e-01f,8.01987886e-01f,9.35896814e-01f,9.79578316e-01f,9.93526995e-01f,9.97951567e-01f,9.99352098e-01f,9.99795079e-01f,9.99935210e-01f,9.99979496e-01f},
  {7.65414059e-01f,-3.76742303e-01f,6.47921681e-01f,9.56380010e-01f,-8.48100007e-01f,-4.88060862e-01f,3.90112430e-01f,7.91239262e-01f,9.32327330e-01f,9.78432178e-01f,9.93162811e-01f,9.97836173e-01f,9.99315560e-01f,9.99783576e-01f,9.99931574e-01f,9.99978364e-01f},
  {9.55073655e-01f,-8.12611222e-01f,8.52673113e-01f,8.89623463e-01f,-7.90967762e-01f,-5.36345184e-01f,3.60805035e-01f,7.80240417e-01f,9.28664625e-01f,9.77255106e-01f,9.92788672e-01f,9.97717679e-01f,9.99278069e-01f,9.99771714e-01f,9.99927819e-01f,9.99977171e-01f},
  {2.66642928e-01f,-9.98210371e-01f,9.72865343e-01f,7.94808388e-01f,-7.25932240e-01f,-5.82933903e-01f,3.31136853e-01f,7.68994927e-01f,9.24909055e-01f,9.76047099e-01f,9.92404640e-01f,9.97596025e-01f,9.99239624e-01f,9.99759495e-01f,9.99923944e-01f,9.99975979e-01f},
  {-6.66938066e-01f,-8.76379430e-01f,9.96578991e-01f,6.74925625e-01f,-6.53643608e-01f,-6.27679706e-01f,3.01137596e-01f,7.57506192e-01f,9.21060979e-01f,9.74808276e-01f,9.92010653e-01f,9.97471273e-01f,9.99200106e-01f,9.99747038e-01f,9.99920011e-01f,9.99974728e-01f},
  {-9.87339258e-01f,-4.84639406e-01f,9.21462357e-01f,5.33756077e-01f,-5.74824035e-01f,-6.70441091e-01f,2.70837069e-01f,7.45777905e-01f,9.17120814e-01f,9.73538578e-01f,9.91606772e-01f,9.97343302e-01f,9.99159634e-01f,9.99734223e-01f,9.99915957e-01f,9.99973416e-01f},
  {-3.99985313e-01f,5.63609414e-02f,7.54965365e-01f,3.75752151e-01f,-4.90260571e-01f,-7.11082935e-01f,2.40265876e-01f,7.33813822e-01f,9.13088918e-01f,9.72238123e-01f,9.91192937e-01f,9.97212172e-01f,9.99118149e-01f,9.99721110e-01f,9.99911785e-01f,9.99972105e-01f},
  {5.55113316e-01f,5.80003142e-01f,5.13598442e-01f,2.05897167e-01f,-4.00799006e-01f,-7.49476731e-01f,2.09454417e-01f,7.21617639e-01f,9.08965766e-01f,9.70906913e-01f,9.90769207e-01f,9.97077882e-01f,9.99075651e-01f,9.99707639e-01f,9.99907553e-01f,9.99970794e-01f},
  {9.99843299e-01f,9.25014675e-01f,2.21298173e-01f,2.95478199e-02f,-3.07332784e-01f,-7.85501122e-01f,1.78433523e-01f,7.09193349e-01f,9.04751658e-01f,9.69545007e-01f,9.90335584e-01f,9.96940494e-01f,9.99032140e-01f,9.99693930e-01f,9.99903202e-01f,9.99969363e-01f},
  {5.25321960e-01f,9.85138178e-01f,-9.29481089e-02f,-1.47732988e-01f,-2.10795805e-01f,-8.19042206e-01f,1.47234216e-01f,6.96544766e-01f,9.00447130e-01f,9.68152404e-01f,9.89892066e-01f,9.96799886e-01f,9.98987675e-01f,9.99679863e-01f,9.99898732e-01f,9.99967992e-01f},
  {-4.32177931e-01f,7.41858006e-01f,-3.97976756e-01f,-3.20354372e-01f,-1.12152621e-01f,-8.49993885e-01f,1.15887694e-01f,6.83675885e-01f,8.96052480e-01f,9.66729224e-01f,9.89438653e-01f,9.96656179e-01f,9.98942196e-01f,9.99665439e-01f,9.99894202e-01f,9.99966562e-01f},
  {-9.92335498e-01f,2.70098448e-01f,-6.63538277e-01f,-4.82871950e-01f,-1.23883775e-02f,-8.78258407e-01f,8.44252855e-02f,6.70590878e-01f,8.91568303e-01f,9.65275466e-01f,9.88975346e-01f,9.96509314e-01f,9.98895705e-01f,9.99650776e-01f,9.99889553e-01f,9.99965072e-01f},
  {-6.40144348e-01f,-2.84846604e-01f,-8.63296509e-01f,-6.30159974e-01f,8.74991715e-02f,-9.03746367e-01f,5.28784581e-02f,6.57293737e-01f,8.86994898e-01f,9.63791192e-01f,9.88502085e-01f,9.96359289e-01f,9.98848200e-01f,9.99635756e-01f,9.99884784e-01f,9.99963582e-01f},
  {3.00592542e-01f,-7.52063990e-01f,-9.77442741e-01f,-7.57573068e-01f,1.86512470e-01f,-9.26377118e-01f,2.12787576e-02f,6.43788815e-01f,8.82332861e-01f,9.62276459e-01f,9.88018990e-01f,9.96206105e-01f,9.98799741e-01f,9.99620378e-01f,9.99879956e-01f,9.99962032e-01f},
  {9.64965999e-01f,-9.87659097e-01f,-9.94656444e-01f,-8.61092687e-01f,2.83662200e-01f,-9.46079254e-01f,-1.03422189e-02f,6.30080283e-01f,8.77582550e-01f,9.60731268e-01f,9.87526000e-01f,9.96049762e-01f,9.98750269e-01f,9.99604762e-01f,9.99875009e-01f,9.99960482e-01f},
  {7.42154181e-01f,-9.19073522e-01f,-9.13230121e-01f,-9.37454224e-01f,3.77977669e-01f,-9.62790370e-01f,-4.19528559e-02f,6.16172493e-01f,8.72744501e-01f,9.59155679e-01f,9.87023175e-01f,9.95890260e-01f,9.98699784e-01f,9.99588788e-01f,9.99869943e-01f,9.99958873e-01f},
  {-1.62990779e-01f,-5.67430019e-01f,-7.41239965e-01f,-9.84248459e-01f,4.68516916e-01f,-9.76457715e-01f,-7.35215396e-02f,6.02069914e-01f,8.67819190e-01f,9.57549810e-01f,9.86510456e-01f,9.95727658e-01f,9.98648286e-01f,9.99572515e-01f,9.99864817e-01f,9.99957263e-01f},
  {-9.18282807e-01f,-4.10281904e-02f,-4.95741814e-01f,-1.00000000e+00f,5.54374516e-01f,-9.87038016e-01f,-1.05016708e-01f,5.87776959e-01f,8.62807095e-01f,9.55913603e-01f,9.85987842e-01f,9.95561838e-01f,9.98595834e-01f,9.99555886e-01f,9.99859571e-01f,9.99955595e-01f},
  {-8.29309821e-01f,4.98009592e-01f,-2.01079622e-01f,-9.84212041e-01f,6.34692967e-01f,-9.94497895e-01f,-1.36406869e-01f,5.73298037e-01f,8.57708693e-01f,9.54247177e-01f,9.85455394e-01f,9.95392919e-01f,9.98542368e-01f,9.99538958e-01f,9.99854207e-01f,9.99953866e-01f},
  {2.21267566e-02f,8.83669317e-01f,1.13521777e-01f,-9.37382519e-01f,7.08669782e-01f,-9.98813629e-01f,-1.67660639e-01f,5.58637917e-01f,8.52524519e-01f,9.52550590e-01f,9.84913111e-01f,9.95220840e-01f,9.98487890e-01f,9.99521732e-01f,9.99848783e-01f,9.99952197e-01f},
  {8.53220105e-01f,9.97174621e-01f,4.16867077e-01f,-8.60988438e-01f,7.75565803e-01f,-9.99971747e-01f,-1.98746875e-01f,5.43801069e-01f,8.47255111e-01f,9.50823903e-01f,9.84360933e-01f,9.95045662e-01f,9.98432398e-01f,9.99504209e-01f,9.99843180e-01f,9.99950409e-01f},
  {8.99866819e-01f,8.03569078e-01f,6.78870201e-01f,-7.57439196e-01f,8.34712923e-01f,-9.97968495e-01f,-2.29634270e-01f,5.28792322e-01f,8.41901004e-01f,9.49067116e-01f,9.83798921e-01f,9.94867265e-01f,9.98375952e-01f,9.99486327e-01f,9.99837577e-01f,9.99948621e-01f},
  {1.19180135e-01f,3.62476677e-01f,8.73550534e-01f,-6.30000710e-01f,8.85519624e-01f,-9.92810190e-01f,-2.60292053e-01f,5.13616323e-01f,8.36462677e-01f,9.47280347e-01f,9.83227074e-01f,9.94685769e-01f,9.98318493e-01f,9.99468148e-01f,9.99831796e-01f,9.99946833e-01f},
  {-7.71080196e-01f,-1.90249100e-01f,9.81602073e-01f,-4.82692331e-01f,9.27478492e-01f,-9.84513164e-01f,-2.90689558e-01f,4.98277903e-01f,8.30940723e-01f,9.45463598e-01f,9.82645452e-01f,9.94501114e-01f,9.98260021e-01f,9.99449670e-01f,9.99825954e-01f,9.99944985e-01f},
  {-9.52412963e-01f,-6.84381902e-01f,9.92308319e-01f,-3.20159167e-01f,9.60170269e-01f,-9.73103702e-01f,-3.20796400e-01f,4.82782036e-01f,8.25335622e-01f,9.43616986e-01f,9.82053936e-01f,9.94313300e-01f,9.98200536e-01f,9.99430835e-01f,9.99819994e-01f,9.99943078e-01f},
  {-2.58101642e-01f,-9.67739642e-01f,9.04607594e-01f,-1.47529200e-01f,9.83268440e-01f,-9.58617806e-01f,-3.50582451e-01f,4.67133403e-01f,8.19648027e-01f,9.41740453e-01f,9.81452644e-01f,9.94122326e-01f,9.98140097e-01f,9.99411702e-01f,9.99813974e-01f,9.99941170e-01f},
  {6.73507154e-01f,-9.53050017e-01f,7.27198064e-01f,2.97537707e-02f,9.96542096e-01f,-9.41101313e-01f,-3.80017966e-01f,4.51337039e-01f,8.13878477e-01f,9.39834237e-01f,9.80841517e-01f,9.93928254e-01f,9.98078644e-01f,9.99392271e-01f,9.99807835e-01f,9.99939203e-01f},
  {9.85896587e-01f,-6.44837022e-01f,4.77671444e-01f,2.06098333e-01f,9.99858618e-01f,-9.20609534e-01f,-4.09073502e-01f,4.35397953e-01f,8.08027506e-01f,9.37898219e-01f,9.80220556e-01f,9.93731022e-01f,9.98016179e-01f,9.99372482e-01f,9.99801576e-01f,9.99937236e-01f}
};
__device__ const float ROPE_SN[64][16] = {
  {0.00000000e+00f,0.00000000e+00f,0.00000000e+00f,0.00000000e+00f,0.00000000e+00f,0.00000000e+00f,0.00000000e+00f,0.00000000e+00f,0.00000000e+00f,0.00000000e+00f,0.00000000e+00f,0.00000000e+00f,0.00000000e+00f,0.00000000e+00f,0.00000000e+00f,0.00000000e+00f},
  {8.41470957e-01f,5.33168435e-01f,3.10983598e-01f,1.76892191e-01f,9.98334214e-02f,5.62044978e-02f,3.16175036e-02f,1.77818574e-02f,9.99983307e-03f,5.62338345e-03f,3.16227227e-03f,1.77827850e-03f,9.99999931e-04f,5.62341243e-04f,3.16227757e-04f,1.77827940e-04f},
  {9.09297407e-01f,9.02130723e-01f,5.91127098e-01f,3.48205268e-01f,1.98669329e-01f,1.12231314e-01f,6.32033944e-02f,3.55580896e-02f,1.99986659e-02f,1.12465890e-02f,6.32451288e-03f,3.55655141e-03f,1.99999870e-03f,1.12468237e-03f,6.32455456e-04f,3.55655880e-04f},
  {1.41120002e-01f,9.93253171e-01f,8.12648892e-01f,5.08536100e-01f,2.95520216e-01f,1.67903304e-01f,9.47260857e-02f,5.33230826e-02f,2.99954992e-02f,1.68694388e-02f,9.48669016e-03f,5.33481315e-03f,2.99999560e-03f,1.68702309e-03f,9.48683126e-04f,5.33483806e-04f},
  {-7.56802499e-01f,7.78471708e-01f,9.53580737e-01f,6.52827978e-01f,3.89418334e-01f,2.23044485e-01f,1.26154065e-01f,7.10712075e-02f,3.99893336e-02f,2.24917568e-02f,1.26487734e-02f,7.11305765e-03f,3.99998948e-03f,2.24936334e-03f,1.26491068e-03f,7.11311703e-04f},
  {-9.58924294e-01f,3.23935270e-01f,9.99946535e-01f,7.76529968e-01f,4.79425550e-01f,2.77480543e-01f,1.57455876e-01f,8.87968615e-02f,4.99791652e-02f,2.81133614e-02f,1.58107281e-02f,8.89127981e-03f,4.99997940e-03f,2.81170290e-03f,1.58113812e-03f,8.89139599e-04f},
  {-2.79415488e-01f,-2.30367512e-01f,9.47148204e-01f,8.75740528e-01f,5.64642489e-01f,3.31039310e-01f,1.88600272e-01f,1.06494442e-01f,5.99640049e-02f,3.37340795e-02f,1.89725272e-02f,1.06694745e-02f,5.99996420e-03f,3.37404152e-03f,1.89736532e-03f,1.06696738e-03f},
  {6.56986594e-01f,-7.13721275e-01f,8.00421596e-01f,9.47330713e-01f,6.44217670e-01f,3.83551568e-01f,2.19556093e-01f,1.24158338e-01f,6.99428469e-02f,3.93537246e-02f,2.21341345e-02f,1.24476347e-02f,6.99994294e-03f,3.93637875e-03f,2.21359241e-03f,1.24479528e-03f},
  {9.89358246e-01f,-9.77261782e-01f,5.74317753e-01f,9.89042461e-01f,7.17356086e-01f,4.34851229e-01f,2.50292331e-01f,1.41782969e-01f,7.99146891e-02f,4.49721329e-02f,2.52955221e-02f,1.42257558e-02f,7.99991470e-03f,4.49871505e-03f,2.52981926e-03f,1.42262306e-03f},
  {4.12118495e-01f,-9.39823508e-01f,2.91259229e-01f,9.99560297e-01f,7.83326924e-01f,4.84776139e-01f,2.80778319e-01f,1.59362778e-01f,8.98785442e-02f,5.05891182e-02f,2.84566563e-02f,1.60038304e-02f,8.99987947e-03f,5.06105041e-03f,2.84604589e-03f,1.60045072e-03f},
  {-5.44021130e-01f,-6.12936914e-01f,-2.06835698e-02f,9.78552461e-01f,8.41470957e-01f,5.33168435e-01f,3.10983568e-01f,1.76892191e-01f,9.98334140e-02f,5.62044978e-02f,3.16175036e-02f,1.77818574e-02f,9.99983400e-03f,5.62338345e-03f,3.16227227e-03f,1.77827850e-03f},
  {-9.99990225e-01f,-9.72764567e-02f,-3.30574960e-01f,9.26681578e-01f,8.91207397e-01f,5.79875171e-01f,3.40877861e-01f,1.94365650e-01f,1.09778300e-01f,6.18181042e-02f,3.47780399e-02f,1.95598267e-02f,1.09997792e-02f,6.18571462e-03f,3.47849843e-03f,1.95610616e-03f},
  {-5.36572933e-01f,4.48342979e-01f,-6.07683420e-01f,8.45583618e-01f,9.32039082e-01f,6.24748647e-01f,3.70431304e-01f,2.11777672e-01f,1.19712204e-01f,6.74297586e-02f,3.79382223e-02f,2.13377345e-02f,1.19997123e-02f,6.74804440e-03f,3.79472389e-03f,2.13393359e-03f},
  {4.20167029e-01f,8.55880976e-01f,-8.24528456e-01f,7.37816215e-01f,9.63558197e-01f,6.67647004e-01f,3.99614304e-01f,2.29122713e-01f,1.29634142e-01f,7.30392784e-02f,4.10980321e-02f,2.31155735e-02f,1.29996343e-02f,7.31037185e-03f,4.11094911e-03f,2.31176103e-03f},
  {9.90607381e-01f,9.99823332e-01f,-9.59605396e-01f,6.06778562e-01f,9.85449731e-01f,7.08434701e-01f,4.28397775e-01f,2.46395305e-01f,1.39543116e-01f,7.86464810e-02f,4.42574248e-02f,2.48933397e-02f,1.39995432e-02f,7.87269697e-03f,4.42717411e-03f,2.48958869e-03f},
  {6.50287867e-01f,8.35838437e-01f,-9.99518692e-01f,4.56603259e-01f,9.97494996e-01f,7.46982634e-01f,4.56752867e-01f,2.63589978e-01f,1.49438128e-01f,8.42512026e-02f,4.74163815e-02f,2.66710296e-02f,1.49994381e-02f,8.43502022e-03f,4.74339863e-03f,2.66741589e-03f},
  {-2.87903309e-01f,4.14430231e-01f,-9.40310359e-01f,2.92027086e-01f,9.99573588e-01f,7.83169091e-01f,4.84651238e-01f,2.80701309e-01f,1.59318209e-01f,8.98532644e-02f,5.05748577e-02f,2.84486320e-02f,1.59993190e-02f,8.99733976e-03f,5.05962269e-03f,2.84524332e-03f},
  {-9.61397469e-01f,-1.34615138e-01f,-7.87851870e-01f,1.18240520e-01f,9.91664827e-01f,8.16879570e-01f,5.12064993e-01f,2.97723860e-01f,1.69182345e-01f,9.54524800e-02f,5.37328273e-02f,3.02261449e-02f,1.69991814e-02f,9.55965649e-03f,5.37584582e-03f,3.02307028e-03f},
  {-7.50987232e-01f,-6.42200708e-01f,-5.57262897e-01f,-5.92755191e-02f,9.73847628e-01f,8.48007560e-01f,5.38966715e-01f,3.14652264e-01f,1.79029569e-01f,1.01048686e-01f,5.68902642e-02f,3.20035629e-02f,1.79990288e-02f,1.01219704e-02f,5.69206895e-03f,3.20089748e-03f},
  {1.49877205e-01f,-9.52000856e-01f,-2.71410108e-01f,-2.34921798e-01f,9.46300089e-01f,8.76454532e-01f,5.65329552e-01f,3.31481189e-01f,1.88858896e-01f,1.06641680e-01f,6.00471310e-02f,3.37808803e-02f,1.89988576e-02f,1.06842816e-02f,6.00829115e-03f,3.37872445e-03f},
  {9.12945271e-01f,-9.68601942e-01f,4.13582884e-02f,-4.03158993e-01f,9.09297407e-01f,9.02130723e-01f,5.91127038e-01f,3.48205268e-01f,1.98669314e-01f,1.12231314e-01f,6.32033944e-02f,3.55580896e-02f,1.99986678e-02f,1.12465890e-02f,6.32451288e-03f,3.55655141e-03f},
  {8.36655617e-01f,-6.86891198e-01f,3.50024760e-01f,-5.58680534e-01f,8.63209307e-01f,9.24954832e-01f,6.16333544e-01f,3.64819258e-01f,2.08459899e-01f,1.17817394e-01f,6.63590282e-02f,3.73351872e-02f,2.09984574e-02f,1.18088927e-02f,6.64073415e-03f,3.73437814e-03f},
  {-8.85130931e-03f,-1.93630233e-01f,6.23979926e-01f,-6.96581721e-01f,8.08496356e-01f,9.44854796e-01f,6.40923738e-01f,3.81317884e-01f,2.18229622e-01f,1.23399742e-01f,6.95140064e-02f,3.91121693e-02f,2.19982266e-02f,1.23711927e-02f,6.95695449e-03f,3.91220488e-03f},
  {-8.46220434e-01f,3.59264523e-01f,8.36055279e-01f,-8.12512875e-01f,7.45705247e-01f,9.61767614e-01f,6.64873064e-01f,3.97695929e-01f,2.27977514e-01f,1.28978193e-01f,7.26682767e-02f,4.08890247e-02f,2.29979735e-02f,1.29334899e-02f,7.27317436e-03f,4.09003161e-03f},
  {-9.05578375e-01f,8.01513135e-01f,9.65219259e-01f,-9.02817786e-01f,6.75463140e-01f,9.75639880e-01f,6.88157499e-01f,4.13948208e-01f,2.37702623e-01f,1.34552568e-01f,7.58218244e-02f,4.26657498e-02f,2.39976961e-02f,1.34957815e-02f,7.58939330e-03f,4.26785741e-03f},
  {-1.32351756e-01f,9.96909976e-01f,9.98663187e-01f,-9.64648306e-01f,5.98472118e-01f,9.86427724e-01f,7.10753918e-01f,4.30069596e-01f,2.47403964e-01f,1.40122697e-01f,7.89746121e-02f,4.44423407e-02f,2.49973964e-02f,1.40580693e-02f,7.90561177e-03f,4.44568414e-03f},
  {7.62558460e-01f,8.85276794e-01f,9.33070183e-01f,-9.96054351e-01f,5.15501261e-01f,9.94096994e-01f,7.32639611e-01f,4.46054995e-01f,2.57080555e-01f,1.45688385e-01f,8.21266174e-02f,4.62187938e-02f,2.59970706e-02f,1.46203535e-02f,8.22182931e-03f,4.62350994e-03f},
  {9.56375957e-01f,5.00994205e-01f,7.74945021e-01f,-9.96045172e-01f,4.27379847e-01f,9.98623490e-01f,7.53792703e-01f,4.61899310e-01f,2.66731411e-01f,1.51249468e-01f,8.52777958e-02f,4.79951017e-02f,2.69967206e-02f,1.51826320e-02f,8.53804592e-03f,4.80133574e-03f},
  {2.70905793e-01f,-3.75856608e-02f,5.39968967e-01f,-9.64621305e-01f,3.34988207e-01f,9.99992907e-01f,7.74192095e-01f,4.77597594e-01f,2.76355654e-01f,1.56805754e-01f,8.84281173e-02f,4.97712530e-02f,2.79963426e-02f,1.57449059e-02f,8.85426160e-03f,4.97916201e-03f},
  {-6.63633883e-01f,-5.64589798e-01f,2.51445323e-01f,-9.02773678e-01f,2.39249229e-01f,9.98200953e-01f,7.93817401e-01f,4.93144840e-01f,2.85952210e-01f,1.62357092e-01f,9.15775672e-02f,5.15472479e-02f,2.89959367e-02f,1.63071752e-02f,9.17047635e-03f,5.15698735e-03f},
  {-9.88031626e-01f,-9.17709649e-01f,-6.20148405e-02f,-8.12452853e-01f,1.41120002e-01f,9.93253171e-01f,8.12648892e-01f,5.08536100e-01f,2.95520186e-01f,1.67903304e-01f,9.47260931e-02f,5.33230826e-02f,2.99955010e-02f,1.68694388e-02f,9.48669016e-03f,5.33481315e-03f},
  {-4.04037654e-01f,-9.88192797e-01f,-3.69325012e-01f,-6.96507812e-01f,4.15805206e-02f,9.85165298e-01f,8.30667794e-01f,5.23766637e-01f,3.05058628e-01f,1.73444211e-01f,9.78736654e-02f,5.50987460e-02f,3.09950355e-02f,1.74316969e-02f,9.80290305e-03f,5.51263802e-03f},
  {5.51426709e-01f,-7.54330218e-01f,-6.40009403e-01f,-5.58595300e-01f,-5.83741926e-02f,9.73962843e-01f,8.47856104e-01f,5.38831532e-01f,3.14566553e-01f,1.78979620e-01f,1.01020269e-01f,5.68742342e-02f,3.19945402e-02f,1.79939512e-02f,1.01191159e-02f,5.69046335e-03f},
  {9.99911845e-01f,-2.88147390e-01f,-8.47224355e-01f,-4.03064936e-01f,-1.57745644e-01f,9.59681332e-01f,8.64196658e-01f,5.53726017e-01f,3.24043006e-01f,1.84509367e-01f,1.04165860e-01f,5.86495437e-02f,3.29940096e-02f,1.85561981e-02f,1.04353270e-02f,5.86828869e-03f},
  {5.29082716e-01f,2.66779721e-01f,-9.70420420e-01f,-2.34822124e-01f,-2.55541205e-01f,9.42365825e-01f,8.79673064e-01f,5.68445385e-01f,3.33487093e-01f,1.90033287e-01f,1.07310407e-01f,6.04246669e-02f,3.39934528e-02f,1.91184394e-02f,1.07515370e-02f,6.04611309e-03f},
  {-4.28182662e-01f,7.39542127e-01f,-9.97380435e-01f,-5.91726787e-02f,-3.50783229e-01f,9.22071040e-01f,8.94269884e-01f,5.82984984e-01f,3.42897803e-01f,1.95551202e-01f,1.10453881e-01f,6.21996038e-02f,3.49928550e-02f,1.96806751e-02f,1.10677453e-02f,6.22393796e-03f},
  {-9.91778851e-01f,9.84540582e-01f,-9.25431013e-01f,1.18342586e-01f,-4.42520559e-01f,8.98861170e-01f,9.07972515e-01f,5.97340286e-01f,3.52274209e-01f,2.01062918e-01f,1.13596253e-01f,6.39743358e-02f,3.59922275e-02f,2.02429052e-02f,1.13839535e-02f,6.40176190e-03f},
  {-6.43538117e-01f,9.26318109e-01f,-7.61706948e-01f,2.92125374e-01f,-5.29836178e-01f,8.72809589e-01f,9.20767248e-01f,6.11506701e-01f,3.61615449e-01f,2.06568271e-01f,1.16737492e-01f,6.57488778e-02f,3.69915590e-02f,2.08051261e-02f,1.17001599e-02f,6.57958630e-03f},
  {2.96368569e-01f,5.82806170e-01f,-5.22444785e-01f,4.56694692e-01f,-6.11857831e-01f,8.43998730e-01f,9.32641268e-01f,6.25479698e-01f,3.70920479e-01f,2.12067112e-01f,1.19877554e-01f,6.75232038e-02f,3.79908569e-02f,2.13673431e-02f,1.20163653e-02f,6.75741071e-03f},
  {9.63795364e-01f,5.98003156e-02f,-2.31372014e-01f,6.06860459e-01f,-6.87766254e-01f,8.12519610e-01f,9.43582714e-01f,6.39254928e-01f,3.80188406e-01f,2.17559248e-01f,1.23016424e-01f,6.92973137e-02f,3.89901139e-02f,2.19295528e-02f,1.23325698e-02f,6.93523418e-03f},
  {7.45113134e-01f,-4.81621295e-01f,8.26458037e-02f,7.37885714e-01f,-7.56802499e-01f,7.78471708e-01f,9.53580678e-01f,6.52827978e-01f,3.89418334e-01f,2.23044485e-01f,1.26154065e-01f,7.10712075e-02f,3.99893373e-02f,2.24917568e-02f,1.26487734e-02f,7.11305765e-03f},
  {-1.58622667e-01f,-8.74714017e-01f,3.88467699e-01f,8.45638454e-01f,-8.18277061e-01f,7.41962790e-01f,9.62625206e-01f,6.66194677e-01f,3.98609310e-01f,2.28522688e-01f,1.29290432e-01f,7.28448778e-02f,4.09885161e-02f,2.30539497e-02f,1.29649751e-02f,7.29088066e-03f},
  {-9.16521549e-01f,-9.98410463e-01f,6.55764699e-01f,9.26720202e-01f,-8.71575892e-01f,7.03108132e-01f,9.70707119e-01f,6.79350674e-01f,4.07760441e-01f,2.33993664e-01f,1.32425532e-01f,7.46183172e-02f,4.19876575e-02f,2.36161388e-02f,1.32811759e-02f,7.46870413e-03f},
  {-8.31774771e-01f,-8.14614236e-01f,8.58030677e-01f,9.78573620e-01f,-9.16166008e-01f,6.62030637e-01f,9.77818429e-01f,6.92291796e-01f,4.16870773e-01f,2.39457220e-01f,1.35559291e-01f,7.63915181e-02f,4.29867506e-02f,2.41783205e-02f,1.35973748e-02f,7.64652714e-03f},
  {1.77019257e-02f,-3.79931390e-01f,9.75206196e-01f,9.99563396e-01f,-9.51602101e-01f,6.18860185e-01f,9.83951986e-01f,7.05014050e-01f,4.25939471e-01f,2.44913206e-01f,1.38691694e-01f,7.81644881e-02f,4.39858064e-02f,2.47404929e-02f,1.39135728e-02f,7.82434922e-03f},
  {8.50903511e-01f,1.71763569e-01f,9.95670974e-01f,9.89027262e-01f,-9.77530122e-01f,5.73733270e-01f,9.89101648e-01f,7.17513323e-01f,4.34965521e-01f,2.50361472e-01f,1.41822711e-01f,7.99371973e-02f,4.49848175e-02f,2.53026579e-02f,1.42297689e-02f,8.00217129e-03f},
  {9.01788354e-01f,6.70557022e-01f,9.17395473e-01f,9.47297752e-01f,-9.93690968e-01f,5.26792526e-01f,9.93262351e-01f,7.29785740e-01f,4.43948090e-01f,2.55801797e-01f,1.44952312e-01f,8.17096606e-02f,4.59837839e-02f,2.58648153e-02f,1.45459641e-02f,8.17999430e-03f},
  {1.23573124e-01f,9.62832689e-01f,7.48142362e-01f,8.75690997e-01f,-9.99923289e-01f,4.78186339e-01f,9.96429801e-01f,7.41827428e-01f,4.52886283e-01f,2.61234075e-01f,1.48080453e-01f,8.34818557e-02f,4.69827019e-02f,2.64269635e-02f,1.48621574e-02f,8.35781638e-03f},
  {-7.68254638e-01f,9.58573103e-01f,5.04697084e-01f,7.76465356e-01f,-9.96164620e-01f,4.28068399e-01f,9.98600960e-01f,7.53634512e-01f,4.61779177e-01f,2.66658038e-01f,1.51207119e-01f,8.52537975e-02f,4.79815714e-02f,2.69891042e-02f,1.51783489e-02f,8.53563752e-03f},
  {-9.53752637e-01f,6.59090102e-01f,2.11200655e-01f,6.52750373e-01f,-9.82452571e-01f,3.76597136e-01f,9.99773562e-01f,7.65203178e-01f,4.70625877e-01f,2.72073567e-01f,1.54332280e-01f,8.70254710e-02f,4.89803962e-02f,2.75512375e-02f,1.54945394e-02f,8.71345960e-03f},
  {-2.62374848e-01f,1.56619072e-01f,-1.03240460e-01f,5.08447945e-01f,-9.58924294e-01f,3.23935270e-01f,9.99946535e-01f,7.76529968e-01f,4.79425550e-01f,2.77480543e-01f,1.57455891e-01f,8.87968615e-02f,4.99791689e-02f,2.81133596e-02f,1.58107281e-02f,8.89127981e-03f},
  {6.70229197e-01f,-3.94086063e-01f,-4.07444149e-01f,3.48108500e-01f,-9.25814748e-01f,2.70249337e-01f,9.99119580e-01f,7.87611187e-01f,4.88177240e-01f,2.82878697e-01f,1.60577938e-01f,9.05679762e-02f,5.09778969e-02f,2.86754742e-02f,1.61269177e-02f,9.06910095e-03f},
  {9.86627579e-01f,-8.23421597e-01f,-6.71240151e-01f,1.76790684e-01f,-8.83454502e-01f,2.15709001e-01f,9.97293651e-01f,7.98443377e-01f,4.96880114e-01f,2.88267940e-01f,1.63698375e-01f,9.23388004e-02f,5.19765690e-02f,2.92375814e-02f,1.64431017e-02f,9.24692024e-03f},
  {3.95925164e-01f,-9.99157965e-01f,-8.68469954e-01f,-1.03020677e-04f,-8.32267344e-01f,1.60486728e-01f,9.94470477e-01f,8.09023023e-01f,5.05533338e-01f,2.93648034e-01f,1.66817173e-01f,9.41093415e-02f,5.29751927e-02f,2.97996756e-02f,1.67592876e-02f,9.42474138e-03f},
  {-5.58789074e-01f,-8.67171526e-01f,-9.79574919e-01f,-1.76993474e-01f,-7.72764444e-01f,1.04756832e-01f,9.90652919e-01f,8.19346905e-01f,5.14135957e-01f,2.99018890e-01f,1.69934288e-01f,9.58795771e-02f,5.39737605e-02f,3.03617641e-02f,1.70754679e-02f,9.60256159e-03f},
  {-9.99755144e-01f,-4.68111664e-01f,-9.93535519e-01f,-3.48301649e-01f,-7.05540299e-01f,4.86960001e-02f,9.85844791e-01f,8.29411685e-01f,5.22687256e-01f,3.04380238e-01f,1.73049718e-01f,9.76495072e-02f,5.49722798e-02f,3.09238415e-02f,1.73916500e-02f,9.78038087e-03f},
  {-5.21551013e-01f,7.51182064e-02f,-9.08967435e-01f,-5.08624554e-01f,-6.31266713e-01f,-7.51878507e-03f,9.80050862e-01f,8.39214146e-01f,5.31186223e-01f,3.09731960e-01f,1.76163420e-01f,9.94191393e-02f,5.59707358e-02f,3.14859077e-02f,1.77078284e-02f,9.95820016e-03f},
  {4.36164767e-01f,5.95211506e-01f,-7.34258294e-01f,-6.52905703e-01f,-5.50685287e-01f,-6.37097955e-02f,9.73276973e-01f,8.48751247e-01f,5.39632022e-01f,3.15073937e-01f,1.79275364e-01f,1.01188451e-01f,5.69691435e-02f,3.20479684e-02f,1.80240069e-02f,1.01360194e-02f},
  {9.92872655e-01f,9.31992829e-01f,-4.86733496e-01f,-7.76594579e-01f,-4.64602023e-01f,-1.19699396e-01f,9.65529919e-01f,8.58020008e-01f,5.48023939e-01f,3.20405900e-01f,1.82385504e-01f,1.02957435e-01f,5.79674877e-02f,3.26100141e-02f,1.83401816e-02f,1.03138378e-02f},
  {6.36738002e-01f,9.81735826e-01f,-1.90938011e-01f,-8.75790000e-01f,-3.73876572e-01f,-1.75310582e-01f,9.56817448e-01f,8.67017388e-01f,5.56361020e-01f,3.25727791e-01f,1.85493827e-01f,1.04726106e-01f,5.89657798e-02f,3.31720486e-02f,1.86563563e-02f,1.04916561e-02f},
  {-3.04810613e-01f,7.29123712e-01f,1.23790950e-01f,-9.47363734e-01f,-2.79415488e-01f,-2.30367512e-01f,9.47148204e-01f,8.75740528e-01f,5.64642429e-01f,3.31039310e-01f,1.88600287e-01f,1.06494442e-01f,5.99640086e-02f,3.37340795e-02f,1.89725272e-02f,1.06694745e-02f},
  {-9.66117799e-01f,2.51952261e-01f,4.26245421e-01f,-9.89057720e-01f,-1.82162598e-01f,-2.84696162e-01f,9.36531842e-01f,8.84186864e-01f,5.72867453e-01f,3.36340427e-01f,1.91704854e-01f,1.08262435e-01f,6.09621815e-02f,3.42960916e-02f,1.92886982e-02f,1.08472919e-02f},
  {-7.39180684e-01f,-3.02812874e-01f,6.86427653e-01f,-9.99557257e-01f,-8.30891207e-02f,-3.38124752e-01f,9.24979091e-01f,8.92353535e-01f,5.81035137e-01f,3.41630876e-01f,1.94807529e-01f,1.10030092e-01f,6.19602874e-02f,3.48580964e-02f,1.96048655e-02f,1.10251084e-02f},
  {1.67355701e-01f,-7.64320076e-01f,8.78538549e-01f,-9.78531301e-01f,1.68140903e-02f,-3.90484393e-01f,9.12501454e-01f,9.00238097e-01f,5.89144766e-01f,3.46910536e-01f,1.97908238e-01f,1.11797392e-01f,6.29583374e-02f,3.54200937e-02f,1.99210308e-02f,1.12029258e-02f}
};


constexpr int D = 1024, ML = 16384, MC = 2048, MT = ML + MC, TL = 2048, TCX = 256, NB = 8;
constexpr int LDP_E = 3328, LDP_O = 5120, DFF = 2816, NKK = 2304;
constexpr int NTHR = 512;
constexpr float EPSN = 1e-6f;

struct Params {
  const float *x, *c, *ctx, *c_ctx, *w_ada, *b_ada, *n1g, *n2g, *w_in_even, *qk_gain, *lambda_a, *subln, *w_gate_up, *b_gate_up,
      *onorm_b, *w_out_even, *w_in_odd, *lb_raw, *onorm_c, *w_out_odd, *w_ffn_in, *w_ffn_out;
  float* out;
  bf16_t *wt_in_even, *wt_in_odd, *wt_out_even, *wt_out_odd, *wt_ffn_in, *wt_ffn_out;
  float* Z;
  float* mod;
  bf16_t *P, *R1, *R2, *Vt;
  float* Gk;
  unsigned* ctr;
};

extern __shared__ __attribute__((aligned(16))) char smem_raw[];

DI bf16_t f2bf(float x) { unsigned u = __float_as_uint(x); u += 0x7fffu + ((u >> 16) & 1u); return (bf16_t)(u >> 16); }
DI float bf2f(bf16_t h) { return __uint_as_float(((unsigned)h) << 16); }
DI unsigned pack2(float a, float b) { return (unsigned)f2bf(a) | ((unsigned)f2bf(b) << 16); }
DI float wave_sum(float v) {
#pragma unroll
  for (int o = 32; o >= 1; o >>= 1) v += __shfl_xor(v, o, 64);
  return v;
}
DI int TID() { int t = threadIdx.x; asm volatile("" : "+v"(t)); return t; }
DI float siluf(float x) { return x / (1.f + __expf(-x)); }
DI float sigmoidf_(float x) { return 1.f / (1.f + __expf(-x)); }

DI void convert_tile(const float* __restrict__ src, int K, int N, bf16_t* __restrict__ dst, int mode, int tile) {
  float* ts = (float*)smem_raw;
  const int tid = TID();
  const int nkt = K >> 6;
  const int kt = tile % nkt, nt = tile / nkt;
  const int k0 = kt << 6, n0 = nt << 6;
#pragma unroll
  for (int i = 0; i < 2; ++i) {
    const int idx = tid + i * NTHR;
    const int kr = idx >> 4, c4 = idx & 15;
    const int n = n0 + 4 * c4;
    float4 v = make_float4(0.f, 0.f, 0.f, 0.f);
    if (n < N) v = *(const float4*)(src + (size_t)(k0 + kr) * N + n);
    float* t = ts + kr * 65 + 4 * c4;
    t[0] = v.x; t[1] = v.y; t[2] = v.z; t[3] = v.w;
  }
  __syncthreads();
  {
    const int nrow = tid >> 3, kq = tid & 7;
    float f[8];
#pragma unroll
    for (int j = 0; j < 8; ++j) f[j] = ts[(kq * 8 + j) * 65 + nrow];
    int n = n0 + nrow;
    int orow = n;
    if (mode == 1) { const int up = n >= DFF ? 1 : 0; const int j = n - up * DFF; orow = (j >> 7) * 256 + up * 128 + (j & 127); }
    uint4 o;
    o.x = pack2(f[0], f[1]); o.y = pack2(f[2], f[3]); o.z = pack2(f[4], f[5]); o.w = pack2(f[6], f[7]);
    *(uint4*)(dst + (size_t)orow * K + k0 + kq * 8) = o;
  }
  __syncthreads();
}

__device__ void phase_init(const Params& p) {
  const int tid = TID(), nb = gridDim.x, bid = blockIdx.x;
  if (bid == 0 && tid < 16) p.ctr[tid] = 0u;
  {
    const float4* xs = (const float4*)p.x; float4* xo = (float4*)p.out;
    const size_t n4 = (size_t)ML * D / 4;
    for (size_t i = (size_t)bid * NTHR + tid; i < n4; i += (size_t)nb * NTHR) xo[i] = xs[i];
    const float4* cs = (const float4*)p.ctx; float4* zo = (float4*)p.Z;
    const size_t m4 = (size_t)MC * D / 4;
    for (size_t i = (size_t)bid * NTHR + tid; i < m4; i += (size_t)nb * NTHR) zo[i] = cs[i];
  }
  {
    const int T0 = 2 * 16 * 52, T1 = T0 + 2 * 16 * 80, T2 = T1 + 2 * 256, T3 = T2 + 2 * 256, T4 = T3 + 4 * 16 * 88, T5 = T4 + 4 * 44 * 16;
    for (int it = bid; it < T5; it += nb) {
      if (it < T0) { const int j = it / 832, t = it % 832; convert_tile(p.w_in_even + (size_t)j * 1024 * 3104, 1024, 3104, p.wt_in_even + (size_t)j * LDP_E * 1024, 0, t); }
      else if (it < T1) { const int q = it - T0; const int j = q / 1280, t = q % 1280; convert_tile(p.w_in_odd + (size_t)j * 1024 * 5120, 1024, 5120, p.wt_in_odd + (size_t)j * 5120 * 1024, 0, t); }
      else if (it < T2) { const int q = it - T1; const int j = q / 256, t = q % 256; convert_tile(p.w_out_even + (size_t)j * 1024 * 1024, 1024, 1024, p.wt_out_even + (size_t)j * 1024 * 1024, 0, t); }
      else if (it < T3) { const int q = it - T2; const int j = q / 256, t = q % 256; convert_tile(p.w_out_odd + (size_t)j * 1024 * 1024, 1024, 1024, p.wt_out_odd + (size_t)j * 1024 * 1024, 0, t); }
      else if (it < T4) { const int q = it - T3; const int j = q / 1408, t = q % 1408; convert_tile(p.w_ffn_in + (size_t)j * 1024 * 5632, 1024, 5632, p.wt_ffn_in + (size_t)j * 5632 * 1024, 1, t); }
      else { const int q = it - T4; const int j = q / 704, t = q % 704; convert_tile(p.w_ffn_out + (size_t)j * DFF * 1024, DFF, 1024, p.wt_ffn_out + (size_t)j * 1024 * DFF, 0, t); }
    }
  }
  {
    float* sc = (float*)smem_raw;
    float* part = sc + 9 * 1024;
    __syncthreads();
    for (int i = tid; i < 9 * 1024; i += NTHR) {
      const int m = i >> 10, k = i & 1023;
      const float v = m < 8 ? p.c[m * 1024 + k] : p.c_ctx[k];
      sc[i] = siluf(v);
    }
    __syncthreads();
    for (int it = bid; it < 4 * 96; it += nb) {
      const int l = it / 96, n0 = (it % 96) * 64;
      const int col4 = tid & 15, ks = tid >> 4;
      float acc[9][4];
#pragma unroll
      for (int m = 0; m < 9; ++m) { acc[m][0] = 0.f; acc[m][1] = 0.f; acc[m][2] = 0.f; acc[m][3] = 0.f; }
      const float* wp = p.w_ada + (size_t)l * 1024 * 6144 + n0 + 4 * col4;
      for (int kk = 0; kk < 32; ++kk) {
        const int k = ks * 32 + kk;
        const float4 w = *(const float4*)(wp + (size_t)k * 6144);
#pragma unroll
        for (int m = 0; m < 9; ++m) { const float s = sc[m * 1024 + k]; acc[m][0] += s * w.x; acc[m][1] += s * w.y; acc[m][2] += s * w.z; acc[m][3] += s * w.w; }
      }
#pragma unroll
      for (int m = 0; m < 9; ++m) {
        float* pp = part + (ks * 9 + m) * 64 + 4 * col4;
        pp[0] = acc[m][0]; pp[1] = acc[m][1]; pp[2] = acc[m][2]; pp[3] = acc[m][3];
      }
      __syncthreads();
      for (int i = tid; i < 9 * 64; i += NTHR) {
        const int m = i >> 6, cc = i & 63;
        float s = p.b_ada[l * 6144 + n0 + cc];
        for (int q = 0; q < 32; ++q) s += part[(q * 9 + m) * 64 + cc];
        p.mod[((size_t)l * 9 + m) * 6144 + n0 + cc] = s;
      }
      __syncthreads();
    }
  }
}

__device__ void phase_norm(const Params& p, int l, int which, int nrows, bf16_t* __restrict__ H) {
  const int wave = TID() >> 6, lane = TID() & 63;
  const float* gain = (which == 0 ? p.n1g : p.n2g) + l * 1024;
  const int sh_idx = which == 0 ? 0 : 3, sc_idx = which == 0 ? 1 : 4;
  for (int row = blockIdx.x * 8 + wave; row < nrows; row += gridDim.x * 8) {
    const float* xr = row < ML ? p.out + (size_t)row * D : p.Z + (size_t)(row - ML) * D;
    const int midx = row < ML ? (row >> 11) : 8;
    const float* md = p.mod + ((size_t)l * 9 + midx) * 6144;
    float4 v[4];
    float ss = 0.f;
#pragma unroll
    for (int i = 0; i < 4; ++i) { v[i] = *(const float4*)(xr + i * 256 + lane * 4); ss += v[i].x * v[i].x + v[i].y * v[i].y + v[i].z * v[i].z + v[i].w * v[i].w; }
    ss = wave_sum(ss);
    const float r = rsqrtf(ss * (1.f / 1024.f) + EPSN);
#pragma unroll
    for (int i = 0; i < 4; ++i) {
      const int col = i * 256 + lane * 4;
      const float4 g = *(const float4*)(gain + col);
      const float4 sh = *(const float4*)(md + sh_idx * 1024 + col);
      const float4 sc = *(const float4*)(md + sc_idx * 1024 + col);
      const float y0 = v[i].x * r * g.x * (1.f + sc.x) + sh.x;
      const float y1 = v[i].y * r * g.y * (1.f + sc.y) + sh.y;
      const float y2 = v[i].z * r * g.z * (1.f + sc.z) + sh.z;
      const float y3 = v[i].w * r * g.w * (1.f + sc.w) + sh.w;
      uint2 o; o.x = pack2(y0, y1); o.y = pack2(y2, y3);
      *(uint2*)(H + (size_t)row * D + col) = o;
    }
  }
}

#define LAS __attribute__((address_space(3)))
constexpr int BM = 256, BK = 64, HALF = 128, HTB = HALF * BK * 2, NXCD = 8, WGM = 8;
DI int lds_byte(int r, int c) { const int st = (r >> 4) * 2 + (c >> 5), rr = r & 15, cc = c & 31, ob = rr * 64 + cc * 2; return st * 1024 + (ob ^ (((ob >> 9) & 1) << 5)); }
DI void stage_rc(int b, int& R, int& C) { const int st = b / 1024, sb = b % 1024, swz = sb ^ (((sb >> 9) & 1) << 5); R = (st >> 1) * 16 + swz / 64; C = (st & 1) * 32 + (swz % 64) / 2; }

struct Unit { int pm, pn; };
struct TileOrder {
  int nM, nN, nwg, G, c;
  DI void init(int M, int N) { nM = M / BM; nN = N / BM; nwg = nM * nN; G = gridDim.x; c = blockIdx.x; }
  DI bool next(int i, Unit& u) const {
    const long L = (long)i * G + c; if (L >= nwg) return false;
    int wgid = (int)L; { const int q = nwg / NXCD, r = nwg % NXCD, xcd = wgid % NXCD, off = wgid / NXCD; wgid = (xcd < r ? xcd * (q + 1) : r * (q + 1) + (xcd - r) * q) + off; }
    const int nig = WGM * nN, gid = wgid / nig, fm = gid * WGM, gsz = (nM - fm) < WGM ? (nM - fm) : WGM;
    u.pm = fm + ((wgid % nig) % gsz); u.pn = (wgid % nig) / gsz; return true;
  }
};

enum { EPI_P = 0, EPI_RES = 1, EPI_SWIGLU = 2 };
struct EpiArgs { bf16_t* outb; int ld; float* xl; float* xz; const float* gate; };

template <int EPI>
DI void gemm_epilogue(const f32x4 (&acc)[2][2][4][2], const Unit& u, int wr, int wc, int fr, int fq, const EpiArgs& ea) {
  const int brow = u.pm * BM, bcol = u.pn * BM;
#pragma unroll
  for (int ai = 0; ai < 2; ++ai)
#pragma unroll
    for (int m = 0; m < 4; ++m) {
      const int row = brow + ai * HALF + wr * 64 + m * 16 + fr;
      if (EPI == EPI_P) {
#pragma unroll
        for (int bj = 0; bj < 2; ++bj)
#pragma unroll
          for (int n = 0; n < 2; ++n) {
            const int col = bcol + bj * HALF + wc * 32 + n * 16 + 4 * fq;
            const f32x4 a = acc[ai][bj][m][n];
            uint2 o; o.x = pack2(a[0], a[1]); o.y = pack2(a[2], a[3]);
            *(uint2*)(ea.outb + (size_t)row * ea.ld + col) = o;
          }
      } else if (EPI == EPI_RES) {
        float* xr = row < ML ? ea.xl + (size_t)row * D : ea.xz + (size_t)(row - ML) * D;
        const int midx = row < ML ? (row >> 11) : 8;
        const float* g = ea.gate + (size_t)midx * 6144;
#pragma unroll
        for (int bj = 0; bj < 2; ++bj)
#pragma unroll
          for (int n = 0; n < 2; ++n) {
            const int col = bcol + bj * HALF + wc * 32 + n * 16 + 4 * fq;
            const f32x4 a = acc[ai][bj][m][n];
            float4 xv = *(float4*)(xr + col);
            const float4 gv = *(const float4*)(g + col);
            xv.x += gv.x * a[0]; xv.y += gv.y * a[1]; xv.z += gv.z * a[2]; xv.w += gv.w * a[3];
            *(float4*)(xr + col) = xv;
          }
      } else {
#pragma unroll
        for (int n = 0; n < 2; ++n) {
          const int col = u.pn * HALF + wc * 32 + n * 16 + 4 * fq;
          const f32x4 g = acc[ai][0][m][n], up = acc[ai][1][m][n];
          uint2 o; o.x = pack2(siluf(g[0]) * up[0], siluf(g[1]) * up[1]); o.y = pack2(siluf(g[2]) * up[2], siluf(g[3]) * up[3]);
          *(uint2*)(ea.outb + (size_t)row * ea.ld + col) = o;
        }
      }
    }
}

template <int EPI>
DI void gemm_phase(const bf16_t* __restrict__ Ag, const bf16_t* __restrict__ Btg, int M, int N, int K, const EpiArgs ea) {
  LAS unsigned char* lds = (LAS unsigned char*)smem_raw;
  TileOrder S; S.init(M, N);
  const int tid = TID(), wid = __builtin_amdgcn_readfirstlane(tid >> 6), lane = tid & 63, wr = wid >> 2, wc = wid & 3, fr = lane & 15, fq = lane >> 4;
  const int nt = K / BK;
  unsigned voffA[2];
#pragma unroll
  for (int i = 0; i < 2; ++i) { int R, C; stage_rc(tid * 16 + i * 8192, R, C); voffA[i] = (unsigned)(R * K + C) * 2u; }
  const size_t kstep = (size_t)(BK * 2);
  const size_t hstep = (size_t)HALF * K * 2;
  const size_t tstep = 2 * hstep;
  const unsigned ldsw = (unsigned)wid * 1024u;
  const int aoff = lds_byte(wr * 64 + fr, fq * 8), boff = lds_byte(wc * 32 + fr, fq * 8);
#define G_SA(b, h) (((b) * 2 + (h)) * HTB)
#define G_SB(b, h) ((4 + (b) * 2 + (h)) * HTB)
#define G_STAGE(bufoff, gbase) do { _Pragma("unroll") for (int _i = 0; _i < 2; ++_i) \
    __builtin_amdgcn_global_load_lds((const unsigned*)((const char*)(gbase) + voffA[_i]), (LAS unsigned*)(lds + (bufoff) + ldsw + _i * 8192), 16, 0, 0); } while (0)
#define G_LDA(dst, b, h) do { _Pragma("unroll") for (int m = 0; m < 4; ++m) _Pragma("unroll") for (int k = 0; k < 2; ++k) dst[m][k] = *(const LAS bf16x8*)(lds + G_SA(b, h) + aoff + m * 2048 + k * 1024); } while (0)
#define G_LDB(dst, b, h) do { _Pragma("unroll") for (int n = 0; n < 2; ++n) _Pragma("unroll") for (int k = 0; k < 2; ++k) dst[n][k] = *(const LAS bf16x8*)(lds + G_SB(b, h) + boff + n * 2048 + k * 1024); } while (0)
#define G_MMA(ai, bj, At_, Bt_) do { __builtin_amdgcn_s_setprio(1); _Pragma("unroll") for (int m = 0; m < 4; ++m) _Pragma("unroll") for (int n = 0; n < 2; ++n) _Pragma("unroll") for (int k = 0; k < 2; ++k) \
    acc[ai][bj][m][n] = __builtin_amdgcn_mfma_f32_16x16x32_bf16(Bt_[n][k], At_[m][k], acc[ai][bj][m][n], 0, 0, 0); __builtin_amdgcn_s_setprio(0); } while (0)
#define G_WAIT_V(n) asm volatile("s_waitcnt vmcnt(" #n ")" ::: "memory")
#define G_WAIT_L(n) asm volatile("s_waitcnt lgkmcnt(" #n ")" ::: "memory")
#define G_BAR __builtin_amdgcn_s_barrier()
#define G_SCHED __builtin_amdgcn_sched_barrier(0)
  Unit cur, nxt; int ui = 0;
  if (S.next(0, cur)) {
    f32x4 acc[2][2][4][2];
#pragma unroll
    for (int a = 0; a < 2; ++a)
#pragma unroll
      for (int b = 0; b < 2; ++b)
#pragma unroll
        for (int m = 0; m < 4; ++m)
#pragma unroll
          for (int n = 0; n < 2; ++n) acc[a][b][m][n] = (f32x4){0.f, 0.f, 0.f, 0.f};
    bf16x8 At[4][2], B0[2][2], B1[2][2];
    const char* cA = (const char*)Ag + (size_t)cur.pm * tstep; const char* cB = (const char*)Btg + (size_t)cur.pn * tstep;
    G_STAGE(G_SB(0, 0), cB); G_STAGE(G_SA(0, 0), cA); G_STAGE(G_SB(0, 1), cB + hstep); G_STAGE(G_SA(0, 1), cA + hstep);
    if (wr == 1) G_BAR;
    G_WAIT_V(4); G_BAR;
    G_STAGE(G_SB(1, 0), cB + kstep); G_STAGE(G_SA(1, 0), cA + kstep); G_STAGE(G_SB(1, 1), cB + hstep + kstep);
    G_WAIT_V(6); G_BAR;
    for (;;) {
      const bool has_next = S.next(ui + 1, nxt);
      const char* nA = has_next ? (const char*)Ag + (size_t)nxt.pm * tstep : cA; const char* nB = has_next ? (const char*)Btg + (size_t)nxt.pn * tstep : cB;
      for (int t = 0; t < nt; t += 2) {
        const bool last = (t == nt - 2);
        const char* a1 = cA + (size_t)(t + 1) * kstep;
        const char* a2 = last ? nA : cA + (size_t)(t + 2) * kstep; const char* b2 = last ? nB : cB + (size_t)(t + 2) * kstep;
        const char* a3 = a2 + kstep; const char* b3 = b2 + kstep;
        G_LDB(B0, 0, 0); G_SCHED; G_LDA(At, 0, 0); G_STAGE(G_SA(1, 1), a1 + hstep);
        G_WAIT_L(8); G_BAR; G_WAIT_L(0); G_MMA(0, 0, At, B0); G_BAR; G_SCHED;
        G_LDB(B1, 0, 1); G_STAGE(G_SB(0, 0), b2);
        G_BAR; G_WAIT_L(0); G_MMA(0, 1, At, B1); G_BAR;
        G_LDA(At, 0, 1); G_STAGE(G_SA(0, 0), a2);
        G_BAR; G_WAIT_L(0); G_MMA(1, 0, At, B0); G_BAR; G_SCHED;
        G_STAGE(G_SB(0, 1), b2 + hstep);
        G_WAIT_V(6); G_BAR; G_MMA(1, 1, At, B1); G_BAR;
        G_LDB(B0, 1, 0); G_SCHED; G_LDA(At, 1, 0); G_STAGE(G_SA(0, 1), a2 + hstep);
        G_WAIT_L(8); G_BAR; G_WAIT_L(0); G_MMA(0, 0, At, B0); G_BAR; G_SCHED;
        G_LDB(B1, 1, 1); G_STAGE(G_SB(1, 0), b3);
        G_BAR; G_WAIT_L(0); G_MMA(0, 1, At, B1); G_BAR;
        G_LDA(At, 1, 1); G_STAGE(G_SA(1, 0), a3);
        G_BAR; G_WAIT_L(0); G_MMA(1, 0, At, B0); G_BAR; G_SCHED;
        G_STAGE(G_SB(1, 1), b3 + hstep);
        G_WAIT_V(6); G_BAR; G_MMA(1, 1, At, B1); G_BAR;
      }
      gemm_epilogue<EPI>(acc, cur, wr, wc, fr, fq, ea);
      if (!has_next) break;
#pragma unroll
      for (int a = 0; a < 2; ++a)
#pragma unroll
        for (int b = 0; b < 2; ++b)
#pragma unroll
          for (int m = 0; m < 4; ++m)
#pragma unroll
            for (int n = 0; n < 2; ++n) acc[a][b][m][n] = (f32x4){0.f, 0.f, 0.f, 0.f};
      cur = nxt; cA = nA; cB = nB; ++ui;
    }
    G_WAIT_V(0);
    if (wr == 0) G_BAR;
    G_BAR;
  }
#undef G_SA
#undef G_SB
#undef G_STAGE
#undef G_LDA
#undef G_LDB
#undef G_MMA
}

__device__ void phase_prep_even(const Params& p, int j) {
  const int wave = TID() >> 6, lane = TID() & 63, tid = TID();
  const float qscale = 0.125f * 1.44269504088896f;
  const float gq = p.qk_gain[j * 128 + lane], gk = p.qk_gain[j * 128 + 64 + lane];
  for (int row = blockIdx.x * 8 + wave; row < MT; row += gridDim.x * 8) {
    bf16_t* pr = p.P + (size_t)row * LDP_E;
    const bool lat = row < ML;
    const int t = row & 2047;
    const int pos = (lane < 32) ? (t >> 6) : (t & 63);
    const float cs = ROPE_CS[pos][lane & 15], sn = ROPE_SN[pos][lane & 15];
    float vals[16];
#pragma unroll
    for (int g = 0; g < 16; ++g) vals[g] = bf2f(pr[g * 64 + lane]);
#pragma unroll
    for (int g = 0; g < 16; ++g) {
      const float v = vals[g];
      const float ss = wave_sum(v * v);
      float y = v * rsqrtf(ss * (1.f / 64.f) + EPSN) * (g < 8 ? gq : gk);
      if (lat) {
        const float o = __shfl_xor(y, 16, 64);
        y = (lane & 16) ? (y * cs + o * sn) : (y * cs - o * sn);
      }
      if (g < 8) y *= qscale;
      pr[g * 64 + lane] = f2bf(y);
    }
  }
  bf16_t* ts = (bf16_t*)smem_raw;
  for (int it = blockIdx.x; it < NB * 4 * 36; it += gridDim.x) {
    const int kb = it % 36, h = (it / 36) & 3, b = it / 144;
    __syncthreads();
    {
      const int r = tid >> 3, ch = tid & 7;
      const int kk = kb * 64 + r;
      const int row = kk < TCX ? ML + b * TCX + kk : b * TL + (kk - TCX);
      const bf16_t* src = p.P + (size_t)row * LDP_E + 1024 + h * 128;
#pragma unroll
      for (int i = 0; i < 2; ++i) {
        const int c8 = (ch + i * 8) * 8;
        const uint4 v = *(const uint4*)(src + c8);
        unsigned* d = (unsigned*)(ts + r * 130 + c8);
        d[0] = v.x; d[1] = v.y; d[2] = v.z; d[3] = v.w;
      }
    }
    __syncthreads();
    {
      const int e = tid >> 2, kq = tid & 3;
      unsigned w[8];
#pragma unroll
      for (int i = 0; i < 8; ++i) {
        const unsigned lo = ts[(kq * 16 + 2 * i) * 130 + e], hi = ts[(kq * 16 + 2 * i + 1) * 130 + e];
        w[i] = lo | (hi << 16);
      }
      bf16_t* dst = p.Vt + ((size_t)(b * 4 + h) * 128 + e) * NKK + kb * 64 + kq * 16;
      *(uint4*)(dst) = make_uint4(w[0], w[1], w[2], w[3]);
      *(uint4*)(dst + 8) = make_uint4(w[4], w[5], w[6], w[7]);
    }
  }
  {
    float* wl = (float*)smem_raw;
    __syncthreads();
    for (int i = tid; i < 2 * 16 * 256; i += NTHR) wl[i] = p.w_gate_up[(size_t)j * 8192 + i];
    for (int i = tid; i < 512; i += NTHR) wl[8192 + i] = p.b_gate_up[j * 512 + i];
    __syncthreads();
    for (int row = blockIdx.x * 8 + wave; row < MT; row += gridDim.x * 8) {
      const bf16_t* pr = p.P + (size_t)row * LDP_E + 3072;
      const float lrv = lane < 32 ? bf2f(pr[lane]) : 0.f;
#pragma unroll
      for (int u = 0; u < 8; ++u) {
        const int col = u * 64 + lane;
        const int dr = col >> 8, cc = col & 255;
        float xg = wl[8192 + col];
#pragma unroll
        for (int rr = 0; rr < 16; ++rr) xg += __shfl(lrv, dr * 16 + rr, 64) * wl[(dr * 16 + rr) * 256 + cc];
        const float ls = fminf(xg, 0.f) - log1pf(__expf(-fabsf(xg)));
        p.Gk[(size_t)row * 512 + col] = ls * (1.f / 16.f);
      }
    }
  }
}

__device__ void attn_item(const Params& p, int item) {
  const int tid = TID(), wave = tid >> 6, lane = tid & 63, r = lane & 31, hh = lane >> 5;
  int b, hc, qrow0, krow_ctx, krow_lat, ntile;
  if (item < 512) { b = item >> 6; hc = (item >> 3) & 7; qrow0 = b * TL + (item & 7) * 256; ntile = 36; }
  else { const int i2 = item - 512; b = i2 >> 3; hc = i2 & 7; qrow0 = ML + b * TCX; ntile = 4; }
  krow_ctx = ML + b * TCX; krow_lat = b * TL;
  const int h = hc >> 1, c = hc & 1;
  bf16_t* Ksm = (bf16_t*)smem_raw;
  bf16_t* Vsm = (bf16_t*)(smem_raw + 2 * 9216);
  const int qrow = qrow0 + wave * 32 + r;
  bf16x8 qf[4];
#pragma unroll
  for (int s = 0; s < 4; ++s) qf[s] = *(const bf16x8*)(p.P + (size_t)qrow * LDP_E + hc * 64 + 16 * s + 8 * hh);
  f32x16 oacc[4];
#pragma unroll
  for (int eb = 0; eb < 4; ++eb)
#pragma unroll
    for (int i = 0; i < 16; ++i) oacc[eb][i] = 0.f;
  float mrun = -1e30f, lsum = 0.f;
  const int kkey = tid >> 3, kch = tid & 7;
  const int ve = tid >> 2, vch = tid & 3;
  const bf16_t* vbase = p.Vt + ((size_t)(b * 4 + h) * 128 + ve) * NKK + vch * 16;
  uint4 kreg, vreg0, vreg1;
  auto gload = [&](int t) {
    const int kk = t * 64 + kkey;
    const int row = kk < TCX ? krow_ctx + kk : krow_lat + (kk - TCX);
    kreg = *(const uint4*)(p.P + (size_t)row * LDP_E + 512 + hc * 64 + kch * 8);
    vreg0 = *(const uint4*)(vbase + t * 64);
    vreg1 = *(const uint4*)(vbase + t * 64 + 8);
  };
  auto sstore = [&](int buf) {
    *(uint4*)(Ksm + buf * 4608 + kkey * 72 + kch * 8) = kreg;
    uint2* d = (uint2*)(Vsm + buf * 8704 + ve * 68 + vch * 16);
    d[0] = make_uint2(vreg0.x, vreg0.y); d[1] = make_uint2(vreg0.z, vreg0.w);
    d[2] = make_uint2(vreg1.x, vreg1.y); d[3] = make_uint2(vreg1.z, vreg1.w);
  };
  __syncthreads();
  gload(0); sstore(0);
  __syncthreads();
  for (int t = 0; t < ntile; ++t) {
    const int buf = t & 1;
    if (t + 1 < ntile) gload(t + 1);
    const bf16_t* Kb = Ksm + buf * 4608;
    const bf16_t* Vb = Vsm + buf * 8704;
    f32x16 sacc[2];
#pragma unroll
    for (int kb = 0; kb < 2; ++kb) {
#pragma unroll
      for (int i = 0; i < 16; ++i) sacc[kb][i] = 0.f;
#pragma unroll
      for (int s = 0; s < 4; ++s) {
        const bf16x8 kf = *(const bf16x8*)(Kb + (32 * kb + r) * 72 + 16 * s + 8 * hh);
        sacc[kb] = __builtin_amdgcn_mfma_f32_32x32x16_bf16(kf, qf[s], sacc[kb], 0, 0, 0);
      }
    }
    float mx = sacc[0][0];
#pragma unroll
    for (int kb = 0; kb < 2; ++kb)
#pragma unroll
      for (int i = 0; i < 16; ++i) mx = fmaxf(mx, sacc[kb][i]);
    mx = fmaxf(mx, __shfl_xor(mx, 32, 64));
    const float mnew = fmaxf(mrun, mx);
    const float alpha = exp2f(mrun - mnew);
    mrun = mnew;
    float ps = 0.f;
#pragma unroll
    for (int kb = 0; kb < 2; ++kb)
#pragma unroll
      for (int i = 0; i < 16; ++i) { const float pv = exp2f(sacc[kb][i] - mnew); sacc[kb][i] = pv; ps += pv; }
    lsum = lsum * alpha + ps;
#pragma unroll
    for (int eb = 0; eb < 4; ++eb)
#pragma unroll
      for (int i = 0; i < 16; ++i) oacc[eb][i] *= alpha;
#pragma unroll
    for (int ks = 0; ks < 4; ++ks) {
      const int kb = ks >> 1, s2 = ks & 1;
      bf16x8 pf;
#pragma unroll
      for (int jj = 0; jj < 8; ++jj) pf[jj] = (short)f2bf(sacc[kb][8 * s2 + jj]);
#pragma unroll
      for (int eb = 0; eb < 4; ++eb) {
        const s16x4 lo = *(const s16x4*)(Vb + (32 * eb + r) * 68 + 16 * ks + 4 * hh);
        const s16x4 hi = *(const s16x4*)(Vb + (32 * eb + r) * 68 + 16 * ks + 8 + 4 * hh);
        const bf16x8 vf = __builtin_shufflevector(lo, hi, 0, 1, 2, 3, 4, 5, 6, 7);
        oacc[eb] = __builtin_amdgcn_mfma_f32_32x32x16_bf16(vf, pf, oacc[eb], 0, 0, 0);
      }
    }
    if (t + 1 < ntile) sstore(buf ^ 1);
    __syncthreads();
  }
  lsum += __shfl_xor(lsum, 32, 64);
  const float inv = 1.f / lsum;
  bf16_t* orow = p.R1 + (size_t)qrow * D + c * 512 + h * 128;
#pragma unroll
  for (int eb = 0; eb < 4; ++eb)
#pragma unroll
    for (int g = 0; g < 4; ++g) {
      const int e = 32 * eb + 8 * g + 4 * hh;
      uint2 o; o.x = pack2(oacc[eb][4 * g] * inv, oacc[eb][4 * g + 1] * inv); o.y = pack2(oacc[eb][4 * g + 2] * inv, oacc[eb][4 * g + 3] * inv);
      *(uint2*)(orow + e) = o;
    }
}

template <int MODE>
__device__ void scan_item(const Params& p, int l, int item) {
  constexpr int DK = MODE ? 128 : 64, DVS = MODE ? 64 : 32, DP = NTHR / DVS, DPT = DK / DP, TC = 32;
  constexpr int NH = MODE ? 8 : 4, NSL = 128 / DVS, LDP = MODE ? LDP_O : LDP_E;
  const int j = l >> 1;
  const int sl = item % NSL, dir = (item / NSL) & 1, h = (item / (NSL * 2)) % NH, b = item / (NSL * 2 * NH);
  float* Qs = (float*)smem_raw; float* Ks = Qs + TC * DK; float* Ds = Ks + TC * DK; float* Vs = Ds + TC * DK; float* Os = Vs + TC * DVS; float* LB = Os + TC * DVS;
  const int tid = TID(), dpart = tid % DP, e = tid / DP;
  float S[DPT];
#pragma unroll
  for (int i = 0; i < DPT; ++i) S[i] = 0.f;
  __syncthreads();
  if (MODE == 1) {
    if (tid < 128) {
      const float* lr = p.lb_raw + (size_t)dir * 4 * 1024 + h * 128 + tid;
      const float r0 = lr[0], r1 = lr[1024], r2 = lr[2048], r3 = lr[3072];
      const float mx = fmaxf(fmaxf(r0, r1), fmaxf(r2, r3));
      const float e0 = __expf(r0 - mx), e1 = __expf(r1 - mx), e2 = __expf(r2 - mx), e3 = __expf(r3 - mx);
      const float inv = 1.f / (e0 + e1 + e2 + e3);
      float acc = 0.f;
      if (l >= 1) acc += e1;
      if (l >= 2) acc += e2;
      if (l >= 3) acc += e3;
      LB[tid] = acc * inv;
    }
  }
  bf16_t* Ro;
  int ldo, ocol;
  if (MODE == 0) { Ro = p.R2 + (size_t)dir * MT * 512; ldo = 512; ocol = h * 128 + sl * DVS; }
  else { Ro = dir ? p.R2 : p.R1; ldo = 1024; ocol = h * 128 + sl * DVS; }
  for (int chunk = 0; chunk < NKK / TC; ++chunk) {
    __syncthreads();
    for (int idx = tid; idx < TC * DK; idx += NTHR) {
      const int tt = idx / DK, d = idx % DK;
      const int n = chunk * TC + tt;
      int row;
      if (n < TCX) row = ML + b * TCX + (dir ? (TCX - 1 - n) : n); else row = b * TL + (dir ? (TL - 1 - (n - TCX)) : (n - TCX));
      const bf16_t* pr = p.P + (size_t)row * LDP;
      float q, k, dec;
      if (MODE == 0) {
        q = bf2f(pr[1536 + h * 64 + d]) * 0.125f;
        k = bf2f(pr[1792 + h * 64 + d]);
        const float* w = p.w_gate_up + ((size_t)(j * 2 + dir) * 16) * 256 + h * 64 + d;
        float xg = p.b_gate_up[(j * 2 + dir) * 256 + h * 64 + d];
#pragma unroll
        for (int rr = 0; rr < 16; ++rr) xg += bf2f(pr[3072 + dir * 16 + rr]) * w[rr * 256];
        const float ls = fminf(xg, 0.f) - log1pf(__expf(-fabsf(xg)));
        dec = __expf(ls * (1.f / 16.f));
      } else {
        q = siluf(bf2f(pr[h * 128 + d])) * 0.08838834764831845f;
        const float lbv = LB[d];
        const float f = lbv + (1.f - lbv) * sigmoidf_(bf2f(pr[1024 + dir * 1024 + h * 128 + d]));
        k = 1.f - f; dec = f;
      }
      Qs[idx] = q; Ks[idx] = k; Ds[idx] = dec;
    }
    for (int idx = tid; idx < TC * DVS; idx += NTHR) {
      const int tt = idx / DVS, ee = idx % DVS;
      const int n = chunk * TC + tt;
      int row;
      if (n < TCX) row = ML + b * TCX + (dir ? (TCX - 1 - n) : n); else row = b * TL + (dir ? (TL - 1 - (n - TCX)) : (n - TCX));
      const bf16_t* pr = p.P + (size_t)row * LDP;
      Vs[idx] = bf2f(pr[(MODE ? 3072 : 2048) + h * 128 + sl * DVS + ee]);
    }
    __syncthreads();
    for (int tt = 0; tt < TC; ++tt) {
      const float v = Vs[tt * DVS + e];
      float part = 0.f;
#pragma unroll
      for (int i4 = 0; i4 < DPT / 4; ++i4) {
        const float4 q4 = *(const float4*)(Qs + tt * DK + dpart * DPT + i4 * 4);
        const float4 k4 = *(const float4*)(Ks + tt * DK + dpart * DPT + i4 * 4);
        const float4 d4 = *(const float4*)(Ds + tt * DK + dpart * DPT + i4 * 4);
        S[i4 * 4 + 0] = S[i4 * 4 + 0] * d4.x + k4.x * v; part += q4.x * S[i4 * 4 + 0];
        S[i4 * 4 + 1] = S[i4 * 4 + 1] * d4.y + k4.y * v; part += q4.y * S[i4 * 4 + 1];
        S[i4 * 4 + 2] = S[i4 * 4 + 2] * d4.z + k4.z * v; part += q4.z * S[i4 * 4 + 2];
        S[i4 * 4 + 3] = S[i4 * 4 + 3] * d4.w + k4.w * v; part += q4.w * S[i4 * 4 + 3];
      }
#pragma unroll
      for (int o = DP / 2; o >= 1; o >>= 1) part += __shfl_xor(part, o, 64);
      if (dpart == 0) Os[tt * DVS + e] = part;
    }
    __syncthreads();
    for (int idx = tid; idx < TC * DVS; idx += NTHR) {
      const int tt = idx / DVS, ee = idx % DVS;
      const int n = chunk * TC + tt;
      int row;
      if (n < TCX) row = ML + b * TCX + (dir ? (TCX - 1 - n) : n); else row = b * TL + (dir ? (TL - 1 - (n - TCX)) : (n - TCX));
      Ro[(size_t)row * ldo + ocol + ee] = f2bf(Os[idx]);
    }
  }
}

template <int MODE>
__device__ void scan2_item(const Params& p, int l, int item) {
  constexpr int DK = MODE ? 128 : 64, NH = MODE ? 8 : 4, LDP = MODE ? LDP_O : LDP_E, NDB = DK / 16, QS = DK + 8, TS = 72;
  const int dir = item & 1, h = (item >> 1) % NH, b = item / (2 * NH);
  bf16_t* Qh = (bf16_t*)smem_raw; bf16_t* Kh = Qh + 64 * QS; bf16_t* KbT = Kh + 64 * QS; bf16_t* VT = KbT + DK * TS; float* ET = (float*)(VT + 128 * TS);
  const int tid = TID(), wave = __builtin_amdgcn_readfirstlane(tid >> 6), lane = tid & 63, r15 = lane & 15, fq = lane >> 4;
  const int pd = tid % DK, pi = __builtin_amdgcn_readfirstlane((tid / DK) & 3);
  const bool pact = true;
  const int ve = tid & 127, vi = __builtin_amdgcn_readfirstlane(tid >> 7);
  float lbv = 0.f;
  if (MODE == 1) {
    const float* lr = p.lb_raw + (size_t)dir * 4 * 1024 + h * 128 + pd;
    const float r0 = lr[0], r1 = lr[1024], r2 = lr[2048], r3 = lr[3072];
    const float mx = fmaxf(fmaxf(r0, r1), fmaxf(r2, r3));
    const float e0 = __expf(r0 - mx), e1 = __expf(r1 - mx), e2 = __expf(r2 - mx), e3 = __expf(r3 - mx);
    float a = 0.f;
    if (l >= 1) a += e1;
    if (l >= 2) a += e2;
    if (l >= 3) a += e3;
    lbv = a / (e0 + e1 + e2 + e3);
  }
  const int qcol = MODE ? h * 128 + pd : 1536 + h * 64 + pd;
  const int kcol = MODE ? 1024 + dir * 1024 + h * 128 + pd : 1792 + h * 64 + pd;
  const int vcol = (MODE ? 3072 : 2048) + h * 128 + ve;
  const int gcol = dir * 256 + h * 64 + pd;
  bf16_t* Ro; int ldo;
  if (MODE == 0) { Ro = p.R2 + (size_t)dir * MT * 512; ldo = 512; } else { Ro = dir ? p.R2 : p.R1; ldo = 1024; }
  Ro += h * 128 + 16 * wave + r15;
  const int rowc = ML + b * TCX, rowl = b * TL;
  auto tokrow = [&](int n) -> int { return n < TCX ? rowc + (dir ? (TCX - 1 - n) : n) : rowl + (dir ? (TL - 1 - (n - TCX)) : (n - TCX)); };
  bf16_t rq[16], rk[16], rv[16]; float rg[16];
  auto load_raw = [&](int ck) {
#pragma unroll
    for (int tt = 0; tt < 16; ++tt) {
      if (pact) {
        const int row = tokrow(ck * 64 + 16 * pi + tt);
        const bf16_t* pr = p.P + (size_t)row * LDP;
        rq[tt] = pr[qcol]; rk[tt] = pr[kcol];
#if EXP2
        if (MODE == 0) {
          const int jx = l >> 1;
          const float* w = p.w_gate_up + ((size_t)(jx * 2 + dir) * 16) * 256 + h * 64 + pd;
          float xg = p.b_gate_up[(jx * 2 + dir) * 256 + h * 64 + pd];
#pragma unroll
          for (int rr = 0; rr < 16; ++rr) xg += bf2f(pr[3072 + dir * 16 + rr]) * w[rr * 256];
          const float ls = fminf(xg, 0.f) - log1pf(__expf(-fabsf(xg)));
          rg[tt] = ls * (1.f / 16.f);
        }
#else
        if (MODE == 0) rg[tt] = p.Gk[(size_t)row * 512 + gcol];
#endif
      }
      const int rowv = tokrow(ck * 64 + 16 * vi + tt);
      rv[tt] = p.P[(size_t)rowv * LDP + vcol];
    }
  };
  f32x4 S[NDB];
#pragma unroll
  for (int db = 0; db < NDB; ++db) S[db] = (f32x4){0.f, 0.f, 0.f, 0.f};
  load_raw(0);
  for (int ck = 0; ck < NKK / 64; ++ck) {
    __syncthreads();
    if (pact) {
      float c = 0.f, cc[16], kk[16];
#pragma unroll
      for (int tt = 0; tt < 16; ++tt) {
        float q, k, g;
        if (MODE == 1) {
          q = siluf(bf2f(rq[tt])) * 0.08838834764831845f;
          const float f = lbv + (1.f - lbv) * sigmoidf_(bf2f(rk[tt]));
          k = 1.f - f; g = __logf(f);
        } else { q = bf2f(rq[tt]) * 0.125f; k = bf2f(rk[tt]); g = rg[tt]; }
        c += g; cc[tt] = c; kk[tt] = k;
        Qh[(16 * pi + tt) * QS + pd] = f2bf(q * __expf(c));
        Kh[(16 * pi + tt) * QS + pd] = f2bf(k * __expf(fminf(-c, 80.f)));
      }
      ET[pi * DK + pd] = __expf(c);
      unsigned w[8];
#pragma unroll
      for (int u = 0; u < 8; ++u) w[u] = pack2(kk[2 * u] * __expf(c - cc[2 * u]), kk[2 * u + 1] * __expf(c - cc[2 * u + 1]));
      *(uint4*)(KbT + pd * TS + 16 * pi) = make_uint4(w[0], w[1], w[2], w[3]);
      *(uint4*)(KbT + pd * TS + 16 * pi + 8) = make_uint4(w[4], w[5], w[6], w[7]);
    }
    {
      unsigned w[8];
#pragma unroll
      for (int u = 0; u < 8; ++u) w[u] = (unsigned)rv[2 * u] | ((unsigned)rv[2 * u + 1] << 16);
      *(uint4*)(VT + ve * TS + 16 * vi) = make_uint4(w[0], w[1], w[2], w[3]);
      *(uint4*)(VT + ve * TS + 16 * vi + 8) = make_uint4(w[4], w[5], w[6], w[7]);
    }
    __syncthreads();
    if (ck + 1 < NKK / 64) load_raw(ck + 1);
#pragma unroll
    for (int i = 0; i < 4; ++i) {
      f32x4 att = (f32x4){0.f, 0.f, 0.f, 0.f};
#pragma unroll
      for (int kb = 0; kb < DK / 32; ++kb) {
        const bf16x8 ka = *(const bf16x8*)(Kh + (16 * i + r15) * QS + 32 * kb + 8 * fq);
        const bf16x8 qb = *(const bf16x8*)(Qh + (16 * i + r15) * QS + 32 * kb + 8 * fq);
        att = __builtin_amdgcn_mfma_f32_16x16x32_bf16(ka, qb, att, 0, 0, 0);
      }
      s16x4 a4;
#pragma unroll
      for (int jj = 0; jj < 4; ++jj) a4[jj] = (4 * fq + jj <= r15) ? (short)f2bf(att[jj]) : (short)0;
      f32x4 o = (f32x4){0.f, 0.f, 0.f, 0.f};
#pragma unroll
      for (int kb = 0; kb < DK / 32; ++kb) {
        const s16x4 qlo = *(const s16x4*)(Qh + (16 * i + r15) * QS + 32 * kb + 4 * fq);
        const s16x4 qhi = *(const s16x4*)(Qh + (16 * i + r15) * QS + 32 * kb + 16 + 4 * fq);
        const bf16x8 qa = __builtin_shufflevector(qlo, qhi, 0, 1, 2, 3, 4, 5, 6, 7);
        bf16x8 sb;
#pragma unroll
        for (int jj = 0; jj < 4; ++jj) { sb[jj] = (short)f2bf(S[2 * kb][jj]); sb[4 + jj] = (short)f2bf(S[2 * kb + 1][jj]); }
        o = __builtin_amdgcn_mfma_f32_16x16x32_bf16(qa, sb, o, 0, 0, 0);
      }
      const s16x4 vb = *(const s16x4*)(VT + (16 * wave + r15) * TS + 16 * i + 4 * fq);
      const s16x4 z4 = (s16x4){0, 0, 0, 0};
      const bf16x8 vb8 = __builtin_shufflevector(vb, z4, 0, 1, 2, 3, 4, 5, 6, 7);
      o = __builtin_amdgcn_mfma_f32_16x16x32_bf16(__builtin_shufflevector(a4, z4, 0, 1, 2, 3, 4, 5, 6, 7), vb8, o, 0, 0, 0);
#pragma unroll
      for (int jj = 0; jj < 4; ++jj) {
        const int row = tokrow(ck * 64 + 16 * i + 4 * fq + jj);
        Ro[(size_t)row * ldo] = f2bf(o[jj]);
      }
#pragma unroll
      for (int db = 0; db < NDB; ++db) {
        const float4 et = *(const float4*)(ET + i * DK + 16 * db + 4 * fq);
        f32x4 s = S[db];
        s[0] *= et.x; s[1] *= et.y; s[2] *= et.z; s[3] *= et.w;
        const s16x4 ka = *(const s16x4*)(KbT + (16 * db + r15) * TS + 16 * i + 4 * fq);
        S[db] = __builtin_amdgcn_mfma_f32_16x16x32_bf16(__builtin_shufflevector(ka, z4, 0, 1, 2, 3, 4, 5, 6, 7), vb8, s, 0, 0, 0);
      }
    }
  }
}

__device__ void phase_post_even(const Params& p, int l) {
  const int j = l >> 1;
  const int wave = TID() >> 6, lane = TID() & 63;
  const float lambda_init = 0.8f - 0.6f * expf(-0.3f * (float)l);
  const float* la = p.lambda_a + j * 256;
  const float s1 = wave_sum(la[lane] * la[64 + lane]);
  const float s2 = wave_sum(la[128 + lane] * la[192 + lane]);
  const float lam = expf(s1) - expf(s2) + lambda_init;
  const float ga0 = p.subln[j * 128 + 2 * lane] * (1.f - lambda_init), ga1 = p.subln[j * 128 + 2 * lane + 1] * (1.f - lambda_init);
  const float gb0 = p.onorm_b[j * 128 + 2 * lane], gb1 = p.onorm_b[j * 128 + 2 * lane + 1];
  for (int row = blockIdx.x * 8 + wave; row < MT; row += gridDim.x * 8) {
    bf16_t* r1 = p.R1 + (size_t)row * D;
    const bf16_t* r2f = p.R2 + (size_t)row * 512;
    const bf16_t* r2b = p.R2 + (size_t)MT * 512 + (size_t)row * 512;
    const bf16_t* pg = p.P + (size_t)row * LDP_E + 2560;
    unsigned a1[4], a2[4], bf_[4], bb_[4], gg[4];
#pragma unroll
    for (int h = 0; h < 4; ++h) {
      a1[h] = *(const unsigned*)(r1 + h * 128 + 2 * lane);
      a2[h] = *(const unsigned*)(r1 + 512 + h * 128 + 2 * lane);
      bf_[h] = *(const unsigned*)(r2f + h * 128 + 2 * lane);
      bb_[h] = *(const unsigned*)(r2b + h * 128 + 2 * lane);
      gg[h] = *(const unsigned*)(pg + h * 128 + 2 * lane);
    }
    unsigned oa[4], ob[4];
#pragma unroll
    for (int h = 0; h < 4; ++h) {
      const float x0 = bf2f((bf16_t)(a1[h] & 0xffff)) - lam * bf2f((bf16_t)(a2[h] & 0xffff));
      const float x1 = bf2f((bf16_t)(a1[h] >> 16)) - lam * bf2f((bf16_t)(a2[h] >> 16));
      const float ra = rsqrtf(wave_sum(x0 * x0 + x1 * x1) * (1.f / 128.f) + EPSN);
      oa[h] = pack2(x0 * ra * ga0, x1 * ra * ga1);
      const float y0 = bf2f((bf16_t)(bf_[h] & 0xffff)) + bf2f((bf16_t)(bb_[h] & 0xffff));
      const float y1 = bf2f((bf16_t)(bf_[h] >> 16)) + bf2f((bf16_t)(bb_[h] >> 16));
      const float rb = rsqrtf(wave_sum(y0 * y0 + y1 * y1) * (1.f / 128.f) + EPSN);
      const float g0 = bf2f((bf16_t)(gg[h] & 0xffff)), g1 = bf2f((bf16_t)(gg[h] >> 16));
      ob[h] = pack2(y0 * rb * gb0 * siluf(g0), y1 * rb * gb1 * siluf(g1));
    }
#pragma unroll
    for (int h = 0; h < 4; ++h) {
      *(unsigned*)(r1 + h * 128 + 2 * lane) = oa[h];
      *(unsigned*)(r1 + 512 + h * 128 + 2 * lane) = ob[h];
    }
  }
}

__device__ void phase_post_odd(const Params& p, int l) {
  const int j = l >> 1;
  const int wave = TID() >> 6, lane = TID() & 63;
  const float g0 = p.onorm_c[j * 128 + 2 * lane], g1 = p.onorm_c[j * 128 + 2 * lane + 1];
  for (int row = blockIdx.x * 8 + wave; row < MT; row += gridDim.x * 8) {
    bf16_t* r1 = p.R1 + (size_t)row * D;
    const bf16_t* r2 = p.R2 + (size_t)row * D;
    const bf16_t* pg = p.P + (size_t)row * LDP_O + 4096;
    unsigned a[8], bq[8], gg[8];
#pragma unroll
    for (int h = 0; h < 8; ++h) {
      a[h] = *(const unsigned*)(r1 + h * 128 + 2 * lane);
      bq[h] = *(const unsigned*)(r2 + h * 128 + 2 * lane);
      gg[h] = *(const unsigned*)(pg + h * 128 + 2 * lane);
    }
    unsigned o[8];
#pragma unroll
    for (int h = 0; h < 8; ++h) {
      const float y0 = bf2f((bf16_t)(a[h] & 0xffff)) + bf2f((bf16_t)(bq[h] & 0xffff));
      const float y1 = bf2f((bf16_t)(a[h] >> 16)) + bf2f((bf16_t)(bq[h] >> 16));
      const float rb = rsqrtf(wave_sum(y0 * y0 + y1 * y1) * (1.f / 128.f) + EPSN);
      const float q0 = bf2f((bf16_t)(gg[h] & 0xffff)), q1 = bf2f((bf16_t)(gg[h] >> 16));
      o[h] = pack2(y0 * rb * g0 * siluf(q0), y1 * rb * g1 * siluf(q1));
    }
#pragma unroll
    for (int h = 0; h < 8; ++h) *(unsigned*)(r1 + h * 128 + 2 * lane) = o[h];
  }
}

constexpr int NPHASE = 1 + 4 * 9;
#ifndef GEMM_INL
#define GEMM_INL
#endif
__device__ GEMM_INL void gemm_call_p(const bf16_t* A, const bf16_t* Bt, int M, int N, int K, EpiArgs ea) { gemm_phase<EPI_P>(A, Bt, M, N, K, ea); }
__device__ GEMM_INL void gemm_call_res(const bf16_t* A, const bf16_t* Bt, int M, int N, int K, EpiArgs ea) { gemm_phase<EPI_RES>(A, Bt, M, N, K, ea); }
__device__ GEMM_INL void gemm_call_sw(const bf16_t* A, const bf16_t* Bt, int M, int N, int K, EpiArgs ea) { gemm_phase<EPI_SWIGLU>(A, Bt, M, N, K, ea); }

__device__ void run_phase(const Params& p, int ph) {
  if (ph == 0) { phase_init(p); return; }
  const int l = (ph - 1) / 9, s = (ph - 1) % 9, j = l >> 1;
  const bool even = (l & 1) == 0;
  const int mrows = l < 3 ? MT : ML;
  const float* modl = p.mod + (size_t)l * 9 * 6144;
  if (s == 1 || s == 5 || s == 8) {
    if (s == 1) {
      EpiArgs ea{p.P, even ? LDP_E : LDP_O, nullptr, nullptr, nullptr};
      const bf16_t* Bt = even ? p.wt_in_even + (size_t)j * LDP_E * 1024 : p.wt_in_odd + (size_t)j * LDP_O * 1024;
      gemm_call_p(p.R1, Bt, MT, even ? LDP_E : LDP_O, 1024, ea);
    } else {
      EpiArgs ea{nullptr, 0, p.out, p.Z, modl + (s == 5 ? 2 : 5) * 1024};
      const bf16_t* A = s == 5 ? p.R1 : p.P;
      const bf16_t* Bt = s == 5 ? (even ? p.wt_out_even : p.wt_out_odd) + (size_t)j * 1024 * 1024 : p.wt_ffn_out + (size_t)l * 1024 * DFF;
      gemm_call_res(A, Bt, mrows, 1024, s == 5 ? 1024 : DFF, ea);
    }
    return;
  }
  switch (s) {
    case 0: phase_norm(p, l, 0, MT, p.R1); break;
    case 2: if (even) phase_prep_even(p, j); break;
    case 3: {
      if (even) {
#if DYNQ
        int* qs = (int*)(smem_raw + 131072 - 16);
        for (;;) {
          __syncthreads();
          if (TID() == 0) *qs = (int)atomicAdd(p.ctr + l, 1u);
          __syncthreads();
          const int it = *qs;
          if (it >= 64 + 576) break;
          if (it < 64) scan2_item<0>(p, l, it); else attn_item(p, it - 64);
        }
#else
#if EXP1
        for (int it = blockIdx.x; it < 256 + 576; it += gridDim.x) { if (it < 256) scan_item<0>(p, l, it); else attn_item(p, it - 256); }
#else
        if (blockIdx.x < 64) scan2_item<0>(p, l, blockIdx.x);
        else for (int it = blockIdx.x - 64; it < 576; it += gridDim.x - 64) attn_item(p, it);
#endif
#endif
      } else {
        for (int it = blockIdx.x; it < 128; it += gridDim.x) scan2_item<1>(p, l, it);
      }
    } break;
    case 4: if (even) phase_post_even(p, l); else phase_post_odd(p, l); break;
    case 6: phase_norm(p, l, 1, mrows, p.R2); break;
    case 7: {
      EpiArgs ea{p.P, DFF, nullptr, nullptr, nullptr};
      gemm_call_sw(p.R2, p.wt_ffn_in + (size_t)l * 5632 * 1024, mrows, 5632, 1024, ea);
    } break;
  }
}

__global__ void __launch_bounds__(NTHR, 2) mega_kernel(Params p, int ph0, int ph1) {
  cg::grid_group grid = cg::this_grid();
  for (int ph = ph0; ph < ph1; ++ph) {
#if DBL_MASK
    { const int s_ = ph == 0 ? 9 : (ph - 1) % 9; const int nrep = ((DBL_MASK >> s_) & 1) ? 2 : 1; for (int rep = 0; rep < nrep; ++rep) run_phase(p, ph); }
#else
    run_phase(p, ph);
#endif
    if (ph + 1 < ph1) grid.sync();
  }
}

extern "C" void kernel_launch(void* const* d_in, const int* in_sizes, int n_in, void* d_out, int out_size, void* d_ws, size_t ws_size, hipStream_t stream) {
  constexpr size_t kDynLds = 131072;
  static int grid_blocks = 0;
  if (!grid_blocks) {
    hipFuncSetAttribute((const void*)mega_kernel, hipFuncAttributeMaxDynamicSharedMemorySize, (int)kDynLds);
    int dev = 0, cus = 0, per_cu = 0;
    hipGetDevice(&dev);
    hipDeviceGetAttribute(&cus, hipDeviceAttributeMultiprocessorCount, dev);
    hipOccupancyMaxActiveBlocksPerMultiprocessor(&per_cu, mega_kernel, NTHR, kDynLds);
    if (per_cu < 1) per_cu = 1;
    grid_blocks = cus * per_cu;
  }
  Params p{};
  const float* const* in = (const float* const*)d_in;
  p.x = in[0]; p.c = in[1]; p.ctx = in[2]; p.c_ctx = in[3]; p.w_ada = in[4]; p.b_ada = in[5]; p.n1g = in[6]; p.n2g = in[7];
  p.w_in_even = in[8]; p.qk_gain = in[9]; p.lambda_a = in[10]; p.subln = in[11]; p.w_gate_up = in[12]; p.b_gate_up = in[13];
  p.onorm_b = in[14]; p.w_out_even = in[15]; p.w_in_odd = in[16]; p.lb_raw = in[17]; p.onorm_c = in[18]; p.w_out_odd = in[19];
  p.w_ffn_in = in[20]; p.w_ffn_out = in[21];
  p.out = (float*)d_out;
  char* w = (char*)d_ws;
  size_t off = 0;
  auto take = [&](size_t bytes) { char* r = w + off; off += (bytes + 255) & ~(size_t)255; return r; };
  p.wt_in_even = (bf16_t*)take((size_t)2 * LDP_E * 1024 * 2);
  p.wt_in_odd = (bf16_t*)take((size_t)2 * LDP_O * 1024 * 2);
  p.wt_out_even = (bf16_t*)take((size_t)2 * 1024 * 1024 * 2);
  p.wt_out_odd = (bf16_t*)take((size_t)2 * 1024 * 1024 * 2);
  p.wt_ffn_in = (bf16_t*)take((size_t)4 * 5632 * 1024 * 2);
  p.wt_ffn_out = (bf16_t*)take((size_t)4 * 1024 * DFF * 2);
  p.Z = (float*)take((size_t)MC * D * 4);
  p.mod = (float*)take((size_t)4 * 9 * 6144 * 4);
  p.P = (bf16_t*)take((size_t)MT * LDP_O * 2);
  p.R1 = (bf16_t*)take((size_t)MT * D * 2);
  p.R2 = (bf16_t*)take((size_t)MT * D * 2);
  p.Vt = p.P + (size_t)MT * LDP_E;
  p.Gk = (float*)(p.Vt + (size_t)NB * 4 * 128 * NKK);
  p.ctr = (unsigned*)take(256);
  if (off > ws_size) { fprintf(stderr, "workspace too small: need %zu have %zu\n", off, ws_size); return; }
#if ONE_LAUNCH
  int ph0 = 0, ph1 = NPHASE;
  void* args[] = {&p, &ph0, &ph1};
  hipError_t e = hipLaunchCooperativeKernel((const void*)mega_kernel, dim3(grid_blocks), dim3(NTHR), args, kDynLds, stream);
  if (e != hipSuccess) fprintf(stderr, "cooperative launch failed: %s (grid %d)\n", hipGetErrorString(e), grid_blocks);
#else
  for (int ph = 0; ph < NPHASE; ++ph) {
    const int l = (ph - 1) / 9, s = (ph - 1) % 9;
    if (ph > 0 && s == 2 && (l & 1)) continue;
    mega_kernel<<<grid_blocks, NTHR, kDynLds, stream>>>(p, ph, ph + 1);
  }
#endif
}
```

```cpp
#include <hip/hip_runtime.h>
#include <hip/hip_cooperative_groups.h>
#include <cstdio>
namespace cg = cooperative_groups;

#ifndef DYNQ
#define DYNQ 1
#endif
#ifndef EXP1
#define EXP1 0
#endif
#ifndef EXP2
#define EXP2 0
#endif
#ifndef DBL_MASK
#define DBL_MASK 0
#endif
#ifndef ONE_LAUNCH
#define ONE_LAUNCH 1
#endif

typedef unsigned short bf16_t;
typedef short bf16x8 __attribute__((ext_vector_type(8)));
typedef short s16x4 __attribute__((ext_vector_type(4)));
typedef float f32x4 __attribute__((ext_vector_type(4)));
typedef float f32x16 __attribute__((ext_vector_type(16)));
#define DI __device__ __forceinline__

__device__ const float ROPE_CS[64][16] = {
  {1.00000000e+00f,1.00000000e+00f,1.00000000e+00f,1.00000000e+00f,1.00000000e+00f,1.00000000e+00f,1.00000000e+00f,1.00000000e+00f,1.00000000e+00f,1.00000000e+00f,1.00000000e+00f,1.00000000e+00f,1.00000000e+00f,1.00000000e+00f,1.00000000e+00f,1.00000000e+00f},
  {5.40302277e-01f,8.46009135e-01f,9.50415254e-01f,9.84230220e-01f,9.95004177e-01f,9.98419285e-01f,9.99500036e-01f,9.99841869e-01f,9.99949992e-01f,9.99984205e-01f,9.99994993e-01f,9.99998391e-01f,9.99999523e-01f,9.99999821e-01f,9.99999940e-01f,1.00000000e+00f},
  {-4.16146845e-01f,4.31462824e-01f,8.06578398e-01f,9.37418282e-01f,9.80066597e-01f,9.93682086e-01f,9.98000681e-01f,9.99367595e-01f,9.99800026e-01f,9.99936759e-01f,9.99979973e-01f,9.99993682e-01f,9.99997973e-01f,9.99999344e-01f,9.99999821e-01f,9.99999940e-01f},
  {-9.89992499e-01f,-1.15966164e-01f,5.82753658e-01f,8.61040652e-01f,9.55336511e-01f,9.85803485e-01f,9.95503366e-01f,9.98577297e-01f,9.99550045e-01f,9.99857724e-01f,9.99954998e-01f,9.99985754e-01f,9.99995530e-01f,9.99998569e-01f,9.99999523e-01f,9.99999881e-01f},
  {-6.53643608e-01f,-6.27679706e-01f,3.01137477e-01f,7.57506192e-01f,9.21060979e-01f,9.74808276e-01f,9.92010653e-01f,9.97471273e-01f,9.99200106e-01f,9.99747038e-01f,9.99920011e-01f,9.99974728e-01f,9.99992013e-01f,9.99997497e-01f,9.99999225e-01f,9.99999762e-01f},
  {2.83662200e-01f,-9.46079254e-01f,-1.03423381e-02f,6.30080283e-01f,8.77582550e-01f,9.60731268e-01f,9.87526000e-01f,9.96049762e-01f,9.98750269e-01f,9.99604762e-01f,9.99875009e-01f,9.99960482e-01f,9.99987483e-01f,9.99996066e-01f,9.99998748e-01f,9.99999583e-01f},
  {9.60170269e-01f,-9.73103702e-01f,-3.20796400e-01f,4.82782036e-01f,8.25335622e-01f,9.43616986e-01f,9.82053936e-01f,9.94313300e-01f,9.98200536e-01f,9.99430835e-01f,9.99819994e-01f,9.99943078e-01f,9.99981999e-01f,9.99994338e-01f,9.99998212e-01f,9.99999404e-01f},
  {7.53902256e-01f,-7.00429797e-01f,-5.99437475e-01f,3.20257008e-01f,7.64842212e-01f,9.23519433e-01f,9.75599885e-01f,9.92262423e-01f,9.97551024e-01f,9.99225318e-01f,9.99755025e-01f,9.99922514e-01f,9.99975502e-01f,9.99992251e-01f,9.99997556e-01f,9.99999225e-01f},
  {-1.45500034e-01f,-2.12036446e-01f,-8.18632424e-01f,1.47631213e-01f,6.96706712e-01f,9.00502324e-01f,9.68170285e-01f,9.89897788e-01f,9.96801734e-01f,9.98988271e-01f,9.99680042e-01f,9.99898791e-01f,9.99967992e-01f,9.99989867e-01f,9.99996781e-01f,9.99998987e-01f},
  {-9.11130250e-01f,3.41660261e-01f,-9.56644177e-01f,-2.96507962e-02f,6.21609926e-01f,8.74638259e-01f,9.59772646e-01f,9.87220109e-01f,9.95952725e-01f,9.98719573e-01f,9.99595046e-01f,9.99871910e-01f,9.99959528e-01f,9.99987185e-01f,9.99995947e-01f,9.99998748e-01f},
  {-8.39071512e-01f,7.90131867e-01f,-9.99786079e-01f,-2.05997631e-01f,5.40302277e-01f,8.46009135e-01f,9.50415313e-01f,9.84230220e-01f,9.95004177e-01f,9.98419285e-01f,9.99500036e-01f,9.99841869e-01f,9.99949992e-01f,9.99984205e-01f,9.99994993e-01f,9.99998391e-01f},
  {4.42569796e-03f,9.95257378e-01f,-9.43779767e-01f,-3.75847399e-01f,4.53596085e-01f,8.14705312e-01f,9.40107584e-01f,9.80929136e-01f,9.93956089e-01f,9.98087406e-01f,9.99395072e-01f,9.99808669e-01f,9.99939501e-01f,9.99980867e-01f,9.99993920e-01f,9.99998093e-01f},
  {8.43853951e-01f,8.93861592e-01f,-7.94179380e-01f,-5.33843040e-01f,3.62357706e-01f,7.80825913e-01f,9.28859890e-01f,9.77317870e-01f,9.92808640e-01f,9.97723997e-01f,9.99280095e-01f,9.99772310e-01f,9.99927998e-01f,9.99977231e-01f,9.99992788e-01f,9.99997735e-01f},
  {9.07446802e-01f,5.17172873e-01f,-5.65820515e-01f,-6.75001681e-01f,2.67498761e-01f,7.44477987e-01f,9.16683376e-01f,9.73397553e-01f,9.91561890e-01f,9.97329056e-01f,9.99155104e-01f,9.99732792e-01f,9.99915481e-01f,9.99973297e-01f,9.99991536e-01f,9.99997318e-01f},
  {1.36737213e-01f,-1.87961515e-02f,-2.81349480e-01f,-7.94870913e-01f,1.69967160e-01f,7.05776393e-01f,9.03590262e-01f,9.69169438e-01f,9.90216017e-01f,9.96902585e-01f,9.99020159e-01f,9.99690115e-01f,9.99902010e-01f,9.99969006e-01f,9.99990225e-01f,9.99996901e-01f},
  {-7.59687901e-01f,-5.48975468e-01f,3.10223512e-02f,-8.89670432e-01f,7.07371980e-02f,6.64843500e-01f,8.89593601e-01f,9.64634836e-01f,9.88771081e-01f,9.96444523e-01f,9.98875201e-01f,9.99644279e-01f,9.99887526e-01f,9.99964416e-01f,9.99988735e-01f,9.99996424e-01f},
  {-9.57659483e-01f,-9.10081089e-01f,3.40318173e-01f,-9.56410050e-01f,-2.91995462e-02f,6.21808827e-01f,8.74707460e-01f,9.59795177e-01f,9.87227261e-01f,9.95954990e-01f,9.98720288e-01f,9.99595284e-01f,9.99872029e-01f,9.99959528e-01f,9.99987185e-01f,9.99995947e-01f},
  {-2.75163352e-01f,-9.90897954e-01f,6.15864813e-01f,-9.92985010e-01f,-1.28844544e-01f,5.76808274e-01f,8.58946681e-01f,9.54652011e-01f,9.85584795e-01f,9.95433986e-01f,9.98555362e-01f,9.99543071e-01f,9.99855518e-01f,9.99954283e-01f,9.99985576e-01f,9.99995410e-01f},
  {6.60316706e-01f,-7.66536534e-01f,8.30336154e-01f,-9.98241663e-01f,-2.27202162e-01f,5.29984176e-01f,8.42327058e-01f,9.49207008e-01f,9.83843684e-01f,9.94881511e-01f,9.98380423e-01f,9.99487758e-01f,9.99837995e-01f,9.99948800e-01f,9.99983788e-01f,9.99994874e-01f},
  {9.88704622e-01f,-3.06095392e-01f,9.62463796e-01f,-9.72014248e-01f,-3.23289543e-01f,4.81484592e-01f,8.24865162e-01f,9.43461835e-01f,9.82004225e-01f,9.94297504e-01f,9.98195529e-01f,9.99429286e-01f,9.99819517e-01f,9.99942899e-01f,9.99981940e-01f,9.99994278e-01f},
  {4.08082068e-01f,2.48616725e-01f,9.99144375e-01f,-9.15129960e-01f,-4.16146845e-01f,4.31462824e-01f,8.06578457e-01f,9.37418282e-01f,9.80066597e-01f,9.93682086e-01f,9.98000681e-01f,9.99367595e-01f,9.99800026e-01f,9.99936759e-01f,9.99979973e-01f,9.99993682e-01f},
  {-5.47729254e-01f,7.26760268e-01f,9.36740458e-01f,-8.29382956e-01f,-5.04846215e-01f,3.80077004e-01f,7.87485182e-01f,9.31078374e-01f,9.78030920e-01f,9.93035257e-01f,9.97795820e-01f,9.99302804e-01f,9.99779522e-01f,9.99930263e-01f,9.99977946e-01f,9.99993026e-01f},
  {-9.99960840e-01f,9.81074572e-01f,7.81440377e-01f,-7.17477441e-01f,-5.88501155e-01f,3.27489585e-01f,7.67604589e-01f,9.24443960e-01f,9.75897431e-01f,9.92357016e-01f,9.97581005e-01f,9.99234855e-01f,9.99758005e-01f,9.99923468e-01f,9.99975801e-01f,9.99992371e-01f},
  {-5.32833040e-01f,9.33235765e-01f,5.48645258e-01f,-5.82943261e-01f,-6.66275978e-01f,2.73866832e-01f,7.46956408e-01f,9.17517304e-01f,9.73666370e-01f,9.91647422e-01f,9.97356176e-01f,9.99163687e-01f,9.99735534e-01f,9.99916375e-01f,9.99973536e-01f,9.99991655e-01f},
  {4.24179018e-01f,5.97977161e-01f,2.61441678e-01f,-4.30023283e-01f,-7.37393796e-01f,2.19378278e-01f,7.25561321e-01f,9.10300434e-01f,9.71337974e-01f,9.90906477e-01f,9.97121394e-01f,9.99089420e-01f,9.99711990e-01f,9.99908924e-01f,9.99971211e-01f,9.99990880e-01f},
  {9.91202831e-01f,7.85522610e-02f,-5.16893305e-02f,-2.63540596e-01f,-8.01143587e-01f,1.64196163e-01f,7.03440726e-01f,9.02795732e-01f,9.68912423e-01f,9.90134120e-01f,9.96876657e-01f,9.99011934e-01f,9.99687493e-01f,9.99901175e-01f,9.99968767e-01f,9.99990106e-01f},
  {6.46919310e-01f,-4.65064496e-01f,-3.59694332e-01f,-8.87455046e-02f,-8.56888831e-01f,1.08494945e-01f,6.80616796e-01f,8.95005584e-01f,9.66389954e-01f,9.89330530e-01f,9.96621907e-01f,9.98931348e-01f,9.99662042e-01f,9.99893129e-01f,9.99966204e-01f,9.99989331e-01f},
  {-2.92138815e-01f,-8.65450621e-01f,-6.32028639e-01f,8.88481140e-02f,-9.04072165e-01f,5.24506159e-02f,6.57112300e-01f,8.86932373e-01f,9.63770926e-01f,9.88495648e-01f,9.96357203e-01f,9.98847544e-01f,9.99635518e-01f,9.99884725e-01f,9.99963522e-01f,9.99988496e-01f},
  {-9.62605894e-01f,-9.99293387e-01f,-8.41684937e-01f,2.63639510e-01f,-9.42222297e-01f,-3.75941908e-03f,6.32950664e-01f,8.78578722e-01f,9.61055458e-01f,9.87629473e-01f,9.96082544e-01f,9.98760641e-01f,9.99608040e-01f,9.99876022e-01f,9.99960780e-01f,9.99987602e-01f},
  {-7.48057544e-01f,-8.25371623e-01f,-9.67871487e-01f,4.30115849e-01f,-9.70958173e-01f,-5.99575676e-02f,6.08156204e-01f,8.69947195e-01f,9.58243906e-01f,9.86732066e-01f,9.95797932e-01f,9.98670578e-01f,9.99579549e-01f,9.99867022e-01f,9.99957979e-01f,9.99986708e-01f},
  {1.54251456e-01f,-3.97251874e-01f,-9.98075247e-01f,5.83026946e-01f,-9.89992499e-01f,-1.15966164e-01f,5.82753658e-01f,8.61040652e-01f,9.55336511e-01f,9.85803485e-01f,9.95503366e-01f,9.98577297e-01f,9.99550045e-01f,9.99857724e-01f,9.99954998e-01f,9.99985754e-01f},
  {9.14742351e-01f,1.53215483e-01f,-9.29300308e-01f,7.17549205e-01f,-9.99135137e-01f,-1.71608135e-01f,5.56768358e-01f,8.51861775e-01f,9.52333570e-01f,9.84843671e-01f,9.95198846e-01f,9.98480916e-01f,9.99519527e-01f,9.99848068e-01f,9.99951959e-01f,9.99984801e-01f},
  {8.34223390e-01f,6.56495154e-01f,-7.68367112e-01f,8.29440355e-01f,-9.98294771e-01f,-2.26707578e-01f,5.30226350e-01f,8.42413545e-01f,9.49235439e-01f,9.83852804e-01f,9.94884372e-01f,9.98381376e-01f,9.99488056e-01f,9.99838114e-01f,9.99948800e-01f,9.99983788e-01f},
  {-1.32767474e-02f,9.57586050e-01f,-5.31235278e-01f,9.15171385e-01f,-9.87479806e-01f,-2.81090319e-01f,5.03154159e-01f,8.32698941e-01f,9.46042359e-01f,9.82830763e-01f,9.94559944e-01f,9.98278618e-01f,9.99455571e-01f,9.99827802e-01f,9.99945521e-01f,9.99982774e-01f},
  {-8.48570287e-01f,9.63757515e-01f,-2.41421118e-01f,9.72038329e-01f,-9.66798186e-01f,-3.34584385e-01f,4.75578904e-01f,8.22721004e-01f,9.42754686e-01f,9.81777668e-01f,9.94225562e-01f,9.98172760e-01f,9.99422073e-01f,9.99817252e-01f,9.99942183e-01f,9.99981701e-01f},
  {-9.03692186e-01f,6.73110247e-01f,7.23346695e-02f,9.98247743e-01f,-9.36456680e-01f,-3.87020677e-01f,4.47528064e-01f,8.12482953e-01f,9.39372718e-01f,9.80693519e-01f,9.93881226e-01f,9.98063743e-01f,9.99387562e-01f,9.99806345e-01f,9.99938726e-01f,9.99980628e-01f},
  {-1.27963692e-01f,1.75156534e-01f,3.78916174e-01f,9.92972851e-01f,-8.96758378e-01f,-4.38233554e-01f,4.19029742e-01f,8.01987886e-01f,9.35896814e-01f,9.79578316e-01f,9.93526995e-01f,9.97951567e-01f,9.99352098e-01f,9.99795079e-01f,9.99935210e-01f,9.99979496e-01f},
  {7.65414059e-01f,-3.76742303e-01f,6.47921681e-01f,9.56380010e-01f,-8.48100007e-01f,-4.88060862e-01f,3.90112430e-01f,7.91239262e-01f,9.32327330e-01f,9.78432178e-01f,9.93162811e-01f,9.97836173e-01f,9.99315560e-01f,9.99783576e-01f,9.99931574e-01f,9.99978364e-01f},
  {9.55073655e-01f,-8.12611222e-01f,8.52673113e-01f,8.89623463e-01f,-7.90967762e-01f,-5.36345184e-01f,3.60805035e-01f,7.80240417e-01f,9.28664625e-01f,9.77255106e-01f,9.92788672e-01f,9.97717679e-01f,9.99278069e-01f,9.99771714e-01f,9.99927819e-01f,9.99977171e-01f},
  {2.66642928e-01f,-9.98210371e-01f,9.72865343e-01f,7.94808388e-01f,-7.25932240e-01f,-5.82933903e-01f,3.31136853e-01f,7.68994927e-01f,9.24909055e-01f,9.76047099e-01f,9.92404640e-01f,9.97596025e-01f,9.99239624e-01f,9.99759495e-01f,9.99923944e-01f,9.99975979e-01f},
  {-6.66938066e-01f,-8.76379430e-01f,9.96578991e-01f,6.74925625e-01f,-6.53643608e-01f,-6.27679706e-01f,3.01137596e-01f,7.57506192e-01f,9.21060979e-01f,9.74808276e-01f,9.92010653e-01f,9.97471273e-01f,9.99200106e-01f,9.99747038e-01f,9.99920011e-01f,9.99974728e-01f},
  {-9.87339258e-01f,-4.84639406e-01f,9.21462357e-01f,5.33756077e-01f,-5.74824035e-01f,-6.70441091e-01f,2.70837069e-01f,7.45777905e-01f,9.17120814e-01f,9.73538578e-01f,9.91606772e-01f,9.97343302e-01f,9.99159634e-01f,9.99734223e-01f,9.99915957e-01f,9.99973416e-01f},
  {-3.99985313e-01f,5.63609414e-02f,7.54965365e-01f,3.75752151e-01f,-4.90260571e-01f,-7.11082935e-01f,2.40265876e-01f,7.33813822e-01f,9.13088918e-01f,9.72238123e-01f,9.91192937e-01f,9.97212172e-01f,9.99118149e-01f,9.99721110e-01f,9.99911785e-01f,9.99972105e-01f},
  {5.55113316e-01f,5.80003142e-01f,5.13598442e-01f,2.05897167e-01f,-4.00799006e-01f,-7.49476731e-01f,2.09454417e-01f,7.21617639e-01f,9.08965766e-01f,9.70906913e-01f,9.90769207e-01f,9.97077882e-01f,9.99075651e-01f,9.99707639e-01f,9.99907553e-01f,9.99970794e-01f},
  {9.99843299e-01f,9.25014675e-01f,2.21298173e-01f,2.95478199e-02f,-3.07332784e-01f,-7.85501122e-01f,1.78433523e-01f,7.09193349e-01f,9.04751658e-01f,9.69545007e-01f,9.90335584e-01f,9.96940494e-01f,9.99032140e-01f,9.99693930e-01f,9.99903202e-01f,9.99969363e-01f},
  {5.25321960e-01f,9.85138178e-01f,-9.29481089e-02f,-1.47732988e-01f,-2.10795805e-01f,-8.19042206e-01f,1.47234216e-01f,6.96544766e-01f,9.00447130e-01f,9.68152404e-01f,9.89892066e-01f,9.96799886e-01f,9.98987675e-01f,9.99679863e-01f,9.99898732e-01f,9.99967992e-01f},
  {-4.32177931e-01f,7.41858006e-01f,-3.97976756e-01f,-3.20354372e-01f,-1.12152621e-01f,-8.49993885e-01f,1.15887694e-01f,6.83675885e-01f,8.96052480e-01f,9.66729224e-01f,9.89438653e-01f,9.96656179e-01f,9.98942196e-01f,9.99665439e-01f,9.99894202e-01f,9.99966562e-01f},
  {-9.92335498e-01f,2.70098448e-01f,-6.63538277e-01f,-4.82871950e-01f,-1.23883775e-02f,-8.78258407e-01f,8.44252855e-02f,6.70590878e-01f,8.91568303e-01f,9.65275466e-01f,9.88975346e-01f,9.96509314e-01f,9.98895705e-01f,9.99650776e-01f,9.99889553e-01f,9.99965072e-01f},
  {-6.40144348e-01f,-2.84846604e-01f,-8.63296509e-01f,-6.30159974e-01f,8.74991715e-02f,-9.03746367e-01f,5.28784581e-02f,6.57293737e-01f,8.86994898e-01f,9.63791192e-01f,9.88502085e-01f,9.96359289e-01f,9.98848200e-01f,9.99635756e-01f,9.99884784e-01f,9.99963582e-01f},
  {3.00592542e-01f,-7.52063990e-01f,-9.77442741e-01f,-7.57573068e-01f,1.86512470e-01f,-9.26377118e-01f,2.12787576e-02f,6.43788815e-01f,8.82332861e-01f,9.62276459e-01f,9.88018990e-01f,9.96206105e-01f,9.98799741e-01f,9.99620378e-01f,9.99879956e-01f,9.99962032e-01f},
  {9.64965999e-01f,-9.87659097e-01f,-9.94656444e-01f,-8.61092687e-01f,2.83662200e-01f,-9.46079254e-01f,-1.03422189e-02f,6.30080283e-01f,8.77582550e-01f,9.60731268e-01f,9.87526000e-01f,9.96049762e-01f,9.98750269e-01f,9.99604762e-01f,9.99875009e-01f,9.99960482e-01f},
  {7.42154181e-01f,-9.19073522e-01f,-9.13230121e-01f,-9.37454224e-01f,3.77977669e-01f,-9.62790370e-01f,-4.19528559e-02f,6.16172493e-01f,8.72744501e-01f,9.59155679e-01f,9.87023175e-01f,9.95890260e-01f,9.98699784e-01f,9.99588788e-01f,9.99869943e-01f,9.99958873e-01f},
  {-1.62990779e-01f,-5.67430019e-01f,-7.41239965e-01f,-9.84248459e-01f,4.68516916e-01f,-9.76457715e-01f,-7.35215396e-02f,6.02069914e-01f,8.67819190e-01f,9.57549810e-01f,9.86510456e-01f,9.95727658e-01f,9.98648286e-01f,9.99572515e-01f,9.99864817e-01f,9.99957263e-01f},
  {-9.18282807e-01f,-4.10281904e-02f,-4.95741814e-01f,-1.00000000e+00f,5.54374516e-01f,-9.87038016e-01f,-1.05016708e-01f,5.87776959e-01f,8.62807095e-01f,9.55913603e-01f,9.85987842e-01f,9.95561838e-01f,9.98595834e-01f,9.99555886e-01f,9.99859571e-01f,9.99955595e-01f},
  {-8.29309821e-01f,4.98009592e-01f,-2.01079622e-01f,-9.84212041e-01f,6.34692967e-01f,-9.94497895e-01f,-1.36406869e-01f,5.73298037e-01f,8.57708693e-01f,9.54247177e-01f,9.85455394e-01f,9.95392919e-01f,9.98542368e-01f,9.99538958e-01f,9.99854207e-01f,9.99953866e-01f},
  {2.21267566e-02f,8.83669317e-01f,1.13521777e-01f,-9.37382519e-01f,7.08669782e-01f,-9.98813629e-01f,-1.67660639e-01f,5.58637917e-01f,8.52524519e-01f,9.52550590e-01f,9.84913111e-01f,9.95220840e-01f,9.98487890e-01f,9.99521732e-01f,9.99848783e-01f,9.99952197e-01f},
  {8.53220105e-01f,9.97174621e-01f,4.16867077e-01f,-8.60988438e-01f,7.75565803e-01f,-9.99971747e-01f,-1.98746875e-01f,5.43801069e-01f,8.47255111e-01f,9.50823903e-01f,9.84360933e-01f,9.95045662e-01f,9.98432398e-01f,9.99504209e-01f,9.99843180e-01f,9.99950409e-01f},
  {8.99866819e-01f,8.03569078e-01f,6.78870201e-01f,-7.57439196e-01f,8.34712923e-01f,-9.97968495e-01f,-2.29634270e-01f,5.28792322e-01f,8.41901004e-01f,9.49067116e-01f,9.83798921e-01f,9.94867265e-01f,9.98375952e-01f,9.99486327e-01f,9.99837577e-01f,9.99948621e-01f},
  {1.19180135e-01f,3.62476677e-01f,8.73550534e-01f,-6.30000710e-01f,8.85519624e-01f,-9.92810190e-01f,-2.60292053e-01f,5.13616323e-01f,8.36462677e-01f,9.47280347e-01f,9.83227074e-01f,9.94685769e-01f,9.98318493e-01f,9.99468148e-01f,9.99831796e-01f,9.99946833e-01f},
  {-7.71080196e-01f,-1.90249100e-01f,9.81602073e-01f,-4.82692331e-01f,9.27478492e-01f,-9.84513164e-01f,-2.90689558e-01f,4.98277903e-01f,8.30940723e-01f,9.45463598e-01f,9.82645452e-01f,9.94501114e-01f,9.98260021e-01f,9.99449670e-01f,9.99825954e-01f,9.99944985e-01f},
  {-9.52412963e-01f,-6.84381902e-01f,9.92308319e-01f,-3.20159167e-01f,9.60170269e-01f,-9.73103702e-01f,-3.20796400e-01f,4.82782036e-01f,8.25335622e-01f,9.43616986e-01f,9.82053936e-01f,9.94313300e-01f,9.98200536e-01f,9.99430835e-01f,9.99819994e-01f,9.99943078e-01f},
  {-2.58101642e-01f,-9.67739642e-01f,9.04607594e-01f,-1.47529200e-01f,9.83268440e-01f,-9.58617806e-01f,-3.50582451e-01f,4.67133403e-01f,8.19648027e-01f,9.41740453e-01f,9.81452644e-01f,9.94122326e-01f,9.98140097e-01f,9.99411702e-01f,9.99813974e-01f,9.99941170e-01f},
  {6.73507154e-01f,-9.53050017e-01f,7.27198064e-01f,2.97537707e-02f,9.96542096e-01f,-9.41101313e-01f,-3.80017966e-01f,4.51337039e-01f,8.13878477e-01f,9.39834237e-01f,9.80841517e-01f,9.93928254e-01f,9.98078644e-01f,9.99392271e-01f,9.99807835e-01f,9.99939203e-01f},
  {9.85896587e-01f,-6.44837022e-01f,4.77671444e-01f,2.06098333e-01f,9.99858618e-01f,-9.20609534e-01f,-4.09073502e-01f,4.35397953e-01f,8.08027506e-01f,9.37898219e-01f,9.80220556e-01f,9.93731022e-01f,9.98016179e-01f,9.99372482e-01f,9.99801576e-01f,9.99937236e-01f}
};
__device__ const float ROPE_SN[64][16] = {
  {0.00000000e+00f,0.00000000e+00f,0.00000000e+00f,0.00000000e+00f,0.00000000e+00f,0.00000000e+00f,0.00000000e+00f,0.00000000e+00f,0.00000000e+00f,0.00000000e+00f,0.00000000e+00f,0.00000000e+00f,0.00000000e+00f,0.00000000e+00f,0.00000000e+00f,0.00000000e+00f},
  {8.41470957e-01f,5.33168435e-01f,3.10983598e-01f,1.76892191e-01f,9.98334214e-02f,5.62044978e-02f,3.16175036e-02f,1.77818574e-02f,9.99983307e-03f,5.62338345e-03f,3.16227227e-03f,1.77827850e-03f,9.99999931e-04f,5.62341243e-04f,3.16227757e-04f,1.77827940e-04f},
  {9.09297407e-01f,9.02130723e-01f,5.91127098e-01f,3.48205268e-01f,1.98669329e-01f,1.12231314e-01f,6.32033944e-02f,3.55580896e-02f,1.99986659e-02f,1.12465890e-02f,6.32451288e-03f,3.55655141e-03f,1.99999870e-03f,1.12468237e-03f,6.32455456e-04f,3.55655880e-04f},
  {1.41120002e-01f,9.93253171e-01f,8.12648892e-01f,5.08536100e-01f,2.95520216e-01f,1.67903304e-01f,9.47260857e-02f,5.33230826e-02f,2.99954992e-02f,1.68694388e-02f,9.48669016e-03f,5.33481315e-03f,2.99999560e-03f,1.68702309e-03f,9.48683126e-04f,5.33483806e-04f},
  {-7.56802499e-01f,7.78471708e-01f,9.53580737e-01f,6.52827978e-01f,3.89418334e-01f,2.23044485e-01f,1.26154065e-01f,7.10712075e-02f,3.99893336e-02f,2.24917568e-02f,1.26487734e-02f,7.11305765e-03f,3.99998948e-03f,2.24936334e-03f,1.26491068e-03f,7.11311703e-04f},
  {-9.58924294e-01f,3.23935270e-01f,9.99946535e-01f,7.76529968e-01f,4.79425550e-01f,2.77480543e-01f,1.57455876e-01f,8.87968615e-02f,4.99791652e-02f,2.81133614e-02f,1.58107281e-02f,8.89127981e-03f,4.99997940e-03f,2.81170290e-03f,1.58113812e-03f,8.89139599e-04f},
  {-2.79415488e-01f,-2.30367512e-01f,9.47148204e-01f,8.75740528e-01f,5.64642489e-01f,3.31039310e-01f,1.88600272e-01f,1.06494442e-01f,5.99640049e-02f,3.37340795e-02f,1.89725272e-02f,1.06694745e-02f,5.99996420e-03f,3.37404152e-03f,1.89736532e-03f,1.06696738e-03f},
  {6.56986594e-01f,-7.13721275e-01f,8.00421596e-01f,9.47330713e-01f,6.44217670e-01f,3.83551568e-01f,2.19556093e-01f,1.24158338e-01f,6.99428469e-02f,3.93537246e-02f,2.21341345e-02f,1.24476347e-02f,6.99994294e-03f,3.93637875e-03f,2.21359241e-03f,1.24479528e-03f},
  {9.89358246e-01f,-9.77261782e-01f,5.74317753e-01f,9.89042461e-01f,7.17356086e-01f,4.34851229e-01f,2.50292331e-01f,1.41782969e-01f,7.99146891e-02f,4.49721329e-02f,2.52955221e-02f,1.42257558e-02f,7.99991470e-03f,4.49871505e-03f,2.52981926e-03f,1.42262306e-03f},
  {4.12118495e-01f,-9.39823508e-01f,2.91259229e-01f,9.99560297e-01f,7.83326924e-01f,4.84776139e-01f,2.80778319e-01f,1.59362778e-01f,8.98785442e-02f,5.05891182e-02f,2.84566563e-02f,1.60038304e-02f,8.99987947e-03f,5.06105041e-03f,2.84604589e-03f,1.60045072e-03f},
  {-5.44021130e-01f,-6.12936914e-01f,-2.06835698e-02f,9.78552461e-01f,8.41470957e-01f,5.33168435e-01f,3.10983568e-01f,1.76892191e-01f,9.98334140e-02f,5.62044978e-02f,3.16175036e-02f,1.77818574e-02f,9.99983400e-03f,5.62338345e-03f,3.16227227e-03f,1.77827850e-03f},
  {-9.99990225e-01f,-9.72764567e-02f,-3.30574960e-01f,9.26681578e-01f,8.91207397e-01f,5.79875171e-01f,3.40877861e-01f,1.94365650e-01f,1.09778300e-01f,6.18181042e-02f,3.47780399e-02f,1.95598267e-02f,1.09997792e-02f,6.18571462e-03f,3.47849843e-03f,1.95610616e-03f},
  {-5.36572933e-01f,4.48342979e-01f,-6.07683420e-01f,8.45583618e-01f,9.32039082e-01f,6.24748647e-01f,3.70431304e-01f,2.11777672e-01f,1.19712204e-01f,6.74297586e-02f,3.79382223e-02f,2.13377345e-02f,1.19997123e-02f,6.74804440e-03f,3.79472389e-03f,2.13393359e-03f},
  {4.20167029e-01f,8.55880976e-01f,-8.24528456e-01f,7.37816215e-01f,9.63558197e-01f,6.67647004e-01f,3.99614304e-01f,2.29122713e-01f,1.29634142e-01f,7.30392784e-02f,4.10980321e-02f,2.31155735e-02f,1.29996343e-02f,7.31037185e-03f,4.11094911e-03f,2.31176103e-03f},
  {9.90607381e-01f,9.99823332e-01f,-9.59605396e-01f,6.06778562e-01f,9.85449731e-01f,7.08434701e-01f,4.28397775e-01f,2.46395305e-01f,1.39543116e-01f,7.86464810e-02f,4.42574248e-02f,2.48933397e-02f,1.39995432e-02f,7.87269697e-03f,4.42717411e-03f,2.48958869e-03f},
  {6.50287867e-01f,8.35838437e-01f,-9.99518692e-01f,4.56603259e-01f,9.97494996e-01f,7.46982634e-01f,4.56752867e-01f,2.63589978e-01f,1.49438128e-01f,8.42512026e-02f,4.74163815e-02f,2.66710296e-02f,1.49994381e-02f,8.43502022e-03f,4.74339863e-03f,2.66741589e-03f},
  {-2.87903309e-01f,4.14430231e-01f,-9.40310359e-01f,2.92027086e-01f,9.99573588e-01f,7.83169091e-01f,4.84651238e-01f,2.80701309e-01f,1.59318209e-01f,8.98532644e-02f,5.05748577e-02f,2.84486320e-02f,1.59993190e-02f,8.99733976e-03f,5.05962269e-03f,2.84524332e-03f},
  {-9.61397469e-01f,-1.34615138e-01f,-7.87851870e-01f,1.18240520e-01f,9.91664827e-01f,8.16879570e-01f,5.12064993e-01f,2.97723860e-01f,1.69182345e-01f,9.54524800e-02f,5.37328273e-02f,3.02261449e-02f,1.69991814e-02f,9.55965649e-03f,5.37584582e-03f,3.02307028e-03f},
  {-7.50987232e-01f,-6.42200708e-01f,-5.57262897e-01f,-5.92755191e-02f,9.73847628e-01f,8.48007560e-01f,5.38966715e-01f,3.14652264e-01f,1.79029569e-01f,1.01048686e-01f,5.68902642e-02f,3.20035629e-02f,1.79990288e-02f,1.01219704e-02f,5.69206895e-03f,3.20089748e-03f},
  {1.49877205e-01f,-9.52000856e-01f,-2.71410108e-01f,-2.34921798e-01f,9.46300089e-01f,8.76454532e-01f,5.65329552e-01f,3.31481189e-01f,1.88858896e-01f,1.06641680e-01f,6.00471310e-02f,3.37808803e-02f,1.89988576e-02f,1.06842816e-02f,6.00829115e-03f,3.37872445e-03f},
  {9.12945271e-01f,-9.68601942e-01f,4.13582884e-02f,-4.03158993e-01f,9.09297407e-01f,9.02130723e-01f,5.91127038e-01f,3.48205268e-01f,1.98669314e-01f,1.12231314e-01f,6.32033944e-02f,3.55580896e-02f,1.99986678e-02f,1.12465890e-02f,6.32451288e-03f,3.55655141e-03f},
  {8.36655617e-01f,-6.86891198e-01f,3.50024760e-01f,-5.58680534e-01f,8.63209307e-01f,9.24954832e-01f,6.16333544e-01f,3.64819258e-01f,2.08459899e-01f,1.17817394e-01f,6.63590282e-02f,3.73351872e-02f,2.09984574e-02f,1.18088927e-02f,6.64073415e-03f,3.73437814e-03f},
  {-8.85130931e-03f,-1.93630233e-01f,6.23979926e-01f,-6.96581721e-01f,8.08496356e-01f,9.44854796e-01f,6.40923738e-01f,3.81317884e-01f,2.18229622e-01f,1.23399742e-01f,6.95140064e-02f,3.91121693e-02f,2.19982266e-02f,1.23711927e-02f,6.95695449e-03f,3.91220488e-03f},
  {-8.46220434e-01f,3.59264523e-01f,8.36055279e-01f,-8.12512875e-01f,7.45705247e-01f,9.61767614e-01f,6.64873064e-01f,3.97695929e-01f,2.27977514e-01f,1.28978193e-01f,7.26682767e-02f,4.08890247e-02f,2.29979735e-02f,1.29334899e-02f,7.27317436e-03f,4.09003161e-03f},
  {-9.05578375e-01f,8.01513135e-01f,9.65219259e-01f,-9.02817786e-01f,6.75463140e-01f,9.75639880e-01f,6.88157499e-01f,4.13948208e-01f,2.37702623e-01f,1.34552568e-01f,7.58218244e-02f,4.26657498e-02f,2.39976961e-02f,1.34957815e-02f,7.58939330e-03f,4.26785741e-03f},
  {-1.32351756e-01f,9.96909976e-01f,9.98663187e-01f,-9.64648306e-01f,5.98472118e-01f,9.86427724e-01f,7.10753918e-01f,4.30069596e-01f,2.47403964e-01f,1.40122697e-01f,7.89746121e-02f,4.44423407e-02f,2.49973964e-02f,1.40580693e-02f,7.90561177e-03f,4.44568414e-03f},
  {7.62558460e-01f,8.85276794e-01f,9.33070183e-01f,-9.96054351e-01f,5.15501261e-01f,9.94096994e-01f,7.32639611e-01f,4.46054995e-01f,2.57080555e-01f,1.45688385e-01f,8.21266174e-02f,4.62187938e-02f,2.59970706e-02f,1.46203535e-02f,8.22182931e-03f,4.62350994e-03f},
  {9.56375957e-01f,5.00994205e-01f,7.74945021e-01f,-9.96045172e-01f,4.27379847e-01f,9.98623490e-01f,7.53792703e-01f,4.61899310e-01f,2.66731411e-01f,1.51249468e-01f,8.52777958e-02f,4.79951017e-02f,2.69967206e-02f,1.51826320e-02f,8.53804592e-03f,4.80133574e-03f},
  {2.70905793e-01f,-3.75856608e-02f,5.39968967e-01f,-9.64621305e-01f,3.34988207e-01f,9.99992907e-01f,7.74192095e-01f,4.77597594e-01f,2.76355654e-01f,1.56805754e-01f,8.84281173e-02f,4.97712530e-02f,2.79963426e-02f,1.57449059e-02f,8.85426160e-03f,4.97916201e-03f},
  {-6.63633883e-01f,-5.64589798e-01f,2.51445323e-01f,-9.02773678e-01f,2.39249229e-01f,9.98200953e-01f,7.93817401e-01f,4.93144840e-01f,2.85952210e-01f,1.62357092e-01f,9.15775672e-02f,5.15472479e-02f,2.89959367e-02f,1.63071752e-02f,9.17047635e-03f,5.15698735e-03f},
  {-9.88031626e-01f,-9.17709649e-01f,-6.20148405e-02f,-8.12452853e-01f,1.41120002e-01f,9.93253171e-01f,8.12648892e-01f,5.08536100e-01f,2.95520186e-01f,1.67903304e-01f,9.47260931e-02f,5.33230826e-02f,2.99955010e-02f,1.68694388e-02f,9.48669016e-03f,5.33481315e-03f},
  {-4.04037654e-01f,-9.88192797e-01f,-3.69325012e-01f,-6.96507812e-01f,4.15805206e-02f,9.85165298e-01f,8.30667794e-01f,5.23766637e-01f,3.05058628e-01f,1.73444211e-01f,9.78736654e-02f,5.50987460e-02f,3.09950355e-02f,1.74316969e-02f,9.80290305e-03f,5.51263802e-03f},
  {5.51426709e-01f,-7.54330218e-01f,-6.40009403e-01f,-5.58595300e-01f,-5.83741926e-02f,9.73962843e-01f,8.47856104e-01f,5.38831532e-01f,3.14566553e-01f,1.78979620e-01f,1.01020269e-01f,5.68742342e-02f,3.19945402e-02f,1.79939512e-02f,1.01191159e-02f,5.69046335e-03f},
  {9.99911845e-01f,-2.88147390e-01f,-8.47224355e-01f,-4.03064936e-01f,-1.57745644e-01f,9.59681332e-01f,8.64196658e-01f,5.53726017e-01f,3.24043006e-01f,1.84509367e-01f,1.04165860e-01f,5.86495437e-02f,3.29940096e-02f,1.85561981e-02f,1.04353270e-02f,5.86828869e-03f},
  {5.29082716e-01f,2.66779721e-01f,-9.70420420e-01f,-2.34822124e-01f,-2.55541205e-01f,9.42365825e-01f,8.79673064e-01f,5.68445385e-01f,3.33487093e-01f,1.90033287e-01f,1.07310407e-01f,6.04246669e-02f,3.39934528e-02f,1.91184394e-02f,1.07515370e-02f,6.04611309e-03f},
  {-4.28182662e-01f,7.39542127e-01f,-9.97380435e-01f,-5.91726787e-02f,-3.50783229e-01f,9.22071040e-01f,8.94269884e-01f,5.82984984e-01f,3.42897803e-01f,1.95551202e-01f,1.10453881e-01f,6.21996038e-02f,3.49928550e-02f,1.96806751e-02f,1.10677453e-02f,6.22393796e-03f},
  {-9.91778851e-01f,9.84540582e-01f,-9.25431013e-01f,1.18342586e-01f,-4.42520559e-01f,8.98861170e-01f,9.07972515e-01f,5.97340286e-01f,3.52274209e-01f,2.01062918e-01f,1.13596253e-01f,6.39743358e-02f,3.59922275e-02f,2.02429052e-02f,1.13839535e-02f,6.40176190e-03f},
  {-6.43538117e-01f,9.26318109e-01f,-7.61706948e-01f,2.92125374e-01f,-5.29836178e-01f,8.72809589e-01f,9.20767248e-01f,6.11506701e-01f,3.61615449e-01f,2.06568271e-01f,1.16737492e-01f,6.57488778e-02f,3.69915590e-02f,2.08051261e-02f,1.17001599e-02f,6.57958630e-03f},
  {2.96368569e-01f,5.82806170e-01f,-5.22444785e-01f,4.56694692e-01f,-6.11857831e-01f,8.43998730e-01f,9.32641268e-01f,6.25479698e-01f,3.70920479e-01f,2.12067112e-01f,1.19877554e-01f,6.75232038e-02f,3.79908569e-02f,2.13673431e-02f,1.20163653e-02f,6.75741071e-03f},
  {9.63795364e-01f,5.98003156e-02f,-2.31372014e-01f,6.06860459e-01f,-6.87766254e-01f,8.12519610e-01f,9.43582714e-01f,6.39254928e-01f,3.80188406e-01f,2.17559248e-01f,1.23016424e-01f,6.92973137e-02f,3.89901139e-02f,2.19295528e-02f,1.23325698e-02f,6.93523418e-03f},
  {7.45113134e-01f,-4.81621295e-01f,8.26458037e-02f,7.37885714e-01f,-7.56802499e-01f,7.78471708e-01f,9.53580678e-01f,6.52827978e-01f,3.89418334e-01f,2.23044485e-01f,1.26154065e-01f,7.10712075e-02f,3.99893373e-02f,2.24917568e-02f,1.26487734e-02f,7.11305765e-03f},
  {-1.58622667e-01f,-8.74714017e-01f,3.88467699e-01f,8.45638454e-01f,-8.18277061e-01f,7.41962790e-01f,9.62625206e-01f,6.66194677e-01f,3.98609310e-01f,2.28522688e-01f,1.29290432e-01f,7.28448778e-02f,4.09885161e-02f,2.30539497e-02f,1.29649751e-02f,7.29088066e-03f},
  {-9.16521549e-01f,-9.98410463e-01f,6.55764699e-01f,9.26720202e-01f,-8.71575892e-01f,7.03108132e-01f,9.70707119e-01f,6.79350674e-01f,4.07760441e-01f,2.33993664e-01f,1.32425532e-01f,7.46183172e-02f,4.19876575e-02f,2.36161388e-02f,1.32811759e-02f,7.46870413e-03f},
  {-8.31774771e-01f,-8.14614236e-01f,8.58030677e-01f,9.78573620e-01f,-9.16166008e-01f,6.62030637e-01f,9.77818429e-01f,6.92291796e-01f,4.16870773e-01f,2.39457220e-01f,1.35559291e-01f,7.63915181e-02f,4.29867506e-02f,2.41783205e-02f,1.35973748e-02f,7.64652714e-03f},
  {1.77019257e-02f,-3.79931390e-01f,9.75206196e-01f,9.99563396e-01f,-9.51602101e-01f,6.18860185e-01f,9.83951986e-01f,7.05014050e-01f,4.25939471e-01f,2.44913206e-01f,1.38691694e-01f,7.81644881e-02f,4.39858064e-02f,2.47404929e-02f,1.39135728e-02f,7.82434922e-03f},
  {8.50903511e-01f,1.71763569e-01f,9.95670974e-01f,9.89027262e-01f,-9.77530122e-01f,5.73733270e-01f,9.89101648e-01f,7.17513323e-01f,4.34965521e-01f,2.50361472e-01f,1.41822711e-01f,7.99371973e-02f,4.49848175e-02f,2.53026579e-02f,1.42297689e-02f,8.00217129e-03f},
  {9.01788354e-01f,6.70557022e-01f,9.17395473e-01f,9.47297752e-01f,-9.93690968e-01f,5.26792526e-01f,9.93262351e-01f,7.29785740e-01f,4.43948090e-01f,2.55801797e-01f,1.44952312e-01f,8.17096606e-02f,4.59837839e-02f,2.58648153e-02f,1.45459641e-02f,8.17999430e-03f},
  {1.23573124e-01f,9.62832689e-01f,7.48142362e-01f,8.75690997e-01f,-9.99923289e-01f,4.78186339e-01f,9.96429801e-01f,7.41827428e-01f,4.52886283e-01f,2.61234075e-01f,1.48080453e-01f,8.34818557e-02f,4.69827019e-02f,2.64269635e-02f,1.48621574e-02f,8.35781638e-03f},
  {-7.68254638e-01f,9.58573103e-01f,5.04697084e-01f,7.76465356e-01f,-9.96164620e-01f,4.28068399e-01f,9.98600960e-01f,7.53634512e-01f,4.61779177e-01f,2.66658038e-01f,1.51207119e-01f,8.52537975e-02f,4.79815714e-02f,2.69891042e-02f,1.51783489e-02f,8.53563752e-03f},
  {-9.53752637e-01f,6.59090102e-01f,2.11200655e-01f,6.52750373e-01f,-9.82452571e-01f,3.76597136e-01f,9.99773562e-01f,7.65203178e-01f,4.70625877e-01f,2.72073567e-01f,1.54332280e-01f,8.70254710e-02f,4.89803962e-02f,2.75512375e-02f,1.54945394e-02f,8.71345960e-03f},
  {-2.62374848e-01f,1.56619072e-01f,-1.03240460e-01f,5.08447945e-01f,-9.58924294e-01f,3.23935270e-01f,9.99946535e-01f,7.76529968e-01f,4.79425550e-01f,2.77480543e-01f,1.57455891e-01f,8.87968615e-02f,4.99791689e-02f,2.81133596e-02f,1.58107281e-02f,8.89127981e-03f},
  {6.70229197e-01f,-3.94086063e-01f,-4.07444149e-01f,3.48108500e-01f,-9.25814748e-01f,2.70249337e-01f,9.99119580e-01f,7.87611187e-01f,4.88177240e-01f,2.82878697e-01f,1.60577938e-01f,9.05679762e-02f,5.09778969e-02f,2.86754742e-02f,1.61269177e-02f,9.06910095e-03f},
  {9.86627579e-01f,-8.23421597e-01f,-6.71240151e-01f,1.76790684e-01f,-8.83454502e-01f,2.15709001e-01f,9.97293651e-01f,7.98443377e-01f,4.96880114e-01f,2.88267940e-01f,1.63698375e-01f,9.23388004e-02f,5.19765690e-02f,2.92375814e-02f,1.64431017e-02f,9.24692024e-03f},
  {3.95925164e-01f,-9.99157965e-01f,-8.68469954e-01f,-1.03020677e-04f,-8.32267344e-01f,1.60486728e-01f,9.94470477e-01f,8.09023023e-01f,5.05533338e-01f,2.93648034e-01f,1.66817173e-01f,9.41093415e-02f,5.29751927e-02f,2.97996756e-02f,1.67592876e-02f,9.42474138e-03f},
  {-5.58789074e-01f,-8.67171526e-01f,-9.79574919e-01f,-1.76993474e-01f,-7.72764444e-01f,1.04756832e-01f,9.90652919e-01f,8.19346905e-01f,5.14135957e-01f,2.99018890e-01f,1.69934288e-01f,9.58795771e-02f,5.39737605e-02f,3.03617641e-02f,1.70754679e-02f,9.60256159e-03f},
  {-9.99755144e-01f,-4.68111664e-01f,-9.93535519e-01f,-3.48301649e-01f,-7.05540299e-01f,4.86960001e-02f,9.85844791e-01f,8.29411685e-01f,5.22687256e-01f,3.04380238e-01f,1.73049718e-01f,9.76495072e-02f,5.49722798e-02f,3.09238415e-02f,1.73916500e-02f,9.78038087e-03f},
  {-5.21551013e-01f,7.51182064e-02f,-9.08967435e-01f,-5.08624554e-01f,-6.31266713e-01f,-7.51878507e-03f,9.80050862e-01f,8.39214146e-01f,5.31186223e-01f,3.09731960e-01f,1.76163420e-01f,9.94191393e-02f,5.59707358e-02f,3.14859077e-02f,1.77078284e-02f,9.95820016e-03f},
  {4.36164767e-01f,5.95211506e-01f,-7.34258294e-01f,-6.52905703e-01f,-5.50685287e-01f,-6.37097955e-02f,9.73276973e-01f,8.48751247e-01f,5.39632022e-01f,3.15073937e-01f,1.79275364e-01f,1.01188451e-01f,5.69691435e-02f,3.20479684e-02f,1.80240069e-02f,1.01360194e-02f},
  {9.92872655e-01f,9.31992829e-01f,-4.86733496e-01f,-7.76594579e-01f,-4.64602023e-01f,-1.19699396e-01f,9.65529919e-01f,8.58020008e-01f,5.48023939e-01f,3.20405900e-01f,1.82385504e-01f,1.02957435e-01f,5.79674877e-02f,3.26100141e-02f,1.83401816e-02f,1.03138378e-02f},
  {6.36738002e-01f,9.81735826e-01f,-1.90938011e-01f,-8.75790000e-01f,-3.73876572e-01f,-1.75310582e-01f,9.56817448e-01f,8.67017388e-01f,5.56361020e-01f,3.25727791e-01f,1.85493827e-01f,1.04726106e-01f,5.89657798e-02f,3.31720486e-02f,1.86563563e-02f,1.04916561e-02f},
  {-3.04810613e-01f,7.29123712e-01f,1.23790950e-01f,-9.47363734e-01f,-2.79415488e-01f,-2.30367512e-01f,9.47148204e-01f,8.75740528e-01f,5.64642429e-01f,3.31039310e-01f,1.88600287e-01f,1.06494442e-01f,5.99640086e-02f,3.37340795e-02f,1.89725272e-02f,1.06694745e-02f},
  {-9.66117799e-01f,2.51952261e-01f,4.26245421e-01f,-9.89057720e-01f,-1.82162598e-01f,-2.84696162e-01f,9.36531842e-01f,8.84186864e-01f,5.72867453e-01f,3.36340427e-01f,1.91704854e-01f,1.08262435e-01f,6.09621815e-02f,3.42960916e-02f,1.92886982e-02f,1.08472919e-02f},
  {-7.39180684e-01f,-3.02812874e-01f,6.86427653e-01f,-9.99557257e-01f,-8.30891207e-02f,-3.38124752e-01f,9.24979091e-01f,8.92353535e-01f,5.81035137e-01f,3.41630876e-01f,1.94807529e-01f,1.10030092e-01f,6.19602874e-02f,3.48580964e-02f,1.96048655e-02f,1.10251084e-02f},
  {1.67355701e-01f,-7.64320076e-01f,8.78538549e-01f,-9.78531301e-01f,1.68140903e-02f,-3.90484393e-01f,9.12501454e-01f,9.00238097e-01f,5.89144766e-01f,3.46910536e-01f,1.97908238e-01f,1.11797392e-01f,6.29583374e-02f,3.54200937e-02f,1.99210308e-02f,1.12029258e-02f}
};


constexpr int D = 1024, ML = 16384, MC = 2048, MT = ML + MC, TL = 2048, TCX = 256, NB = 8;
constexpr int LDP_E = 3328, LDP_O = 5120, DFF = 2816, NKK = 2304;
constexpr int NTHR = 512;
constexpr float EPSN = 1e-6f;

struct Params {
  const float *x, *c, *ctx, *c_ctx, *w_ada, *b_ada, *n1g, *n2g, *w_in_even, *qk_gain, *lambda_a, *subln, *w_gate_up, *b_gate_up,
      *onorm_b, *w_out_even, *w_in_odd, *lb_raw, *onorm_c, *w_out_odd, *w_ffn_in, *w_ffn_out;
  float* out;
  bf16_t *wt_in_even, *wt_in_odd, *wt_out_even, *wt_out_odd, *wt_ffn_in, *wt_ffn_out;
  float* Z;
  float* mod;
  bf16_t *P, *R1, *R2, *Vt;
  float* Gk;
  unsigned* ctr;
};

extern __shared__ __attribute__((aligned(16))) char smem_raw[];

typedef float f32x2 __attribute__((ext_vector_type(2)));
typedef __bf16 hbf16x2 __attribute__((ext_vector_type(2)));
DI unsigned pack2(float a, float b) { const f32x2 v = {a, b}; return __builtin_bit_cast(unsigned, __builtin_convertvector(v, hbf16x2)); }
DI bf16_t f2bf(float x) { return (bf16_t)(pack2(x, 0.f) & 0xffffu); }
DI float bf2f(bf16_t h) { return __uint_as_float(((unsigned)h) << 16); }
DI float wave_sum(float v) {
#pragma unroll
  for (int o = 32; o >= 1; o >>= 1) v += __shfl_xor(v, o, 64);
  return v;
}
DI int TID() { int t = threadIdx.x; asm volatile("" : "+v"(t)); return t; }
DI float siluf(float x) { return x / (1.f + __expf(-x)); }
DI float sigmoidf_(float x) { return 1.f / (1.f + __expf(-x)); }

DI void convert_tile(const float* __restrict__ src, int K, int N, bf16_t* __restrict__ dst, int mode, int tile) {
  float* ts = (float*)smem_raw;
  const int tid = TID();
  const int nkt = K >> 6;
  const int kt = tile % nkt, nt = tile / nkt;
  const int k0 = kt << 6, n0 = nt << 6;
#pragma unroll
  for (int i = 0; i < 2; ++i) {
    const int idx = tid + i * NTHR;
    const int kr = idx >> 4, c4 = idx & 15;
    const int n = n0 + 4 * c4;
    float4 v = make_float4(0.f, 0.f, 0.f, 0.f);
    if (n < N) v = *(const float4*)(src + (size_t)(k0 + kr) * N + n);
    float* t = ts + kr * 65 + 4 * c4;
    t[0] = v.x; t[1] = v.y; t[2] = v.z; t[3] = v.w;
  }
  __syncthreads();
  {
    const int nrow = tid >> 3, kq = tid & 7;
    float f[8];
#pragma unroll
    for (int j = 0; j < 8; ++j) f[j] = ts[(kq * 8 + j) * 65 + nrow];
    int n = n0 + nrow;
    int orow = n;
    if (mode == 1) { const int up = n >= DFF ? 1 : 0; const int j = n - up * DFF; orow = (j >> 7) * 256 + up * 128 + (j & 127); }
    uint4 o;
    o.x = pack2(f[0], f[1]); o.y = pack2(f[2], f[3]); o.z = pack2(f[4], f[5]); o.w = pack2(f[6], f[7]);
    *(uint4*)(dst + (size_t)orow * K + k0 + kq * 8) = o;
  }
  __syncthreads();
}

__device__ void phase_init(const Params& p) {
  const int tid = TID(), nb = gridDim.x, bid = blockIdx.x;
  if (bid == 0 && tid < 16) p.ctr[tid] = 0u;
  {
    const float4* xs = (const float4*)p.x; float4* xo = (float4*)p.out;
    const size_t n4 = (size_t)ML * D / 4;
    for (size_t i = (size_t)bid * NTHR + tid; i < n4; i += (size_t)nb * NTHR) xo[i] = xs[i];
    const float4* cs = (const float4*)p.ctx; float4* zo = (float4*)p.Z;
    const size_t m4 = (size_t)MC * D / 4;
    for (size_t i = (size_t)bid * NTHR + tid; i < m4; i += (size_t)nb * NTHR) zo[i] = cs[i];
  }
  {
    const int T0 = 2 * 16 * 52, T1 = T0 + 2 * 16 * 80, T2 = T1 + 2 * 256, T3 = T2 + 2 * 256, T4 = T3 + 4 * 16 * 88, T5 = T4 + 4 * 44 * 16;
    for (int it = bid; it < T5; it += nb) {
      if (it < T0) { const int j = it / 832, t = it % 832; convert_tile(p.w_in_even + (size_t)j * 1024 * 3104, 1024, 3104, p.wt_in_even + (size_t)j * LDP_E * 1024, 0, t); }
      else if (it < T1) { const int q = it - T0; const int j = q / 1280, t = q % 1280; convert_tile(p.w_in_odd + (size_t)j * 1024 * 5120, 1024, 5120, p.wt_in_odd + (size_t)j * 5120 * 1024, 0, t); }
      else if (it < T2) { const int q = it - T1; const int j = q / 256, t = q % 256; convert_tile(p.w_out_even + (size_t)j * 1024 * 1024, 1024, 1024, p.wt_out_even + (size_t)j * 1024 * 1024, 0, t); }
      else if (it < T3) { const int q = it - T2; const int j = q / 256, t = q % 256; convert_tile(p.w_out_odd + (size_t)j * 1024 * 1024, 1024, 1024, p.wt_out_odd + (size_t)j * 1024 * 1024, 0, t); }
      else if (it < T4) { const int q = it - T3; const int j = q / 1408, t = q % 1408; convert_tile(p.w_ffn_in + (size_t)j * 1024 * 5632, 1024, 5632, p.wt_ffn_in + (size_t)j * 5632 * 1024, 1, t); }
      else { const int q = it - T4; const int j = q / 704, t = q % 704; convert_tile(p.w_ffn_out + (size_t)j * DFF * 1024, DFF, 1024, p.wt_ffn_out + (size_t)j * 1024 * DFF, 0, t); }
    }
  }
  {
    float* sc = (float*)smem_raw;
    float* part = sc + 9 * 1024;
    __syncthreads();
    for (int i = tid; i < 9 * 1024; i += NTHR) {
      const int m = i >> 10, k = i & 1023;
      const float v = m < 8 ? p.c[m * 1024 + k] : p.c_ctx[k];
      sc[i] = siluf(v);
    }
    __syncthreads();
    for (int it = bid; it < 4 * 96; it += nb) {
      const int l = it / 96, n0 = (it % 96) * 64;
      const int col4 = tid & 15, ks = tid >> 4;
      float acc[9][4];
#pragma unroll
      for (int m = 0; m < 9; ++m) { acc[m][0] = 0.f; acc[m][1] = 0.f; acc[m][2] = 0.f; acc[m][3] = 0.f; }
      const float* wp = p.w_ada + (size_t)l * 1024 * 6144 + n0 + 4 * col4;
      for (int kk = 0; kk < 32; ++kk) {
        const int k = ks * 32 + kk;
        const float4 w = *(const float4*)(wp + (size_t)k * 6144);
#pragma unroll
        for (int m = 0; m < 9; ++m) { const float s = sc[m * 1024 + k]; acc[m][0] += s * w.x; acc[m][1] += s * w.y; acc[m][2] += s * w.z; acc[m][3] += s * w.w; }
      }
#pragma unroll
      for (int m = 0; m < 9; ++m) {
        float* pp = part + (ks * 9 + m) * 64 + 4 * col4;
        pp[0] = acc[m][0]; pp[1] = acc[m][1]; pp[2] = acc[m][2]; pp[3] = acc[m][3];
      }
      __syncthreads();
      for (int i = tid; i < 9 * 64; i += NTHR) {
        const int m = i >> 6, cc = i & 63;
        float s = p.b_ada[l * 6144 + n0 + cc];
        for (int q = 0; q < 32; ++q) s += part[(q * 9 + m) * 64 + cc];
        p.mod[((size_t)l * 9 + m) * 6144 + n0 + cc] = s;
      }
      __syncthreads();
    }
  }
}

__device__ void phase_norm(const Params& p, int l, int which, int nrows, bf16_t* __restrict__ H) {
  const int wave = TID() >> 6, lane = TID() & 63;
  const float* gain = (which == 0 ? p.n1g : p.n2g) + l * 1024;
  const int sh_idx = which == 0 ? 0 : 3, sc_idx = which == 0 ? 1 : 4;
  for (int row = blockIdx.x * 8 + wave; row < nrows; row += gridDim.x * 8) {
    const float* xr = row < ML ? p.out + (size_t)row * D : p.Z + (size_t)(row - ML) * D;
    const int midx = row < ML ? (row >> 11) : 8;
    const float* md = p.mod + ((size_t)l * 9 + midx) * 6144;
    float4 v[4];
    float ss = 0.f;
#pragma unroll
    for (int i = 0; i < 4; ++i) { v[i] = *(const float4*)(xr + i * 256 + lane * 4); ss += v[i].x * v[i].x + v[i].y * v[i].y + v[i].z * v[i].z + v[i].w * v[i].w; }
    ss = wave_sum(ss);
    const float r = rsqrtf(ss * (1.f / 1024.f) + EPSN);
#pragma unroll
    for (int i = 0; i < 4; ++i) {
      const int col = i * 256 + lane * 4;
      const float4 g = *(const float4*)(gain + col);
      const float4 sh = *(const float4*)(md + sh_idx * 1024 + col);
      const float4 sc = *(const float4*)(md + sc_idx * 1024 + col);
      const float y0 = v[i].x * r * g.x * (1.f + sc.x) + sh.x;
      const float y1 = v[i].y * r * g.y * (1.f + sc.y) + sh.y;
      const float y2 = v[i].z * r * g.z * (1.f + sc.z) + sh.z;
      const float y3 = v[i].w * r * g.w * (1.f + sc.w) + sh.w;
      uint2 o; o.x = pack2(y0, y1); o.y = pack2(y2, y3);
      *(uint2*)(H + (size_t)row * D + col) = o;
    }
  }
}

#define LAS __attribute__((address_space(3)))
constexpr int BM = 256, BK = 64, HALF = 128, HTB = HALF * BK * 2, NXCD = 8, WGM = 8;
DI int lds_byte(int r, int c) { const int st = (r >> 4) * 2 + (c >> 5), rr = r & 15, cc = c & 31, ob = rr * 64 + cc * 2; return st * 1024 + (ob ^ (((ob >> 9) & 1) << 5)); }
DI void stage_rc(int b, int& R, int& C) { const int st = b / 1024, sb = b % 1024, swz = sb ^ (((sb >> 9) & 1) << 5); R = (st >> 1) * 16 + swz / 64; C = (st & 1) * 32 + (swz % 64) / 2; }

struct Unit { int pm, pn; };
struct TileOrder {
  int nM, nN, nwg, G, c;
  DI void init(int M, int N) { nM = M / BM; nN = N / BM; nwg = nM * nN; G = gridDim.x; c = blockIdx.x; }
  DI bool next(int i, Unit& u) const {
    const long L = (long)i * G + c; if (L >= nwg) return false;
    int wgid = (int)L; { const int q = nwg / NXCD, r = nwg % NXCD, xcd = wgid % NXCD, off = wgid / NXCD; wgid = (xcd < r ? xcd * (q + 1) : r * (q + 1) + (xcd - r) * q) + off; }
    const int nig = WGM * nN, gid = wgid / nig, fm = gid * WGM, gsz = (nM - fm) < WGM ? (nM - fm) : WGM;
    u.pm = fm + ((wgid % nig) % gsz); u.pn = (wgid % nig) / gsz; return true;
  }
};

enum { EPI_P = 0, EPI_RES = 1, EPI_SWIGLU = 2 };
struct EpiArgs { bf16_t* outb; int ld; float* xl; float* xz; const float* gate; };

template <int EPI>
DI void gemm_epilogue(const f32x4 (&acc)[2][2][4][2], const Unit& u, int wr, int wc, int fr, int fq, const EpiArgs& ea) {
  const int brow = u.pm * BM, bcol = u.pn * BM;
#pragma unroll
  for (int ai = 0; ai < 2; ++ai)
#pragma unroll
    for (int m = 0; m < 4; ++m) {
      const int row = brow + ai * HALF + wr * 64 + m * 16 + fr;
      if (EPI == EPI_P) {
#pragma unroll
        for (int bj = 0; bj < 2; ++bj)
#pragma unroll
          for (int n = 0; n < 2; ++n) {
            const int col = bcol + bj * HALF + wc * 32 + n * 16 + 4 * fq;
            const f32x4 a = acc[ai][bj][m][n];
            uint2 o; o.x = pack2(a[0], a[1]); o.y = pack2(a[2], a[3]);
            *(uint2*)(ea.outb + (size_t)row * ea.ld + col) = o;
          }
      } else if (EPI == EPI_RES) {
        float* xr = row < ML ? ea.xl + (size_t)row * D : ea.xz + (size_t)(row - ML) * D;
        const int midx = row < ML ? (row >> 11) : 8;
        const float* g = ea.gate + (size_t)midx * 6144;
#pragma unroll
        for (int bj = 0; bj < 2; ++bj)
#pragma unroll
          for (int n = 0; n < 2; ++n) {
            const int col = bcol + bj * HALF + wc * 32 + n * 16 + 4 * fq;
            const f32x4 a = acc[ai][bj][m][n];
            float4 xv = *(float4*)(xr + col);
            const float4 gv = *(const float4*)(g + col);
            xv.x += gv.x * a[0]; xv.y += gv.y * a[1]; xv.z += gv.z * a[2]; xv.w += gv.w * a[3];
            *(float4*)(xr + col) = xv;
          }
      } else {
#pragma unroll
        for (int n = 0; n < 2; ++n) {
          const int col = u.pn * HALF + wc * 32 + n * 16 + 4 * fq;
          const f32x4 g = acc[ai][0][m][n], up = acc[ai][1][m][n];
          uint2 o; o.x = pack2(siluf(g[0]) * up[0], siluf(g[1]) * up[1]); o.y = pack2(siluf(g[2]) * up[2], siluf(g[3]) * up[3]);
          *(uint2*)(ea.outb + (size_t)row * ea.ld + col) = o;
        }
      }
    }
}

template <int EPI>
DI void gemm_phase(const bf16_t* __restrict__ Ag, const bf16_t* __restrict__ Btg, int M, int N, int K, const EpiArgs ea) {
  LAS unsigned char* lds = (LAS unsigned char*)smem_raw;
  TileOrder S; S.init(M, N);
  const int tid = TID(), wid = __builtin_amdgcn_readfirstlane(tid >> 6), lane = tid & 63, wr = wid >> 2, wc = wid & 3, fr = lane & 15, fq = lane >> 4;
  const int nt = K / BK;
  unsigned voffA[2];
#pragma unroll
  for (int i = 0; i < 2; ++i) { int R, C; stage_rc(tid * 16 + i * 8192, R, C); voffA[i] = (unsigned)(R * K + C) * 2u; }
  const size_t kstep = (size_t)(BK * 2);
  const size_t hstep = (size_t)HALF * K * 2;
  const size_t tstep = 2 * hstep;
  const unsigned ldsw = (unsigned)wid * 1024u;
  const int aoff = lds_byte(wr * 64 + fr, fq * 8), boff = lds_byte(wc * 32 + fr, fq * 8);
#define G_SA(b, h) (((b) * 2 + (h)) * HTB)
#define G_SB(b, h) ((4 + (b) * 2 + (h)) * HTB)
#define G_STAGE(bufoff, gbase) do { _Pragma("unroll") for (int _i = 0; _i < 2; ++_i) \
    __builtin_amdgcn_global_load_lds((const unsigned*)((const char*)(gbase) + voffA[_i]), (LAS unsigned*)(lds + (bufoff) + ldsw + _i * 8192), 16, 0, 0); } while (0)
#define G_LDA(dst, b, h) do { _Pragma("unroll") for (int m = 0; m < 4; ++m) _Pragma("unroll") for (int k = 0; k < 2; ++k) dst[m][k] = *(const LAS bf16x8*)(lds + G_SA(b, h) + aoff + m * 2048 + k * 1024); } while (0)
#define G_LDB(dst, b, h) do { _Pragma("unroll") for (int n = 0; n < 2; ++n) _Pragma("unroll") for (int k = 0; k < 2; ++k) dst[n][k] = *(const LAS bf16x8*)(lds + G_SB(b, h) + boff + n * 2048 + k * 1024); } while (0)
#define G_MMA(ai, bj, At_, Bt_) do { __builtin_amdgcn_s_setprio(1); _Pragma("unroll") for (int m = 0; m < 4; ++m) _Pragma("unroll") for (int n = 0; n < 2; ++n) _Pragma("unroll") for (int k = 0; k < 2; ++k) \
    acc[ai][bj][m][n] = __builtin_amdgcn_mfma_f32_16x16x32_bf16(Bt_[n][k], At_[m][k], acc[ai][bj][m][n], 0, 0, 0); __builtin_amdgcn_s_setprio(0); } while (0)
#define G_WAIT_V(n) asm volatile("s_waitcnt vmcnt(" #n ")" ::: "memory")
#define G_WAIT_L(n) asm volatile("s_waitcnt lgkmcnt(" #n ")" ::: "memory")
#define G_BAR __builtin_amdgcn_s_barrier()
#define G_SCHED __builtin_amdgcn_sched_barrier(0)
  Unit cur, nxt; int ui = 0;
  if (S.next(0, cur)) {
    f32x4 acc[2][2][4][2];
#pragma unroll
    for (int a = 0; a < 2; ++a)
#pragma unroll
      for (int b = 0; b < 2; ++b)
#pragma unroll
        for (int m = 0; m < 4; ++m)
#pragma unroll
          for (int n = 0; n < 2; ++n) acc[a][b][m][n] = (f32x4){0.f, 0.f, 0.f, 0.f};
    bf16x8 At[4][2], B0[2][2], B1[2][2];
    const char* cA = (const char*)Ag + (size_t)cur.pm * tstep; const char* cB = (const char*)Btg + (size_t)cur.pn * tstep;
    G_STAGE(G_SB(0, 0), cB); G_STAGE(G_SA(0, 0), cA); G_STAGE(G_SB(0, 1), cB + hstep); G_STAGE(G_SA(0, 1), cA + hstep);
    if (wr == 1) G_BAR;
    G_WAIT_V(4); G_BAR;
    G_STAGE(G_SB(1, 0), cB + kstep); G_STAGE(G_SA(1, 0), cA + kstep); G_STAGE(G_SB(1, 1), cB + hstep + kstep);
    G_WAIT_V(6); G_BAR;
    for (;;) {
      const bool has_next = S.next(ui + 1, nxt);
      const char* nA = has_next ? (const char*)Ag + (size_t)nxt.pm * tstep : cA; const char* nB = has_next ? (const char*)Btg + (size_t)nxt.pn * tstep : cB;
      for (int t = 0; t < nt; t += 2) {
        const bool last = (t == nt - 2);
        const char* a1 = cA + (size_t)(t + 1) * kstep;
        const char* a2 = last ? nA : cA + (size_t)(t + 2) * kstep; const char* b2 = last ? nB : cB + (size_t)(t + 2) * kstep;
        const char* a3 = a2 + kstep; const char* b3 = b2 + kstep;
        G_LDB(B0, 0, 0); G_SCHED; G_LDA(At, 0, 0); G_STAGE(G_SA(1, 1), a1 + hstep);
        G_WAIT_L(8); G_BAR; G_WAIT_L(0); G_MMA(0, 0, At, B0); G_BAR; G_SCHED;
        G_LDB(B1, 0, 1); G_STAGE(G_SB(0, 0), b2);
        G_BAR; G_WAIT_L(0); G_MMA(0, 1, At, B1); G_BAR;
        G_LDA(At, 0, 1); G_STAGE(G_SA(0, 0), a2);
        G_BAR; G_WAIT_L(0); G_MMA(1, 0, At, B0); G_BAR; G_SCHED;
        G_STAGE(G_SB(0, 1), b2 + hstep);
        G_WAIT_V(6); G_BAR; G_MMA(1, 1, At, B1); G_BAR;
        G_LDB(B0, 1, 0); G_SCHED; G_LDA(At, 1, 0); G_STAGE(G_SA(0, 1), a2 + hstep);
        G_WAIT_L(8); G_BAR; G_WAIT_L(0); G_MMA(0, 0, At, B0); G_BAR; G_SCHED;
        G_LDB(B1, 1, 1); G_STAGE(G_SB(1, 0), b3);
        G_BAR; G_WAIT_L(0); G_MMA(0, 1, At, B1); G_BAR;
        G_LDA(At, 1, 1); G_STAGE(G_SA(1, 0), a3);
        G_BAR; G_WAIT_L(0); G_MMA(1, 0, At, B0); G_BAR; G_SCHED;
        G_STAGE(G_SB(1, 1), b3 + hstep);
        G_WAIT_V(6); G_BAR; G_MMA(1, 1, At, B1); G_BAR;
      }
      gemm_epilogue<EPI>(acc, cur, wr, wc, fr, fq, ea);
      if (!has_next) break;
#pragma unroll
      for (int a = 0; a < 2; ++a)
#pragma unroll
        for (int b = 0; b < 2; ++b)
#pragma unroll
          for (int m = 0; m < 4; ++m)
#pragma unroll
            for (int n = 0; n < 2; ++n) acc[a][b][m][n] = (f32x4){0.f, 0.f, 0.f, 0.f};
      cur = nxt; cA = nA; cB = nB; ++ui;
    }
    G_WAIT_V(0);
    if (wr == 0) G_BAR;
    G_BAR;
  }
#undef G_SA
#undef G_SB
#undef G_STAGE
#undef G_LDA
#undef G_LDB
#undef G_MMA
}

__device__ void phase_prep_even(const Params& p, int j) {
  const int wave = TID() >> 6, lane = TID() & 63, tid = TID();
  const float qscale = 0.125f * 1.44269504088896f;
  const float gq = p.qk_gain[j * 128 + lane], gk = p.qk_gain[j * 128 + 64 + lane];
  for (int row = blockIdx.x * 8 + wave; row < MT; row += gridDim.x * 8) {
    bf16_t* pr = p.P + (size_t)row * LDP_E;
    const bool lat = row < ML;
    const int t = row & 2047;
    const int pos = (lane < 32) ? (t >> 6) : (t & 63);
    const float cs = ROPE_CS[pos][lane & 15], sn = ROPE_SN[pos][lane & 15];
    float vals[16];
#pragma unroll
    for (int g = 0; g < 16; ++g) vals[g] = bf2f(pr[g * 64 + lane]);
#pragma unroll
    for (int g = 0; g < 16; ++g) {
      const float v = vals[g];
      const float ss = wave_sum(v * v);
      float y = v * rsqrtf(ss * (1.f / 64.f) + EPSN) * (g < 8 ? gq : gk);
      if (lat) {
        const float o = __shfl_xor(y, 16, 64);
        y = (lane & 16) ? (y * cs + o * sn) : (y * cs - o * sn);
      }
      if (g < 8) y *= qscale;
      pr[g * 64 + lane] = f2bf(y);
    }
  }
  bf16_t* ts = (bf16_t*)smem_raw;
  for (int it = blockIdx.x; it < NB * 4 * 36; it += gridDim.x) {
    const int kb = it % 36, h = (it / 36) & 3, b = it / 144;
    __syncthreads();
    {
      const int r = tid >> 3, ch = tid & 7;
      const int kk = kb * 64 + r;
      const int row = kk < TCX ? ML + b * TCX + kk : b * TL + (kk - TCX);
      const bf16_t* src = p.P + (size_t)row * LDP_E + 1024 + h * 128;
#pragma unroll
      for (int i = 0; i < 2; ++i) {
        const int c8 = (ch + i * 8) * 8;
        const uint4 v = *(const uint4*)(src + c8);
        unsigned* d = (unsigned*)(ts + r * 130 + c8);
        d[0] = v.x; d[1] = v.y; d[2] = v.z; d[3] = v.w;
      }
    }
    __syncthreads();
    {
      const int e = tid >> 2, kq = tid & 3;
      unsigned w[8];
#pragma unroll
      for (int i = 0; i < 8; ++i) {
        const unsigned lo = ts[(kq * 16 + 2 * i) * 130 + e], hi = ts[(kq * 16 + 2 * i + 1) * 130 + e];
        w[i] = lo | (hi << 16);
      }
      bf16_t* dst = p.Vt + ((size_t)(b * 4 + h) * 128 + e) * NKK + kb * 64 + kq * 16;
      *(uint4*)(dst) = make_uint4(w[0], w[1], w[2], w[3]);
      *(uint4*)(dst + 8) = make_uint4(w[4], w[5], w[6], w[7]);
    }
  }
  {
    float* wl = (float*)smem_raw;
    __syncthreads();
    for (int i = tid; i < 2 * 16 * 256; i += NTHR) wl[i] = p.w_gate_up[(size_t)j * 8192 + i];
    for (int i = tid; i < 512; i += NTHR) wl[8192 + i] = p.b_gate_up[j * 512 + i];
    __syncthreads();
    for (int row = blockIdx.x * 8 + wave; row < MT; row += gridDim.x * 8) {
      const bf16_t* pr = p.P + (size_t)row * LDP_E + 3072;
      const float lrv = lane < 32 ? bf2f(pr[lane]) : 0.f;
#pragma unroll
      for (int u = 0; u < 8; ++u) {
        const int col = u * 64 + lane;
        const int dr = col >> 8, cc = col & 255;
        float xg = wl[8192 + col];
#pragma unroll
        for (int rr = 0; rr < 16; ++rr) xg += __shfl(lrv, dr * 16 + rr, 64) * wl[(dr * 16 + rr) * 256 + cc];
        const float ls = fminf(xg, 0.f) - log1pf(__expf(-fabsf(xg)));
        p.Gk[(size_t)row * 512 + col] = ls * (1.f / 16.f);
      }
    }
  }
}

__device__ void attn_item(const Params& p, int item) {
  const int tid = TID(), wave = tid >> 6, lane = tid & 63, r = lane & 31, hh = lane >> 5;
  int b, hc, qrow0, krow_ctx, krow_lat, ntile;
  if (item < 512) { b = item >> 6; hc = (item >> 3) & 7; qrow0 = b * TL + (item & 7) * 256; ntile = 36; }
  else { const int i2 = item - 512; b = i2 >> 3; hc = i2 & 7; qrow0 = ML + b * TCX; ntile = 4; }
  krow_ctx = ML + b * TCX; krow_lat = b * TL;
  const int h = hc >> 1, c = hc & 1;
  bf16_t* Ksm = (bf16_t*)smem_raw;
  bf16_t* Vsm = (bf16_t*)(smem_raw + 2 * 9216);
  const int qrow = qrow0 + wave * 32 + r;
  bf16x8 qf[4];
#pragma unroll
  for (int s = 0; s < 4; ++s) qf[s] = *(const bf16x8*)(p.P + (size_t)qrow * LDP_E + hc * 64 + 16 * s + 8 * hh);
  f32x16 oacc[4];
#pragma unroll
  for (int eb = 0; eb < 4; ++eb)
#pragma unroll
    for (int i = 0; i < 16; ++i) oacc[eb][i] = 0.f;
  float mrun = -1e30f, lsum = 0.f;
  const int kkey = tid >> 3, kch = tid & 7;
  const int ve = tid >> 2, vch = tid & 3;
  const bf16_t* vbase = p.Vt + ((size_t)(b * 4 + h) * 128 + ve) * NKK + vch * 16;
  uint4 kreg, vreg0, vreg1;
  auto gload = [&](int t) {
    const int kk = t * 64 + kkey;
    const int row = kk < TCX ? krow_ctx + kk : krow_lat + (kk - TCX);
    kreg = *(const uint4*)(p.P + (size_t)row * LDP_E + 512 + hc * 64 + kch * 8);
    vreg0 = *(const uint4*)(vbase + t * 64);
    vreg1 = *(const uint4*)(vbase + t * 64 + 8);
  };
  auto sstore = [&](int buf) {
    *(uint4*)(Ksm + buf * 4608 + kkey * 72 + kch * 8) = kreg;
    uint2* d = (uint2*)(Vsm + buf * 8704 + ve * 68 + vch * 16);
    d[0] = make_uint2(vreg0.x, vreg0.y); d[1] = make_uint2(vreg0.z, vreg0.w);
    d[2] = make_uint2(vreg1.x, vreg1.y); d[3] = make_uint2(vreg1.z, vreg1.w);
  };
  __syncthreads();
  gload(0); sstore(0);
  __syncthreads();
  for (int t = 0; t < ntile; ++t) {
    const int buf = t & 1;
    if (t + 1 < ntile) gload(t + 1);
    const bf16_t* Kb = Ksm + buf * 4608;
    const bf16_t* Vb = Vsm + buf * 8704;
    f32x16 sacc[2];
#pragma unroll
    for (int kb = 0; kb < 2; ++kb) {
#pragma unroll
      for (int i = 0; i < 16; ++i) sacc[kb][i] = 0.f;
#pragma unroll
      for (int s = 0; s < 4; ++s) {
        const bf16x8 kf = *(const bf16x8*)(Kb + (32 * kb + r) * 72 + 16 * s + 8 * hh);
        sacc[kb] = __builtin_amdgcn_mfma_f32_32x32x16_bf16(kf, qf[s], sacc[kb], 0, 0, 0);
      }
    }
    float mx = sacc[0][0];
#pragma unroll
    for (int kb = 0; kb < 2; ++kb)
#pragma unroll
      for (int i = 0; i < 16; ++i) mx = fmaxf(mx, sacc[kb][i]);
    mx = fmaxf(mx, __shfl_xor(mx, 32, 64));
    if (__builtin_amdgcn_ballot_w64(mx > mrun + 8.f)) {
      const float mnew = fmaxf(mrun, mx);
      const float alpha = __builtin_amdgcn_exp2f(mrun - mnew);
      mrun = mnew;
      lsum *= alpha;
#pragma unroll
      for (int eb = 0; eb < 4; ++eb)
#pragma unroll
        for (int i = 0; i < 16; ++i) oacc[eb][i] *= alpha;
    }
    float ps = 0.f;
#pragma unroll
    for (int kb = 0; kb < 2; ++kb)
#pragma unroll
      for (int i = 0; i < 16; ++i) { const float pv = __builtin_amdgcn_exp2f(sacc[kb][i] - mrun); sacc[kb][i] = pv; ps += pv; }
    lsum += ps;
#pragma unroll
    for (int ks = 0; ks < 4; ++ks) {
      const int kb = ks >> 1, s2 = ks & 1;
      uint4 pu;
      pu.x = pack2(sacc[kb][8 * s2 + 0], sacc[kb][8 * s2 + 1]); pu.y = pack2(sacc[kb][8 * s2 + 2], sacc[kb][8 * s2 + 3]);
      pu.z = pack2(sacc[kb][8 * s2 + 4], sacc[kb][8 * s2 + 5]); pu.w = pack2(sacc[kb][8 * s2 + 6], sacc[kb][8 * s2 + 7]);
      const bf16x8 pf = __builtin_bit_cast(bf16x8, pu);
#pragma unroll
      for (int eb = 0; eb < 4; ++eb) {
        const s16x4 lo = *(const s16x4*)(Vb + (32 * eb + r) * 68 + 16 * ks + 4 * hh);
        const s16x4 hi = *(const s16x4*)(Vb + (32 * eb + r) * 68 + 16 * ks + 8 + 4 * hh);
        const bf16x8 vf = __builtin_shufflevector(lo, hi, 0, 1, 2, 3, 4, 5, 6, 7);
        oacc[eb] = __builtin_amdgcn_mfma_f32_32x32x16_bf16(vf, pf, oacc[eb], 0, 0, 0);
      }
    }
    if (t + 1 < ntile) sstore(buf ^ 1);
    __syncthreads();
  }
  lsum += __shfl_xor(lsum, 32, 64);
  const float inv = 1.f / lsum;
  bf16_t* orow = p.R1 + (size_t)qrow * D + c * 512 + h * 128;
#pragma unroll
  for (int eb = 0; eb < 4; ++eb)
#pragma unroll
    for (int g = 0; g < 4; ++g) {
      const int e = 32 * eb + 8 * g + 4 * hh;
      uint2 o; o.x = pack2(oacc[eb][4 * g] * inv, oacc[eb][4 * g + 1] * inv); o.y = pack2(oacc[eb][4 * g + 2] * inv, oacc[eb][4 * g + 3] * inv);
      *(uint2*)(orow + e) = o;
    }
}

template <int MODE>
__device__ void scan_item(const Params& p, int l, int item) {
  constexpr int DK = MODE ? 128 : 64, DVS = MODE ? 64 : 32, DP = NTHR / DVS, DPT = DK / DP, TC = 32;
  constexpr int NH = MODE ? 8 : 4, NSL = 128 / DVS, LDP = MODE ? LDP_O : LDP_E;
  const int j = l >> 1;
  const int sl = item % NSL, dir = (item / NSL) & 1, h = (item / (NSL * 2)) % NH, b = item / (NSL * 2 * NH);
  float* Qs = (float*)smem_raw; float* Ks = Qs + TC * DK; float* Ds = Ks + TC * DK; float* Vs = Ds + TC * DK; float* Os = Vs + TC * DVS; float* LB = Os + TC * DVS;
  const int tid = TID(), dpart = tid % DP, e = tid / DP;
  float S[DPT];
#pragma unroll
  for (int i = 0; i < DPT; ++i) S[i] = 0.f;
  __syncthreads();
  if (MODE == 1) {
    if (tid < 128) {
      const float* lr = p.lb_raw + (size_t)dir * 4 * 1024 + h * 128 + tid;
      const float r0 = lr[0], r1 = lr[1024], r2 = lr[2048], r3 = lr[3072];
      const float mx = fmaxf(fmaxf(r0, r1), fmaxf(r2, r3));
      const float e0 = __expf(r0 - mx), e1 = __expf(r1 - mx), e2 = __expf(r2 - mx), e3 = __expf(r3 - mx);
      const float inv = 1.f / (e0 + e1 + e2 + e3);
      float acc = 0.f;
      if (l >= 1) acc += e1;
      if (l >= 2) acc += e2;
      if (l >= 3) acc += e3;
      LB[tid] = acc * inv;
    }
  }
  bf16_t* Ro;
  int ldo, ocol;
  if (MODE == 0) { Ro = p.R2 + (size_t)dir * MT * 512; ldo = 512; ocol = h * 128 + sl * DVS; }
  else { Ro = dir ? p.R2 : p.R1; ldo = 1024; ocol = h * 128 + sl * DVS; }
  for (int chunk = 0; chunk < NKK / TC; ++chunk) {
    __syncthreads();
    for (int idx = tid; idx < TC * DK; idx += NTHR) {
      const int tt = idx / DK, d = idx % DK;
      const int n = chunk * TC + tt;
      int row;
      if (n < TCX) row = ML + b * TCX + (dir ? (TCX - 1 - n) : n); else row = b * TL + (dir ? (TL - 1 - (n - TCX)) : (n - TCX));
      const bf16_t* pr = p.P + (size_t)row * LDP;
      float q, k, dec;
      if (MODE == 0) {
        q = bf2f(pr[1536 + h * 64 + d]) * 0.125f;
        k = bf2f(pr[1792 + h * 64 + d]);
        const float* w = p.w_gate_up + ((size_t)(j * 2 + dir) * 16) * 256 + h * 64 + d;
        float xg = p.b_gate_up[(j * 2 + dir) * 256 + h * 64 + d];
#pragma unroll
        for (int rr = 0; rr < 16; ++rr) xg += bf2f(pr[3072 + dir * 16 + rr]) * w[rr * 256];
        const float ls = fminf(xg, 0.f) - log1pf(__expf(-fabsf(xg)));
        dec = __expf(ls * (1.f / 16.f));
      } else {
        q = siluf(bf2f(pr[h * 128 + d])) * 0.08838834764831845f;
        const float lbv = LB[d];
        const float f = lbv + (1.f - lbv) * sigmoidf_(bf2f(pr[1024 + dir * 1024 + h * 128 + d]));
        k = 1.f - f; dec = f;
      }
      Qs[idx] = q; Ks[idx] = k; Ds[idx] = dec;
    }
    for (int idx = tid; idx < TC * DVS; idx += NTHR) {
      const int tt = idx / DVS, ee = idx % DVS;
      const int n = chunk * TC + tt;
      int row;
      if (n < TCX) row = ML + b * TCX + (dir ? (TCX - 1 - n) : n); else row = b * TL + (dir ? (TL - 1 - (n - TCX)) : (n - TCX));
      const bf16_t* pr = p.P + (size_t)row * LDP;
      Vs[idx] = bf2f(pr[(MODE ? 3072 : 2048) + h * 128 + sl * DVS + ee]);
    }
    __syncthreads();
    for (int tt = 0; tt < TC; ++tt) {
      const float v = Vs[tt * DVS + e];
      float part = 0.f;
#pragma unroll
      for (int i4 = 0; i4 < DPT / 4; ++i4) {
        const float4 q4 = *(const float4*)(Qs + tt * DK + dpart * DPT + i4 * 4);
        const float4 k4 = *(const float4*)(Ks + tt * DK + dpart * DPT + i4 * 4);
        const float4 d4 = *(const float4*)(Ds + tt * DK + dpart * DPT + i4 * 4);
        S[i4 * 4 + 0] = S[i4 * 4 + 0] * d4.x + k4.x * v; part += q4.x * S[i4 * 4 + 0];
        S[i4 * 4 + 1] = S[i4 * 4 + 1] * d4.y + k4.y * v; part += q4.y * S[i4 * 4 + 1];
        S[i4 * 4 + 2] = S[i4 * 4 + 2] * d4.z + k4.z * v; part += q4.z * S[i4 * 4 + 2];
        S[i4 * 4 + 3] = S[i4 * 4 + 3] * d4.w + k4.w * v; part += q4.w * S[i4 * 4 + 3];
      }
#pragma unroll
      for (int o = DP / 2; o >= 1; o >>= 1) part += __shfl_xor(part, o, 64);
      if (dpart == 0) Os[tt * DVS + e] = part;
    }
    __syncthreads();
    for (int idx = tid; idx < TC * DVS; idx += NTHR) {
      const int tt = idx / DVS, ee = idx % DVS;
      const int n = chunk * TC + tt;
      int row;
      if (n < TCX) row = ML + b * TCX + (dir ? (TCX - 1 - n) : n); else row = b * TL + (dir ? (TL - 1 - (n - TCX)) : (n - TCX));
      Ro[(size_t)row * ldo + ocol + ee] = f2bf(Os[idx]);
    }
  }
}

template <int MODE>
__device__ void scan2_item(const Params& p, int l, int item) {
  constexpr int DK = MODE ? 128 : 64, NH = MODE ? 8 : 4, LDP = MODE ? LDP_O : LDP_E, NDB = DK / 16, QS = DK + 8, TS = 72;
  const int dir = item & 1, h = (item >> 1) % NH, b = item / (2 * NH);
  bf16_t* Qh = (bf16_t*)smem_raw; bf16_t* Kh = Qh + 64 * QS; bf16_t* KbT = Kh + 64 * QS; bf16_t* VT = KbT + DK * TS; float* ET = (float*)(VT + 128 * TS);
  const int tid = TID(), wave = __builtin_amdgcn_readfirstlane(tid >> 6), lane = tid & 63, r15 = lane & 15, fq = lane >> 4;
  const int pd = tid % DK, pi = __builtin_amdgcn_readfirstlane(tid / DK);
  const bool pact = pi < 4;
  const int ve = tid & 127, vi = __builtin_amdgcn_readfirstlane(tid >> 7);
  float lbv = 0.f;
  if (MODE == 1) {
    const float* lr = p.lb_raw + (size_t)dir * 4 * 1024 + h * 128 + pd;
    const float r0 = lr[0], r1 = lr[1024], r2 = lr[2048], r3 = lr[3072];
    const float mx = fmaxf(fmaxf(r0, r1), fmaxf(r2, r3));
    const float e0 = __expf(r0 - mx), e1 = __expf(r1 - mx), e2 = __expf(r2 - mx), e3 = __expf(r3 - mx);
    float a = 0.f;
    if (l >= 1) a += e1;
    if (l >= 2) a += e2;
    if (l >= 3) a += e3;
    lbv = a / (e0 + e1 + e2 + e3);
  }
  const int qcol = MODE ? h * 128 + pd : 1536 + h * 64 + pd;
  const int kcol = MODE ? 1024 + dir * 1024 + h * 128 + pd : 1792 + h * 64 + pd;
  const int vcol = (MODE ? 3072 : 2048) + h * 128 + ve;
  const int gcol = dir * 256 + h * 64 + pd;
  bf16_t* Ro; int ldo;
  if (MODE == 0) { Ro = p.R2 + (size_t)dir * MT * 512; ldo = 512; } else { Ro = dir ? p.R2 : p.R1; ldo = 1024; }
  Ro += h * 128 + 16 * wave + r15;
  const int rowc = ML + b * TCX, rowl = b * TL;
  auto tokrow = [&](int n) -> int { return n < TCX ? rowc + (dir ? (TCX - 1 - n) : n) : rowl + (dir ? (TL - 1 - (n - TCX)) : (n - TCX)); };
  bf16_t rq[16], rk[16], rv[16]; float rg[16];
  auto load_raw = [&](int ck) {
#pragma unroll
    for (int tt = 0; tt < 16; ++tt) {
      if (pact) {
        const int row = tokrow(ck * 64 + 16 * pi + tt);
        const bf16_t* pr = p.P + (size_t)row * LDP;
        rq[tt] = pr[qcol]; rk[tt] = pr[kcol];
#if EXP2
        if (MODE == 0) {
          const int jx = l >> 1;
          const float* w = p.w_gate_up + ((size_t)(jx * 2 + dir) * 16) * 256 + h * 64 + pd;
          float xg = p.b_gate_up[(jx * 2 + dir) * 256 + h * 64 + pd];
#pragma unroll
          for (int rr = 0; rr < 16; ++rr) xg += bf2f(pr[3072 + dir * 16 + rr]) * w[rr * 256];
          const float ls = fminf(xg, 0.f) - log1pf(__expf(-fabsf(xg)));
          rg[tt] = ls * (1.f / 16.f);
        }
#else
        if (MODE == 0) rg[tt] = p.Gk[(size_t)row * 512 + gcol];
#endif
      }
      const int rowv = tokrow(ck * 64 + 16 * vi + tt);
      rv[tt] = p.P[(size_t)rowv * LDP + vcol];
    }
  };
  f32x4 S[NDB];
#pragma unroll
  for (int db = 0; db < NDB; ++db) S[db] = (f32x4){0.f, 0.f, 0.f, 0.f};
  load_raw(0);
  for (int ck = 0; ck < NKK / 64; ++ck) {
    __syncthreads();
    if (pact) {
      float c = 0.f, cc[16], kk[16];
#pragma unroll
      for (int tt = 0; tt < 16; ++tt) {
        float q, k, g;
        if (MODE == 1) {
          q = siluf(bf2f(rq[tt])) * 0.08838834764831845f;
          const float f = lbv + (1.f - lbv) * sigmoidf_(bf2f(rk[tt]));
          k = 1.f - f; g = __logf(f);
        } else { q = bf2f(rq[tt]) * 0.125f; k = bf2f(rk[tt]); g = rg[tt]; }
        c += g; cc[tt] = c; kk[tt] = k;
        Qh[(16 * pi + tt) * QS + pd] = f2bf(q * __expf(c));
        Kh[(16 * pi + tt) * QS + pd] = f2bf(k * __expf(fminf(-c, 80.f)));
      }
      ET[pi * DK + pd] = __expf(c);
      unsigned w[8];
#pragma unroll
      for (int u = 0; u < 8; ++u) w[u] = pack2(kk[2 * u] * __expf(c - cc[2 * u]), kk[2 * u + 1] * __expf(c - cc[2 * u + 1]));
      *(uint4*)(KbT + pd * TS + 16 * pi) = make_uint4(w[0], w[1], w[2], w[3]);
      *(uint4*)(KbT + pd * TS + 16 * pi + 8) = make_uint4(w[4], w[5], w[6], w[7]);
    }
    {
      unsigned w[8];
#pragma unroll
      for (int u = 0; u < 8; ++u) w[u] = (unsigned)rv[2 * u] | ((unsigned)rv[2 * u + 1] << 16);
      *(uint4*)(VT + ve * TS + 16 * vi) = make_uint4(w[0], w[1], w[2], w[3]);
      *(uint4*)(VT + ve * TS + 16 * vi + 8) = make_uint4(w[4], w[5], w[6], w[7]);
    }
    __syncthreads();
    if (ck + 1 < NKK / 64) load_raw(ck + 1);
#pragma unroll
    for (int i = 0; i < 4; ++i) {
      f32x4 att = (f32x4){0.f, 0.f, 0.f, 0.f};
#pragma unroll
      for (int kb = 0; kb < DK / 32; ++kb) {
        const bf16x8 ka = *(const bf16x8*)(Kh + (16 * i + r15) * QS + 32 * kb + 8 * fq);
        const bf16x8 qb = *(const bf16x8*)(Qh + (16 * i + r15) * QS + 32 * kb + 8 * fq);
        att = __builtin_amdgcn_mfma_f32_16x16x32_bf16(ka, qb, att, 0, 0, 0);
      }
      s16x4 a4;
#pragma unroll
      for (int jj = 0; jj < 4; ++jj) a4[jj] = (4 * fq + jj <= r15) ? (short)f2bf(att[jj]) : (short)0;
      f32x4 o = (f32x4){0.f, 0.f, 0.f, 0.f};
#pragma unroll
      for (int kb = 0; kb < DK / 32; ++kb) {
        const s16x4 qlo = *(const s16x4*)(Qh + (16 * i + r15) * QS + 32 * kb + 4 * fq);
        const s16x4 qhi = *(const s16x4*)(Qh + (16 * i + r15) * QS + 32 * kb + 16 + 4 * fq);
        const bf16x8 qa = __builtin_shufflevector(qlo, qhi, 0, 1, 2, 3, 4, 5, 6, 7);
        bf16x8 sb;
#pragma unroll
        for (int jj = 0; jj < 4; ++jj) { sb[jj] = (short)f2bf(S[2 * kb][jj]); sb[4 + jj] = (short)f2bf(S[2 * kb + 1][jj]); }
        o = __builtin_amdgcn_mfma_f32_16x16x32_bf16(qa, sb, o, 0, 0, 0);
      }
      const s16x4 vb = *(const s16x4*)(VT + (16 * wave + r15) * TS + 16 * i + 4 * fq);
      const s16x4 z4 = (s16x4){0, 0, 0, 0};
      const bf16x8 vb8 = __builtin_shufflevector(vb, z4, 0, 1, 2, 3, 4, 5, 6, 7);
      o = __builtin_amdgcn_mfma_f32_16x16x32_bf16(__builtin_shufflevector(a4, z4, 0, 1, 2, 3, 4, 5, 6, 7), vb8, o, 0, 0, 0);
#pragma unroll
      for (int jj = 0; jj < 4; ++jj) {
        const int row = tokrow(ck * 64 + 16 * i + 4 * fq + jj);
        Ro[(size_t)row * ldo] = f2bf(o[jj]);
      }
#pragma unroll
      for (int db = 0; db < NDB; ++db) {
        const float4 et = *(const float4*)(ET + i * DK + 16 * db + 4 * fq);
        f32x4 s = S[db];
        s[0] *= et.x; s[1] *= et.y; s[2] *= et.z; s[3] *= et.w;
        const s16x4 ka = *(const s16x4*)(KbT + (16 * db + r15) * TS + 16 * i + 4 * fq);
        S[db] = __builtin_amdgcn_mfma_f32_16x16x32_bf16(__builtin_shufflevector(ka, z4, 0, 1, 2, 3, 4, 5, 6, 7), vb8, s, 0, 0, 0);
      }
    }
  }
}

__device__ void phase_post_even(const Params& p, int l) {
  const int j = l >> 1;
  const int wave = TID() >> 6, lane = TID() & 63;
  const float lambda_init = 0.8f - 0.6f * expf(-0.3f * (float)l);
  const float* la = p.lambda_a + j * 256;
  const float s1 = wave_sum(la[lane] * la[64 + lane]);
  const float s2 = wave_sum(la[128 + lane] * la[192 + lane]);
  const float lam = expf(s1) - expf(s2) + lambda_init;
  const float ga0 = p.subln[j * 128 + 2 * lane] * (1.f - lambda_init), ga1 = p.subln[j * 128 + 2 * lane + 1] * (1.f - lambda_init);
  const float gb0 = p.onorm_b[j * 128 + 2 * lane], gb1 = p.onorm_b[j * 128 + 2 * lane + 1];
  for (int row = blockIdx.x * 8 + wave; row < MT; row += gridDim.x * 8) {
    bf16_t* r1 = p.R1 + (size_t)row * D;
    const bf16_t* r2f = p.R2 + (size_t)row * 512;
    const bf16_t* r2b = p.R2 + (size_t)MT * 512 + (size_t)row * 512;
    const bf16_t* pg = p.P + (size_t)row * LDP_E + 2560;
    unsigned a1[4], a2[4], bf_[4], bb_[4], gg[4];
#pragma unroll
    for (int h = 0; h < 4; ++h) {
      a1[h] = *(const unsigned*)(r1 + h * 128 + 2 * lane);
      a2[h] = *(const unsigned*)(r1 + 512 + h * 128 + 2 * lane);
      bf_[h] = *(const unsigned*)(r2f + h * 128 + 2 * lane);
      bb_[h] = *(const unsigned*)(r2b + h * 128 + 2 * lane);
      gg[h] = *(const unsigned*)(pg + h * 128 + 2 * lane);
    }
    unsigned oa[4], ob[4];
#pragma unroll
    for (int h = 0; h < 4; ++h) {
      const float x0 = bf2f((bf16_t)(a1[h] & 0xffff)) - lam * bf2f((bf16_t)(a2[h] & 0xffff));
      const float x1 = bf2f((bf16_t)(a1[h] >> 16)) - lam * bf2f((bf16_t)(a2[h] >> 16));
      const float ra = rsqrtf(wave_sum(x0 * x0 + x1 * x1) * (1.f / 128.f) + EPSN);
      oa[h] = pack2(x0 * ra * ga0, x1 * ra * ga1);
      const float y0 = bf2f((bf16_t)(bf_[h] & 0xffff)) + bf2f((bf16_t)(bb_[h] & 0xffff));
      const float y1 = bf2f((bf16_t)(bf_[h] >> 16)) + bf2f((bf16_t)(bb_[h] >> 16));
      const float rb = rsqrtf(wave_sum(y0 * y0 + y1 * y1) * (1.f / 128.f) + EPSN);
      const float g0 = bf2f((bf16_t)(gg[h] & 0xffff)), g1 = bf2f((bf16_t)(gg[h] >> 16));
      ob[h] = pack2(y0 * rb * gb0 * siluf(g0), y1 * rb * gb1 * siluf(g1));
    }
#pragma unroll
    for (int h = 0; h < 4; ++h) {
      *(unsigned*)(r1 + h * 128 + 2 * lane) = oa[h];
      *(unsigned*)(r1 + 512 + h * 128 + 2 * lane) = ob[h];
    }
  }
}

__device__ void phase_post_odd(const Params& p, int l) {
  const int j = l >> 1;
  const int wave = TID() >> 6, lane = TID() & 63;
  const float g0 = p.onorm_c[j * 128 + 2 * lane], g1 = p.onorm_c[j * 128 + 2 * lane + 1];
  for (int row = blockIdx.x * 8 + wave; row < MT; row += gridDim.x * 8) {
    bf16_t* r1 = p.R1 + (size_t)row * D;
    const bf16_t* r2 = p.R2 + (size_t)row * D;
    const bf16_t* pg = p.P + (size_t)row * LDP_O + 4096;
    unsigned a[8], bq[8], gg[8];
#pragma unroll
    for (int h = 0; h < 8; ++h) {
      a[h] = *(const unsigned*)(r1 + h * 128 + 2 * lane);
      bq[h] = *(const unsigned*)(r2 + h * 128 + 2 * lane);
      gg[h] = *(const unsigned*)(pg + h * 128 + 2 * lane);
    }
    unsigned o[8];
#pragma unroll
    for (int h = 0; h < 8; ++h) {
      const float y0 = bf2f((bf16_t)(a[h] & 0xffff)) + bf2f((bf16_t)(bq[h] & 0xffff));
      const float y1 = bf2f((bf16_t)(a[h] >> 16)) + bf2f((bf16_t)(bq[h] >> 16));
      const float rb = rsqrtf(wave_sum(y0 * y0 + y1 * y1) * (1.f / 128.f) + EPSN);
      const float q0 = bf2f((bf16_t)(gg[h] & 0xffff)), q1 = bf2f((bf16_t)(gg[h] >> 16));
      o[h] = pack2(y0 * rb * g0 * siluf(q0), y1 * rb * g1 * siluf(q1));
    }
#pragma unroll
    for (int h = 0; h < 8; ++h) *(unsigned*)(r1 + h * 128 + 2 * lane) = o[h];
  }
}

constexpr int NPHASE = 1 + 4 * 9;
#ifndef GEMM_INL
#define GEMM_INL
#endif
__device__ GEMM_INL void gemm_call_p(const bf16_t* A, const bf16_t* Bt, int M, int N, int K, EpiArgs ea) { gemm_phase<EPI_P>(A, Bt, M, N, K, ea); }
__device__ GEMM_INL void gemm_call_res(const bf16_t* A, const bf16_t* Bt, int M, int N, int K, EpiArgs ea) { gemm_phase<EPI_RES>(A, Bt, M, N, K, ea); }
__device__ GEMM_INL void gemm_call_sw(const bf16_t* A, const bf16_t* Bt, int M, int N, int K, EpiArgs ea) { gemm_phase<EPI_SWIGLU>(A, Bt, M, N, K, ea); }

__device__ void run_phase(const Params& p, int ph) {
  if (ph == 0) { phase_init(p); return; }
  const int l = (ph - 1) / 9, s = (ph - 1) % 9, j = l >> 1;
  const bool even = (l & 1) == 0;
  const int mrows = l < 3 ? MT : ML;
  const float* modl = p.mod + (size_t)l * 9 * 6144;
  if (s == 1 || s == 5 || s == 8) {
    if (s == 1) {
      EpiArgs ea{p.P, even ? LDP_E : LDP_O, nullptr, nullptr, nullptr};
      const bf16_t* Bt = even ? p.wt_in_even + (size_t)j * LDP_E * 1024 : p.wt_in_odd + (size_t)j * LDP_O * 1024;
      gemm_call_p(p.R1, Bt, MT, even ? LDP_E : LDP_O, 1024, ea);
    } else {
      EpiArgs ea{nullptr, 0, p.out, p.Z, modl + (s == 5 ? 2 : 5) * 1024};
      const bf16_t* A = s == 5 ? p.R1 : p.P;
      const bf16_t* Bt = s == 5 ? (even ? p.wt_out_even : p.wt_out_odd) + (size_t)j * 1024 * 1024 : p.wt_ffn_out + (size_t)l * 1024 * DFF;
      gemm_call_res(A, Bt, mrows, 1024, s == 5 ? 1024 : DFF, ea);
    }
    return;
  }
  switch (s) {
    case 0: phase_norm(p, l, 0, MT, p.R1); break;
    case 2: if (even) phase_prep_even(p, j); break;
    case 3: {
      if (even) {
#if DYNQ
        int* qs = (int*)(smem_raw + 131072 - 16);
        for (;;) {
          __syncthreads();
          if (TID() == 0) *qs = (int)atomicAdd(p.ctr + l, 1u);
          __syncthreads();
          const int it = *qs;
          if (it >= 64 + 576) break;
          if (it < 64) scan2_item<0>(p, l, it); else attn_item(p, it - 64);
        }
#else
#if EXP1
        for (int it = blockIdx.x; it < 256 + 576; it += gridDim.x) { if (it < 256) scan_item<0>(p, l, it); else attn_item(p, it - 256); }
#else
        for (int it = blockIdx.x; it < 64 + 576; it += gridDim.x) { if (it < 64) scan2_item<0>(p, l, it); else attn_item(p, it - 64); }
#endif
#endif
      } else {
        for (int it = blockIdx.x; it < 128; it += gridDim.x) scan2_item<1>(p, l, it);
      }
    } break;
    case 4: if (even) phase_post_even(p, l); else phase_post_odd(p, l); break;
    case 6: phase_norm(p, l, 1, mrows, p.R2); break;
    case 7: {
      EpiArgs ea{p.P, DFF, nullptr, nullptr, nullptr};
      gemm_call_sw(p.R2, p.wt_ffn_in + (size_t)l * 5632 * 1024, mrows, 5632, 1024, ea);
    } break;
  }
}

__global__ void __launch_bounds__(NTHR, 2) mega_kernel(Params p, int ph0, int ph1) {
  cg::grid_group grid = cg::this_grid();
  for (int ph = ph0; ph < ph1; ++ph) {
#if DBL_MASK
    { const int s_ = ph == 0 ? 9 : (ph - 1) % 9; const int nrep = ((DBL_MASK >> s_) & 1) ? 2 : 1; for (int rep = 0; rep < nrep; ++rep) run_phase(p, ph); }
#else
    run_phase(p, ph);
#endif
    if (ph + 1 < ph1) grid.sync();
  }
}

extern "C" void kernel_launch(void* const* d_in, const int* in_sizes, int n_in, void* d_out, int out_size, void* d_ws, size_t ws_size, hipStream_t stream) {
  constexpr size_t kDynLds = 131072;
  static int grid_blocks = 0;
  if (!grid_blocks) {
    hipFuncSetAttribute((const void*)mega_kernel, hipFuncAttributeMaxDynamicSharedMemorySize, (int)kDynLds);
    int dev = 0, cus = 0, per_cu = 0;
    hipGetDevice(&dev);
    hipDeviceGetAttribute(&cus, hipDeviceAttributeMultiprocessorCount, dev);
    hipOccupancyMaxActiveBlocksPerMultiprocessor(&per_cu, mega_kernel, NTHR, kDynLds);
    if (per_cu < 1) per_cu = 1;
    grid_blocks = cus * per_cu;
  }
  Params p{};
  const float* const* in = (const float* const*)d_in;
  p.x = in[0]; p.c = in[1]; p.ctx = in[2]; p.c_ctx = in[3]; p.w_ada = in[4]; p.b_ada = in[5]; p.n1g = in[6]; p.n2g = in[7];
  p.w_in_even = in[8]; p.qk_gain = in[9]; p.lambda_a = in[10]; p.subln = in[11]; p.w_gate_up = in[12]; p.b_gate_up = in[13];
  p.onorm_b = in[14]; p.w_out_even = in[15]; p.w_in_odd = in[16]; p.lb_raw = in[17]; p.onorm_c = in[18]; p.w_out_odd = in[19];
  p.w_ffn_in = in[20]; p.w_ffn_out = in[21];
  p.out = (float*)d_out;
  char* w = (char*)d_ws;
  size_t off = 0;
  auto take = [&](size_t bytes) { char* r = w + off; off += (bytes + 255) & ~(size_t)255; return r; };
  p.wt_in_even = (bf16_t*)take((size_t)2 * LDP_E * 1024 * 2);
  p.wt_in_odd = (bf16_t*)take((size_t)2 * LDP_O * 1024 * 2);
  p.wt_out_even = (bf16_t*)take((size_t)2 * 1024 * 1024 * 2);
  p.wt_out_odd = (bf16_t*)take((size_t)2 * 1024 * 1024 * 2);
  p.wt_ffn_in = (bf16_t*)take((size_t)4 * 5632 * 1024 * 2);
  p.wt_ffn_out = (bf16_t*)take((size_t)4 * 1024 * DFF * 2);
  p.Z = (float*)take((size_t)MC * D * 4);
  p.mod = (float*)take((size_t)4 * 9 * 6144 * 4);
  p.P = (bf16_t*)take((size_t)MT * LDP_O * 2);
  p.R1 = (bf16_t*)take((size_t)MT * D * 2);
  p.R2 = (bf16_t*)take((size_t)MT * D * 2);
  p.Vt = p.P + (size_t)MT * LDP_E;
  p.Gk = (float*)(p.Vt + (size_t)NB * 4 * 128 * NKK);
  p.ctr = (unsigned*)take(256);
  if (off > ws_size) { fprintf(stderr, "workspace too small: need %zu have %zu\n", off, ws_size); return; }
#if ONE_LAUNCH
  int ph0 = 0, ph1 = NPHASE;
  void* args[] = {&p, &ph0, &ph1};
  hipError_t e = hipLaunchCooperativeKernel((const void*)mega_kernel, dim3(grid_blocks), dim3(NTHR), args, kDynLds, stream);
  if (e != hipSuccess) fprintf(stderr, "cooperative launch failed: %s (grid %d)\n", hipGetErrorString(e), grid_blocks);
#else
  for (int ph = 0; ph < NPHASE; ++ph) {
    const int l = (ph - 1) / 9, s = (ph - 1) % 9;
    if (ph > 0 && s == 2 && (l & 1)) continue;
    mega_kernel<<<grid_blocks, NTHR, kDynLds, stream>>>(p, ph, ph + 1);
  }
#endif
}
```

```cpp
#include <hip/hip_runtime.h>
#include <hip/hip_cooperative_groups.h>
#include <cstdio>
namespace cg = cooperative_groups;

#ifndef DYNQ
#define DYNQ 1
#endif
#ifndef EXP1
#define EXP1 0
#endif
#ifndef EXP2
#define EXP2 0
#endif
#ifndef DBL_MASK
#define DBL_MASK 0
#endif
#ifndef ONE_LAUNCH
#define ONE_LAUNCH 1
#endif

typedef unsigned short bf16_t;
typedef short bf16x8 __attribute__((ext_vector_type(8)));
typedef short s16x4 __attribute__((ext_vector_type(4)));
typedef float f32x4 __attribute__((ext_vector_type(4)));
typedef float f32x16 __attribute__((ext_vector_type(16)));
#define DI __device__ __forceinline__

__device__ const float ROPE_CS[64][16] = {
  {1.00000000e+00f,1.00000000e+00f,1.00000000e+00f,1.00000000e+00f,1.00000000e+00f,1.00000000e+00f,1.00000000e+00f,1.00000000e+00f,1.00000000e+00f,1.00000000e+00f,1.00000000e+00f,1.00000000e+00f,1.00000000e+00f,1.00000000e+00f,1.00000000e+00f,1.00000000e+00f},
  {5.40302277e-01f,8.46009135e-01f,9.50415254e-01f,9.84230220e-01f,9.95004177e-01f,9.98419285e-01f,9.99500036e-01f,9.99841869e-01f,9.99949992e-01f,9.99984205e-01f,9.99994993e-01f,9.99998391e-01f,9.99999523e-01f,9.99999821e-01f,9.99999940e-01f,1.00000000e+00f},
  {-4.16146845e-01f,4.31462824e-01f,8.06578398e-01f,9.37418282e-01f,9.80066597e-01f,9.93682086e-01f,9.98000681e-01f,9.99367595e-01f,9.99800026e-01f,9.99936759e-01f,9.99979973e-01f,9.99993682e-01f,9.99997973e-01f,9.99999344e-01f,9.99999821e-01f,9.99999940e-01f},
  {-9.89992499e-01f,-1.15966164e-01f,5.82753658e-01f,8.61040652e-01f,9.55336511e-01f,9.85803485e-01f,9.95503366e-01f,9.98577297e-01f,9.99550045e-01f,9.99857724e-01f,9.99954998e-01f,9.99985754e-01f,9.99995530e-01f,9.99998569e-01f,9.99999523e-01f,9.99999881e-01f},
  {-6.53643608e-01f,-6.27679706e-01f,3.01137477e-01f,7.57506192e-01f,9.21060979e-01f,9.74808276e-01f,9.92010653e-01f,9.97471273e-01f,9.99200106e-01f,9.99747038e-01f,9.99920011e-01f,9.99974728e-01f,9.99992013e-01f,9.99997497e-01f,9.99999225e-01f,9.99999762e-01f},
  {2.83662200e-01f,-9.46079254e-01f,-1.03423381e-02f,6.30080283e-01f,8.77582550e-01f,9.60731268e-01f,9.87526000e-01f,9.96049762e-01f,9.98750269e-01f,9.99604762e-01f,9.99875009e-01f,9.99960482e-01f,9.99987483e-01f,9.99996066e-01f,9.99998748e-01f,9.99999583e-01f},
  {9.60170269e-01f,-9.73103702e-01f,-3.20796400e-01f,4.82782036e-01f,8.25335622e-01f,9.43616986e-01f,9.82053936e-01f,9.94313300e-01f,9.98200536e-01f,9.99430835e-01f,9.99819994e-01f,9.99943078e-01f,9.99981999e-01f,9.99994338e-01f,9.99998212e-01f,9.99999404e-01f},
  {7.53902256e-01f,-7.00429797e-01f,-5.99437475e-01f,3.20257008e-01f,7.64842212e-01f,9.23519433e-01f,9.75599885e-01f,9.92262423e-01f,9.97551024e-01f,9.99225318e-01f,9.99755025e-01f,9.99922514e-01f,9.99975502e-01f,9.99992251e-01f,9.99997556e-01f,9.99999225e-01f},
  {-1.45500034e-01f,-2.12036446e-01f,-8.18632424e-01f,1.47631213e-01f,6.96706712e-01f,9.00502324e-01f,9.68170285e-01f,9.89897788e-01f,9.96801734e-01f,9.98988271e-01f,9.99680042e-01f,9.99898791e-01f,9.99967992e-01f,9.99989867e-01f,9.99996781e-01f,9.99998987e-01f},
  {-9.11130250e-01f,3.41660261e-01f,-9.56644177e-01f,-2.96507962e-02f,6.21609926e-01f,8.74638259e-01f,9.59772646e-01f,9.87220109e-01f,9.95952725e-01f,9.98719573e-01f,9.99595046e-01f,9.99871910e-01f,9.99959528e-01f,9.99987185e-01f,9.99995947e-01f,9.99998748e-01f},
  {-8.39071512e-01f,7.90131867e-01f,-9.99786079e-01f,-2.05997631e-01f,5.40302277e-01f,8.46009135e-01f,9.50415313e-01f,9.84230220e-01f,9.95004177e-01f,9.98419285e-01f,9.99500036e-01f,9.99841869e-01f,9.99949992e-01f,9.99984205e-01f,9.99994993e-01f,9.99998391e-01f},
  {4.42569796e-03f,9.95257378e-01f,-9.43779767e-01f,-3.75847399e-01f,4.53596085e-01f,8.14705312e-01f,9.40107584e-01f,9.80929136e-01f,9.93956089e-01f,9.98087406e-01f,9.99395072e-01f,9.99808669e-01f,9.99939501e-01f,9.99980867e-01f,9.99993920e-01f,9.99998093e-01f},
  {8.43853951e-01f,8.93861592e-01f,-7.94179380e-01f,-5.33843040e-01f,3.62357706e-01f,7.80825913e-01f,9.28859890e-01f,9.77317870e-01f,9.92808640e-01f,9.97723997e-01f,9.99280095e-01f,9.99772310e-01f,9.99927998e-01f,9.99977231e-01f,9.99992788e-01f,9.99997735e-01f},
  {9.07446802e-01f,5.17172873e-01f,-5.65820515e-01f,-6.75001681e-01f,2.67498761e-01f,7.44477987e-01f,9.16683376e-01f,9.73397553e-01f,9.91561890e-01f,9.97329056e-01f,9.99155104e-01f,9.99732792e-01f,9.99915481e-01f,9.99973297e-01f,9.99991536e-01f,9.99997318e-01f},
  {1.36737213e-01f,-1.87961515e-02f,-2.81349480e-01f,-7.94870913e-01f,1.69967160e-01f,7.05776393e-01f,9.03590262e-01f,9.69169438e-01f,9.90216017e-01f,9.96902585e-01f,9.99020159e-01f,9.99690115e-01f,9.99902010e-01f,9.99969006e-01f,9.99990225e-01f,9.99996901e-01f},
  {-7.59687901e-01f,-5.48975468e-01f,3.10223512e-02f,-8.89670432e-01f,7.07371980e-02f,6.64843500e-01f,8.89593601e-01f,9.64634836e-01f,9.88771081e-01f,9.96444523e-01f,9.98875201e-01f,9.99644279e-01f,9.99887526e-01f,9.99964416e-01f,9.99988735e-01f,9.99996424e-01f},
  {-9.57659483e-01f,-9.10081089e-01f,3.40318173e-01f,-9.56410050e-01f,-2.91995462e-02f,6.21808827e-01f,8.74707460e-01f,9.59795177e-01f,9.87227261e-01f,9.95954990e-01f,9.98720288e-01f,9.99595284e-01f,9.99872029e-01f,9.99959528e-01f,9.99987185e-01f,9.99995947e-01f},
  {-2.75163352e-01f,-9.90897954e-01f,6.15864813e-01f,-9.92985010e-01f,-1.28844544e-01f,5.76808274e-01f,8.58946681e-01f,9.54652011e-01f,9.85584795e-01f,9.95433986e-01f,9.98555362e-01f,9.99543071e-01f,9.99855518e-01f,9.99954283e-01f,9.99985576e-01f,9.99995410e-01f},
  {6.60316706e-01f,-7.66536534e-01f,8.30336154e-01f,-9.98241663e-01f,-2.27202162e-01f,5.29984176e-01f,8.42327058e-01f,9.49207008e-01f,9.83843684e-01f,9.94881511e-01f,9.98380423e-01f,9.99487758e-01f,9.99837995e-01f,9.99948800e-01f,9.99983788e-01f,9.99994874e-01f},
  {9.88704622e-01f,-3.06095392e-01f,9.62463796e-01f,-9.72014248e-01f,-3.23289543e-01f,4.81484592e-01f,8.24865162e-01f,9.43461835e-01f,9.82004225e-01f,9.94297504e-01f,9.98195529e-01f,9.99429286e-01f,9.99819517e-01f,9.99942899e-01f,9.99981940e-01f,9.99994278e-01f},
  {4.08082068e-01f,2.48616725e-01f,9.99144375e-01f,-9.15129960e-01f,-4.16146845e-01f,4.31462824e-01f,8.06578457e-01f,9.37418282e-01f,9.80066597e-01f,9.93682086e-01f,9.98000681e-01f,9.99367595e-01f,9.99800026e-01f,9.99936759e-01f,9.99979973e-01f,9.99993682e-01f},
  {-5.47729254e-01f,7.26760268e-01f,9.36740458e-01f,-8.29382956e-01f,-5.04846215e-01f,3.80077004e-01f,7.87485182e-01f,9.31078374e-01f,9.78030920e-01f,9.93035257e-01f,9.97795820e-01f,9.99302804e-01f,9.99779522e-01f,9.99930263e-01f,9.99977946e-01f,9.99993026e-01f},
  {-9.99960840e-01f,9.81074572e-01f,7.81440377e-01f,-7.17477441e-01f,-5.88501155e-01f,3.27489585e-01f,7.67604589e-01f,9.24443960e-01f,9.75897431e-01f,9.92357016e-01f,9.97581005e-01f,9.99234855e-01f,9.99758005e-01f,9.99923468e-01f,9.99975801e-01f,9.99992371e-01f},
  {-5.32833040e-01f,9.33235765e-01f,5.48645258e-01f,-5.82943261e-01f,-6.66275978e-01f,2.73866832e-01f,7.46956408e-01f,9.17517304e-01f,9.73666370e-01f,9.91647422e-01f,9.97356176e-01f,9.99163687e-01f,9.99735534e-01f,9.99916375e-01f,9.99973536e-01f,9.99991655e-01f},
  {4.24179018e-01f,5.97977161e-01f,2.61441678e-01f,-4.30023283e-01f,-7.37393796e-01f,2.19378278e-01f,7.25561321e-01f,9.10300434e-01f,9.71337974e-01f,9.90906477e-01f,9.97121394e-01f,9.99089420e-01f,9.99711990e-01f,9.99908924e-01f,9.99971211e-01f,9.99990880e-01f},
  {9.91202831e-01f,7.85522610e-02f,-5.16893305e-02f,-2.63540596e-01f,-8.01143587e-01f,1.64196163e-01f,7.03440726e-01f,9.02795732e-01f,9.68912423e-01f,9.90134120e-01f,9.96876657e-01f,9.99011934e-01f,9.99687493e-01f,9.99901175e-01f,9.99968767e-01f,9.99990106e-01f},
  {6.46919310e-01f,-4.65064496e-01f,-3.59694332e-01f,-8.87455046e-02f,-8.56888831e-01f,1.08494945e-01f,6.80616796e-01f,8.95005584e-01f,9.66389954e-01f,9.89330530e-01f,9.96621907e-01f,9.98931348e-01f,9.99662042e-01f,9.99893129e-01f,9.99966204e-01f,9.99989331e-01f},
  {-2.92138815e-01f,-8.65450621e-01f,-6.32028639e-01f,8.88481140e-02f,-9.04072165e-01f,5.24506159e-02f,6.57112300e-01f,8.86932373e-01f,9.63770926e-01f,9.88495648e-01f,9.96357203e-01f,9.98847544e-01f,9.99635518e-01f,9.99884725e-01f,9.99963522e-01f,9.99988496e-01f},
  {-9.62605894e-01f,-9.99293387e-01f,-8.41684937e-01f,2.63639510e-01f,-9.42222297e-01f,-3.75941908e-03f,6.32950664e-01f,8.78578722e-01f,9.61055458e-01f,9.87629473e-01f,9.96082544e-01f,9.98760641e-01f,9.99608040e-01f,9.99876022e-01f,9.99960780e-01f,9.99987602e-01f},
  {-7.48057544e-01f,-8.25371623e-01f,-9.67871487e-01f,4.30115849e-01f,-9.70958173e-01f,-5.99575676e-02f,6.08156204e-01f,8.69947195e-01f,9.58243906e-01f,9.86732066e-01f,9.95797932e-01f,9.98670578e-01f,9.99579549e-01f,9.99867022e-01f,9.99957979e-01f,9.99986708e-01f},
  {1.54251456e-01f,-3.97251874e-01f,-9.98075247e-01f,5.83026946e-01f,-9.89992499e-01f,-1.15966164e-01f,5.82753658e-01f,8.61040652e-01f,9.55336511e-01f,9.85803485e-01f,9.95503366e-01f,9.98577297e-01f,9.99550045e-01f,9.99857724e-01f,9.99954998e-01f,9.99985754e-01f},
  {9.14742351e-01f,1.53215483e-01f,-9.29300308e-01f,7.17549205e-01f,-9.99135137e-01f,-1.71608135e-01f,5.56768358e-01f,8.51861775e-01f,9.52333570e-01f,9.84843671e-01f,9.95198846e-01f,9.98480916e-01f,9.99519527e-01f,9.99848068e-01f,9.99951959e-01f,9.99984801e-01f},
  {8.34223390e-01f,6.56495154e-01f,-7.68367112e-01f,8.29440355e-01f,-9.98294771e-01f,-2.26707578e-01f,5.30226350e-01f,8.42413545e-01f,9.49235439e-01f,9.83852804e-01f,9.94884372e-01f,9.98381376e-01f,9.99488056e-01f,9.99838114e-01f,9.99948800e-01f,9.99983788e-01f},
  {-1.32767474e-02f,9.57586050e-01f,-5.31235278e-01f,9.15171385e-01f,-9.87479806e-01f,-2.81090319e-01f,5.03154159e-01f,8.32698941e-01f,9.46042359e-01f,9.82830763e-01f,9.94559944e-01f,9.98278618e-01f,9.99455571e-01f,9.99827802e-01f,9.99945521e-01f,9.99982774e-01f},
  {-8.48570287e-01f,9.63757515e-01f,-2.41421118e-01f,9.72038329e-01f,-9.66798186e-01f,-3.34584385e-01f,4.75578904e-01f,8.22721004e-01f,9.42754686e-01f,9.81777668e-01f,9.94225562e-01f,9.98172760e-01f,9.99422073e-01f,9.99817252e-01f,9.99942183e-01f,9.99981701e-01f},
  {-9.03692186e-01f,6.73110247e-01f,7.23346695e-02f,9.98247743e-01f,-9.36456680e-01f,-3.87020677e-01f,4.47528064e-01f,8.12482953e-01f,9.39372718e-01f,9.80693519e-01f,9.93881226e-01f,9.98063743e-01f,9.99387562e-01f,9.99806345e-01f,9.99938726e-01f,9.99980628e-01f},
  {-1.27963692e-01f,1.75156534e-01f,3.78916174e-01f,9.92972851e-01f,-8.96758378e-01f,-4.38233554e-01f,4.19029742e-01f,8.01987886e-01f,9.35896814e-01f,9.79578316e-01f,9.93526995e-01f,9.97951567e-01f,9.99352098e-01f,9.99795079e-01f,9.99935210e-01f,9.99979496e-01f},
  {7.65414059e-01f,-3.76742303e-01f,6.47921681e-01f,9.56380010e-01f,-8.48100007e-01f,-4.88060862e-01f,3.90112430e-01f,7.91239262e-01f,9.32327330e-01f,9.78432178e-01f,9.93162811e-01f,9.97836173e-01f,9.99315560e-01f,9.99783576e-01f,9.99931574e-01f,9.99978364e-01f},
  {9.55073655e-01f,-8.12611222e-01f,8.52673113e-01f,8.89623463e-01f,-7.90967762e-01f,-5.36345184e-01f,3.60805035e-01f,7.80240417e-01f,9.28664625e-01f,9.77255106e-01f,9.92788672e-01f,9.97717679e-01f,9.99278069e-01f,9.99771714e-01f,9.99927819e-01f,9.99977171e-01f},
  {2.66642928e-01f,-9.98210371e-01f,9.72865343e-01f,7.94808388e-01f,-7.25932240e-01f,-5.82933903e-01f,3.31136853e-01f,7.68994927e-01f,9.24909055e-01f,9.76047099e-01f,9.92404640e-01f,9.97596025e-01f,9.99239624e-01f,9.99759495e-01f,9.99923944e-01f,9.99975979e-01f},
  {-6.66938066e-01f,-8.76379430e-01f,9.96578991e-01f,6.74925625e-01f,-6.53643608e-01f,-6.27679706e-01f,3.01137596e-01f,7.57506192e-01f,9.21060979e-01f,9.74808276e-01f,9.92010653e-01f,9.97471273e-01f,9.99200106e-01f,9.99747038e-01f,9.99920011e-01f,9.99974728e-01f},
  {-9.87339258e-01f,-4.84639406e-01f,9.21462357e-01f,5.33756077e-01f,-5.74824035e-01f,-6.70441091e-01f,2.70837069e-01f,7.45777905e-01f,9.17120814e-01f,9.73538578e-01f,9.91606772e-01f,9.97343302e-01f,9.99159634e-01f,9.99734223e-01f,9.99915957e-01f,9.99973416e-01f},
  {-3.99985313e-01f,5.63609414e-02f,7.54965365e-01f,3.75752151e-01f,-4.90260571e-01f,-7.11082935e-01f,2.40265876e-01f,7.33813822e-01f,9.13088918e-01f,9.72238123e-01f,9.91192937e-01f,9.97212172e-01f,9.99118149e-01f,9.99721110e-01f,9.99911785e-01f,9.99972105e-01f},
  {5.55113316e-01f,5.80003142e-01f,5.13598442e-01f,2.05897167e-01f,-4.00799006e-01f,-7.49476731e-01f,2.09454417e-01f,7.21617639e-01f,9.08965766e-01f,9.70906913e-01f,9.90769207e-01f,9.97077882e-01f,9.99075651e-01f,9.99707639e-01f,9.99907553e-01f,9.99970794e-01f},
  {9.99843299e-01f,9.25014675e-01f,2.21298173e-01f,2.95478199e-02f,-3.07332784e-01f,-7.85501122e-01f,1.78433523e-01f,7.09193349e-01f,9.04751658e-01f,9.69545007e-01f,9.90335584e-01f,9.96940494e-01f,9.99032140e-01f,9.99693930e-01f,9.99903202e-01f,9.99969363e-01f},
  {5.25321960e-01f,9.85138178e-01f,-9.29481089e-02f,-1.47732988e-01f,-2.10795805e-01f,-8.19042206e-01f,1.47234216e-01f,6.96544766e-01f,9.00447130e-01f,9.68152404e-01f,9.89892066e-01f,9.96799886e-01f,9.98987675e-01f,9.99679863e-01f,9.99898732e-01f,9.99967992e-01f},
  {-4.32177931e-01f,7.41858006e-01f,-3.97976756e-01f,-3.20354372e-01f,-1.12152621e-01f,-8.49993885e-01f,1.15887694e-01f,6.83675885e-01f,8.96052480e-01f,9.66729224e-01f,9.89438653e-01f,9.96656179e-01f,9.98942196e-01f,9.99665439e-01f,9.99894202e-01f,9.99966562e-01f},
  {-9.92335498e-01f,2.70098448e-01f,-6.63538277e-01f,-4.82871950e-01f,-1.23883775e-02f,-8.78258407e-01f,8.44252855e-02f,6.70590878e-01f,8.91568303e-01f,9.65275466e-01f,9.88975346e-01f,9.96509314e-01f,9.98895705e-01f,9.99650776e-01f,9.99889553e-01f,9.99965072e-01f},
  {-6.40144348e-01f,-2.84846604e-01f,-8.63296509e-01f,-6.30159974e-01f,8.74991715e-02f,-9.03746367e-01f,5.28784581e-02f,6.57293737e-01f,8.86994898e-01f,9.63791192e-01f,9.88502085e-01f,9.96359289e-01f,9.98848200e-01f,9.99635756e-01f,9.99884784e-01f,9.99963582e-01f},
  {3.00592542e-01f,-7.52063990e-01f,-9.77442741e-01f,-7.57573068e-01f,1.86512470e-01f,-9.26377118e-01f,2.12787576e-02f,6.43788815e-01f,8.82332861e-01f,9.62276459e-01f,9.88018990e-01f,9.96206105e-01f,9.98799741e-01f,9.99620378e-01f,9.99879956e-01f,9.99962032e-01f},
  {9.64965999e-01f,-9.87659097e-01f,-9.94656444e-01f,-8.61092687e-01f,2.83662200e-01f,-9.46079254e-01f,-1.03422189e-02f,6.30080283e-01f,8.77582550e-01f,9.60731268e-01f,9.87526000e-01f,9.96049762e-01f,9.98750269e-01f,9.99604762e-01f,9.99875009e-01f,9.99960482e-01f},
  {7.42154181e-01f,-9.19073522e-01f,-9.13230121e-01f,-9.37454224e-01f,3.77977669e-01f,-9.62790370e-01f,-4.19528559e-02f,6.16172493e-01f,8.72744501e-01f,9.59155679e-01f,9.87023175e-01f,9.95890260e-01f,9.98699784e-01f,9.99588788e-01f,9.99869943e-01f,9.99958873e-01f},
  {-1.62990779e-01f,-5.67430019e-01f,-7.41239965e-01f,-9.84248459e-01f,4.68516916e-01f,-9.76457715e-01f,-7.35215396e-02f,6.02069914e-01f,8.67819190e-01f,9.57549810e-01f,9.86510456e-01f,9.95727658e-01f,9.98648286e-01f,9.99572515e-01f,9.99864817e-01f,9.99957263e-01f},
  {-9.18282807e-01f,-4.10281904e-02f,-4.95741814e-01f,-1.00000000e+00f,5.54374516e-01f,-9.87038016e-01f,-1.05016708e-01f,5.87776959e-01f,8.62807095e-01f,9.55913603e-01f,9.85987842e-01f,9.95561838e-01f,9.98595834e-01f,9.99555886e-01f,9.99859571e-01f,9.99955595e-01f},
  {-8.29309821e-01f,4.98009592e-01f,-2.01079622e-01f,-9.84212041e-01f,6.34692967e-01f,-9.94497895e-01f,-1.36406869e-01f,5.73298037e-01f,8.57708693e-01f,9.54247177e-01f,9.85455394e-01f,9.95392919e-01f,9.98542368e-01f,9.99538958e-01f,9.99854207e-01f,9.99953866e-01f},
  {2.21267566e-02f,8.83669317e-01f,1.13521777e-01f,-9.37382519e-01f,7.08669782e-01f,-9.98813629e-01f,-1.67660639e-01f,5.58637917e-01f,8.52524519e-01f,9.52550590e-01f,9.84913111e-01f,9.95220840e-01f,9.98487890e-01f,9.99521732e-01f,9.99848783e-01f,9.99952197e-01f},
  {8.53220105e-01f,9.97174621e-01f,4.16867077e-01f,-8.60988438e-01f,7.75565803e-01f,-9.99971747e-01f,-1.98746875e-01f,5.43801069e-01f,8.47255111e-01f,9.50823903e-01f,9.84360933e-01f,9.95045662e-01f,9.98432398e-01f,9.99504209e-01f,9.99843180e-01f,9.99950409e-01f},
  {8.99866819e-01f,8.03569078e-01f,6.78870201e-01f,-7.57439196e-01f,8.34712923e-01f,-9.97968495e-01f,-2.29634270e-01f,5.28792322e-01f,8.41901004e-01f,9.49067116e-01f,9.83798921e-01f,9.94867265e-01f,9.98375952e-01f,9.99486327e-01f,9.99837577e-01f,9.99948621e-01f},
  {1.19180135e-01f,3.62476677e-01f,8.73550534e-01f,-6.30000710e-01f,8.85519624e-01f,-9.92810190e-01f,-2.60292053e-01f,5.13616323e-01f,8.36462677e-01f,9.47280347e-01f,9.83227074e-01f,9.94685769e-01f,9.98318493e-01f,9.99468148e-01f,9.99831796e-01f,9.99946833e-01f},
  {-7.71080196e-01f,-1.90249100e-01f,9.81602073e-01f,-4.82692331e-01f,9.27478492e-01f,-9.84513164e-01f,-2.90689558e-01f,4.98277903e-01f,8.30940723e-01f,9.45463598e-01f,9.82645452e-01f,9.94501114e-01f,9.98260021e-01f,9.99449670e-01f,9.99825954e-01f,9.99944985e-01f},
  {-9.52412963e-01f,-6.84381902e-01f,9.92308319e-01f,-3.20159167e-01f,9.60170269e-01f,-9.73103702e-01f,-3.20796400e-01f,4.82782036e-01f,8.25335622e-01f,9.43616986e-01f,9.82053936e-01f,9.94313300e-01f,9.98200536e-01f,9.99430835e-01f,9.99819994e-01f,9.99943078e-01f},
  {-2.58101642e-01f,-9.67739642e-01f,9.04607594e-01f,-1.47529200e-01f,9.83268440e-01f,-9.58617806e-01f,-3.50582451e-01f,4.67133403e-01f,8.19648027e-01f,9.41740453e-01f,9.81452644e-01f,9.94122326e-01f,9.98140097e-01f,9.99411702e-01f,9.99813974e-01f,9.99941170e-01f},
  {6.73507154e-01f,-9.53050017e-01f,7.27198064e-01f,2.97537707e-02f,9.96542096e-01f,-9.41101313e-01f,-3.80017966e-01f,4.51337039e-01f,8.13878477e-01f,9.39834237e-01f,9.80841517e-01f,9.93928254e-01f,9.98078644e-01f,9.99392271e-01f,9.99807835e-01f,9.99939203e-01f},
  {9.85896587e-01f,-6.44837022e-01f,4.77671444e-01f,2.06098333e-01f,9.99858618e-01f,-9.20609534e-01f,-4.09073502e-01f,4.35397953e-01f,8.08027506e-01f,9.37898219e-01f,9.80220556e-01f,9.93731022e-01f,9.98016179e-01f,9.99372482e-01f,9.99801576e-01f,9.99937236e-01f}
};
__device__ const float ROPE_SN[64][16] = {
  {0.00000000e+00f,0.00000000e+00f,0.00000000e+00f,0.00000000e+00f,0.00000000e+00f,0.00000000e+00f,0.00000000e+00f,0.00000000e+00f,0.00000000e+00f,0.00000000e+00f,0.00000000e+00f,0.00000000e+00f,0.00000000e+00f,0.00000000e+00f,0.00000000e+00f,0.00000000e+00f},
  {8.41470957e-01f,5.33168435e-01f,3.10983598e-01f,1.76892191e-01f,9.98334214e-02f,5.62044978e-02f,3.16175036e-02f,1.77818574e-02f,9.99983307e-03f,5.62338345e-03f,3.16227227e-03f,1.77827850e-03f,9.99999931e-04f,5.62341243e-04f,3.16227757e-04f,1.77827940e-04f},
  {9.09297407e-01f,9.02130723e-01f,5.91127098e-01f,3.48205268e-01f,1.98669329e-01f,1.12231314e-01f,6.32033944e-02f,3.55580896e-02f,1.99986659e-02f,1.12465890e-02f,6.32451288e-03f,3.55655141e-03f,1.99999870e-03f,1.12468237e-03f,6.32455456e-04f,3.55655880e-04f},
  {1.41120002e-01f,9.93253171e-01f,8.12648892e-01f,5.08536100e-01f,2.95520216e-01f,1.67903304e-01f,9.47260857e-02f,5.33230826e-02f,2.99954992e-02f,1.68694388e-02f,9.48669016e-03f,5.33481315e-03f,2.99999560e-03f,1.68702309e-03f,9.48683126e-04f,5.33483806e-04f},
  {-7.56802499e-01f,7.78471708e-01f,9.53580737e-01f,6.52827978e-01f,3.89418334e-01f,2.23044485e-01f,1.26154065e-01f,7.10712075e-02f,3.99893336e-02f,2.24917568e-02f,1.26487734e-02f,7.11305765e-03f,3.99998948e-03f,2.24936334e-03f,1.26491068e-03f,7.11311703e-04f},
  {-9.58924294e-01f,3.23935270e-01f,9.99946535e-01f,7.76529968e-01f,4.79425550e-01f,2.77480543e-01f,1.57455876e-01f,8.87968615e-02f,4.99791652e-02f,2.81133614e-02f,1.58107281e-02f,8.89127981e-03f,4.99997940e-03f,2.81170290e-03f,1.58113812e-03f,8.89139599e-04f},
  {-2.79415488e-01f,-2.30367512e-01f,9.47148204e-01f,8.75740528e-01f,5.64642489e-01f,3.31039310e-01f,1.88600272e-01f,1.06494442e-01f,5.99640049e-02f,3.37340795e-02f,1.89725272e-02f,1.06694745e-02f,5.99996420e-03f,3.37404152e-03f,1.89736532e-03f,1.06696738e-03f},
  {6.56986594e-01f,-7.13721275e-01f,8.00421596e-01f,9.47330713e-01f,6.44217670e-01f,3.83551568e-01f,2.19556093e-01f,1.24158338e-01f,6.99428469e-02f,3.93537246e-02f,2.21341345e-02f,1.24476347e-02f,6.99994294e-03f,3.93637875e-03f,2.21359241e-03f,1.24479528e-03f},
  {9.89358246e-01f,-9.77261782e-01f,5.74317753e-01f,9.89042461e-01f,7.17356086e-01f,4.34851229e-01f,2.50292331e-01f,1.41782969e-01f,7.99146891e-02f,4.49721329e-02f,2.52955221e-02f,1.42257558e-02f,7.99991470e-03f,4.49871505e-03f,2.52981926e-03f,1.42262306e-03f},
  {4.12118495e-01f,-9.39823508e-01f,2.91259229e-01f,9.99560297e-01f,7.83326924e-01f,4.84776139e-01f,2.80778319e-01f,1.59362778e-01f,8.98785442e-02f,5.05891182e-02f,2.84566563e-02f,1.60038304e-02f,8.99987947e-03f,5.06105041e-03f,2.84604589e-03f,1.60045072e-03f},
  {-5.44021130e-01f,-6.12936914e-01f,-2.06835698e-02f,9.78552461e-01f,8.41470957e-01f,5.33168435e-01f,3.10983568e-01f,1.76892191e-01f,9.98334140e-02f,5.62044978e-02f,3.16175036e-02f,1.77818574e-02f,9.99983400e-03f,5.62338345e-03f,3.16227227e-03f,1.77827850e-03f},
  {-9.99990225e-01f,-9.72764567e-02f,-3.30574960e-01f,9.26681578e-01f,8.91207397e-01f,5.79875171e-01f,3.40877861e-01f,1.94365650e-01f,1.09778300e-01f,6.18181042e-02f,3.47780399e-02f,1.95598267e-02f,1.09997792e-02f,6.18571462e-03f,3.47849843e-03f,1.95610616e-03f},
  {-5.36572933e-01f,4.48342979e-01f,-6.07683420e-01f,8.45583618e-01f,9.32039082e-01f,6.24748647e-01f,3.70431304e-01f,2.11777672e-01f,1.19712204e-01f,6.74297586e-02f,3.79382223e-02f,2.13377345e-02f,1.19997123e-02f,6.74804440e-03f,3.79472389e-03f,2.13393359e-03f},
  {4.20167029e-01f,8.55880976e-01f,-8.24528456e-01f,7.37816215e-01f,9.63558197e-01f,6.67647004e-01f,3.99614304e-01f,2.29122713e-01f,1.29634142e-01f,7.30392784e-02f,4.10980321e-02f,2.31155735e-02f,1.29996343e-02f,7.31037185e-03f,4.11094911e-03f,2.31176103e-03f},
  {9.90607381e-01f,9.99823332e-01f,-9.59605396e-01f,6.06778562e-01f,9.85449731e-01f,7.08434701e-01f,4.28397775e-01f,2.46395305e-01f,1.39543116e-01f,7.86464810e-02f,4.42574248e-02f,2.48933397e-02f,1.39995432e-02f,7.87269697e-03f,4.42717411e-03f,2.48958869e-03f},
  {6.50287867e-01f,8.35838437e-01f,-9.99518692e-01f,4.56603259e-01f,9.97494996e-01f,7.46982634e-01f,4.56752867e-01f,2.63589978e-01f,1.49438128e-01f,8.42512026e-02f,4.74163815e-02f,2.66710296e-02f,1.49994381e-02f,8.43502022e-03f,4.74339863e-03f,2.66741589e-03f},
  {-2.87903309e-01f,4.14430231e-01f,-9.40310359e-01f,2.92027086e-01f,9.99573588e-01f,7.83169091e-01f,4.84651238e-01f,2.80701309e-01f,1.59318209e-01f,8.98532644e-02f,5.05748577e-02f,2.84486320e-02f,1.59993190e-02f,8.99733976e-03f,5.05962269e-03f,2.84524332e-03f},
  {-9.61397469e-01f,-1.34615138e-01f,-7.87851870e-01f,1.18240520e-01f,9.91664827e-01f,8.16879570e-01f,5.12064993e-01f,2.97723860e-01f,1.69182345e-01f,9.54524800e-02f,5.37328273e-02f,3.02261449e-02f,1.69991814e-02f,9.55965649e-03f,5.37584582e-03f,3.02307028e-03f},
  {-7.50987232e-01f,-6.42200708e-01f,-5.57262897e-01f,-5.92755191e-02f,9.73847628e-01f,8.48007560e-01f,5.38966715e-01f,3.14652264e-01f,1.79029569e-01f,1.01048686e-01f,5.68902642e-02f,3.20035629e-02f,1.79990288e-02f,1.01219704e-02f,5.69206895e-03f,3.20089748e-03f},
  {1.49877205e-01f,-9.52000856e-01f,-2.71410108e-01f,-2.34921798e-01f,9.46300089e-01f,8.76454532e-01f,5.65329552e-01f,3.31481189e-01f,1.88858896e-01f,1.06641680e-01f,6.00471310e-02f,3.37808803e-02f,1.89988576e-02f,1.06842816e-02f,6.00829115e-03f,3.37872445e-03f},
  {9.12945271e-01f,-9.68601942e-01f,4.13582884e-02f,-4.03158993e-01f,9.09297407e-01f,9.02130723e-01f,5.91127038e-01f,3.48205268e-01f,1.98669314e-01f,1.12231314e-01f,6.32033944e-02f,3.55580896e-02f,1.99986678e-02f,1.12465890e-02f,6.32451288e-03f,3.55655141e-03f},
  {8.36655617e-01f,-6.86891198e-01f,3.50024760e-01f,-5.58680534e-01f,8.63209307e-01f,9.24954832e-01f,6.16333544e-01f,3.64819258e-01f,2.08459899e-01f,1.17817394e-01f,6.63590282e-02f,3.73351872e-02f,2.09984574e-02f,1.18088927e-02f,6.64073415e-03f,3.73437814e-03f},
  {-8.85130931e-03f,-1.93630233e-01f,6.23979926e-01f,-6.96581721e-01f,8.08496356e-01f,9.44854796e-01f,6.40923738e-01f,3.81317884e-01f,2.18229622e-01f,1.23399742e-01f,6.95140064e-02f,3.91121693e-02f,2.19982266e-02f,1.23711927e-02f,6.95695449e-03f,3.91220488e-03f},
  {-8.46220434e-01f,3.59264523e-01f,8.36055279e-01f,-8.12512875e-01f,7.45705247e-01f,9.61767614e-01f,6.64873064e-01f,3.97695929e-01f,2.27977514e-01f,1.28978193e-01f,7.26682767e-02f,4.08890247e-02f,2.29979735e-02f,1.29334899e-02f,7.27317436e-03f,4.09003161e-03f},
  {-9.05578375e-01f,8.01513135e-01f,9.65219259e-01f,-9.02817786e-01f,6.75463140e-01f,9.75639880e-01f,6.88157499e-01f,4.13948208e-01f,2.37702623e-01f,1.34552568e-01f,7.58218244e-02f,4.26657498e-02f,2.39976961e-02f,1.34957815e-02f,7.58939330e-03f,4.26785741e-03f},
  {-1.32351756e-01f,9.96909976e-01f,9.98663187e-01f,-9.64648306e-01f,5.98472118e-01f,9.86427724e-01f,7.10753918e-01f,4.30069596e-01f,2.47403964e-01f,1.40122697e-01f,7.89746121e-02f,4.44423407e-02f,2.49973964e-02f,1.40580693e-02f,7.90561177e-03f,4.44568414e-03f},
  {7.62558460e-01f,8.85276794e-01f,9.33070183e-01f,-9.96054351e-01f,5.15501261e-01f,9.94096994e-01f,7.32639611e-01f,4.46054995e-01f,2.57080555e-01f,1.45688385e-01f,8.21266174e-02f,4.62187938e-02f,2.59970706e-02f,1.46203535e-02f,8.22182931e-03f,4.62350994e-03f},
  {9.56375957e-01f,5.00994205e-01f,7.74945021e-01f,-9.96045172e-01f,4.27379847e-01f,9.98623490e-01f,7.53792703e-01f,4.61899310e-01f,2.66731411e-01f,1.51249468e-01f,8.52777958e-02f,4.79951017e-02f,2.69967206e-02f,1.51826320e-02f,8.53804592e-03f,4.80133574e-03f},
  {2.70905793e-01f,-3.75856608e-02f,5.39968967e-01f,-9.64621305e-01f,3.34988207e-01f,9.99992907e-01f,7.74192095e-01f,4.77597594e-01f,2.76355654e-01f,1.56805754e-01f,8.84281173e-02f,4.97712530e-02f,2.79963426e-02f,1.57449059e-02f,8.85426160e-03f,4.97916201e-03f},
  {-6.63633883e-01f,-5.64589798e-01f,2.51445323e-01f,-9.02773678e-01f,2.39249229e-01f,9.98200953e-01f,7.93817401e-01f,4.93144840e-01f,2.85952210e-01f,1.62357092e-01f,9.15775672e-02f,5.15472479e-02f,2.89959367e-02f,1.63071752e-02f,9.17047635e-03f,5.15698735e-03f},
  {-9.88031626e-01f,-9.17709649e-01f,-6.20148405e-02f,-8.12452853e-01f,1.41120002e-01f,9.93253171e-01f,8.12648892e-01f,5.08536100e-01f,2.95520186e-01f,1.67903304e-01f,9.47260931e-02f,5.33230826e-02f,2.99955010e-02f,1.68694388e-02f,9.48669016e-03f,5.33481315e-03f},
  {-4.04037654e-01f,-9.88192797e-01f,-3.69325012e-01f,-6.96507812e-01f,4.15805206e-02f,9.85165298e-01f,8.30667794e-01f,5.23766637e-01f,3.05058628e-01f,1.73444211e-01f,9.78736654e-02f,5.50987460e-02f,3.09950355e-02f,1.74316969e-02f,9.80290305e-03f,5.51263802e-03f},
  {5.51426709e-01f,-7.54330218e-01f,-6.40009403e-01f,-5.58595300e-01f,-5.83741926e-02f,9.73962843e-01f,8.47856104e-01f,5.38831532e-01f,3.14566553e-01f,1.78979620e-01f,1.01020269e-01f,5.68742342e-02f,3.19945402e-02f,1.79939512e-02f,1.01191159e-02f,5.69046335e-03f},
  {9.99911845e-01f,-2.88147390e-01f,-8.47224355e-01f,-4.03064936e-01f,-1.57745644e-01f,9.59681332e-01f,8.64196658e-01f,5.53726017e-01f,3.24043006e-01f,1.84509367e-01f,1.04165860e-01f,5.86495437e-02f,3.29940096e-02f,1.85561981e-02f,1.04353270e-02f,5.86828869e-03f},
  {5.29082716e-01f,2.66779721e-01f,-9.70420420e-01f,-2.34822124e-01f,-2.55541205e-01f,9.42365825e-01f,8.79673064e-01f,5.68445385e-01f,3.33487093e-01f,1.90033287e-01f,1.07310407e-01f,6.04246669e-02f,3.39934528e-02f,1.91184394e-02f,1.07515370e-02f,6.04611309e-03f},
  {-4.28182662e-01f,7.39542127e-01f,-9.97380435e-01f,-5.91726787e-02f,-3.50783229e-01f,9.22071040e-01f,8.94269884e-01f,5.82984984e-01f,3.42897803e-01f,1.95551202e-01f,1.10453881e-01f,6.21996038e-02f,3.49928550e-02f,1.96806751e-02f,1.10677453e-02f,6.22393796e-03f},
  {-9.91778851e-01f,9.84540582e-01f,-9.25431013e-01f,1.18342586e-01f,-4.42520559e-01f,8.98861170e-01f,9.07972515e-01f,5.97340286e-01f,3.52274209e-01f,2.01062918e-01f,1.13596253e-01f,6.39743358e-02f,3.59922275e-02f,2.02429052e-02f,1.13839535e-02f,6.40176190e-03f},
  {-6.43538117e-01f,9.26318109e-01f,-7.61706948e-01f,2.92125374e-01f,-5.29836178e-01f,8.72809589e-01f,9.20767248e-01f,6.11506701e-01f,3.61615449e-01f,2.06568271e-01f,1.16737492e-01f,6.57488778e-02f,3.69915590e-02f,2.08051261e-02f,1.17001599e-02f,6.57958630e-03f},
  {2.96368569e-01f,5.82806170e-01f,-5.22444785e-01f,4.56694692e-01f,-6.11857831e-01f,8.43998730e-01f,9.32641268e-01f,6.25479698e-01f,3.70920479e-01f,2.12067112e-01f,1.19877554e-01f,6.75232038e-02f,3.79908569e-02f,2.13673431e-02f,1.20163653e-02f,6.75741071e-03f},
  {9.63795364e-01f,5.98003156e-02f,-2.31372014e-01f,6.06860459e-01f,-6.87766254e-01f,8.12519610e-01f,9.43582714e-01f,6.39254928e-01f,3.80188406e-01f,2.17559248e-01f,1.23016424e-01f,6.92973137e-02f,3.89901139e-02f,2.19295528e-02f,1.23325698e-02f,6.93523418e-03f},
  {7.45113134e-01f,-4.81621295e-01f,8.26458037e-02f,7.37885714e-01f,-7.56802499e-01f,7.78471708e-01f,9.53580678e-01f,6.52827978e-01f,3.89418334e-01f,2.23044485e-01f,1.26154065e-01f,7.10712075e-02f,3.99893373e-02f,2.24917568e-02f,1.26487734e-02f,7.11305765e-03f},
  {-1.58622667e-01f,-8.74714017e-01f,3.88467699e-01f,8.45638454e-01f,-8.18277061e-01f,7.41962790e-01f,9.62625206e-01f,6.66194677e-01f,3.98609310e-01f,2.28522688e-01f,1.29290432e-01f,7.28448778e-02f,4.09885161e-02f,2.30539497e-02f,1.29649751e-02f,7.29088066e-03f},
  {-9.16521549e-01f,-9.98410463e-01f,6.55764699e-01f,9.26720202e-01f,-8.71575892e-01f,7.03108132e-01f,9.70707119e-01f,6.79350674e-01f,4.07760441e-01f,2.33993664e-01f,1.32425532e-01f,7.46183172e-02f,4.19876575e-02f,2.36161388e-02f,1.32811759e-02f,7.46870413e-03f},
  {-8.31774771e-01f,-8.14614236e-01f,8.58030677e-01f,9.78573620e-01f,-9.16166008e-01f,6.62030637e-01f,9.77818429e-01f,6.92291796e-01f,4.16870773e-01f,2.39457220e-01f,1.35559291e-01f,7.63915181e-02f,4.29867506e-02f,2.41783205e-02f,1.35973748e-02f,7.64652714e-03f},
  {1.77019257e-02f,-3.79931390e-01f,9.75206196e-01f,9.99563396e-01f,-9.51602101e-01f,6.18860185e-01f,9.83951986e-01f,7.05014050e-01f,4.25939471e-01f,2.44913206e-01f,1.38691694e-01f,7.81644881e-02f,4.39858064e-02f,2.47404929e-02f,1.39135728e-02f,7.82434922e-03f},
  {8.50903511e-01f,1.71763569e-01f,9.95670974e-01f,9.89027262e-01f,-9.77530122e-01f,5.73733270e-01f,9.89101648e-01f,7.17513323e-01f,4.34965521e-01f,2.50361472e-01f,1.41822711e-01f,7.99371973e-02f,4.49848175e-02f,2.53026579e-02f,1.42297689e-02f,8.00217129e-03f},
  {9.01788354e-01f,6.70557022e-01f,9.17395473e-01f,9.47297752e-01f,-9.93690968e-01f,5.26792526e-01f,9.93262351e-01f,7.29785740e-01f,4.43948090e-01f,2.55801797e-01f,1.44952312e-01f,8.17096606e-02f,4.59837839e-02f,2.58648153e-02f,1.45459641e-02f,8.17999430e-03f},
  {1.23573124e-01f,9.62832689e-01f,7.48142362e-01f,8.75690997e-01f,-9.99923289e-01f,4.78186339e-01f,9.96429801e-01f,7.41827428e-01f,4.52886283e-01f,2.61234075e-01f,1.48080453e-01f,8.34818557e-02f,4.69827019e-02f,2.64269635e-02f,1.48621574e-02f,8.35781638e-03f},
  {-7.68254638e-01f,9.58573103e-01f,5.04697084e-01f,7.76465356e-01f,-9.96164620e-01f,4.28068399e-01f,9.98600960e-01f,7.53634512e-01f,4.61779177e-01f,2.66658038e-01f,1.51207119e-01f,8.52537975e-02f,4.79815714e-02f,2.69891042e-02f,1.51783489e-02f,8.53563752e-03f},
  {-9.53752637e-01f,6.59090102e-01f,2.11200655e-01f,6.52750373e-01f,-9.82452571e-01f,3.76597136e-01f,9.99773562e-01f,7.65203178e-01f,4.70625877e-01f,2.72073567e-01f,1.54332280e-01f,8.70254710e-02f,4.89803962e-02f,2.75512375e-02f,1.54945394e-02f,8.71345960e-03f},
  {-2.62374848e-01f,1.56619072e-01f,-1.03240460e-01f,5.08447945e-01f,-9.58924294e-01f,3.23935270e-01f,9.99946535e-01f,7.76529968e-01f,4.79425550e-01f,2.77480543e-01f,1.57455891e-01f,8.87968615e-02f,4.99791689e-02f,2.81133596e-02f,1.58107281e-02f,8.89127981e-03f},
  {6.70229197e-01f,-3.94086063e-01f,-4.07444149e-01f,3.48108500e-01f,-9.25814748e-01f,2.70249337e-01f,9.99119580e-01f,7.87611187e-01f,4.88177240e-01f,2.82878697e-01f,1.60577938e-01f,9.05679762e-02f,5.09778969e-02f,2.86754742e-02f,1.61269177e-02f,9.06910095e-03f},
  {9.86627579e-01f,-8.23421597e-01f,-6.71240151e-01f,1.76790684e-01f,-8.83454502e-01f,2.15709001e-01f,9.97293651e-01f,7.98443377e-01f,4.96880114e-01f,2.88267940e-01f,1.63698375e-01f,9.23388004e-02f,5.19765690e-02f,2.92375814e-02f,1.64431017e-02f,9.24692024e-03f},
  {3.95925164e-01f,-9.99157965e-01f,-8.68469954e-01f,-1.03020677e-04f,-8.32267344e-01f,1.60486728e-01f,9.94470477e-01f,8.09023023e-01f,5.05533338e-01f,2.93648034e-01f,1.66817173e-01f,9.41093415e-02f,5.29751927e-02f,2.97996756e-02f,1.67592876e-02f,9.42474138e-03f},
  {-5.58789074e-01f,-8.67171526e-01f,-9.79574919e-01f,-1.76993474e-01f,-7.72764444e-01f,1.04756832e-01f,9.90652919e-01f,8.19346905e-01f,5.14135957e-01f,2.99018890e-01f,1.69934288e-01f,9.58795771e-02f,5.39737605e-02f,3.03617641e-02f,1.70754679e-02f,9.60256159e-03f},
  {-9.99755144e-01f,-4.68111664e-01f,-9.93535519e-01f,-3.48301649e-01f,-7.05540299e-01f,4.86960001e-02f,9.85844791e-01f,8.29411685e-01f,5.22687256e-01f,3.04380238e-01f,1.73049718e-01f,9.76495072e-02f,5.49722798e-02f,3.09238415e-02f,1.73916500e-02f,9.78038087e-03f},
  {-5.21551013e-01f,7.51182064e-02f,-9.08967435e-01f,-5.08624554e-01f,-6.31266713e-01f,-7.51878507e-03f,9.80050862e-01f,8.39214146e-01f,5.31186223e-01f,3.09731960e-01f,1.76163420e-01f,9.94191393e-02f,5.59707358e-02f,3.14859077e-02f,1.77078284e-02f,9.95820016e-03f},
  {4.36164767e-01f,5.95211506e-01f,-7.34258294e-01f,-6.52905703e-01f,-5.50685287e-01f,-6.37097955e-02f,9.73276973e-01f,8.48751247e-01f,5.39632022e-01f,3.15073937e-01f,1.79275364e-01f,1.01188451e-01f,5.69691435e-02f,3.20479684e-02f,1.80240069e-02f,1.01360194e-02f},
  {9.92872655e-01f,9.31992829e-01f,-4.86733496e-01f,-7.76594579e-01f,-4.64602023e-01f,-1.19699396e-01f,9.65529919e-01f,8.58020008e-01f,5.48023939e-01f,3.20405900e-01f,1.82385504e-01f,1.02957435e-01f,5.79674877e-02f,3.26100141e-02f,1.83401816e-02f,1.03138378e-02f},
  {6.36738002e-01f,9.81735826e-01f,-1.90938011e-01f,-8.75790000e-01f,-3.73876572e-01f,-1.75310582e-01f,9.56817448e-01f,8.67017388e-01f,5.56361020e-01f,3.25727791e-01f,1.85493827e-01f,1.04726106e-01f,5.89657798e-02f,3.31720486e-02f,1.86563563e-02f,1.04916561e-02f},
  {-3.04810613e-01f,7.29123712e-01f,1.23790950e-01f,-9.47363734e-01f,-2.79415488e-01f,-2.30367512e-01f,9.47148204e-01f,8.75740528e-01f,5.64642429e-01f,3.31039310e-01f,1.88600287e-01f,1.06494442e-01f,5.99640086e-02f,3.37340795e-02f,1.89725272e-02f,1.06694745e-02f},
  {-9.66117799e-01f,2.51952261e-01f,4.26245421e-01f,-9.89057720e-01f,-1.82162598e-01f,-2.84696162e-01f,9.36531842e-01f,8.84186864e-01f,5.72867453e-01f,3.36340427e-01f,1.91704854e-01f,1.08262435e-01f,6.09621815e-02f,3.42960916e-02f,1.92886982e-02f,1.08472919e-02f},
  {-7.39180684e-01f,-3.02812874e-01f,6.86427653e-01f,-9.99557257e-01f,-8.30891207e-02f,-3.38124752e-01f,9.24979091e-01f,8.92353535e-01f,5.81035137e-01f,3.41630876e-01f,1.94807529e-01f,1.10030092e-01f,6.19602874e-02f,3.48580964e-02f,1.96048655e-02f,1.10251084e-02f},
  {1.67355701e-01f,-7.64320076e-01f,8.78538549e-01f,-9.78531301e-01f,1.68140903e-02f,-3.90484393e-01f,9.12501454e-01f,9.00238097e-01f,5.89144766e-01f,3.46910536e-01f,1.97908238e-01f,1.11797392e-01f,6.29583374e-02f,3.54200937e-02f,1.99210308e-02f,1.12029258e-02f}
};


constexpr int D = 1024, ML = 16384, MC = 2048, MT = ML + MC, TL = 2048, TCX = 256, NB = 8;
constexpr int LDP_E = 3328, LDP_O = 5120, DFF = 2816, NKK = 2304;
constexpr int NTHR = 512;
constexpr int LDS_BYTES = 152 * 1024;
constexpr float EPSN = 1e-6f;

struct Params {
  const float *x, *c, *ctx, *c_ctx, *w_ada, *b_ada, *n1g, *n2g, *w_in_even, *qk_gain, *lambda_a, *subln, *w_gate_up, *b_gate_up,
      *onorm_b, *w_out_even, *w_in_odd, *lb_raw, *onorm_c, *w_out_odd, *w_ffn_in, *w_ffn_out;
  float* out;
  bf16_t *wt_in_even, *wt_in_odd, *wt_out_even, *wt_out_odd, *wt_ffn_in, *wt_ffn_out;
  float* Z;
  float* mod;
  bf16_t *P, *R1, *R2, *Vt;
  float* Gk;
  unsigned* ctr;
};

extern __shared__ __attribute__((aligned(16))) char smem_raw[];

typedef float f32x2 __attribute__((ext_vector_type(2)));
typedef __bf16 hbf16x2 __attribute__((ext_vector_type(2)));
DI unsigned pack2(float a, float b) { const f32x2 v = {a, b}; return __builtin_bit_cast(unsigned, __builtin_convertvector(v, hbf16x2)); }
DI bf16_t f2bf(float x) { return (bf16_t)(pack2(x, 0.f) & 0xffffu); }
DI float bf2f(bf16_t h) { return __uint_as_float(((unsigned)h) << 16); }
DI float wave_sum(float v) {
#pragma unroll
  for (int o = 32; o >= 1; o >>= 1) v += __shfl_xor(v, o, 64);
  return v;
}
DI int TID() { int t = threadIdx.x; asm volatile("" : "+v"(t)); return t; }
DI float sigmoidf_(float x) { return __builtin_amdgcn_rcpf(1.f + __builtin_amdgcn_exp2f(x * -1.44269504088896f)); }
DI float siluf(float x) { return x * sigmoidf_(x); }

DI void convert_tile(const float* __restrict__ src, int K, int N, bf16_t* __restrict__ dst, int mode, int tile) {
  float* ts = (float*)smem_raw;
  const int tid = TID();
  const int nkt = K >> 6;
  const int kt = tile % nkt, nt = tile / nkt;
  const int k0 = kt << 6, n0 = nt << 6;
#pragma unroll
  for (int i = 0; i < 2; ++i) {
    const int idx = tid + i * NTHR;
    const int kr = idx >> 4, c4 = idx & 15;
    const int n = n0 + 4 * c4;
    float4 v = make_float4(0.f, 0.f, 0.f, 0.f);
    if (n < N) v = *(const float4*)(src + (size_t)(k0 + kr) * N + n);
    float* t = ts + kr * 65 + 4 * c4;
    t[0] = v.x; t[1] = v.y; t[2] = v.z; t[3] = v.w;
  }
  __syncthreads();
  {
    const int nrow = tid >> 3, kq = tid & 7;
    float f[8];
#pragma unroll
    for (int j = 0; j < 8; ++j) f[j] = ts[(kq * 8 + j) * 65 + nrow];
    int n = n0 + nrow;
    int orow = n;
    if (mode == 1) { const int up = n >= DFF ? 1 : 0; const int j = n - up * DFF; orow = (j >> 7) * 256 + up * 128 + (j & 127); }
    uint4 o;
    o.x = pack2(f[0], f[1]); o.y = pack2(f[2], f[3]); o.z = pack2(f[4], f[5]); o.w = pack2(f[6], f[7]);
    *(uint4*)(dst + (size_t)orow * K + k0 + kq * 8) = o;
  }
  __syncthreads();
}

__device__ void phase_init(const Params& p) {
  const int tid = TID(), nb = gridDim.x, bid = blockIdx.x;
  if (bid == 0 && tid < 16) p.ctr[tid] = 0u;
  {
    const float4* xs = (const float4*)p.x; float4* xo = (float4*)p.out;
    const size_t n4 = (size_t)ML * D / 4;
    for (size_t i = (size_t)bid * NTHR + tid; i < n4; i += (size_t)nb * NTHR) xo[i] = xs[i];
    const float4* cs = (const float4*)p.ctx; float4* zo = (float4*)p.Z;
    const size_t m4 = (size_t)MC * D / 4;
    for (size_t i = (size_t)bid * NTHR + tid; i < m4; i += (size_t)nb * NTHR) zo[i] = cs[i];
  }
  {
    const int T0 = 2 * 16 * 52, T1 = T0 + 2 * 16 * 80, T2 = T1 + 2 * 256, T3 = T2 + 2 * 256, T4 = T3 + 4 * 16 * 88, T5 = T4 + 4 * 44 * 16;
    for (int it = bid; it < T5; it += nb) {
      if (it < T0) { const int j = it / 832, t = it % 832; convert_tile(p.w_in_even + (size_t)j * 1024 * 3104, 1024, 3104, p.wt_in_even + (size_t)j * LDP_E * 1024, 0, t); }
      else if (it < T1) { const int q = it - T0; const int j = q / 1280, t = q % 1280; convert_tile(p.w_in_odd + (size_t)j * 1024 * 5120, 1024, 5120, p.wt_in_odd + (size_t)j * 5120 * 1024, 0, t); }
      else if (it < T2) { const int q = it - T1; const int j = q / 256, t = q % 256; convert_tile(p.w_out_even + (size_t)j * 1024 * 1024, 1024, 1024, p.wt_out_even + (size_t)j * 1024 * 1024, 0, t); }
      else if (it < T3) { const int q = it - T2; const int j = q / 256, t = q % 256; convert_tile(p.w_out_odd + (size_t)j * 1024 * 1024, 1024, 1024, p.wt_out_odd + (size_t)j * 1024 * 1024, 0, t); }
      else if (it < T4) { const int q = it - T3; const int j = q / 1408, t = q % 1408; convert_tile(p.w_ffn_in + (size_t)j * 1024 * 5632, 1024, 5632, p.wt_ffn_in + (size_t)j * 5632 * 1024, 1, t); }
      else { const int q = it - T4; const int j = q / 704, t = q % 704; convert_tile(p.w_ffn_out + (size_t)j * DFF * 1024, DFF, 1024, p.wt_ffn_out + (size_t)j * 1024 * DFF, 0, t); }
    }
  }
  {
    float* sc = (float*)smem_raw;
    float* part = sc + 9 * 1024;
    __syncthreads();
    for (int i = tid; i < 9 * 1024; i += NTHR) {
      const int m = i >> 10, k = i & 1023;
      const float v = m < 8 ? p.c[m * 1024 + k] : p.c_ctx[k];
      sc[i] = siluf(v);
    }
    __syncthreads();
    for (int it = bid; it < 4 * 96; it += nb) {
      const int l = it / 96, n0 = (it % 96) * 64;
      const int col4 = tid & 15, ks = tid >> 4;
      float acc[9][4];
#pragma unroll
      for (int m = 0; m < 9; ++m) { acc[m][0] = 0.f; acc[m][1] = 0.f; acc[m][2] = 0.f; acc[m][3] = 0.f; }
      const float* wp = p.w_ada + (size_t)l * 1024 * 6144 + n0 + 4 * col4;
      for (int kk = 0; kk < 32; ++kk) {
        const int k = ks * 32 + kk;
        const float4 w = *(const float4*)(wp + (size_t)k * 6144);
#pragma unroll
        for (int m = 0; m < 9; ++m) { const float s = sc[m * 1024 + k]; acc[m][0] += s * w.x; acc[m][1] += s * w.y; acc[m][2] += s * w.z; acc[m][3] += s * w.w; }
      }
#pragma unroll
      for (int m = 0; m < 9; ++m) {
        float* pp = part + (ks * 9 + m) * 64 + 4 * col4;
        pp[0] = acc[m][0]; pp[1] = acc[m][1]; pp[2] = acc[m][2]; pp[3] = acc[m][3];
      }
      __syncthreads();
      for (int i = tid; i < 9 * 64; i += NTHR) {
        const int m = i >> 6, cc = i & 63;
        float s = p.b_ada[l * 6144 + n0 + cc];
        for (int q = 0; q < 32; ++q) s += part[(q * 9 + m) * 64 + cc];
        p.mod[((size_t)l * 9 + m) * 6144 + n0 + cc] = s;
      }
      __syncthreads();
    }
  }
}

__device__ void phase_norm(const Params& p, int l, int which, int nrows, bf16_t* __restrict__ H) {
  const int wave = TID() >> 6, lane = TID() & 63;
  const float* gain = (which == 0 ? p.n1g : p.n2g) + l * 1024;
  const int sh_idx = which == 0 ? 0 : 3, sc_idx = which == 0 ? 1 : 4;
  for (int row = blockIdx.x * 8 + wave; row < nrows; row += gridDim.x * 8) {
    const float* xr = row < ML ? p.out + (size_t)row * D : p.Z + (size_t)(row - ML) * D;
    const int midx = row < ML ? (row >> 11) : 8;
    const float* md = p.mod + ((size_t)l * 9 + midx) * 6144;
    float4 v[4];
    float ss = 0.f;
#pragma unroll
    for (int i = 0; i < 4; ++i) { v[i] = *(const float4*)(xr + i * 256 + lane * 4); ss += v[i].x * v[i].x + v[i].y * v[i].y + v[i].z * v[i].z + v[i].w * v[i].w; }
    ss = wave_sum(ss);
    const float r = rsqrtf(ss * (1.f / 1024.f) + EPSN);
#pragma unroll
    for (int i = 0; i < 4; ++i) {
      const int col = i * 256 + lane * 4;
      const float4 g = *(const float4*)(gain + col);
      const float4 sh = *(const float4*)(md + sh_idx * 1024 + col);
      const float4 sc = *(const float4*)(md + sc_idx * 1024 + col);
      const float y0 = v[i].x * r * g.x * (1.f + sc.x) + sh.x;
      const float y1 = v[i].y * r * g.y * (1.f + sc.y) + sh.y;
      const float y2 = v[i].z * r * g.z * (1.f + sc.z) + sh.z;
      const float y3 = v[i].w * r * g.w * (1.f + sc.w) + sh.w;
      uint2 o; o.x = pack2(y0, y1); o.y = pack2(y2, y3);
      *(uint2*)(H + (size_t)row * D + col) = o;
    }
  }
}

#define LAS __attribute__((address_space(3)))
constexpr int BM = 256, BK = 64, HALF = 128, HTB = HALF * BK * 2, NXCD = 8, WGM = 8;
DI int lds_byte(int r, int c) { const int st = (r >> 4) * 2 + (c >> 5), rr = r & 15, cc = c & 31, ob = rr * 64 + cc * 2; return st * 1024 + (ob ^ (((ob >> 9) & 1) << 5)); }
DI void stage_rc(int b, int& R, int& C) { const int st = b / 1024, sb = b % 1024, swz = sb ^ (((sb >> 9) & 1) << 5); R = (st >> 1) * 16 + swz / 64; C = (st & 1) * 32 + (swz % 64) / 2; }

struct Unit { int pm, pn; };
struct TileOrder {
  int nM, nN, nwg, G, c;
  DI void init(int M, int N) { nM = M / BM; nN = N / BM; nwg = nM * nN; G = gridDim.x; c = blockIdx.x; }
  DI bool next(int i, Unit& u) const {
    const long L = (long)i * G + c; if (L >= nwg) return false;
    int wgid = (int)L; { const int q = nwg / NXCD, r = nwg % NXCD, xcd = wgid % NXCD, off = wgid / NXCD; wgid = (xcd < r ? xcd * (q + 1) : r * (q + 1) + (xcd - r) * q) + off; }
    const int nig = WGM * nN, gid = wgid / nig, fm = gid * WGM, gsz = (nM - fm) < WGM ? (nM - fm) : WGM;
    u.pm = fm + ((wgid % nig) % gsz); u.pn = (wgid % nig) / gsz; return true;
  }
};

enum { EPI_P = 0, EPI_RES = 1, EPI_SWIGLU = 2 };
struct EpiArgs { bf16_t* outb; int ld; float* xl; float* xz; const float* gate; };

template <int EPI>
DI void gemm_epilogue(const f32x4 (&acc)[2][2][4][2], const Unit& u, int wr, int wc, int fr, int fq, const EpiArgs& ea) {
  const int brow = u.pm * BM, bcol = u.pn * BM;
#pragma unroll
  for (int ai = 0; ai < 2; ++ai)
#pragma unroll
    for (int m = 0; m < 4; ++m) {
      const int row = brow + ai * HALF + wr * 64 + m * 16 + fr;
      if (EPI == EPI_P) {
#pragma unroll
        for (int bj = 0; bj < 2; ++bj)
#pragma unroll
          for (int n = 0; n < 2; ++n) {
            const int col = bcol + bj * HALF + wc * 32 + n * 16 + 4 * fq;
            const f32x4 a = acc[ai][bj][m][n];
            uint2 o; o.x = pack2(a[0], a[1]); o.y = pack2(a[2], a[3]);
            *(uint2*)(ea.outb + (size_t)row * ea.ld + col) = o;
          }
      } else if (EPI == EPI_RES) {
        float* xr = row < ML ? ea.xl + (size_t)row * D : ea.xz + (size_t)(row - ML) * D;
        const int midx = row < ML ? (row >> 11) : 8;
        const float* g = ea.gate + (size_t)midx * 6144;
#pragma unroll
        for (int bj = 0; bj < 2; ++bj)
#pragma unroll
          for (int n = 0; n < 2; ++n) {
            const int col = bcol + bj * HALF + wc * 32 + n * 16 + 4 * fq;
            const f32x4 a = acc[ai][bj][m][n];
            float4 xv = *(float4*)(xr + col);
            const float4 gv = *(const float4*)(g + col);
            xv.x += gv.x * a[0]; xv.y += gv.y * a[1]; xv.z += gv.z * a[2]; xv.w += gv.w * a[3];
            *(float4*)(xr + col) = xv;
          }
      } else {
#pragma unroll
        for (int n = 0; n < 2; ++n) {
          const int col = u.pn * HALF + wc * 32 + n * 16 + 4 * fq;
          const f32x4 g = acc[ai][0][m][n], up = acc[ai][1][m][n];
          uint2 o; o.x = pack2(siluf(g[0]) * up[0], siluf(g[1]) * up[1]); o.y = pack2(siluf(g[2]) * up[2], siluf(g[3]) * up[3]);
          *(uint2*)(ea.outb + (size_t)row * ea.ld + col) = o;
        }
      }
    }
}

template <int EPI>
DI void gemm_phase(const bf16_t* __restrict__ Ag, const bf16_t* __restrict__ Btg, int M, int N, int K, const EpiArgs ea) {
  LAS unsigned char* lds = (LAS unsigned char*)smem_raw;
  TileOrder S; S.init(M, N);
  const int tid = TID(), wid = __builtin_amdgcn_readfirstlane(tid >> 6), lane = tid & 63, wr = wid >> 2, wc = wid & 3, fr = lane & 15, fq = lane >> 4;
  const int nt = K / BK;
  unsigned voffA[2];
#pragma unroll
  for (int i = 0; i < 2; ++i) { int R, C; stage_rc(tid * 16 + i * 8192, R, C); voffA[i] = (unsigned)(R * K + C) * 2u; }
  const size_t kstep = (size_t)(BK * 2);
  const size_t hstep = (size_t)HALF * K * 2;
  const size_t tstep = 2 * hstep;
  const unsigned ldsw = (unsigned)wid * 1024u;
  const int aoff = lds_byte(wr * 64 + fr, fq * 8), boff = lds_byte(wc * 32 + fr, fq * 8);
#define G_SA(b, h) (((b) * 2 + (h)) * HTB)
#define G_SB(b, h) ((4 + (b) * 2 + (h)) * HTB)
#define G_STAGE(bufoff, gbase) do { _Pragma("unroll") for (int _i = 0; _i < 2; ++_i) \
    __builtin_amdgcn_global_load_lds((const unsigned*)((const char*)(gbase) + voffA[_i]), (LAS unsigned*)(lds + (bufoff) + ldsw + _i * 8192), 16, 0, 0); } while (0)
#define G_LDA(dst, b, h) do { _Pragma("unroll") for (int m = 0; m < 4; ++m) _Pragma("unroll") for (int k = 0; k < 2; ++k) dst[m][k] = *(const LAS bf16x8*)(lds + G_SA(b, h) + aoff + m * 2048 + k * 1024); } while (0)
#define G_LDB(dst, b, h) do { _Pragma("unroll") for (int n = 0; n < 2; ++n) _Pragma("unroll") for (int k = 0; k < 2; ++k) dst[n][k] = *(const LAS bf16x8*)(lds + G_SB(b, h) + boff + n * 2048 + k * 1024); } while (0)
#define G_MMA(ai, bj, At_, Bt_) do { __builtin_amdgcn_s_setprio(1); _Pragma("unroll") for (int m = 0; m < 4; ++m) _Pragma("unroll") for (int n = 0; n < 2; ++n) _Pragma("unroll") for (int k = 0; k < 2; ++k) \
    acc[ai][bj][m][n] = __builtin_amdgcn_mfma_f32_16x16x32_bf16(Bt_[n][k], At_[m][k], acc[ai][bj][m][n], 0, 0, 0); __builtin_amdgcn_s_setprio(0); } while (0)
#define G_WAIT_V(n) asm volatile("s_waitcnt vmcnt(" #n ")" ::: "memory")
#define G_WAIT_L(n) asm volatile("s_waitcnt lgkmcnt(" #n ")" ::: "memory")
#define G_BAR __builtin_amdgcn_s_barrier()
#define G_SCHED __builtin_amdgcn_sched_barrier(0)
  Unit cur, nxt; int ui = 0;
  if (S.next(0, cur)) {
    f32x4 acc[2][2][4][2];
#pragma unroll
    for (int a = 0; a < 2; ++a)
#pragma unroll
      for (int b = 0; b < 2; ++b)
#pragma unroll
        for (int m = 0; m < 4; ++m)
#pragma unroll
          for (int n = 0; n < 2; ++n) acc[a][b][m][n] = (f32x4){0.f, 0.f, 0.f, 0.f};
    bf16x8 At[4][2], B0[2][2], B1[2][2];
    const char* cA = (const char*)Ag + (size_t)cur.pm * tstep; const char* cB = (const char*)Btg + (size_t)cur.pn * tstep;
    G_STAGE(G_SB(0, 0), cB); G_STAGE(G_SA(0, 0), cA); G_STAGE(G_SB(0, 1), cB + hstep); G_STAGE(G_SA(0, 1), cA + hstep);
    if (wr == 1) G_BAR;
    G_WAIT_V(4); G_BAR;
    G_STAGE(G_SB(1, 0), cB + kstep); G_STAGE(G_SA(1, 0), cA + kstep); G_STAGE(G_SB(1, 1), cB + hstep + kstep);
    G_WAIT_V(6); G_BAR;
    for (;;) {
      const bool has_next = S.next(ui + 1, nxt);
      const char* nA = has_next ? (const char*)Ag + (size_t)nxt.pm * tstep : cA; const char* nB = has_next ? (const char*)Btg + (size_t)nxt.pn * tstep : cB;
      for (int t = 0; t < nt; t += 2) {
        const bool last = (t == nt - 2);
        const char* a1 = cA + (size_t)(t + 1) * kstep;
        const char* a2 = last ? nA : cA + (size_t)(t + 2) * kstep; const char* b2 = last ? nB : cB + (size_t)(t + 2) * kstep;
        const char* a3 = a2 + kstep; const char* b3 = b2 + kstep;
        G_LDB(B0, 0, 0); G_SCHED; G_LDA(At, 0, 0); G_STAGE(G_SA(1, 1), a1 + hstep);
        G_WAIT_L(8); G_BAR; G_WAIT_L(0); G_MMA(0, 0, At, B0); G_BAR; G_SCHED;
        G_LDB(B1, 0, 1); G_STAGE(G_SB(0, 0), b2);
        G_BAR; G_WAIT_L(0); G_MMA(0, 1, At, B1); G_BAR;
        G_LDA(At, 0, 1); G_STAGE(G_SA(0, 0), a2);
        G_BAR; G_WAIT_L(0); G_MMA(1, 0, At, B0); G_BAR; G_SCHED;
        G_STAGE(G_SB(0, 1), b2 + hstep);
        G_WAIT_V(6); G_BAR; G_MMA(1, 1, At, B1); G_BAR;
        G_LDB(B0, 1, 0); G_SCHED; G_LDA(At, 1, 0); G_STAGE(G_SA(0, 1), a2 + hstep);
        G_WAIT_L(8); G_BAR; G_WAIT_L(0); G_MMA(0, 0, At, B0); G_BAR; G_SCHED;
        G_LDB(B1, 1, 1); G_STAGE(G_SB(1, 0), b3);
        G_BAR; G_WAIT_L(0); G_MMA(0, 1, At, B1); G_BAR;
        G_LDA(At, 1, 1); G_STAGE(G_SA(1, 0), a3);
        G_BAR; G_WAIT_L(0); G_MMA(1, 0, At, B0); G_BAR; G_SCHED;
        G_STAGE(G_SB(1, 1), b3 + hstep);
        G_WAIT_V(6); G_BAR; G_MMA(1, 1, At, B1); G_BAR;
      }
      gemm_epilogue<EPI>(acc, cur, wr, wc, fr, fq, ea);
      if (!has_next) break;
#pragma unroll
      for (int a = 0; a < 2; ++a)
#pragma unroll
        for (int b = 0; b < 2; ++b)
#pragma unroll
          for (int m = 0; m < 4; ++m)
#pragma unroll
            for (int n = 0; n < 2; ++n) acc[a][b][m][n] = (f32x4){0.f, 0.f, 0.f, 0.f};
      cur = nxt; cA = nA; cB = nB; ++ui;
    }
    G_WAIT_V(0);
    if (wr == 0) G_BAR;
    G_BAR;
  }
#undef G_SA
#undef G_SB
#undef G_STAGE
#undef G_LDA
#undef G_LDB
#undef G_MMA
}

__device__ void phase_prep_even(const Params& p, int j) {
  const int wave = TID() >> 6, lane = TID() & 63, tid = TID();
  const float qscale = 0.125f * 1.44269504088896f;
  const float gq = p.qk_gain[j * 128 + lane], gk = p.qk_gain[j * 128 + 64 + lane];
  for (int row = blockIdx.x * 8 + wave; row < MT; row += gridDim.x * 8) {
    bf16_t* pr = p.P + (size_t)row * LDP_E;
    const bool lat = row < ML;
    const int t = row & 2047;
    const int pos = (lane < 32) ? (t >> 6) : (t & 63);
    const float cs = ROPE_CS[pos][lane & 15], sn = ROPE_SN[pos][lane & 15];
    float vals[16];
#pragma unroll
    for (int g = 0; g < 16; ++g) vals[g] = bf2f(pr[g * 64 + lane]);
#pragma unroll
    for (int g = 0; g < 16; ++g) {
      const float v = vals[g];
      const float ss = wave_sum(v * v);
      float y = v * rsqrtf(ss * (1.f / 64.f) + EPSN) * (g < 8 ? gq : gk);
      if (lat) {
        const float o = __shfl_xor(y, 16, 64);
        y = (lane & 16) ? (y * cs + o * sn) : (y * cs - o * sn);
      }
      if (g < 8) y *= qscale;
      pr[g * 64 + lane] = f2bf(y);
    }
  }
  bf16_t* ts = (bf16_t*)smem_raw;
  for (int it = blockIdx.x; it < NB * 4 * 36; it += gridDim.x) {
    const int kb = it % 36, h = (it / 36) & 3, b = it / 144;
    __syncthreads();
    {
      const int r = tid >> 3, ch = tid & 7;
      const int kk = kb * 64 + r;
      const int row = kk < TCX ? ML + b * TCX + kk : b * TL + (kk - TCX);
      const bf16_t* src = p.P + (size_t)row * LDP_E + 1024 + h * 128;
#pragma unroll
      for (int i = 0; i < 2; ++i) {
        const int c8 = (ch + i * 8) * 8;
        const uint4 v = *(const uint4*)(src + c8);
        unsigned* d = (unsigned*)(ts + r * 130 + c8);
        d[0] = v.x; d[1] = v.y; d[2] = v.z; d[3] = v.w;
      }
    }
    __syncthreads();
    {
      const int e = tid >> 2, kq = tid & 3;
      unsigned w[8];
#pragma unroll
      for (int i = 0; i < 8; ++i) {
        const unsigned lo = ts[(kq * 16 + 2 * i) * 130 + e], hi = ts[(kq * 16 + 2 * i + 1) * 130 + e];
        w[i] = lo | (hi << 16);
      }
      bf16_t* dst = p.Vt + ((size_t)(b * 4 + h) * 128 + e) * NKK + kb * 64 + kq * 16;
      *(uint4*)(dst) = make_uint4(w[0], w[1], w[2], w[3]);
      *(uint4*)(dst + 8) = make_uint4(w[4], w[5], w[6], w[7]);
    }
  }
  {
    float* wl = (float*)smem_raw;
    __syncthreads();
    for (int i = tid; i < 2 * 16 * 256; i += NTHR) wl[i] = p.w_gate_up[(size_t)j * 8192 + i];
    for (int i = tid; i < 512; i += NTHR) wl[8192 + i] = p.b_gate_up[j * 512 + i];
    __syncthreads();
    for (int row = blockIdx.x * 8 + wave; row < MT; row += gridDim.x * 8) {
      const bf16_t* pr = p.P + (size_t)row * LDP_E + 3072;
      const float lrv = lane < 32 ? bf2f(pr[lane]) : 0.f;
#pragma unroll
      for (int u = 0; u < 8; ++u) {
        const int col = u * 64 + lane;
        const int dr = col >> 8, cc = col & 255;
        float xg = wl[8192 + col];
#pragma unroll
        for (int rr = 0; rr < 16; ++rr) xg += __shfl(lrv, dr * 16 + rr, 64) * wl[(dr * 16 + rr) * 256 + cc];
        const float ls = fminf(xg, 0.f) - log1pf(__expf(-fabsf(xg)));
        p.Gk[(size_t)row * 512 + col] = __expf(ls * (1.f / 16.f));
      }
    }
  }
}

__device__ void attn_item(const Params& p, int item) {
  const int tid = TID(), wave = tid >> 6, lane = tid & 63, r = lane & 31, hh = lane >> 5;
  int b, hc, qrow0, krow_ctx, krow_lat, ntile;
  if (item < 512) { b = item >> 6; hc = (item >> 3) & 7; qrow0 = b * TL + (item & 7) * 256; ntile = 36; }
  else { const int i2 = item - 512; b = i2 >> 3; hc = i2 & 7; qrow0 = ML + b * TCX; ntile = 4; }
  krow_ctx = ML + b * TCX; krow_lat = b * TL;
  const int h = hc >> 1, c = hc & 1;
  bf16_t* Ksm = (bf16_t*)smem_raw;
  bf16_t* Vsm = (bf16_t*)(smem_raw + 2 * 9216);
  const int qrow = qrow0 + wave * 32 + r;
  bf16x8 qf[4];
#pragma unroll
  for (int s = 0; s < 4; ++s) qf[s] = *(const bf16x8*)(p.P + (size_t)qrow * LDP_E + hc * 64 + 16 * s + 8 * hh);
  f32x16 oacc[4];
#pragma unroll
  for (int eb = 0; eb < 4; ++eb)
#pragma unroll
    for (int i = 0; i < 16; ++i) oacc[eb][i] = 0.f;
  float mrun = -1e30f, lsum = 0.f;
  const int kkey = tid >> 3, kch = tid & 7;
  const int ve = tid >> 2, vch = tid & 3;
  const bf16_t* vbase = p.Vt + ((size_t)(b * 4 + h) * 128 + ve) * NKK + vch * 16;
  uint4 kreg, vreg0, vreg1;
  auto gload = [&](int t) {
    const int kk = t * 64 + kkey;
    const int row = kk < TCX ? krow_ctx + kk : krow_lat + (kk - TCX);
    kreg = *(const uint4*)(p.P + (size_t)row * LDP_E + 512 + hc * 64 + kch * 8);
    vreg0 = *(const uint4*)(vbase + t * 64);
    vreg1 = *(const uint4*)(vbase + t * 64 + 8);
  };
  auto sstore = [&](int buf) {
    *(uint4*)(Ksm + buf * 4608 + kkey * 72 + kch * 8) = kreg;
    uint2* d = (uint2*)(Vsm + buf * 8704 + ve * 68 + vch * 16);
    d[0] = make_uint2(vreg0.x, vreg0.y); d[1] = make_uint2(vreg0.z, vreg0.w);
    d[2] = make_uint2(vreg1.x, vreg1.y); d[3] = make_uint2(vreg1.z, vreg1.w);
  };
  __syncthreads();
  gload(0); sstore(0);
  __syncthreads();
  for (int t = 0; t < ntile; ++t) {
    const int buf = t & 1;
    if (t + 1 < ntile) gload(t + 1);
    const bf16_t* Kb = Ksm + buf * 4608;
    const bf16_t* Vb = Vsm + buf * 8704;
    f32x16 sacc[2];
#pragma unroll
    for (int kb = 0; kb < 2; ++kb) {
#pragma unroll
      for (int i = 0; i < 16; ++i) sacc[kb][i] = 0.f;
#pragma unroll
      for (int s = 0; s < 4; ++s) {
        const bf16x8 kf = *(const bf16x8*)(Kb + (32 * kb + r) * 72 + 16 * s + 8 * hh);
        sacc[kb] = __builtin_amdgcn_mfma_f32_32x32x16_bf16(kf, qf[s], sacc[kb], 0, 0, 0);
      }
    }
    float mx = sacc[0][0];
#pragma unroll
    for (int kb = 0; kb < 2; ++kb)
#pragma unroll
      for (int i = 0; i < 16; ++i) mx = fmaxf(mx, sacc[kb][i]);
    mx = fmaxf(mx, __shfl_xor(mx, 32, 64));
    if (__builtin_amdgcn_ballot_w64(mx > mrun + 8.f)) {
      const float mnew = fmaxf(mrun, mx);
      const float alpha = __builtin_amdgcn_exp2f(mrun - mnew);
      mrun = mnew;
      lsum *= alpha;
#pragma unroll
      for (int eb = 0; eb < 4; ++eb)
#pragma unroll
        for (int i = 0; i < 16; ++i) oacc[eb][i] *= alpha;
    }
    float ps = 0.f;
#pragma unroll
    for (int kb = 0; kb < 2; ++kb)
#pragma unroll
      for (int i = 0; i < 16; ++i) { const float pv = __builtin_amdgcn_exp2f(sacc[kb][i] - mrun); sacc[kb][i] = pv; ps += pv; }
    lsum += ps;
#pragma unroll
    for (int ks = 0; ks < 4; ++ks) {
      const int kb = ks >> 1, s2 = ks & 1;
      uint4 pu;
      pu.x = pack2(sacc[kb][8 * s2 + 0], sacc[kb][8 * s2 + 1]); pu.y = pack2(sacc[kb][8 * s2 + 2], sacc[kb][8 * s2 + 3]);
      pu.z = pack2(sacc[kb][8 * s2 + 4], sacc[kb][8 * s2 + 5]); pu.w = pack2(sacc[kb][8 * s2 + 6], sacc[kb][8 * s2 + 7]);
      const bf16x8 pf = __builtin_bit_cast(bf16x8, pu);
#pragma unroll
      for (int eb = 0; eb < 4; ++eb) {
        const s16x4 lo = *(const s16x4*)(Vb + (32 * eb + r) * 68 + 16 * ks + 4 * hh);
        const s16x4 hi = *(const s16x4*)(Vb + (32 * eb + r) * 68 + 16 * ks + 8 + 4 * hh);
        const bf16x8 vf = __builtin_shufflevector(lo, hi, 0, 1, 2, 3, 4, 5, 6, 7);
        oacc[eb] = __builtin_amdgcn_mfma_f32_32x32x16_bf16(vf, pf, oacc[eb], 0, 0, 0);
      }
    }
    if (t + 1 < ntile) sstore(buf ^ 1);
    __syncthreads();
  }
  lsum += __shfl_xor(lsum, 32, 64);
  const float inv = 1.f / lsum;
  bf16_t* orow = p.R1 + (size_t)qrow * D + c * 512 + h * 128;
#pragma unroll
  for (int eb = 0; eb < 4; ++eb)
#pragma unroll
    for (int g = 0; g < 4; ++g) {
      const int e = 32 * eb + 8 * g + 4 * hh;
      uint2 o; o.x = pack2(oacc[eb][4 * g] * inv, oacc[eb][4 * g + 1] * inv); o.y = pack2(oacc[eb][4 * g + 2] * inv, oacc[eb][4 * g + 3] * inv);
      *(uint2*)(orow + e) = o;
    }
}

template <int MODE>
__device__ void scan_item(const Params& p, int l, int item) {
  constexpr int DK = MODE ? 128 : 64, DVS = MODE ? 64 : 32, DP = NTHR / DVS, DPT = DK / DP, TC = 32;
  constexpr int NH = MODE ? 8 : 4, NSL = 128 / DVS, LDP = MODE ? LDP_O : LDP_E;
  const int j = l >> 1;
  const int sl = item % NSL, dir = (item / NSL) & 1, h = (item / (NSL * 2)) % NH, b = item / (NSL * 2 * NH);
  float* Qs = (float*)smem_raw; float* Ks = Qs + TC * DK; float* Ds = Ks + TC * DK; float* Vs = Ds + TC * DK; float* Os = Vs + TC * DVS; float* LB = Os + TC * DVS;
  const int tid = TID(), dpart = tid % DP, e = tid / DP;
  float S[DPT];
#pragma unroll
  for (int i = 0; i < DPT; ++i) S[i] = 0.f;
  __syncthreads();
  if (MODE == 1) {
    if (tid < 128) {
      const float* lr = p.lb_raw + (size_t)dir * 4 * 1024 + h * 128 + tid;
      const float r0 = lr[0], r1 = lr[1024], r2 = lr[2048], r3 = lr[3072];
      const float mx = fmaxf(fmaxf(r0, r1), fmaxf(r2, r3));
      const float e0 = __expf(r0 - mx), e1 = __expf(r1 - mx), e2 = __expf(r2 - mx), e3 = __expf(r3 - mx);
      const float inv = 1.f / (e0 + e1 + e2 + e3);
      float acc = 0.f;
      if (l >= 1) acc += e1;
      if (l >= 2) acc += e2;
      if (l >= 3) acc += e3;
      LB[tid] = acc * inv;
    }
  }
  bf16_t* Ro;
  int ldo, ocol;
  if (MODE == 0) { Ro = p.R2 + (size_t)dir * MT * 512; ldo = 512; ocol = h * 128 + sl * DVS; }
  else { Ro = dir ? p.R2 : p.R1; ldo = 1024; ocol = h * 128 + sl * DVS; }
  for (int chunk = 0; chunk < NKK / TC; ++chunk) {
    __syncthreads();
    for (int idx = tid; idx < TC * DK; idx += NTHR) {
      const int tt = idx / DK, d = idx % DK;
      const int n = chunk * TC + tt;
      int row;
      if (n < TCX) row = ML + b * TCX + (dir ? (TCX - 1 - n) : n); else row = b * TL + (dir ? (TL - 1 - (n - TCX)) : (n - TCX));
      const bf16_t* pr = p.P + (size_t)row * LDP;
      float q, k, dec;
      if (MODE == 0) {
        q = bf2f(pr[1536 + h * 64 + d]) * 0.125f;
        k = bf2f(pr[1792 + h * 64 + d]);
        const float* w = p.w_gate_up + ((size_t)(j * 2 + dir) * 16) * 256 + h * 64 + d;
        float xg = p.b_gate_up[(j * 2 + dir) * 256 + h * 64 + d];
#pragma unroll
        for (int rr = 0; rr < 16; ++rr) xg += bf2f(pr[3072 + dir * 16 + rr]) * w[rr * 256];
        const float ls = fminf(xg, 0.f) - log1pf(__expf(-fabsf(xg)));
        dec = __expf(ls * (1.f / 16.f));
      } else {
        q = siluf(bf2f(pr[h * 128 + d])) * 0.08838834764831845f;
        const float lbv = LB[d];
        const float f = lbv + (1.f - lbv) * sigmoidf_(bf2f(pr[1024 + dir * 1024 + h * 128 + d]));
        k = 1.f - f; dec = f;
      }
      Qs[idx] = q; Ks[idx] = k; Ds[idx] = dec;
    }
    for (int idx = tid; idx < TC * DVS; idx += NTHR) {
      const int tt = idx / DVS, ee = idx % DVS;
      const int n = chunk * TC + tt;
      int row;
      if (n < TCX) row = ML + b * TCX + (dir ? (TCX - 1 - n) : n); else row = b * TL + (dir ? (TL - 1 - (n - TCX)) : (n - TCX));
      const bf16_t* pr = p.P + (size_t)row * LDP;
      Vs[idx] = bf2f(pr[(MODE ? 3072 : 2048) + h * 128 + sl * DVS + ee]);
    }
    __syncthreads();
    for (int tt = 0; tt < TC; ++tt) {
      const float v = Vs[tt * DVS + e];
      float part = 0.f;
#pragma unroll
      for (int i4 = 0; i4 < DPT / 4; ++i4) {
        const float4 q4 = *(const float4*)(Qs + tt * DK + dpart * DPT + i4 * 4);
        const float4 k4 = *(const float4*)(Ks + tt * DK + dpart * DPT + i4 * 4);
        const float4 d4 = *(const float4*)(Ds + tt * DK + dpart * DPT + i4 * 4);
        S[i4 * 4 + 0] = S[i4 * 4 + 0] * d4.x + k4.x * v; part += q4.x * S[i4 * 4 + 0];
        S[i4 * 4 + 1] = S[i4 * 4 + 1] * d4.y + k4.y * v; part += q4.y * S[i4 * 4 + 1];
        S[i4 * 4 + 2] = S[i4 * 4 + 2] * d4.z + k4.z * v; part += q4.z * S[i4 * 4 + 2];
        S[i4 * 4 + 3] = S[i4 * 4 + 3] * d4.w + k4.w * v; part += q4.w * S[i4 * 4 + 3];
      }
#pragma unroll
      for (int o = DP / 2; o >= 1; o >>= 1) part += __shfl_xor(part, o, 64);
      if (dpart == 0) Os[tt * DVS + e] = part;
    }
    __syncthreads();
    for (int idx = tid; idx < TC * DVS; idx += NTHR) {
      const int tt = idx / DVS, ee = idx % DVS;
      const int n = chunk * TC + tt;
      int row;
      if (n < TCX) row = ML + b * TCX + (dir ? (TCX - 1 - n) : n); else row = b * TL + (dir ? (TL - 1 - (n - TCX)) : (n - TCX));
      Ro[(size_t)row * ldo + ocol + ee] = f2bf(Os[idx]);
    }
  }
}

template <int MODE>
__device__ void scan2_item(const Params& p, int l, int item) {
  constexpr int DK = MODE ? 128 : 64, NH = MODE ? 8 : 4, LDP = MODE ? LDP_O : LDP_E, NDB = DK / 16, QS = DK + 8, TS = 72;
  const int dir = item & 1, h = (item >> 1) % NH, b = item / (2 * NH);
  bf16_t* Qh = (bf16_t*)smem_raw; bf16_t* Kh = Qh + 64 * QS; bf16_t* KbT = Kh + 64 * QS; bf16_t* VT = KbT + DK * TS; float* ET = (float*)(VT + 128 * TS);
  const int tid = TID(), wave = __builtin_amdgcn_readfirstlane(tid >> 6), lane = tid & 63, r15 = lane & 15, fq = lane >> 4;
  const int pd = tid % DK, pi = __builtin_amdgcn_readfirstlane(tid / DK);
  const bool pact = pi < 4;
  const int ve = tid & 127, vi = __builtin_amdgcn_readfirstlane(tid >> 7);
  float lbv = 0.f;
  if (MODE == 1) {
    const float* lr = p.lb_raw + (size_t)dir * 4 * 1024 + h * 128 + pd;
    const float r0 = lr[0], r1 = lr[1024], r2 = lr[2048], r3 = lr[3072];
    const float mx = fmaxf(fmaxf(r0, r1), fmaxf(r2, r3));
    const float e0 = __expf(r0 - mx), e1 = __expf(r1 - mx), e2 = __expf(r2 - mx), e3 = __expf(r3 - mx);
    float a = 0.f;
    if (l >= 1) a += e1;
    if (l >= 2) a += e2;
    if (l >= 3) a += e3;
    lbv = a / (e0 + e1 + e2 + e3);
  }
  const int qcol = MODE ? h * 128 + pd : 1536 + h * 64 + pd;
  const int kcol = MODE ? 1024 + dir * 1024 + h * 128 + pd : 1792 + h * 64 + pd;
  const int vcol = (MODE ? 3072 : 2048) + h * 128 + ve;
  const int gcol = dir * 256 + h * 64 + pd;
  bf16_t* Ro; int ldo;
  if (MODE == 0) { Ro = p.R2 + (size_t)dir * MT * 512; ldo = 512; } else { Ro = dir ? p.R2 : p.R1; ldo = 1024; }
  Ro += h * 128 + 16 * wave + r15;
  const int rowc = ML + b * TCX, rowl = b * TL;
  auto tokrow = [&](int n) -> int { return n < TCX ? rowc + (dir ? (TCX - 1 - n) : n) : rowl + (dir ? (TL - 1 - (n - TCX)) : (n - TCX)); };
  bf16_t rq[16], rk[16], rv[16]; float rg[16];
  auto load_raw = [&](int ck) {
#pragma unroll
    for (int tt = 0; tt < 16; ++tt) {
      if (pact) {
        const int row = tokrow(ck * 64 + 16 * pi + tt);
        const bf16_t* pr = p.P + (size_t)row * LDP;
        rq[tt] = pr[qcol]; rk[tt] = pr[kcol];
#if EXP2
        if (MODE == 0) {
          const int jx = l >> 1;
          const float* w = p.w_gate_up + ((size_t)(jx * 2 + dir) * 16) * 256 + h * 64 + pd;
          float xg = p.b_gate_up[(jx * 2 + dir) * 256 + h * 64 + pd];
#pragma unroll
          for (int rr = 0; rr < 16; ++rr) xg += bf2f(pr[3072 + dir * 16 + rr]) * w[rr * 256];
          const float ls = fminf(xg, 0.f) - log1pf(__expf(-fabsf(xg)));
          rg[tt] = ls * (1.f / 16.f);
        }
#else
        if (MODE == 0) rg[tt] = p.Gk[(size_t)row * 512 + gcol];
#endif
      }
      const int rowv = tokrow(ck * 64 + 16 * vi + tt);
      rv[tt] = p.P[(size_t)rowv * LDP + vcol];
    }
  };
  f32x4 S[NDB];
#pragma unroll
  for (int db = 0; db < NDB; ++db) S[db] = (f32x4){0.f, 0.f, 0.f, 0.f};
  constexpr int BUFE = 2 * 64 * QS + DK * TS + 128 * TS + 2 * 4 * DK;
  auto prep = [&](int bi) {
    bf16_t* Qh_ = Qh + bi * BUFE; bf16_t* Kh_ = Kh + bi * BUFE; bf16_t* KbT_ = KbT + bi * BUFE; bf16_t* VT_ = VT + bi * BUFE; float* ET_ = (float*)(VT_ + 128 * TS);
    if (pact) {
      float E = 1.f, kh[16];
#pragma unroll
      for (int tt = 0; tt < 16; ++tt) {
        float q, k, dec;
        if (MODE == 1) {
          q = siluf(bf2f(rq[tt])) * 0.08838834764831845f;
          dec = lbv + (1.f - lbv) * sigmoidf_(bf2f(rk[tt]));
          k = 1.f - dec;
        } else { q = bf2f(rq[tt]) * 0.125f; k = bf2f(rk[tt]); dec = rg[tt]; }
        E *= dec;
        const float kE = k * __builtin_amdgcn_rcpf(E);
        kh[tt] = kE;
        Qh_[(16 * pi + tt) * QS + pd] = f2bf(q * E);
        Kh_[(16 * pi + tt) * QS + pd] = f2bf(kE);
      }
      ET_[pi * DK + pd] = E;
      unsigned w[8];
#pragma unroll
      for (int u = 0; u < 8; ++u) w[u] = pack2(kh[2 * u] * E, kh[2 * u + 1] * E);
      *(uint4*)(KbT_ + pd * TS + 16 * pi) = make_uint4(w[0], w[1], w[2], w[3]);
      *(uint4*)(KbT_ + pd * TS + 16 * pi + 8) = make_uint4(w[4], w[5], w[6], w[7]);
    }
    {
      unsigned w[8];
#pragma unroll
      for (int u = 0; u < 8; ++u) w[u] = (unsigned)rv[2 * u] | ((unsigned)rv[2 * u + 1] << 16);
      *(uint4*)(VT_ + ve * TS + 16 * vi) = make_uint4(w[0], w[1], w[2], w[3]);
      *(uint4*)(VT_ + ve * TS + 16 * vi + 8) = make_uint4(w[4], w[5], w[6], w[7]);
    }
  };
  __syncthreads();
  load_raw(0);
  prep(0);
  load_raw(1);
  __syncthreads();
  for (int ck = 0; ck < NKK / 64; ++ck) {
    if (ck + 1 < NKK / 64) { prep((ck + 1) & 1); if (ck + 2 < NKK / 64) load_raw(ck + 2); }
    const int bo = (ck & 1) * BUFE;
    const bf16_t* Qb = Qh + bo; const bf16_t* Kb = Kh + bo; const bf16_t* KTb = KbT + bo; const bf16_t* Vb = VT + bo; const float* Eb = (const float*)(Vb + 128 * TS);
#pragma unroll
    for (int i = 0; i < 4; ++i) {
      f32x4 att = (f32x4){0.f, 0.f, 0.f, 0.f};
#pragma unroll
      for (int kb = 0; kb < DK / 32; ++kb) {
        const bf16x8 ka = *(const bf16x8*)(Kb + (16 * i + r15) * QS + 32 * kb + 8 * fq);
        const bf16x8 qb = *(const bf16x8*)(Qb + (16 * i + r15) * QS + 32 * kb + 8 * fq);
        att = __builtin_amdgcn_mfma_f32_16x16x32_bf16(ka, qb, att, 0, 0, 0);
      }
      const unsigned a01 = pack2((4 * fq + 0 <= r15) ? att[0] : 0.f, (4 * fq + 1 <= r15) ? att[1] : 0.f);
      const unsigned a23 = pack2((4 * fq + 2 <= r15) ? att[2] : 0.f, (4 * fq + 3 <= r15) ? att[3] : 0.f);
      const bf16x8 a8 = __builtin_bit_cast(bf16x8, make_uint4(a01, a23, 0u, 0u));
      f32x4 o = (f32x4){0.f, 0.f, 0.f, 0.f};
#pragma unroll
      for (int kb = 0; kb < DK / 32; ++kb) {
        const s16x4 qlo = *(const s16x4*)(Qb + (16 * i + r15) * QS + 32 * kb + 4 * fq);
        const s16x4 qhi = *(const s16x4*)(Qb + (16 * i + r15) * QS + 32 * kb + 16 + 4 * fq);
        const bf16x8 qa = __builtin_shufflevector(qlo, qhi, 0, 1, 2, 3, 4, 5, 6, 7);
        const bf16x8 sb = __builtin_bit_cast(bf16x8, make_uint4(pack2(S[2 * kb][0], S[2 * kb][1]), pack2(S[2 * kb][2], S[2 * kb][3]),
                                                                  pack2(S[2 * kb + 1][0], S[2 * kb + 1][1]), pack2(S[2 * kb + 1][2], S[2 * kb + 1][3])));
        o = __builtin_amdgcn_mfma_f32_16x16x32_bf16(qa, sb, o, 0, 0, 0);
      }
      const s16x4 vb = *(const s16x4*)(Vb + (16 * wave + r15) * TS + 16 * i + 4 * fq);
      const s16x4 z4 = (s16x4){0, 0, 0, 0};
      const bf16x8 vb8 = __builtin_shufflevector(vb, z4, 0, 1, 2, 3, 4, 5, 6, 7);
      o = __builtin_amdgcn_mfma_f32_16x16x32_bf16(a8, vb8, o, 0, 0, 0);
#pragma unroll
      for (int jj = 0; jj < 4; ++jj) {
        const int row = tokrow(ck * 64 + 16 * i + 4 * fq + jj);
        Ro[(size_t)row * ldo] = f2bf(o[jj]);
      }
#pragma unroll
      for (int db = 0; db < NDB; ++db) {
        const float4 et = *(const float4*)(Eb + i * DK + 16 * db + 4 * fq);
        f32x4 s = S[db];
        s[0] *= et.x; s[1] *= et.y; s[2] *= et.z; s[3] *= et.w;
        const s16x4 ka = *(const s16x4*)(KTb + (16 * db + r15) * TS + 16 * i + 4 * fq);
        S[db] = __builtin_amdgcn_mfma_f32_16x16x32_bf16(__builtin_shufflevector(ka, z4, 0, 1, 2, 3, 4, 5, 6, 7), vb8, s, 0, 0, 0);
      }
    }
    __syncthreads();
  }
}

__device__ void phase_post_even(const Params& p, int l) {
  const int j = l >> 1;
  const int wave = TID() >> 6, lane = TID() & 63;
  const float lambda_init = 0.8f - 0.6f * expf(-0.3f * (float)l);
  const float* la = p.lambda_a + j * 256;
  const float s1 = wave_sum(la[lane] * la[64 + lane]);
  const float s2 = wave_sum(la[128 + lane] * la[192 + lane]);
  const float lam = expf(s1) - expf(s2) + lambda_init;
  const float ga0 = p.subln[j * 128 + 2 * lane] * (1.f - lambda_init), ga1 = p.subln[j * 128 + 2 * lane + 1] * (1.f - lambda_init);
  const float gb0 = p.onorm_b[j * 128 + 2 * lane], gb1 = p.onorm_b[j * 128 + 2 * lane + 1];
  for (int row = blockIdx.x * 8 + wave; row < MT; row += gridDim.x * 8) {
    bf16_t* r1 = p.R1 + (size_t)row * D;
    const bf16_t* r2f = p.R2 + (size_t)row * 512;
    const bf16_t* r2b = p.R2 + (size_t)MT * 512 + (size_t)row * 512;
    const bf16_t* pg = p.P + (size_t)row * LDP_E + 2560;
    unsigned a1[4], a2[4], bf_[4], bb_[4], gg[4];
#pragma unroll
    for (int h = 0; h < 4; ++h) {
      a1[h] = *(const unsigned*)(r1 + h * 128 + 2 * lane);
      a2[h] = *(const unsigned*)(r1 + 512 + h * 128 + 2 * lane);
      bf_[h] = *(const unsigned*)(r2f + h * 128 + 2 * lane);
      bb_[h] = *(const unsigned*)(r2b + h * 128 + 2 * lane);
      gg[h] = *(const unsigned*)(pg + h * 128 + 2 * lane);
    }
    unsigned oa[4], ob[4];
#pragma unroll
    for (int h = 0; h < 4; ++h) {
      const float x0 = bf2f((bf16_t)(a1[h] & 0xffff)) - lam * bf2f((bf16_t)(a2[h] & 0xffff));
      const float x1 = bf2f((bf16_t)(a1[h] >> 16)) - lam * bf2f((bf16_t)(a2[h] >> 16));
      const float ra = rsqrtf(wave_sum(x0 * x0 + x1 * x1) * (1.f / 128.f) + EPSN);
      oa[h] = pack2(x0 * ra * ga0, x1 * ra * ga1);
      const float y0 = bf2f((bf16_t)(bf_[h] & 0xffff)) + bf2f((bf16_t)(bb_[h] & 0xffff));
      const float y1 = bf2f((bf16_t)(bf_[h] >> 16)) + bf2f((bf16_t)(bb_[h] >> 16));
      const float rb = rsqrtf(wave_sum(y0 * y0 + y1 * y1) * (1.f / 128.f) + EPSN);
      const float g0 = bf2f((bf16_t)(gg[h] & 0xffff)), g1 = bf2f((bf16_t)(gg[h] >> 16));
      ob[h] = pack2(y0 * rb * gb0 * siluf(g0), y1 * rb * gb1 * siluf(g1));
    }
#pragma unroll
    for (int h = 0; h < 4; ++h) {
      *(unsigned*)(r1 + h * 128 + 2 * lane) = oa[h];
      *(unsigned*)(r1 + 512 + h * 128 + 2 * lane) = ob[h];
    }
  }
}

__device__ void phase_post_odd(const Params& p, int l) {
  const int j = l >> 1;
  const int wave = TID() >> 6, lane = TID() & 63;
  const float g0 = p.onorm_c[j * 128 + 2 * lane], g1 = p.onorm_c[j * 128 + 2 * lane + 1];
  for (int row = blockIdx.x * 8 + wave; row < MT; row += gridDim.x * 8) {
    bf16_t* r1 = p.R1 + (size_t)row * D;
    const bf16_t* r2 = p.R2 + (size_t)row * D;
    const bf16_t* pg = p.P + (size_t)row * LDP_O + 4096;
    unsigned a[8], bq[8], gg[8];
#pragma unroll
    for (int h = 0; h < 8; ++h) {
      a[h] = *(const unsigned*)(r1 + h * 128 + 2 * lane);
      bq[h] = *(const unsigned*)(r2 + h * 128 + 2 * lane);
      gg[h] = *(const unsigned*)(pg + h * 128 + 2 * lane);
    }
    unsigned o[8];
#pragma unroll
    for (int h = 0; h < 8; ++h) {
      const float y0 = bf2f((bf16_t)(a[h] & 0xffff)) + bf2f((bf16_t)(bq[h] & 0xffff));
      const float y1 = bf2f((bf16_t)(a[h] >> 16)) + bf2f((bf16_t)(bq[h] >> 16));
      const float rb = rsqrtf(wave_sum(y0 * y0 + y1 * y1) * (1.f / 128.f) + EPSN);
      const float q0 = bf2f((bf16_t)(gg[h] & 0xffff)), q1 = bf2f((bf16_t)(gg[h] >> 16));
      o[h] = pack2(y0 * rb * g0 * siluf(q0), y1 * rb * g1 * siluf(q1));
    }
#pragma unroll
    for (int h = 0; h < 8; ++h) *(unsigned*)(r1 + h * 128 + 2 * lane) = o[h];
  }
}

constexpr int NPHASE = 1 + 4 * 9;
#ifndef GEMM_INL
#define GEMM_INL
#endif
__device__ GEMM_INL void gemm_call_p(const bf16_t* A, const bf16_t* Bt, int M, int N, int K, EpiArgs ea) { gemm_phase<EPI_P>(A, Bt, M, N, K, ea); }
__device__ GEMM_INL void gemm_call_res(const bf16_t* A, const bf16_t* Bt, int M, int N, int K, EpiArgs ea) { gemm_phase<EPI_RES>(A, Bt, M, N, K, ea); }
__device__ GEMM_INL void gemm_call_sw(const bf16_t* A, const bf16_t* Bt, int M, int N, int K, EpiArgs ea) { gemm_phase<EPI_SWIGLU>(A, Bt, M, N, K, ea); }

__device__ void run_phase(const Params& p, int ph) {
  if (ph == 0) { phase_init(p); return; }
  const int l = (ph - 1) / 9, s = (ph - 1) % 9, j = l >> 1;
  const bool even = (l & 1) == 0;
  const int mrows = l < 3 ? MT : ML;
  const float* modl = p.mod + (size_t)l * 9 * 6144;
  if (s == 1 || s == 5 || s == 8) {
    if (s == 1) {
      EpiArgs ea{p.P, even ? LDP_E : LDP_O, nullptr, nullptr, nullptr};
      const bf16_t* Bt = even ? p.wt_in_even + (size_t)j * LDP_E * 1024 : p.wt_in_odd + (size_t)j * LDP_O * 1024;
      gemm_call_p(p.R1, Bt, MT, even ? LDP_E : LDP_O, 1024, ea);
    } else {
      EpiArgs ea{nullptr, 0, p.out, p.Z, modl + (s == 5 ? 2 : 5) * 1024};
      const bf16_t* A = s == 5 ? p.R1 : p.P;
      const bf16_t* Bt = s == 5 ? (even ? p.wt_out_even : p.wt_out_odd) + (size_t)j * 1024 * 1024 : p.wt_ffn_out + (size_t)l * 1024 * DFF;
      gemm_call_res(A, Bt, mrows, 1024, s == 5 ? 1024 : DFF, ea);
    }
    return;
  }
  switch (s) {
    case 0: phase_norm(p, l, 0, MT, p.R1); break;
    case 2: if (even) phase_prep_even(p, j); break;
    case 3: {
      if (even) {
#if DYNQ
        int* qs = (int*)(smem_raw + LDS_BYTES - 16);
        for (;;) {
          __syncthreads();
          if (TID() == 0) *qs = (int)atomicAdd(p.ctr + l, 1u);
          __syncthreads();
          const int it = *qs;
          if (it >= 64 + 576) break;
          if (it < 64) scan2_item<0>(p, l, it); else attn_item(p, it - 64);
        }
#else
#if EXP1
        for (int it = blockIdx.x; it < 256 + 576; it += gridDim.x) { if (it < 256) scan_item<0>(p, l, it); else attn_item(p, it - 256); }
#else
        for (int it = blockIdx.x; it < 64 + 576; it += gridDim.x) { if (it < 64) scan2_item<0>(p, l, it); else attn_item(p, it - 64); }
#endif
#endif
      } else {
        for (int it = blockIdx.x; it < 128; it += gridDim.x) scan2_item<1>(p, l, it);
      }
    } break;
    case 4: if (even) phase_post_even(p, l); else phase_post_odd(p, l); break;
    case 6: phase_norm(p, l, 1, mrows, p.R2); break;
    case 7: {
      EpiArgs ea{p.P, DFF, nullptr, nullptr, nullptr};
      gemm_call_sw(p.R2, p.wt_ffn_in + (size_t)l * 5632 * 1024, mrows, 5632, 1024, ea);
    } break;
  }
}

__global__ void __launch_bounds__(NTHR, 2) mega_kernel(Params p, int ph0, int ph1) {
  cg::grid_group grid = cg::this_grid();
  for (int ph = ph0; ph < ph1; ++ph) {
#if DBL_MASK
    { const int s_ = ph == 0 ? 9 : (ph - 1) % 9; const int nrep = ((DBL_MASK >> s_) & 1) ? 2 : 1; for (int rep = 0; rep < nrep; ++rep) run_phase(p, ph); }
#else
    run_phase(p, ph);
#endif
    if (ph + 1 < ph1) grid.sync();
  }
}

extern "C" void kernel_launch(void* const* d_in, const int* in_sizes, int n_in, void* d_out, int out_size, void* d_ws, size_t ws_size, hipStream_t stream) {
  constexpr size_t kDynLds = LDS_BYTES;
  static int grid_blocks = 0;
  if (!grid_blocks) {
    hipFuncSetAttribute((const void*)mega_kernel, hipFuncAttributeMaxDynamicSharedMemorySize, (int)kDynLds);
    int dev = 0, cus = 0, per_cu = 0;
    hipGetDevice(&dev);
    hipDeviceGetAttribute(&cus, hipDeviceAttributeMultiprocessorCount, dev);
    hipOccupancyMaxActiveBlocksPerMultiprocessor(&per_cu, mega_kernel, NTHR, kDynLds);
    if (per_cu < 1) per_cu = 1;
    grid_blocks = cus * per_cu;
  }
  Params p{};
  const float* const* in = (const float* const*)d_in;
  p.x = in[0]; p.c = in[1]; p.ctx = in[2]; p.c_ctx = in[3]; p.w_ada = in[4]; p.b_ada = in[5]; p.n1g = in[6]; p.n2g = in[7];
  p.w_in_even = in[8]; p.qk_gain = in[9]; p.lambda_a = in[10]; p.subln = in[11]; p.w_gate_up = in[12]; p.b_gate_up = in[13];
  p.onorm_b = in[14]; p.w_out_even = in[15]; p.w_in_odd = in[16]; p.lb_raw = in[17]; p.onorm_c = in[18]; p.w_out_odd = in[19];
  p.w_ffn_in = in[20]; p.w_ffn_out = in[21];
  p.out = (float*)d_out;
  char* w = (char*)d_ws;
  size_t off = 0;
  auto take = [&](size_t bytes) { char* r = w + off; off += (bytes + 255) & ~(size_t)255; return r; };
  p.wt_in_even = (bf16_t*)take((size_t)2 * LDP_E * 1024 * 2);
  p.wt_in_odd = (bf16_t*)take((size_t)2 * LDP_O * 1024 * 2);
  p.wt_out_even = (bf16_t*)take((size_t)2 * 1024 * 1024 * 2);
  p.wt_out_odd = (bf16_t*)take((size_t)2 * 1024 * 1024 * 2);
  p.wt_ffn_in = (bf16_t*)take((size_t)4 * 5632 * 1024 * 2);
  p.wt_ffn_out = (bf16_t*)take((size_t)4 * 1024 * DFF * 2);
  p.Z = (float*)take((size_t)MC * D * 4);
  p.mod = (float*)take((size_t)4 * 9 * 6144 * 4);
  p.P = (bf16_t*)take((size_t)MT * LDP_O * 2);
  p.R1 = (bf16_t*)take((size_t)MT * D * 2);
  p.R2 = (bf16_t*)take((size_t)MT * D * 2);
  p.Vt = p.P + (size_t)MT * LDP_E;
  p.Gk = (float*)(p.Vt + (size_t)NB * 4 * 128 * NKK);
  p.ctr = (unsigned*)take(256);
  if (off > ws_size) { fprintf(stderr, "workspace too small: need %zu have %zu\n", off, ws_size); return; }
#if ONE_LAUNCH
  int ph0 = 0, ph1 = NPHASE;
  void* args[] = {&p, &ph0, &ph1};
  hipError_t e = hipLaunchCooperativeKernel((const void*)mega_kernel, dim3(grid_blocks), dim3(NTHR), args, kDynLds, stream);
  if (e != hipSuccess) fprintf(stderr, "cooperative launch failed: %s (grid %d)\n", hipGetErrorString(e), grid_blocks);
#else
  for (int ph = 0; ph < NPHASE; ++ph) {
    const int l = (ph - 1) / 9, s = (ph - 1) % 9;
    if (ph > 0 && s == 2 && (l & 1)) continue;
    mega_kernel<<<grid_blocks, NTHR, kDynLds, stream>>>(p, ph, ph + 1);
  }
#endif
}
```

```cpp
#include <hip/hip_runtime.h>
#include <hip/hip_cooperative_groups.h>
#include <cstdio>
namespace cg = cooperative_groups;

#ifndef DYNQ
#define DYNQ 1
#endif
#ifndef EXP1
#define EXP1 0
#endif
#ifndef EXP2
#define EXP2 0
#endif
#ifndef EXTRA_SYNC
#define EXTRA_SYNC 0
#endif
#ifndef CUSTOM_BAR
#define CUSTOM_BAR 0
#endif
#ifndef DBL_MASK
#define DBL_MASK 0
#endif
#ifndef ONE_LAUNCH
#define ONE_LAUNCH 1
#endif

typedef unsigned short bf16_t;
typedef short bf16x8 __attribute__((ext_vector_type(8)));
typedef short s16x4 __attribute__((ext_vector_type(4)));
typedef float f32x4 __attribute__((ext_vector_type(4)));
typedef float f32x16 __attribute__((ext_vector_type(16)));
#define DI __device__ __forceinline__

__device__ const float ROPE_CS[64][16] = {
  {1.00000000e+00f,1.00000000e+00f,1.00000000e+00f,1.00000000e+00f,1.00000000e+00f,1.00000000e+00f,1.00000000e+00f,1.00000000e+00f,1.00000000e+00f,1.00000000e+00f,1.00000000e+00f,1.00000000e+00f,1.00000000e+00f,1.00000000e+00f,1.00000000e+00f,1.00000000e+00f},
  {5.40302277e-01f,8.46009135e-01f,9.50415254e-01f,9.84230220e-01f,9.95004177e-01f,9.98419285e-01f,9.99500036e-01f,9.99841869e-01f,9.99949992e-01f,9.99984205e-01f,9.99994993e-01f,9.99998391e-01f,9.99999523e-01f,9.99999821e-01f,9.99999940e-01f,1.00000000e+00f},
  {-4.16146845e-01f,4.31462824e-01f,8.06578398e-01f,9.37418282e-01f,9.80066597e-01f,9.93682086e-01f,9.98000681e-01f,9.99367595e-01f,9.99800026e-01f,9.99936759e-01f,9.99979973e-01f,9.99993682e-01f,9.99997973e-01f,9.99999344e-01f,9.99999821e-01f,9.99999940e-01f},
  {-9.89992499e-01f,-1.15966164e-01f,5.82753658e-01f,8.61040652e-01f,9.55336511e-01f,9.85803485e-01f,9.95503366e-01f,9.98577297e-01f,9.99550045e-01f,9.99857724e-01f,9.99954998e-01f,9.99985754e-01f,9.99995530e-01f,9.99998569e-01f,9.99999523e-01f,9.99999881e-01f},
  {-6.53643608e-01f,-6.27679706e-01f,3.01137477e-01f,7.57506192e-01f,9.21060979e-01f,9.74808276e-01f,9.92010653e-01f,9.97471273e-01f,9.99200106e-01f,9.99747038e-01f,9.99920011e-01f,9.99974728e-01f,9.99992013e-01f,9.99997497e-01f,9.99999225e-01f,9.99999762e-01f},
  {2.83662200e-01f,-9.46079254e-01f,-1.03423381e-02f,6.30080283e-01f,8.77582550e-01f,9.60731268e-01f,9.87526000e-01f,9.96049762e-01f,9.98750269e-01f,9.99604762e-01f,9.99875009e-01f,9.99960482e-01f,9.99987483e-01f,9.99996066e-01f,9.99998748e-01f,9.99999583e-01f},
  {9.60170269e-01f,-9.73103702e-01f,-3.20796400e-01f,4.82782036e-01f,8.25335622e-01f,9.43616986e-01f,9.82053936e-01f,9.94313300e-01f,9.98200536e-01f,9.99430835e-01f,9.99819994e-01f,9.99943078e-01f,9.99981999e-01f,9.99994338e-01f,9.99998212e-01f,9.99999404e-01f},
  {7.53902256e-01f,-7.00429797e-01f,-5.99437475e-01f,3.20257008e-01f,7.64842212e-01f,9.23519433e-01f,9.75599885e-01f,9.92262423e-01f,9.97551024e-01f,9.99225318e-01f,9.99755025e-01f,9.99922514e-01f,9.99975502e-01f,9.99992251e-01f,9.99997556e-01f,9.99999225e-01f},
  {-1.45500034e-01f,-2.12036446e-01f,-8.18632424e-01f,1.47631213e-01f,6.96706712e-01f,9.00502324e-01f,9.68170285e-01f,9.89897788e-01f,9.96801734e-01f,9.98988271e-01f,9.99680042e-01f,9.99898791e-01f,9.99967992e-01f,9.99989867e-01f,9.99996781e-01f,9.99998987e-01f},
  {-9.11130250e-01f,3.41660261e-01f,-9.56644177e-01f,-2.96507962e-02f,6.21609926e-01f,8.74638259e-01f,9.59772646e-01f,9.87220109e-01f,9.95952725e-01f,9.98719573e-01f,9.99595046e-01f,9.99871910e-01f,9.99959528e-01f,9.99987185e-01f,9.99995947e-01f,9.99998748e-01f},
  {-8.39071512e-01f,7.90131867e-01f,-9.99786079e-01f,-2.05997631e-01f,5.40302277e-01f,8.46009135e-01f,9.50415313e-01f,9.84230220e-01f,9.95004177e-01f,9.98419285e-01f,9.99500036e-01f,9.99841869e-01f,9.99949992e-01f,9.99984205e-01f,9.99994993e-01f,9.99998391e-01f},
  {4.42569796e-03f,9.95257378e-01f,-9.43779767e-01f,-3.75847399e-01f,4.53596085e-01f,8.14705312e-01f,9.40107584e-01f,9.80929136e-01f,9.93956089e-01f,9.98087406e-01f,9.99395072e-01f,9.99808669e-01f,9.99939501e-01f,9.99980867e-01f,9.99993920e-01f,9.99998093e-01f},
  {8.43853951e-01f,8.93861592e-01f,-7.94179380e-01f,-5.33843040e-01f,3.62357706e-01f,7.80825913e-01f,9.28859890e-01f,9.77317870e-01f,9.92808640e-01f,9.97723997e-01f,9.99280095e-01f,9.99772310e-01f,9.99927998e-01f,9.99977231e-01f,9.99992788e-01f,9.99997735e-01f},
  {9.07446802e-01f,5.17172873e-01f,-5.65820515e-01f,-6.75001681e-01f,2.67498761e-01f,7.44477987e-01f,9.16683376e-01f,9.73397553e-01f,9.91561890e-01f,9.97329056e-01f,9.99155104e-01f,9.99732792e-01f,9.99915481e-01f,9.99973297e-01f,9.99991536e-01f,9.99997318e-01f},
  {1.36737213e-01f,-1.87961515e-02f,-2.81349480e-01f,-7.94870913e-01f,1.69967160e-01f,7.05776393e-01f,9.03590262e-01f,9.69169438e-01f,9.90216017e-01f,9.96902585e-01f,9.99020159e-01f,9.99690115e-01f,9.99902010e-01f,9.99969006e-01f,9.99990225e-01f,9.99996901e-01f},
  {-7.59687901e-01f,-5.48975468e-01f,3.10223512e-02f,-8.89670432e-01f,7.07371980e-02f,6.64843500e-01f,8.89593601e-01f,9.64634836e-01f,9.88771081e-01f,9.96444523e-01f,9.98875201e-01f,9.99644279e-01f,9.99887526e-01f,9.99964416e-01f,9.99988735e-01f,9.99996424e-01f},
  {-9.57659483e-01f,-9.10081089e-01f,3.40318173e-01f,-9.56410050e-01f,-2.91995462e-02f,6.21808827e-01f,8.74707460e-01f,9.59795177e-01f,9.87227261e-01f,9.95954990e-01f,9.98720288e-01f,9.99595284e-01f,9.99872029e-01f,9.99959528e-01f,9.99987185e-01f,9.99995947e-01f},
  {-2.75163352e-01f,-9.90897954e-01f,6.15864813e-01f,-9.92985010e-01f,-1.28844544e-01f,5.76808274e-01f,8.58946681e-01f,9.54652011e-01f,9.85584795e-01f,9.95433986e-01f,9.98555362e-01f,9.99543071e-01f,9.99855518e-01f,9.99954283e-01f,9.99985576e-01f,9.99995410e-01f},
  {6.60316706e-01f,-7.66536534e-01f,8.30336154e-01f,-9.98241663e-01f,-2.27202162e-01f,5.29984176e-01f,8.42327058e-01f,9.49207008e-01f,9.83843684e-01f,9.94881511e-01f,9.98380423e-01f,9.99487758e-01f,9.99837995e-01f,9.99948800e-01f,9.99983788e-01f,9.99994874e-01f},
  {9.88704622e-01f,-3.06095392e-01f,9.62463796e-01f,-9.72014248e-01f,-3.23289543e-01f,4.81484592e-01f,8.24865162e-01f,9.43461835e-01f,9.82004225e-01f,9.94297504e-01f,9.98195529e-01f,9.99429286e-01f,9.99819517e-01f,9.99942899e-01f,9.99981940e-01f,9.99994278e-01f},
  {4.08082068e-01f,2.48616725e-01f,9.99144375e-01f,-9.15129960e-01f,-4.16146845e-01f,4.31462824e-01f,8.06578457e-01f,9.37418282e-01f,9.80066597e-01f,9.93682086e-01f,9.98000681e-01f,9.99367595e-01f,9.99800026e-01f,9.99936759e-01f,9.99979973e-01f,9.99993682e-01f},
  {-5.47729254e-01f,7.26760268e-01f,9.36740458e-01f,-8.29382956e-01f,-5.04846215e-01f,3.80077004e-01f,7.87485182e-01f,9.31078374e-01f,9.78030920e-01f,9.93035257e-01f,9.97795820e-01f,9.99302804e-01f,9.99779522e-01f,9.99930263e-01f,9.99977946e-01f,9.99993026e-01f},
  {-9.99960840e-01f,9.81074572e-01f,7.81440377e-01f,-7.17477441e-01f,-5.88501155e-01f,3.27489585e-01f,7.67604589e-01f,9.24443960e-01f,9.75897431e-01f,9.92357016e-01f,9.97581005e-01f,9.99234855e-01f,9.99758005e-01f,9.99923468e-01f,9.99975801e-01f,9.99992371e-01f},
  {-5.32833040e-01f,9.33235765e-01f,5.48645258e-01f,-5.82943261e-01f,-6.66275978e-01f,2.73866832e-01f,7.46956408e-01f,9.17517304e-01f,9.73666370e-01f,9.91647422e-01f,9.97356176e-01f,9.99163687e-01f,9.99735534e-01f,9.99916375e-01f,9.99973536e-01f,9.99991655e-01f},
  {4.24179018e-01f,5.97977161e-01f,2.61441678e-01f,-4.30023283e-01f,-7.37393796e-01f,2.19378278e-01f,7.25561321e-01f,9.10300434e-01f,9.71337974e-01f,9.90906477e-01f,9.97121394e-01f,9.99089420e-01f,9.99711990e-01f,9.99908924e-01f,9.99971211e-01f,9.99990880e-01f},
  {9.91202831e-01f,7.85522610e-02f,-5.16893305e-02f,-2.63540596e-01f,-8.01143587e-01f,1.64196163e-01f,7.03440726e-01f,9.02795732e-01f,9.68912423e-01f,9.90134120e-01f,9.96876657e-01f,9.99011934e-01f,9.99687493e-01f,9.99901175e-01f,9.99968767e-01f,9.99990106e-01f},
  {6.46919310e-01f,-4.65064496e-01f,-3.59694332e-01f,-8.87455046e-02f,-8.56888831e-01f,1.08494945e-01f,6.80616796e-01f,8.95005584e-01f,9.66389954e-01f,9.89330530e-01f,9.96621907e-01f,9.98931348e-01f,9.99662042e-01f,9.99893129e-01f,9.99966204e-01f,9.99989331e-01f},
  {-2.92138815e-01f,-8.65450621e-01f,-6.32028639e-01f,8.88481140e-02f,-9.04072165e-01f,5.24506159e-02f,6.57112300e-01f,8.86932373e-01f,9.63770926e-01f,9.88495648e-01f,9.96357203e-01f,9.98847544e-01f,9.99635518e-01f,9.99884725e-01f,9.99963522e-01f,9.99988496e-01f},
  {-9.62605894e-01f,-9.99293387e-01f,-8.41684937e-01f,2.63639510e-01f,-9.42222297e-01f,-3.75941908e-03f,6.32950664e-01f,8.78578722e-01f,9.61055458e-01f,9.87629473e-01f,9.96082544e-01f,9.98760641e-01f,9.99608040e-01f,9.99876022e-01f,9.99960780e-01f,9.99987602e-01f},
  {-7.48057544e-01f,-8.25371623e-01f,-9.67871487e-01f,4.30115849e-01f,-9.70958173e-01f,-5.99575676e-02f,6.08156204e-01f,8.69947195e-01f,9.58243906e-01f,9.86732066e-01f,9.95797932e-01f,9.98670578e-01f,9.99579549e-01f,9.99867022e-01f,9.99957979e-01f,9.99986708e-01f},
  {1.54251456e-01f,-3.97251874e-01f,-9.98075247e-01f,5.83026946e-01f,-9.89992499e-01f,-1.15966164e-01f,5.82753658e-01f,8.61040652e-01f,9.55336511e-01f,9.85803485e-01f,9.95503366e-01f,9.98577297e-01f,9.99550045e-01f,9.99857724e-01f,9.99954998e-01f,9.99985754e-01f},
  {9.14742351e-01f,1.53215483e-01f,-9.29300308e-01f,7.17549205e-01f,-9.99135137e-01f,-1.71608135e-01f,5.56768358e-01f,8.51861775e-01f,9.52333570e-01f,9.84843671e-01f,9.95198846e-01f,9.98480916e-01f,9.99519527e-01f,9.99848068e-01f,9.99951959e-01f,9.99984801e-01f},
  {8.34223390e-01f,6.56495154e-01f,-7.68367112e-01f,8.29440355e-01f,-9.98294771e-01f,-2.26707578e-01f,5.30226350e-01f,8.42413545e-01f,9.49235439e-01f,9.83852804e-01f,9.94884372e-01f,9.98381376e-01f,9.99488056e-01f,9.99838114e-01f,9.99948800e-01f,9.99983788e-01f},
  {-1.32767474e-02f,9.57586050e-01f,-5.31235278e-01f,9.15171385e-01f,-9.87479806e-01f,-2.81090319e-01f,5.03154159e-01f,8.32698941e-01f,9.46042359e-01f,9.82830763e-01f,9.94559944e-01f,9.98278618e-01f,9.99455571e-01f,9.99827802e-01f,9.99945521e-01f,9.99982774e-01f},
  {-8.48570287e-01f,9.63757515e-01f,-2.41421118e-01f,9.72038329e-01f,-9.66798186e-01f,-3.34584385e-01f,4.75578904e-01f,8.22721004e-01f,9.42754686e-01f,9.81777668e-01f,9.94225562e-01f,9.98172760e-01f,9.99422073e-01f,9.99817252e-01f,9.99942183e-01f,9.99981701e-01f},
  {-9.03692186e-01f,6.73110247e-01f,7.23346695e-02f,9.98247743e-01f,-9.36456680e-01f,-3.87020677e-01f,4.47528064e-01f,8.12482953e-01f,9.39372718e-01f,9.80693519e-01f,9.93881226e-01f,9.98063743e-01f,9.99387562e-01f,9.99806345e-01f,9.99938726e-01f,9.99980628e-01f},
  {-1.27963692e-01f,1.75156534e-01f,3.78916174e-01f,9.92972851e-01f,-8.96758378e-01f,-4.38233554e-01f,4.19029742e-01f,8.01987886e-01f,9.35896814e-01f,9.79578316e-01f,9.93526995e-01f,9.97951567e-01f,9.99352098e-01f,9.99795079e-01f,9.99935210e-01f,9.99979496e-01f},
  {7.65414059e-01f,-3.76742303e-01f,6.47921681e-01f,9.56380010e-01f,-8.48100007e-01f,-4.88060862e-01f,3.90112430e-01f,7.91239262e-01f,9.32327330e-01f,9.78432178e-01f,9.93162811e-01f,9.97836173e-01f,9.99315560e-01f,9.99783576e-01f,9.99931574e-01f,9.99978364e-01f},
  {9.55073655e-01f,-8.12611222e-01f,8.52673113e-01f,8.89623463e-01f,-7.90967762e-01f,-5.36345184e-01f,3.60805035e-01f,7.80240417e-01f,9.28664625e-01f,9.77255106e-01f,9.92788672e-01f,9.97717679e-01f,9.99278069e-01f,9.99771714e-01f,9.99927819e-01f,9.99977171e-01f},
  {2.66642928e-01f,-9.98210371e-01f,9.72865343e-01f,7.94808388e-01f,-7.25932240e-01f,-5.82933903e-01f,3.31136853e-01f,7.68994927e-01f,9.24909055e-01f,9.76047099e-01f,9.92404640e-01f,9.97596025e-01f,9.99239624e-01f,9.99759495e-01f,9.99923944e-01f,9.99975979e-01f},
  {-6.66938066e-01f,-8.76379430e-01f,9.96578991e-01f,6.74925625e-01f,-6.53643608e-01f,-6.27679706e-01f,3.01137596e-01f,7.57506192e-01f,9.21060979e-01f,9.74808276e-01f,9.92010653e-01f,9.97471273e-01f,9.99200106e-01f,9.99747038e-01f,9.99920011e-01f,9.99974728e-01f},
  {-9.87339258e-01f,-4.84639406e-01f,9.21462357e-01f,5.33756077e-01f,-5.74824035e-01f,-6.70441091e-01f,2.70837069e-01f,7.45777905e-01f,9.17120814e-01f,9.73538578e-01f,9.91606772e-01f,9.97343302e-01f,9.99159634e-01f,9.99734223e-01f,9.99915957e-01f,9.99973416e-01f},
  {-3.99985313e-01f,5.63609414e-02f,7.54965365e-01f,3.75752151e-01f,-4.90260571e-01f,-7.11082935e-01f,2.40265876e-01f,7.33813822e-01f,9.13088918e-01f,9.72238123e-01f,9.91192937e-01f,9.97212172e-01f,9.99118149e-01f,9.99721110e-01f,9.99911785e-01f,9.99972105e-01f},
  {5.55113316e-01f,5.80003142e-01f,5.13598442e-01f,2.05897167e-01f,-4.00799006e-01f,-7.49476731e-01f,2.09454417e-01f,7.21617639e-01f,9.08965766e-01f,9.70906913e-01f,9.90769207e-01f,9.97077882e-01f,9.99075651e-01f,9.99707639e-01f,9.99907553e-01f,9.99970794e-01f},
  {9.99843299e-01f,9.25014675e-01f,2.21298173e-01f,2.95478199e-02f,-3.07332784e-01f,-7.85501122e-01f,1.78433523e-01f,7.09193349e-01f,9.04751658e-01f,9.69545007e-01f,9.90335584e-01f,9.96940494e-01f,9.99032140e-01f,9.99693930e-01f,9.99903202e-01f,9.99969363e-01f},
  {5.25321960e-01f,9.85138178e-01f,-9.29481089e-02f,-1.47732988e-01f,-2.10795805e-01f,-8.19042206e-01f,1.47234216e-01f,6.96544766e-01f,9.00447130e-01f,9.68152404e-01f,9.89892066e-01f,9.96799886e-01f,9.98987675e-01f,9.99679863e-01f,9.99898732e-01f,9.99967992e-01f},
  {-4.32177931e-01f,7.41858006e-01f,-3.97976756e-01f,-3.20354372e-01f,-1.12152621e-01f,-8.49993885e-01f,1.15887694e-01f,6.83675885e-01f,8.96052480e-01f,9.66729224e-01f,9.89438653e-01f,9.96656179e-01f,9.98942196e-01f,9.99665439e-01f,9.99894202e-01f,9.99966562e-01f},
  {-9.92335498e-01f,2.70098448e-01f,-6.63538277e-01f,-4.82871950e-01f,-1.23883775e-02f,-8.78258407e-01f,8.44252855e-02f,6.70590878e-01f,8.91568303e-01f,9.65275466e-01f,9.88975346e-01f,9.96509314e-01f,9.98895705e-01f,9.99650776e-01f,9.99889553e-01f,9.99965072e-01f},
  {-6.40144348e-01f,-2.84846604e-01f,-8.63296509e-01f,-6.30159974e-01f,8.74991715e-02f,-9.03746367e-01f,5.28784581e-02f,6.57293737e-01f,8.86994898e-01f,9.63791192e-01f,9.88502085e-01f,9.96359289e-01f,9.98848200e-01f,9.99635756e-01f,9.99884784e-01f,9.99963582e-01f},
  {3.00592542e-01f,-7.52063990e-01f,-9.77442741e-01f,-7.57573068e-01f,1.86512470e-01f,-9.26377118e-01f,2.12787576e-02f,6.43788815e-01f,8.82332861e-01f,9.62276459e-01f,9.88018990e-01f,9.96206105e-01f,9.98799741e-01f,9.99620378e-01f,9.99879956e-01f,9.99962032e-01f},
  {9.64965999e-01f,-9.87659097e-01f,-9.94656444e-01f,-8.61092687e-01f,2.83662200e-01f,-9.46079254e-01f,-1.03422189e-02f,6.30080283e-01f,8.77582550e-01f,9.60731268e-01f,9.87526000e-01f,9.96049762e-01f,9.98750269e-01f,9.99604762e-01f,9.99875009e-01f,9.99960482e-01f},
  {7.42154181e-01f,-9.19073522e-01f,-9.13230121e-01f,-9.37454224e-01f,3.77977669e-01f,-9.62790370e-01f,-4.19528559e-02f,6.16172493e-01f,8.72744501e-01f,9.59155679e-01f,9.87023175e-01f,9.95890260e-01f,9.98699784e-01f,9.99588788e-01f,9.99869943e-01f,9.99958873e-01f},
  {-1.62990779e-01f,-5.67430019e-01f,-7.41239965e-01f,-9.84248459e-01f,4.68516916e-01f,-9.76457715e-01f,-7.35215396e-02f,6.02069914e-01f,8.67819190e-01f,9.57549810e-01f,9.86510456e-01f,9.95727658e-01f,9.98648286e-01f,9.99572515e-01f,9.99864817e-01f,9.99957263e-01f},
  {-9.18282807e-01f,-4.10281904e-02f,-4.95741814e-01f,-1.00000000e+00f,5.54374516e-01f,-9.87038016e-01f,-1.05016708e-01f,5.87776959e-01f,8.62807095e-01f,9.55913603e-01f,9.85987842e-01f,9.95561838e-01f,9.98595834e-01f,9.99555886e-01f,9.99859571e-01f,9.99955595e-01f},
  {-8.29309821e-01f,4.98009592e-01f,-2.01079622e-01f,-9.84212041e-01f,6.34692967e-01f,-9.94497895e-01f,-1.36406869e-01f,5.73298037e-01f,8.57708693e-01f,9.54247177e-01f,9.85455394e-01f,9.95392919e-01f,9.98542368e-01f,9.99538958e-01f,9.99854207e-01f,9.99953866e-01f},
  {2.21267566e-02f,8.83669317e-01f,1.13521777e-01f,-9.37382519e-01f,7.08669782e-01f,-9.98813629e-01f,-1.67660639e-01f,5.58637917e-01f,8.52524519e-01f,9.52550590e-01f,9.84913111e-01f,9.95220840e-01f,9.98487890e-01f,9.99521732e-01f,9.99848783e-01f,9.99952197e-01f},
  {8.53220105e-01f,9.97174621e-01f,4.16867077e-01f,-8.60988438e-01f,7.75565803e-01f,-9.99971747e-01f,-1.98746875e-01f,5.43801069e-01f,8.47255111e-01f,9.50823903e-01f,9.84360933e-01f,9.95045662e-01f,9.98432398e-01f,9.99504209e-01f,9.99843180e-01f,9.99950409e-01f},
  {8.99866819e-01f,8.03569078e-01f,6.78870201e-01f,-7.57439196e-01f,8.34712923e-01f,-9.97968495e-01f,-2.29634270e-01f,5.28792322e-01f,8.41901004e-01f,9.49067116e-01f,9.83798921e-01f,9.94867265e-01f,9.98375952e-01f,9.99486327e-01f,9.99837577e-01f,9.99948621e-01f},
  {1.19180135e-01f,3.62476677e-01f,8.73550534e-01f,-6.30000710e-01f,8.85519624e-01f,-9.92810190e-01f,-2.60292053e-01f,5.13616323e-01f,8.36462677e-01f,9.47280347e-01f,9.83227074e-01f,9.94685769e-01f,9.98318493e-01f,9.99468148e-01f,9.99831796e-01f,9.99946833e-01f},
  {-7.71080196e-01f,-1.90249100e-01f,9.81602073e-01f,-4.82692331e-01f,9.27478492e-01f,-9.84513164e-01f,-2.90689558e-01f,4.98277903e-01f,8.30940723e-01f,9.45463598e-01f,9.82645452e-01f,9.94501114e-01f,9.98260021e-01f,9.99449670e-01f,9.99825954e-01f,9.99944985e-01f},
  {-9.52412963e-01f,-6.84381902e-01f,9.92308319e-01f,-3.20159167e-01f,9.60170269e-01f,-9.73103702e-01f,-3.20796400e-01f,4.82782036e-01f,8.25335622e-01f,9.43616986e-01f,9.82053936e-01f,9.94313300e-01f,9.98200536e-01f,9.99430835e-01f,9.99819994e-01f,9.99943078e-01f},
  {-2.58101642e-01f,-9.67739642e-01f,9.04607594e-01f,-1.47529200e-01f,9.83268440e-01f,-9.58617806e-01f,-3.50582451e-01f,4.67133403e-01f,8.19648027e-01f,9.41740453e-01f,9.81452644e-01f,9.94122326e-01f,9.98140097e-01f,9.99411702e-01f,9.99813974e-01f,9.99941170e-01f},
  {6.73507154e-01f,-9.53050017e-01f,7.27198064e-01f,2.97537707e-02f,9.96542096e-01f,-9.41101313e-01f,-3.80017966e-01f,4.51337039e-01f,8.13878477e-01f,9.39834237e-01f,9.80841517e-01f,9.93928254e-01f,9.98078644e-01f,9.99392271e-01f,9.99807835e-01f,9.99939203e-01f},
  {9.85896587e-01f,-6.44837022e-01f,4.77671444e-01f,2.06098333e-01f,9.99858618e-01f,-9.20609534e-01f,-4.09073502e-01f,4.35397953e-01f,8.08027506e-01f,9.37898219e-01f,9.80220556e-01f,9.93731022e-01f,9.98016179e-01f,9.99372482e-01f,9.99801576e-01f,9.99937236e-01f}
};
__device__ const float ROPE_SN[64][16] = {
  {0.00000000e+00f,0.00000000e+00f,0.00000000e+00f,0.00000000e+00f,0.00000000e+00f,0.00000000e+00f,0.00000000e+00f,0.00000000e+00f,0.00000000e+00f,0.00000000e+00f,0.00000000e+00f,0.00000000e+00f,0.00000000e+00f,0.00000000e+00f,0.00000000e+00f,0.00000000e+00f},
  {8.41470957e-01f,5.33168435e-01f,3.10983598e-01f,1.76892191e-01f,9.98334214e-02f,5.62044978e-02f,3.16175036e-02f,1.77818574e-02f,9.99983307e-03f,5.62338345e-03f,3.16227227e-03f,1.77827850e-03f,9.99999931e-04f,5.62341243e-04f,3.16227757e-04f,1.77827940e-04f},
  {9.09297407e-01f,9.02130723e-01f,5.91127098e-01f,3.48205268e-01f,1.98669329e-01f,1.12231314e-01f,6.32033944e-02f,3.55580896e-02f,1.99986659e-02f,1.12465890e-02f,6.32451288e-03f,3.55655141e-03f,1.99999870e-03f,1.12468237e-03f,6.32455456e-04f,3.55655880e-04f},
  {1.41120002e-01f,9.93253171e-01f,8.12648892e-01f,5.08536100e-01f,2.95520216e-01f,1.67903304e-01f,9.47260857e-02f,5.33230826e-02f,2.99954992e-02f,1.68694388e-02f,9.48669016e-03f,5.33481315e-03f,2.99999560e-03f,1.68702309e-03f,9.48683126e-04f,5.33483806e-04f},
  {-7.56802499e-01f,7.78471708e-01f,9.53580737e-01f,6.52827978e-01f,3.89418334e-01f,2.23044485e-01f,1.26154065e-01f,7.10712075e-02f,3.99893336e-02f,2.24917568e-02f,1.26487734e-02f,7.11305765e-03f,3.99998948e-03f,2.24936334e-03f,1.26491068e-03f,7.11311703e-04f},
  {-9.58924294e-01f,3.23935270e-01f,9.99946535e-01f,7.76529968e-01f,4.79425550e-01f,2.77480543e-01f,1.57455876e-01f,8.87968615e-02f,4.99791652e-02f,2.81133614e-02f,1.58107281e-02f,8.89127981e-03f,4.99997940e-03f,2.81170290e-03f,1.58113812e-03f,8.89139599e-04f},
  {-2.79415488e-01f,-2.30367512e-01f,9.47148204e-01f,8.75740528e-01f,5.64642489e-01f,3.31039310e-01f,1.88600272e-01f,1.06494442e-01f,5.99640049e-02f,3.37340795e-02f,1.89725272e-02f,1.06694745e-02f,5.99996420e-03f,3.37404152e-03f,1.89736532e-03f,1.06696738e-03f},
  {6.56986594e-01f,-7.13721275e-01f,8.00421596e-01f,9.47330713e-01f,6.44217670e-01f,3.83551568e-01f,2.19556093e-01f,1.24158338e-01f,6.99428469e-02f,3.93537246e-02f,2.21341345e-02f,1.24476347e-02f,6.99994294e-03f,3.93637875e-03f,2.21359241e-03f,1.24479528e-03f},
  {9.89358246e-01f,-9.77261782e-01f,5.74317753e-01f,9.89042461e-01f,7.17356086e-01f,4.34851229e-01f,2.50292331e-01f,1.41782969e-01f,7.99146891e-02f,4.49721329e-02f,2.52955221e-02f,1.42257558e-02f,7.99991470e-03f,4.49871505e-03f,2.52981926e-03f,1.42262306e-03f},
  {4.12118495e-01f,-9.39823508e-01f,2.91259229e-01f,9.99560297e-01f,7.83326924e-01f,4.84776139e-01f,2.80778319e-01f,1.59362778e-01f,8.98785442e-02f,5.05891182e-02f,2.84566563e-02f,1.60038304e-02f,8.99987947e-03f,5.06105041e-03f,2.84604589e-03f,1.60045072e-03f},
  {-5.44021130e-01f,-6.12936914e-01f,-2.06835698e-02f,9.78552461e-01f,8.41470957e-01f,5.33168435e-01f,3.10983568e-01f,1.76892191e-01f,9.98334140e-02f,5.62044978e-02f,3.16175036e-02f,1.77818574e-02f,9.99983400e-03f,5.62338345e-03f,3.16227227e-03f,1.77827850e-03f},
  {-9.99990225e-01f,-9.72764567e-02f,-3.30574960e-01f,9.26681578e-01f,8.91207397e-01f,5.79875171e-01f,3.40877861e-01f,1.94365650e-01f,1.09778300e-01f,6.18181042e-02f,3.47780399e-02f,1.95598267e-02f,1.09997792e-02f,6.18571462e-03f,3.47849843e-03f,1.95610616e-03f},
  {-5.36572933e-01f,4.48342979e-01f,-6.07683420e-01f,8.45583618e-01f,9.32039082e-01f,6.24748647e-01f,3.70431304e-01f,2.11777672e-01f,1.19712204e-01f,6.74297586e-02f,3.79382223e-02f,2.13377345e-02f,1.19997123e-02f,6.74804440e-03f,3.79472389e-03f,2.13393359e-03f},
  {4.20167029e-01f,8.55880976e-01f,-8.24528456e-01f,7.37816215e-01f,9.63558197e-01f,6.67647004e-01f,3.99614304e-01f,2.29122713e-01f,1.29634142e-01f,7.30392784e-02f,4.10980321e-02f,2.31155735e-02f,1.29996343e-02f,7.31037185e-03f,4.11094911e-03f,2.31176103e-03f},
  {9.90607381e-01f,9.99823332e-01f,-9.59605396e-01f,6.06778562e-01f,9.85449731e-01f,7.08434701e-01f,4.28397775e-01f,2.46395305e-01f,1.39543116e-01f,7.86464810e-02f,4.42574248e-02f,2.48933397e-02f,1.39995432e-02f,7.87269697e-03f,4.42717411e-03f,2.48958869e-03f},
  {6.50287867e-01f,8.35838437e-01f,-9.99518692e-01f,4.56603259e-01f,9.97494996e-01f,7.46982634e-01f,4.56752867e-01f,2.63589978e-01f,1.49438128e-01f,8.42512026e-02f,4.74163815e-02f,2.66710296e-02f,1.49994381e-02f,8.43502022e-03f,4.74339863e-03f,2.66741589e-03f},
  {-2.87903309e-01f,4.14430231e-01f,-9.40310359e-01f,2.92027086e-01f,9.99573588e-01f,7.83169091e-01f,4.84651238e-01f,2.80701309e-01f,1.59318209e-01f,8.98532644e-02f,5.05748577e-02f,2.84486320e-02f,1.59993190e-02f,8.99733976e-03f,5.05962269e-03f,2.84524332e-03f},
  {-9.61397469e-01f,-1.34615138e-01f,-7.87851870e-01f,1.18240520e-01f,9.91664827e-01f,8.16879570e-01f,5.12064993e-01f,2.97723860e-01f,1.69182345e-01f,9.54524800e-02f,5.37328273e-02f,3.02261449e-02f,1.69991814e-02f,9.55965649e-03f,5.37584582e-03f,3.02307028e-03f},
  {-7.50987232e-01f,-6.42200708e-01f,-5.57262897e-01f,-5.92755191e-02f,9.73847628e-01f,8.48007560e-01f,5.38966715e-01f,3.14652264e-01f,1.79029569e-01f,1.01048686e-01f,5.68902642e-02f,3.20035629e-02f,1.79990288e-02f,1.01219704e-02f,5.69206895e-03f,3.20089748e-03f},
  {1.49877205e-01f,-9.52000856e-01f,-2.71410108e-01f,-2.34921798e-01f,9.46300089e-01f,8.76454532e-01f,5.65329552e-01f,3.31481189e-01f,1.88858896e-01f,1.06641680e-01f,6.00471310e-02f,3.37808803e-02f,1.89988576e-02f,1.06842816e-02f,6.00829115e-03f,3.37872445e-03f},
  {9.12945271e-01f,-9.68601942e-01f,4.13582884e-02f,-4.03158993e-01f,9.09297407e-01f,9.02130723e-01f,5.91127038e-01f,3.48205268e-01f,1.98669314e-01f,1.12231314e-01f,6.32033944e-02f,3.55580896e-02f,1.99986678e-02f,1.12465890e-02f,6.32451288e-03f,3.55655141e-03f},
  {8.36655617e-01f,-6.86891198e-01f,3.50024760e-01f,-5.58680534e-01f,8.63209307e-01f,9.24954832e-01f,6.16333544e-01f,3.64819258e-01f,2.08459899e-01f,1.17817394e-01f,6.63590282e-02f,3.73351872e-02f,2.09984574e-02f,1.18088927e-02f,6.64073415e-03f,3.73437814e-03f},
  {-8.85130931e-03f,-1.93630233e-01f,6.23979926e-01f,-6.96581721e-01f,8.08496356e-01f,9.44854796e-01f,6.40923738e-01f,3.81317884e-01f,2.18229622e-01f,1.23399742e-01f,6.95140064e-02f,3.91121693e-02f,2.19982266e-02f,1.23711927e-02f,6.95695449e-03f,3.91220488e-03f},
  {-8.46220434e-01f,3.59264523e-01f,8.36055279e-01f,-8.12512875e-01f,7.45705247e-01f,9.61767614e-01f,6.64873064e-01f,3.97695929e-01f,2.27977514e-01f,1.28978193e-01f,7.26682767e-02f,4.08890247e-02f,2.29979735e-02f,1.29334899e-02f,7.27317436e-03f,4.09003161e-03f},
  {-9.05578375e-01f,8.01513135e-01f,9.65219259e-01f,-9.02817786e-01f,6.75463140e-01f,9.75639880e-01f,6.88157499e-01f,4.13948208e-01f,2.37702623e-01f,1.34552568e-01f,7.58218244e-02f,4.26657498e-02f,2.39976961e-02f,1.34957815e-02f,7.58939330e-03f,4.26785741e-03f},
  {-1.32351756e-01f,9.96909976e-01f,9.98663187e-01f,-9.64648306e-01f,5.98472118e-01f,9.86427724e-01f,7.10753918e-01f,4.30069596e-01f,2.47403964e-01f,1.40122697e-01f,7.89746121e-02f,4.44423407e-02f,2.49973964e-02f,1.40580693e-02f,7.90561177e-03f,4.44568414e-03f},
  {7.62558460e-01f,8.85276794e-01f,9.33070183e-01f,-9.96054351e-01f,5.15501261e-01f,9.94096994e-01f,7.32639611e-01f,4.46054995e-01f,2.57080555e-01f,1.45688385e-01f,8.21266174e-02f,4.62187938e-02f,2.59970706e-02f,1.46203535e-02f,8.22182931e-03f,4.62350994e-03f},
  {9.56375957e-01f,5.00994205e-01f,7.74945021e-01f,-9.96045172e-01f,4.27379847e-01f,9.98623490e-01f,7.53792703e-01f,4.61899310e-01f,2.66731411e-01f,1.51249468e-01f,8.52777958e-02f,4.79951017e-02f,2.69967206e-02f,1.51826320e-02f,8.53804592e-03f,4.80133574e-03f},
  {2.70905793e-01f,-3.75856608e-02f,5.39968967e-01f,-9.64621305e-01f,3.34988207e-01f,9.99992907e-01f,7.74192095e-01f,4.77597594e-01f,2.76355654e-01f,1.56805754e-01f,8.84281173e-02f,4.97712530e-02f,2.79963426e-02f,1.57449059e-02f,8.85426160e-03f,4.97916201e-03f},
  {-6.63633883e-01f,-5.64589798e-01f,2.51445323e-01f,-9.02773678e-01f,2.39249229e-01f,9.98200953e-01f,7.93817401e-01f,4.93144840e-01f,2.85952210e-01f,1.62357092e-01f,9.15775672e-02f,5.15472479e-02f,2.89959367e-02f,1.63071752e-02f,9.17047635e-03f,5.15698735e-03f},
  {-9.88031626e-01f,-9.17709649e-01f,-6.20148405e-02f,-8.12452853e-01f,1.41120002e-01f,9.93253171e-01f,8.12648892e-01f,5.08536100e-01f,2.95520186e-01f,1.67903304e-01f,9.47260931e-02f,5.33230826e-02f,2.99955010e-02f,1.68694388e-02f,9.48669016e-03f,5.33481315e-03f},
  {-4.04037654e-01f,-9.88192797e-01f,-3.69325012e-01f,-6.96507812e-01f,4.15805206e-02f,9.85165298e-01f,8.30667794e-01f,5.23766637e-01f,3.05058628e-01f,1.73444211e-01f,9.78736654e-02f,5.50987460e-02f,3.09950355e-02f,1.74316969e-02f,9.80290305e-03f,5.51263802e-03f},
  {5.51426709e-01f,-7.54330218e-01f,-6.40009403e-01f,-5.58595300e-01f,-5.83741926e-02f,9.73962843e-01f,8.47856104e-01f,5.38831532e-01f,3.14566553e-01f,1.78979620e-01f,1.01020269e-01f,5.68742342e-02f,3.19945402e-02f,1.79939512e-02f,1.01191159e-02f,5.69046335e-03f},
  {9.99911845e-01f,-2.88147390e-01f,-8.47224355e-01f,-4.03064936e-01f,-1.57745644e-01f,9.59681332e-01f,8.64196658e-01f,5.53726017e-01f,3.24043006e-01f,1.84509367e-01f,1.04165860e-01f,5.86495437e-02f,3.29940096e-02f,1.85561981e-02f,1.04353270e-02f,5.86828869e-03f},
  {5.29082716e-01f,2.66779721e-01f,-9.70420420e-01f,-2.34822124e-01f,-2.55541205e-01f,9.42365825e-01f,8.79673064e-01f,5.68445385e-01f,3.33487093e-01f,1.90033287e-01f,1.07310407e-01f,6.04246669e-02f,3.39934528e-02f,1.91184394e-02f,1.07515370e-02f,6.04611309e-03f},
  {-4.28182662e-01f,7.39542127e-01f,-9.97380435e-01f,-5.91726787e-02f,-3.50783229e-01f,9.22071040e-01f,8.94269884e-01f,5.82984984e-01f,3.42897803e-01f,1.95551202e-01f,1.10453881e-01f,6.21996038e-02f,3.49928550e-02f,1.96806751e-02f,1.10677453e-02f,6.22393796e-03f},
  {-9.91778851e-01f,9.84540582e-01f,-9.25431013e-01f,1.18342586e-01f,-4.42520559e-01f,8.98861170e-01f,9.07972515e-01f,5.97340286e-01f,3.52274209e-01f,2.01062918e-01f,1.13596253e-01f,6.39743358e-02f,3.59922275e-02f,2.02429052e-02f,1.13839535e-02f,6.40176190e-03f},
  {-6.43538117e-01f,9.26318109e-01f,-7.61706948e-01f,2.92125374e-01f,-5.29836178e-01f,8.72809589e-01f,9.20767248e-01f,6.11506701e-01f,3.61615449e-01f,2.06568271e-01f,1.16737492e-01f,6.57488778e-02f,3.69915590e-02f,2.08051261e-02f,1.17001599e-02f,6.57958630e-03f},
  {2.96368569e-01f,5.82806170e-01f,-5.22444785e-01f,4.56694692e-01f,-6.11857831e-01f,8.43998730e-01f,9.32641268e-01f,6.25479698e-01f,3.70920479e-01f,2.12067112e-01f,1.19877554e-01f,6.75232038e-02f,3.79908569e-02f,2.13673431e-02f,1.20163653e-02f,6.75741071e-03f},
  {9.63795364e-01f,5.98003156e-02f,-2.31372014e-01f,6.06860459e-01f,-6.87766254e-01f,8.12519610e-01f,9.43582714e-01f,6.39254928e-01f,3.80188406e-01f,2.17559248e-01f,1.23016424e-01f,6.92973137e-02f,3.89901139e-02f,2.19295528e-02f,1.23325698e-02f,6.93523418e-03f},
  {7.45113134e-01f,-4.81621295e-01f,8.26458037e-02f,7.37885714e-01f,-7.56802499e-01f,7.78471708e-01f,9.53580678e-01f,6.52827978e-01f,3.89418334e-01f,2.23044485e-01f,1.26154065e-01f,7.10712075e-02f,3.99893373e-02f,2.24917568e-02f,1.26487734e-02f,7.11305765e-03f},
  {-1.58622667e-01f,-8.74714017e-01f,3.88467699e-01f,8.45638454e-01f,-8.18277061e-01f,7.41962790e-01f,9.62625206e-01f,6.66194677e-01f,3.98609310e-01f,2.28522688e-01f,1.29290432e-01f,7.28448778e-02f,4.09885161e-02f,2.30539497e-02f,1.29649751e-02f,7.29088066e-03f},
  {-9.16521549e-01f,-9.98410463e-01f,6.55764699e-01f,9.26720202e-01f,-8.71575892e-01f,7.03108132e-01f,9.70707119e-01f,6.79350674e-01f,4.07760441e-01f,2.33993664e-01f,1.32425532e-01f,7.46183172e-02f,4.19876575e-02f,2.36161388e-02f,1.32811759e-02f,7.46870413e-03f},
  {-8.31774771e-01f,-8.14614236e-01f,8.58030677e-01f,9.78573620e-01f,-9.16166008e-01f,6.62030637e-01f,9.77818429e-01f,6.92291796e-01f,4.16870773e-01f,2.39457220e-01f,1.35559291e-01f,7.63915181e-02f,4.29867506e-02f,2.41783205e-02f,1.35973748e-02f,7.64652714e-03f},
  {1.77019257e-02f,-3.79931390e-01f,9.75206196e-01f,9.99563396e-01f,-9.51602101e-01f,6.18860185e-01f,9.83951986e-01f,7.05014050e-01f,4.25939471e-01f,2.44913206e-01f,1.38691694e-01f,7.81644881e-02f,4.39858064e-02f,2.47404929e-02f,1.39135728e-02f,7.82434922e-03f},
  {8.50903511e-01f,1.71763569e-01f,9.95670974e-01f,9.89027262e-01f,-9.77530122e-01f,5.73733270e-01f,9.89101648e-01f,7.17513323e-01f,4.34965521e-01f,2.50361472e-01f,1.41822711e-01f,7.99371973e-02f,4.49848175e-02f,2.53026579e-02f,1.42297689e-02f,8.00217129e-03f},
  {9.01788354e-01f,6.70557022e-01f,9.17395473e-01f,9.47297752e-01f,-9.93690968e-01f,5.26792526e-01f,9.93262351e-01f,7.29785740e-01f,4.43948090e-01f,2.55801797e-01f,1.44952312e-01f,8.17096606e-02f,4.59837839e-02f,2.58648153e-02f,1.45459641e-02f,8.17999430e-03f},
  {1.23573124e-01f,9.62832689e-01f,7.48142362e-01f,8.75690997e-01f,-9.99923289e-01f,4.78186339e-01f,9.96429801e-01f,7.41827428e-01f,4.52886283e-01f,2.61234075e-01f,1.48080453e-01f,8.34818557e-02f,4.69827019e-02f,2.64269635e-02f,1.48621574e-02f,8.35781638e-03f},
  {-7.68254638e-01f,9.58573103e-01f,5.04697084e-01f,7.76465356e-01f,-9.96164620e-01f,4.28068399e-01f,9.98600960e-01f,7.53634512e-01f,4.61779177e-01f,2.66658038e-01f,1.51207119e-01f,8.52537975e-02f,4.79815714e-02f,2.69891042e-02f,1.51783489e-02f,8.53563752e-03f},
  {-9.53752637e-01f,6.59090102e-01f,2.11200655e-01f,6.52750373e-01f,-9.82452571e-01f,3.76597136e-01f,9.99773562e-01f,7.65203178e-01f,4.70625877e-01f,2.72073567e-01f,1.54332280e-01f,8.70254710e-02f,4.89803962e-02f,2.75512375e-02f,1.54945394e-02f,8.71345960e-03f},
  {-2.62374848e-01f,1.56619072e-01f,-1.03240460e-01f,5.08447945e-01f,-9.58924294e-01f,3.23935270e-01f,9.99946535e-01f,7.76529968e-01f,4.79425550e-01f,2.77480543e-01f,1.57455891e-01f,8.87968615e-02f,4.99791689e-02f,2.81133596e-02f,1.58107281e-02f,8.89127981e-03f},
  {6.70229197e-01f,-3.94086063e-01f,-4.07444149e-01f,3.48108500e-01f,-9.25814748e-01f,2.70249337e-01f,9.99119580e-01f,7.87611187e-01f,4.88177240e-01f,2.82878697e-01f,1.60577938e-01f,9.05679762e-02f,5.09778969e-02f,2.86754742e-02f,1.61269177e-02f,9.06910095e-03f},
  {9.86627579e-01f,-8.23421597e-01f,-6.71240151e-01f,1.76790684e-01f,-8.83454502e-01f,2.15709001e-01f,9.97293651e-01f,7.98443377e-01f,4.96880114e-01f,2.88267940e-01f,1.63698375e-01f,9.23388004e-02f,5.19765690e-02f,2.92375814e-02f,1.64431017e-02f,9.24692024e-03f},
  {3.95925164e-01f,-9.99157965e-01f,-8.68469954e-01f,-1.03020677e-04f,-8.32267344e-01f,1.60486728e-01f,9.94470477e-01f,8.09023023e-01f,5.05533338e-01f,2.93648034e-01f,1.66817173e-01f,9.41093415e-02f,5.29751927e-02f,2.97996756e-02f,1.67592876e-02f,9.42474138e-03f},
  {-5.58789074e-01f,-8.67171526e-01f,-9.79574919e-01f,-1.76993474e-01f,-7.72764444e-01f,1.04756832e-01f,9.90652919e-01f,8.19346905e-01f,5.14135957e-01f,2.99018890e-01f,1.69934288e-01f,9.58795771e-02f,5.39737605e-02f,3.03617641e-02f,1.70754679e-02f,9.60256159e-03f},
  {-9.99755144e-01f,-4.68111664e-01f,-9.93535519e-01f,-3.48301649e-01f,-7.05540299e-01f,4.86960001e-02f,9.85844791e-01f,8.29411685e-01f,5.22687256e-01f,3.04380238e-01f,1.73049718e-01f,9.76495072e-02f,5.49722798e-02f,3.09238415e-02f,1.73916500e-02f,9.78038087e-03f},
  {-5.21551013e-01f,7.51182064e-02f,-9.08967435e-01f,-5.08624554e-01f,-6.31266713e-01f,-7.51878507e-03f,9.80050862e-01f,8.39214146e-01f,5.31186223e-01f,3.09731960e-01f,1.76163420e-01f,9.94191393e-02f,5.59707358e-02f,3.14859077e-02f,1.77078284e-02f,9.95820016e-03f},
  {4.36164767e-01f,5.95211506e-01f,-7.34258294e-01f,-6.52905703e-01f,-5.50685287e-01f,-6.37097955e-02f,9.73276973e-01f,8.48751247e-01f,5.39632022e-01f,3.15073937e-01f,1.79275364e-01f,1.01188451e-01f,5.69691435e-02f,3.20479684e-02f,1.80240069e-02f,1.01360194e-02f},
  {9.92872655e-01f,9.31992829e-01f,-4.86733496e-01f,-7.76594579e-01f,-4.64602023e-01f,-1.19699396e-01f,9.65529919e-01f,8.58020008e-01f,5.48023939e-01f,3.20405900e-01f,1.82385504e-01f,1.02957435e-01f,5.79674877e-02f,3.26100141e-02f,1.83401816e-02f,1.03138378e-02f},
  {6.36738002e-01f,9.81735826e-01f,-1.90938011e-01f,-8.75790000e-01f,-3.73876572e-01f,-1.75310582e-01f,9.56817448e-01f,8.67017388e-01f,5.56361020e-01f,3.25727791e-01f,1.85493827e-01f,1.04726106e-01f,5.89657798e-02f,3.31720486e-02f,1.86563563e-02f,1.04916561e-02f},
  {-3.04810613e-01f,7.29123712e-01f,1.23790950e-01f,-9.47363734e-01f,-2.79415488e-01f,-2.30367512e-01f,9.47148204e-01f,8.75740528e-01f,5.64642429e-01f,3.31039310e-01f,1.88600287e-01f,1.06494442e-01f,5.99640086e-02f,3.37340795e-02f,1.89725272e-02f,1.06694745e-02f},
  {-9.66117799e-01f,2.51952261e-01f,4.26245421e-01f,-9.89057720e-01f,-1.82162598e-01f,-2.84696162e-01f,9.36531842e-01f,8.84186864e-01f,5.72867453e-01f,3.36340427e-01f,1.91704854e-01f,1.08262435e-01f,6.09621815e-02f,3.42960916e-02f,1.92886982e-02f,1.08472919e-02f},
  {-7.39180684e-01f,-3.02812874e-01f,6.86427653e-01f,-9.99557257e-01f,-8.30891207e-02f,-3.38124752e-01f,9.24979091e-01f,8.92353535e-01f,5.81035137e-01f,3.41630876e-01f,1.94807529e-01f,1.10030092e-01f,6.19602874e-02f,3.48580964e-02f,1.96048655e-02f,1.10251084e-02f},
  {1.67355701e-01f,-7.64320076e-01f,8.78538549e-01f,-9.78531301e-01f,1.68140903e-02f,-3.90484393e-01f,9.12501454e-01f,9.00238097e-01f,5.89144766e-01f,3.46910536e-01f,1.97908238e-01f,1.11797392e-01f,6.29583374e-02f,3.54200937e-02f,1.99210308e-02f,1.12029258e-02f}
};


constexpr int D = 1024, ML = 16384, MC = 2048, MT = ML + MC, TL = 2048, TCX = 256, NB = 8;
constexpr int LDP_E = 3328, LDP_O = 5120, DFF = 2816, NKK = 2304;
constexpr int NTHR = 512;
constexpr int LDS_BYTES = 152 * 1024;
constexpr float EPSN = 1e-6f;

struct Params {
  const float *x, *c, *ctx, *c_ctx, *w_ada, *b_ada, *n1g, *n2g, *w_in_even, *qk_gain, *lambda_a, *subln, *w_gate_up, *b_gate_up,
      *onorm_b, *w_out_even, *w_in_odd, *lb_raw, *onorm_c, *w_out_odd, *w_ffn_in, *w_ffn_out;
  float* out;
  bf16_t *wt_in_even, *wt_in_odd, *wt_out_even, *wt_out_odd, *wt_ffn_in, *wt_ffn_out;
  float* Z;
  float* mod;
  bf16_t *P, *R1, *R2, *Vt;
  float* Gk;
  unsigned* ctr;
};

extern __shared__ __attribute__((aligned(16))) char smem_raw[];

typedef float f32x2 __attribute__((ext_vector_type(2)));
typedef __bf16 hbf16x2 __attribute__((ext_vector_type(2)));
DI unsigned pack2(float a, float b) { const f32x2 v = {a, b}; return __builtin_bit_cast(unsigned, __builtin_convertvector(v, hbf16x2)); }
DI bf16_t f2bf(float x) { return (bf16_t)(pack2(x, 0.f) & 0xffffu); }
DI float bf2f(bf16_t h) { return __uint_as_float(((unsigned)h) << 16); }
DI float wave_sum(float v) {
#pragma unroll
  for (int o = 32; o >= 1; o >>= 1) v += __shfl_xor(v, o, 64);
  return v;
}
DI int TID() { int t = threadIdx.x; asm volatile("" : "+v"(t)); return t; }
DI float sigmoidf_(float x) { return __builtin_amdgcn_rcpf(1.f + __builtin_amdgcn_exp2f(x * -1.44269504088896f)); }
DI float siluf(float x) { return x * sigmoidf_(x); }

DI void convert_tile(const float* __restrict__ src, int K, int N, bf16_t* __restrict__ dst, int mode, int tile) {
  float* ts = (float*)smem_raw;
  const int tid = TID();
  const int nkt = K >> 6;
  const int kt = tile % nkt, nt = tile / nkt;
  const int k0 = kt << 6, n0 = nt << 6;
#pragma unroll
  for (int i = 0; i < 2; ++i) {
    const int idx = tid + i * NTHR;
    const int kr = idx >> 4, c4 = idx & 15;
    const int n = n0 + 4 * c4;
    float4 v = make_float4(0.f, 0.f, 0.f, 0.f);
    if (n < N) v = *(const float4*)(src + (size_t)(k0 + kr) * N + n);
    float* t = ts + kr * 65 + 4 * c4;
    t[0] = v.x; t[1] = v.y; t[2] = v.z; t[3] = v.w;
  }
  __syncthreads();
  {
    const int nrow = tid >> 3, kq = tid & 7;
    float f[8];
#pragma unroll
    for (int j = 0; j < 8; ++j) f[j] = ts[(kq * 8 + j) * 65 + nrow];
    int n = n0 + nrow;
    int orow = n;
    if (mode == 1) { const int up = n >= DFF ? 1 : 0; const int j = n - up * DFF; orow = (j >> 7) * 256 + up * 128 + (j & 127); }
    uint4 o;
    o.x = pack2(f[0], f[1]); o.y = pack2(f[2], f[3]); o.z = pack2(f[4], f[5]); o.w = pack2(f[6], f[7]);
    *(uint4*)(dst + (size_t)orow * K + k0 + kq * 8) = o;
  }
  __syncthreads();
}

__device__ void phase_init(const Params& p) {
  const int tid = TID(), nb = gridDim.x, bid = blockIdx.x;
  if (bid == 0 && tid < 64) p.ctr[tid] = 0u;
  {
    const float4* xs = (const float4*)p.x; float4* xo = (float4*)p.out;
    const size_t n4 = (size_t)ML * D / 4;
    for (size_t i = (size_t)bid * NTHR + tid; i < n4; i += (size_t)nb * NTHR) xo[i] = xs[i];
    const float4* cs = (const float4*)p.ctx; float4* zo = (float4*)p.Z;
    const size_t m4 = (size_t)MC * D / 4;
    for (size_t i = (size_t)bid * NTHR + tid; i < m4; i += (size_t)nb * NTHR) zo[i] = cs[i];
  }
  {
    const int T0 = 2 * 16 * 52, T1 = T0 + 2 * 16 * 80, T2 = T1 + 2 * 256, T3 = T2 + 2 * 256, T4 = T3 + 4 * 16 * 88, T5 = T4 + 4 * 44 * 16;
    for (int it = bid; it < T5; it += nb) {
      if (it < T0) { const int j = it / 832, t = it % 832; convert_tile(p.w_in_even + (size_t)j * 1024 * 3104, 1024, 3104, p.wt_in_even + (size_t)j * LDP_E * 1024, 0, t); }
      else if (it < T1) { const int q = it - T0; const int j = q / 1280, t = q % 1280; convert_tile(p.w_in_odd + (size_t)j * 1024 * 5120, 1024, 5120, p.wt_in_odd + (size_t)j * 5120 * 1024, 0, t); }
      else if (it < T2) { const int q = it - T1; const int j = q / 256, t = q % 256; convert_tile(p.w_out_even + (size_t)j * 1024 * 1024, 1024, 1024, p.wt_out_even + (size_t)j * 1024 * 1024, 0, t); }
      else if (it < T3) { const int q = it - T2; const int j = q / 256, t = q % 256; convert_tile(p.w_out_odd + (size_t)j * 1024 * 1024, 1024, 1024, p.wt_out_odd + (size_t)j * 1024 * 1024, 0, t); }
      else if (it < T4) { const int q = it - T3; const int j = q / 1408, t = q % 1408; convert_tile(p.w_ffn_in + (size_t)j * 1024 * 5632, 1024, 5632, p.wt_ffn_in + (size_t)j * 5632 * 1024, 1, t); }
      else { const int q = it - T4; const int j = q / 704, t = q % 704; convert_tile(p.w_ffn_out + (size_t)j * DFF * 1024, DFF, 1024, p.wt_ffn_out + (size_t)j * 1024 * DFF, 0, t); }
    }
  }
  {
    float* sc = (float*)smem_raw;
    float* part = sc + 9 * 1024;
    __syncthreads();
    for (int i = tid; i < 9 * 1024; i += NTHR) {
      const int m = i >> 10, k = i & 1023;
      const float v = m < 8 ? p.c[m * 1024 + k] : p.c_ctx[k];
      sc[i] = siluf(v);
    }
    __syncthreads();
    for (int it = bid; it < 4 * 96; it += nb) {
      const int l = it / 96, n0 = (it % 96) * 64;
      const int col4 = tid & 15, ks = tid >> 4;
      float acc[9][4];
#pragma unroll
      for (int m = 0; m < 9; ++m) { acc[m][0] = 0.f; acc[m][1] = 0.f; acc[m][2] = 0.f; acc[m][3] = 0.f; }
      const float* wp = p.w_ada + (size_t)l * 1024 * 6144 + n0 + 4 * col4;
      for (int kk = 0; kk < 32; ++kk) {
        const int k = ks * 32 + kk;
        const float4 w = *(const float4*)(wp + (size_t)k * 6144);
#pragma unroll
        for (int m = 0; m < 9; ++m) { const float s = sc[m * 1024 + k]; acc[m][0] += s * w.x; acc[m][1] += s * w.y; acc[m][2] += s * w.z; acc[m][3] += s * w.w; }
      }
#pragma unroll
      for (int m = 0; m < 9; ++m) {
        float* pp = part + (ks * 9 + m) * 64 + 4 * col4;
        pp[0] = acc[m][0]; pp[1] = acc[m][1]; pp[2] = acc[m][2]; pp[3] = acc[m][3];
      }
      __syncthreads();
      for (int i = tid; i < 9 * 64; i += NTHR) {
        const int m = i >> 6, cc = i & 63;
        float s = p.b_ada[l * 6144 + n0 + cc];
        for (int q = 0; q < 32; ++q) s += part[(q * 9 + m) * 64 + cc];
        p.mod[((size_t)l * 9 + m) * 6144 + n0 + cc] = s;
      }
      __syncthreads();
    }
  }
}

__device__ void phase_norm(const Params& p, int l, int which, int nrows, bf16_t* __restrict__ H, const float* fold_gate, const float* slab) {
  const int wave = TID() >> 6, lane = TID() & 63;
  const float* gain = (which == 0 ? p.n1g : p.n2g) + l * 1024;
  const int sh_idx = which == 0 ? 0 : 3, sc_idx = which == 0 ? 1 : 4;
  for (int row = blockIdx.x * 8 + wave; row < nrows; row += gridDim.x * 8) {
    const float* xr = row < ML ? p.out + (size_t)row * D : p.Z + (size_t)(row - ML) * D;
    const int midx = row < ML ? (row >> 11) : 8;
    const float* md = p.mod + ((size_t)l * 9 + midx) * 6144;
    float4 v[4];
    float ss = 0.f;
#pragma unroll
    for (int i = 0; i < 4; ++i) v[i] = *(const float4*)(xr + i * 256 + lane * 4);
    if (fold_gate != nullptr && row >= ML) {
      float* zw = p.Z + (size_t)(row - ML) * D;
#pragma unroll
      for (int i = 0; i < 4; ++i) {
        const int col = i * 256 + lane * 4;
        float4 s = make_float4(0.f, 0.f, 0.f, 0.f);
#pragma unroll
        for (int pc = 0; pc < 8; ++pc) { const float4 t = *(const float4*)(slab + ((size_t)pc * MC + (row - ML)) * D + col); s.x += t.x; s.y += t.y; s.z += t.z; s.w += t.w; }
        const float4 g = *(const float4*)(fold_gate + col);
        v[i].x += g.x * s.x; v[i].y += g.y * s.y; v[i].z += g.z * s.z; v[i].w += g.w * s.w;
        *(float4*)(zw + col) = v[i];
      }
    }
#pragma unroll
    for (int i = 0; i < 4; ++i) ss += v[i].x * v[i].x + v[i].y * v[i].y + v[i].z * v[i].z + v[i].w * v[i].w;
    ss = wave_sum(ss);
    const float r = rsqrtf(ss * (1.f / 1024.f) + EPSN);
#pragma unroll
    for (int i = 0; i < 4; ++i) {
      const int col = i * 256 + lane * 4;
      const float4 g = *(const float4*)(gain + col);
      const float4 sh = *(const float4*)(md + sh_idx * 1024 + col);
      const float4 sc = *(const float4*)(md + sc_idx * 1024 + col);
      const float y0 = v[i].x * r * g.x * (1.f + sc.x) + sh.x;
      const float y1 = v[i].y * r * g.y * (1.f + sc.y) + sh.y;
      const float y2 = v[i].z * r * g.z * (1.f + sc.z) + sh.z;
      const float y3 = v[i].w * r * g.w * (1.f + sc.w) + sh.w;
      uint2 o; o.x = pack2(y0, y1); o.y = pack2(y2, y3);
      *(uint2*)(H + (size_t)row * D + col) = o;
    }
  }
}

#define LAS __attribute__((address_space(3)))
constexpr int BM = 256, BK = 64, HALF = 128, HTB = HALF * BK * 2, NXCD = 8, WGM = 8;
DI int lds_byte(int r, int c) { const int st = (r >> 4) * 2 + (c >> 5), rr = r & 15, cc = c & 31, ob = rr * 64 + cc * 2; return st * 1024 + (ob ^ (((ob >> 9) & 1) << 5)); }
DI void stage_rc(int b, int& R, int& C) { const int st = b / 1024, sb = b % 1024, swz = sb ^ (((sb >> 9) & 1) << 5); R = (st >> 1) * 16 + swz / 64; C = (st & 1) * 32 + (swz % 64) / 2; }

struct Unit { int pm, pn, k0, nk, part; };
struct TileOrder {
  int nM, nN, nwg, G, c, ntk, nwhole, nMw;
  DI void init(int M, int N, int K, bool split) {
    nM = M / BM; nN = N / BM; nwg = nM * nN; G = gridDim.x; c = blockIdx.x; ntk = K / BK;
    nMw = (split && M == MT) ? ML / BM : nM; nwhole = nMw * nN;
  }
  DI bool next(int i, Unit& u) const {
    const long L = (long)i * G + c;
    if (L >= nwhole) {
      const long q = L - nwhole; const int tile = (int)(q >> 3); if (tile >= nwg - nwhole) return false;
      const int pc = (int)(q & 7);
      const int base = (ntk >> 4) << 1, extra = (ntk - 8 * base) >> 1;
      u.nk = base + (pc < extra ? 2 : 0); u.k0 = pc * base + 2 * (pc < extra ? pc : extra); u.part = 1 + pc;
      u.pm = nMw + tile / nN; u.pn = tile % nN; return true;
    }
    u.k0 = 0; u.nk = ntk; u.part = 0;
    int wgid = (int)L; { const int q = nwhole / NXCD, r = nwhole % NXCD, xcd = wgid % NXCD, off = wgid / NXCD; wgid = (xcd < r ? xcd * (q + 1) : r * (q + 1) + (xcd - r) * q) + off; }
    const int nig = WGM * nN, gid = wgid / nig, fm = gid * WGM, gsz = (nMw - fm) < WGM ? (nMw - fm) : WGM;
    u.pm = fm + ((wgid % nig) % gsz); u.pn = (wgid % nig) / gsz; return true;
  }
};

enum { EPI_P = 0, EPI_RES = 1, EPI_SWIGLU = 2 };
struct EpiArgs { bf16_t* outb; int ld; float* xl; float* xz; const float* gate; float* slab; };

template <int EPI, bool PART>
DI void gemm_epilogue(const f32x4 (&acc)[2][2][4][2], const Unit& u, int wr, int wc, int fr, int fq, const EpiArgs& ea) {
  const int brow = u.pm * BM, bcol = u.pn * BM;
#pragma unroll
  for (int ai = 0; ai < 2; ++ai)
#pragma unroll
    for (int m = 0; m < 4; ++m) {
      const int row = brow + ai * HALF + wr * 64 + m * 16 + fr;
      if (EPI == EPI_P) {
#pragma unroll
        for (int bj = 0; bj < 2; ++bj)
#pragma unroll
          for (int n = 0; n < 2; ++n) {
            const int col = bcol + bj * HALF + wc * 32 + n * 16 + 4 * fq;
            const f32x4 a = acc[ai][bj][m][n];
            uint2 o; o.x = pack2(a[0], a[1]); o.y = pack2(a[2], a[3]);
            *(uint2*)(ea.outb + (size_t)row * ea.ld + col) = o;
          }
      } else if (EPI == EPI_RES) {
        float* xr = row < ML ? ea.xl + (size_t)row * D : ea.xz + (size_t)(row - ML) * D;
        const int midx = row < ML ? (row >> 11) : 8;
        const float* g = ea.gate + (size_t)midx * 6144;
#pragma unroll
        for (int bj = 0; bj < 2; ++bj)
#pragma unroll
          for (int n = 0; n < 2; ++n) {
            const int col = bcol + bj * HALF + wc * 32 + n * 16 + 4 * fq;
            const f32x4 a = acc[ai][bj][m][n];
            if (PART) {
              *(float4*)(ea.slab + ((size_t)(u.part - 1) * MC + (row - ML)) * D + col) = make_float4(a[0], a[1], a[2], a[3]);
            } else {
              const float4 gv = *(const float4*)(g + col);
              float4 xv = *(float4*)(xr + col);
              xv.x += gv.x * a[0]; xv.y += gv.y * a[1]; xv.z += gv.z * a[2]; xv.w += gv.w * a[3];
              *(float4*)(xr + col) = xv;
            }
          }
      } else {
#pragma unroll
        for (int n = 0; n < 2; ++n) {
          const int col = u.pn * HALF + wc * 32 + n * 16 + 4 * fq;
          const f32x4 g = acc[ai][0][m][n], up = acc[ai][1][m][n];
          uint2 o; o.x = pack2(siluf(g[0]) * up[0], siluf(g[1]) * up[1]); o.y = pack2(siluf(g[2]) * up[2], siluf(g[3]) * up[3]);
          *(uint2*)(ea.outb + (size_t)row * ea.ld + col) = o;
        }
      }
    }
}

template <int EPI>
DI void gemm_phase(const bf16_t* __restrict__ Ag, const bf16_t* __restrict__ Btg, int M, int N, int K, const EpiArgs ea) {
  LAS unsigned char* lds = (LAS unsigned char*)smem_raw;
  TileOrder S; S.init(M, N, K, EPI == EPI_RES);
  const int tid = TID(), wid = __builtin_amdgcn_readfirstlane(tid >> 6), lane = tid & 63, wr = wid >> 2, wc = wid & 3, fr = lane & 15, fq = lane >> 4;
  unsigned voffA[2];
#pragma unroll
  for (int i = 0; i < 2; ++i) { int R, C; stage_rc(tid * 16 + i * 8192, R, C); voffA[i] = (unsigned)(R * K + C) * 2u; }
  const size_t kstep = (size_t)(BK * 2);
  const size_t hstep = (size_t)HALF * K * 2;
  const size_t tstep = 2 * hstep;
  const unsigned ldsw = (unsigned)wid * 1024u;
  const int aoff = lds_byte(wr * 64 + fr, fq * 8), boff = lds_byte(wc * 32 + fr, fq * 8);
#define G_SA(b, h) (((b) * 2 + (h)) * HTB)
#define G_SB(b, h) ((4 + (b) * 2 + (h)) * HTB)
#define G_STAGE(bufoff, gbase) do { _Pragma("unroll") for (int _i = 0; _i < 2; ++_i) \
    __builtin_amdgcn_global_load_lds((const unsigned*)((const char*)(gbase) + voffA[_i]), (LAS unsigned*)(lds + (bufoff) + ldsw + _i * 8192), 16, 0, 0); } while (0)
#define G_LDA(dst, b, h) do { _Pragma("unroll") for (int m = 0; m < 4; ++m) _Pragma("unroll") for (int k = 0; k < 2; ++k) dst[m][k] = *(const LAS bf16x8*)(lds + G_SA(b, h) + aoff + m * 2048 + k * 1024); } while (0)
#define G_LDB(dst, b, h) do { _Pragma("unroll") for (int n = 0; n < 2; ++n) _Pragma("unroll") for (int k = 0; k < 2; ++k) dst[n][k] = *(const LAS bf16x8*)(lds + G_SB(b, h) + boff + n * 2048 + k * 1024); } while (0)
#define G_MMA(ai, bj, At_, Bt_) do { __builtin_amdgcn_s_setprio(1); _Pragma("unroll") for (int m = 0; m < 4; ++m) _Pragma("unroll") for (int n = 0; n < 2; ++n) _Pragma("unroll") for (int k = 0; k < 2; ++k) \
    acc[ai][bj][m][n] = __builtin_amdgcn_mfma_f32_16x16x32_bf16(Bt_[n][k], At_[m][k], acc[ai][bj][m][n], 0, 0, 0); __builtin_amdgcn_s_setprio(0); } while (0)
#define G_WAIT_V(n) asm volatile("s_waitcnt vmcnt(" #n ")" ::: "memory")
#define G_WAIT_L(n) asm volatile("s_waitcnt lgkmcnt(" #n ")" ::: "memory")
#define G_BAR __builtin_amdgcn_s_barrier()
#define G_SCHED __builtin_amdgcn_sched_barrier(0)
  Unit cur, nxt; int ui = 0;
  if (S.next(0, cur)) {
    f32x4 acc[2][2][4][2];
#pragma unroll
    for (int a = 0; a < 2; ++a)
#pragma unroll
      for (int b = 0; b < 2; ++b)
#pragma unroll
        for (int m = 0; m < 4; ++m)
#pragma unroll
          for (int n = 0; n < 2; ++n) acc[a][b][m][n] = (f32x4){0.f, 0.f, 0.f, 0.f};
    bf16x8 At[4][2], B0[2][2], B1[2][2];
    const char* cA = (const char*)Ag + (size_t)cur.pm * tstep + (size_t)cur.k0 * kstep; const char* cB = (const char*)Btg + (size_t)cur.pn * tstep + (size_t)cur.k0 * kstep;
    G_STAGE(G_SB(0, 0), cB); G_STAGE(G_SA(0, 0), cA); G_STAGE(G_SB(0, 1), cB + hstep); G_STAGE(G_SA(0, 1), cA + hstep);
    if (wr == 1) G_BAR;
    G_WAIT_V(4); G_BAR;
    G_STAGE(G_SB(1, 0), cB + kstep); G_STAGE(G_SA(1, 0), cA + kstep); G_STAGE(G_SB(1, 1), cB + hstep + kstep);
    G_WAIT_V(6); G_BAR;
    for (;;) {
      const bool has_next = S.next(ui + 1, nxt);
      const char* nA = has_next ? (const char*)Ag + (size_t)nxt.pm * tstep + (size_t)nxt.k0 * kstep : cA; const char* nB = has_next ? (const char*)Btg + (size_t)nxt.pn * tstep + (size_t)nxt.k0 * kstep : cB;
      const int nt = cur.nk;
      for (int t = 0; t < nt; t += 2) {
        const bool last = (t == nt - 2);
        const char* a1 = cA + (size_t)(t + 1) * kstep;
        const char* a2 = last ? nA : cA + (size_t)(t + 2) * kstep; const char* b2 = last ? nB : cB + (size_t)(t + 2) * kstep;
        const char* a3 = a2 + kstep; const char* b3 = b2 + kstep;
        G_LDB(B0, 0, 0); G_SCHED; G_LDA(At, 0, 0); G_STAGE(G_SA(1, 1), a1 + hstep);
        G_WAIT_L(8); G_BAR; G_WAIT_L(0); G_MMA(0, 0, At, B0); G_BAR; G_SCHED;
        G_LDB(B1, 0, 1); G_STAGE(G_SB(0, 0), b2);
        G_BAR; G_WAIT_L(0); G_MMA(0, 1, At, B1); G_BAR;
        G_LDA(At, 0, 1); G_STAGE(G_SA(0, 0), a2);
        G_BAR; G_WAIT_L(0); G_MMA(1, 0, At, B0); G_BAR; G_SCHED;
        G_STAGE(G_SB(0, 1), b2 + hstep);
        G_WAIT_V(6); G_BAR; G_MMA(1, 1, At, B1); G_BAR;
        G_LDB(B0, 1, 0); G_SCHED; G_LDA(At, 1, 0); G_STAGE(G_SA(0, 1), a2 + hstep);
        G_WAIT_L(8); G_BAR; G_WAIT_L(0); G_MMA(0, 0, At, B0); G_BAR; G_SCHED;
        G_LDB(B1, 1, 1); G_STAGE(G_SB(1, 0), b3);
        G_BAR; G_WAIT_L(0); G_MMA(0, 1, At, B1); G_BAR;
        G_LDA(At, 1, 1); G_STAGE(G_SA(1, 0), a3);
        G_BAR; G_WAIT_L(0); G_MMA(1, 0, At, B0); G_BAR; G_SCHED;
        G_STAGE(G_SB(1, 1), b3 + hstep);
        G_WAIT_V(6); G_BAR; G_MMA(1, 1, At, B1); G_BAR;
      }
      if (EPI == EPI_RES && cur.part) gemm_epilogue<EPI, true>(acc, cur, wr, wc, fr, fq, ea); else gemm_epilogue<EPI, false>(acc, cur, wr, wc, fr, fq, ea);
      if (!has_next) break;
#pragma unroll
      for (int a = 0; a < 2; ++a)
#pragma unroll
        for (int b = 0; b < 2; ++b)
#pragma unroll
          for (int m = 0; m < 4; ++m)
#pragma unroll
            for (int n = 0; n < 2; ++n) acc[a][b][m][n] = (f32x4){0.f, 0.f, 0.f, 0.f};
      cur = nxt; cA = nA; cB = nB; ++ui;
    }
    G_WAIT_V(0);
    if (wr == 0) G_BAR;
    G_BAR;
  }
#undef G_SA
#undef G_SB
#undef G_STAGE
#undef G_LDA
#undef G_LDB
#undef G_MMA
}

__device__ void phase_prep_even(const Params& p, int j) {
  const int wave = TID() >> 6, lane = TID() & 63, tid = TID();
  const float qscale = 0.125f * 1.44269504088896f;
  const float gq = p.qk_gain[j * 128 + lane], gk = p.qk_gain[j * 128 + 64 + lane];
  for (int row = blockIdx.x * 8 + wave; row < MT; row += gridDim.x * 8) {
    bf16_t* pr = p.P + (size_t)row * LDP_E;
    const bool lat = row < ML;
    const int t = row & 2047;
    const int pos = (lane < 32) ? (t >> 6) : (t & 63);
    const float cs = ROPE_CS[pos][lane & 15], sn = ROPE_SN[pos][lane & 15];
    float vals[16];
#pragma unroll
    for (int g = 0; g < 16; ++g) vals[g] = bf2f(pr[g * 64 + lane]);
#pragma unroll
    for (int g = 0; g < 16; ++g) {
      const float v = vals[g];
      const float ss = wave_sum(v * v);
      float y = v * rsqrtf(ss * (1.f / 64.f) + EPSN) * (g < 8 ? gq : gk);
      if (lat) {
        const float o = __shfl_xor(y, 16, 64);
        y = (lane & 16) ? (y * cs + o * sn) : (y * cs - o * sn);
      }
      if (g < 8) y *= qscale;
      pr[g * 64 + lane] = f2bf(y);
    }
  }
  bf16_t* ts = (bf16_t*)smem_raw;
  for (int it = blockIdx.x; it < NB * 4 * 36; it += gridDim.x) {
    const int kb = it % 36, h = (it / 36) & 3, b = it / 144;
    __syncthreads();
    {
      const int r = tid >> 3, ch = tid & 7;
      const int kk = kb * 64 + r;
      const int row = kk < TCX ? ML + b * TCX + kk : b * TL + (kk - TCX);
      const bf16_t* src = p.P + (size_t)row * LDP_E + 1024 + h * 128;
#pragma unroll
      for (int i = 0; i < 2; ++i) {
        const int c8 = (ch + i * 8) * 8;
        const uint4 v = *(const uint4*)(src + c8);
        unsigned* d = (unsigned*)(ts + r * 130 + c8);
        d[0] = v.x; d[1] = v.y; d[2] = v.z; d[3] = v.w;
      }
    }
    __syncthreads();
    {
      const int e = tid >> 2, kq = tid & 3;
      unsigned w[8];
#pragma unroll
      for (int i = 0; i < 8; ++i) {
        const unsigned lo = ts[(kq * 16 + 2 * i) * 130 + e], hi = ts[(kq * 16 + 2 * i + 1) * 130 + e];
        w[i] = lo | (hi << 16);
      }
      bf16_t* dst = p.Vt + ((size_t)(b * 4 + h) * 128 + e) * NKK + kb * 64 + kq * 16;
      *(uint4*)(dst) = make_uint4(w[0], w[1], w[2], w[3]);
      *(uint4*)(dst + 8) = make_uint4(w[4], w[5], w[6], w[7]);
    }
  }
  {
    float* wl = (float*)smem_raw;
    __syncthreads();
    for (int i = tid; i < 2 * 16 * 256; i += NTHR) wl[i] = p.w_gate_up[(size_t)j * 8192 + i];
    for (int i = tid; i < 512; i += NTHR) wl[8192 + i] = p.b_gate_up[j * 512 + i];
    __syncthreads();
    for (int row = blockIdx.x * 8 + wave; row < MT; row += gridDim.x * 8) {
      const bf16_t* pr = p.P + (size_t)row * LDP_E + 3072;
      const float lrv = lane < 32 ? bf2f(pr[lane]) : 0.f;
#pragma unroll
      for (int u = 0; u < 8; ++u) {
        const int col = u * 64 + lane;
        const int dr = col >> 8, cc = col & 255;
        float xg = wl[8192 + col];
#pragma unroll
        for (int rr = 0; rr < 16; ++rr) xg += __shfl(lrv, dr * 16 + rr, 64) * wl[(dr * 16 + rr) * 256 + cc];
        const float ls = fminf(xg, 0.f) - log1pf(__expf(-fabsf(xg)));
        p.Gk[(size_t)row * 512 + col] = __expf(ls * (1.f / 16.f));
      }
    }
  }
}

__device__ void attn_item(const Params& p, int item) {
  const int tid = TID(), wave = tid >> 6, lane = tid & 63, r = lane & 31, hh = lane >> 5;
  int b, hc, qrow0, krow_ctx, krow_lat, ntile;
  if (item < 512) { b = item >> 6; hc = (item >> 3) & 7; qrow0 = b * TL + (item & 7) * 256; ntile = 36; }
  else { const int i2 = item - 512; b = i2 >> 3; hc = i2 & 7; qrow0 = ML + b * TCX; ntile = 4; }
  krow_ctx = ML + b * TCX; krow_lat = b * TL;
  const int h = hc >> 1, c = hc & 1;
  bf16_t* Ksm = (bf16_t*)smem_raw;
  bf16_t* Vsm = (bf16_t*)(smem_raw + 2 * 9216);
  const int qrow = qrow0 + wave * 32 + r;
  bf16x8 qf[4];
#pragma unroll
  for (int s = 0; s < 4; ++s) qf[s] = *(const bf16x8*)(p.P + (size_t)qrow * LDP_E + hc * 64 + 16 * s + 8 * hh);
  f32x16 oacc[4];
#pragma unroll
  for (int eb = 0; eb < 4; ++eb)
#pragma unroll
    for (int i = 0; i < 16; ++i) oacc[eb][i] = 0.f;
  float mrun = -1e30f, lsum = 0.f;
  const int kkey = tid >> 3, kch = tid & 7;
  const int ve = tid >> 2, vch = tid & 3;
  const bf16_t* vbase = p.Vt + ((size_t)(b * 4 + h) * 128 + ve) * NKK + vch * 16;
  uint4 kreg, vreg0, vreg1;
  auto gload = [&](int t) {
    const int kk = t * 64 + kkey;
    const int row = kk < TCX ? krow_ctx + kk : krow_lat + (kk - TCX);
    kreg = *(const uint4*)(p.P + (size_t)row * LDP_E + 512 + hc * 64 + kch * 8);
    vreg0 = *(const uint4*)(vbase + t * 64);
    vreg1 = *(const uint4*)(vbase + t * 64 + 8);
  };
  auto sstore = [&](int buf) {
    *(uint4*)(Ksm + buf * 4608 + kkey * 72 + kch * 8) = kreg;
    uint2* d = (uint2*)(Vsm + buf * 8704 + ve * 68 + vch * 16);
    d[0] = make_uint2(vreg0.x, vreg0.y); d[1] = make_uint2(vreg0.z, vreg0.w);
    d[2] = make_uint2(vreg1.x, vreg1.y); d[3] = make_uint2(vreg1.z, vreg1.w);
  };
  __syncthreads();
  gload(0); sstore(0);
  __syncthreads();
  for (int t = 0; t < ntile; ++t) {
    const int buf = t & 1;
    if (t + 1 < ntile) gload(t + 1);
    const bf16_t* Kb = Ksm + buf * 4608;
    const bf16_t* Vb = Vsm + buf * 8704;
    f32x16 sacc[2];
#pragma unroll
    for (int kb = 0; kb < 2; ++kb) {
#pragma unroll
      for (int i = 0; i < 16; ++i) sacc[kb][i] = 0.f;
#pragma unroll
      for (int s = 0; s < 4; ++s) {
        const bf16x8 kf = *(const bf16x8*)(Kb + (32 * kb + r) * 72 + 16 * s + 8 * hh);
        sacc[kb] = __builtin_amdgcn_mfma_f32_32x32x16_bf16(kf, qf[s], sacc[kb], 0, 0, 0);
      }
    }
    float mx = sacc[0][0];
#pragma unroll
    for (int kb = 0; kb < 2; ++kb)
#pragma unroll
      for (int i = 0; i < 16; ++i) mx = fmaxf(mx, sacc[kb][i]);
    mx = fmaxf(mx, __shfl_xor(mx, 32, 64));
    if (__builtin_amdgcn_ballot_w64(mx > mrun + 8.f)) {
      const float mnew = fmaxf(mrun, mx);
      const float alpha = __builtin_amdgcn_exp2f(mrun - mnew);
      mrun = mnew;
      lsum *= alpha;
#pragma unroll
      for (int eb = 0; eb < 4; ++eb)
#pragma unroll
        for (int i = 0; i < 16; ++i) oacc[eb][i] *= alpha;
    }
    float ps = 0.f;
#pragma unroll
    for (int kb = 0; kb < 2; ++kb)
#pragma unroll
      for (int i = 0; i < 16; ++i) { const float pv = __builtin_amdgcn_exp2f(sacc[kb][i] - mrun); sacc[kb][i] = pv; ps += pv; }
    lsum += ps;
#pragma unroll
    for (int ks = 0; ks < 4; ++ks) {
      const int kb = ks >> 1, s2 = ks & 1;
      uint4 pu;
      pu.x = pack2(sacc[kb][8 * s2 + 0], sacc[kb][8 * s2 + 1]); pu.y = pack2(sacc[kb][8 * s2 + 2], sacc[kb][8 * s2 + 3]);
      pu.z = pack2(sacc[kb][8 * s2 + 4], sacc[kb][8 * s2 + 5]); pu.w = pack2(sacc[kb][8 * s2 + 6], sacc[kb][8 * s2 + 7]);
      const bf16x8 pf = __builtin_bit_cast(bf16x8, pu);
#pragma unroll
      for (int eb = 0; eb < 4; ++eb) {
        const s16x4 lo = *(const s16x4*)(Vb + (32 * eb + r) * 68 + 16 * ks + 4 * hh);
        const s16x4 hi = *(const s16x4*)(Vb + (32 * eb + r) * 68 + 16 * ks + 8 + 4 * hh);
        const bf16x8 vf = __builtin_shufflevector(lo, hi, 0, 1, 2, 3, 4, 5, 6, 7);
        oacc[eb] = __builtin_amdgcn_mfma_f32_32x32x16_bf16(vf, pf, oacc[eb], 0, 0, 0);
      }
    }
    if (t + 1 < ntile) sstore(buf ^ 1);
    __syncthreads();
  }
  lsum += __shfl_xor(lsum, 32, 64);
  const float inv = 1.f / lsum;
  bf16_t* orow = p.R1 + (size_t)qrow * D + c * 512 + h * 128;
#pragma unroll
  for (int eb = 0; eb < 4; ++eb)
#pragma unroll
    for (int g = 0; g < 4; ++g) {
      const int e = 32 * eb + 8 * g + 4 * hh;
      uint2 o; o.x = pack2(oacc[eb][4 * g] * inv, oacc[eb][4 * g + 1] * inv); o.y = pack2(oacc[eb][4 * g + 2] * inv, oacc[eb][4 * g + 3] * inv);
      *(uint2*)(orow + e) = o;
    }
}

template <int MODE>
__device__ void scan_item(const Params& p, int l, int item) {
  constexpr int DK = MODE ? 128 : 64, DVS = MODE ? 64 : 32, DP = NTHR / DVS, DPT = DK / DP, TC = 32;
  constexpr int NH = MODE ? 8 : 4, NSL = 128 / DVS, LDP = MODE ? LDP_O : LDP_E;
  const int j = l >> 1;
  const int sl = item % NSL, dir = (item / NSL) & 1, h = (item / (NSL * 2)) % NH, b = item / (NSL * 2 * NH);
  float* Qs = (float*)smem_raw; float* Ks = Qs + TC * DK; float* Ds = Ks + TC * DK; float* Vs = Ds + TC * DK; float* Os = Vs + TC * DVS; float* LB = Os + TC * DVS;
  const int tid = TID(), dpart = tid % DP, e = tid / DP;
  float S[DPT];
#pragma unroll
  for (int i = 0; i < DPT; ++i) S[i] = 0.f;
  __syncthreads();
  if (MODE == 1) {
    if (tid < 128) {
      const float* lr = p.lb_raw + (size_t)dir * 4 * 1024 + h * 128 + tid;
      const float r0 = lr[0], r1 = lr[1024], r2 = lr[2048], r3 = lr[3072];
      const float mx = fmaxf(fmaxf(r0, r1), fmaxf(r2, r3));
      const float e0 = __expf(r0 - mx), e1 = __expf(r1 - mx), e2 = __expf(r2 - mx), e3 = __expf(r3 - mx);
      const float inv = 1.f / (e0 + e1 + e2 + e3);
      float acc = 0.f;
      if (l >= 1) acc += e1;
      if (l >= 2) acc += e2;
      if (l >= 3) acc += e3;
      LB[tid] = acc * inv;
    }
  }
  bf16_t* Ro;
  int ldo, ocol;
  if (MODE == 0) { Ro = p.R2 + (size_t)dir * MT * 512; ldo = 512; ocol = h * 128 + sl * DVS; }
  else { Ro = dir ? p.R2 : p.R1; ldo = 1024; ocol = h * 128 + sl * DVS; }
  for (int chunk = 0; chunk < NKK / TC; ++chunk) {
    __syncthreads();
    for (int idx = tid; idx < TC * DK; idx += NTHR) {
      const int tt = idx / DK, d = idx % DK;
      const int n = chunk * TC + tt;
      int row;
      if (n < TCX) row = ML + b * TCX + (dir ? (TCX - 1 - n) : n); else row = b * TL + (dir ? (TL - 1 - (n - TCX)) : (n - TCX));
      const bf16_t* pr = p.P + (size_t)row * LDP;
      float q, k, dec;
      if (MODE == 0) {
        q = bf2f(pr[1536 + h * 64 + d]) * 0.125f;
        k = bf2f(pr[1792 + h * 64 + d]);
        const float* w = p.w_gate_up + ((size_t)(j * 2 + dir) * 16) * 256 + h * 64 + d;
        float xg = p.b_gate_up[(j * 2 + dir) * 256 + h * 64 + d];
#pragma unroll
        for (int rr = 0; rr < 16; ++rr) xg += bf2f(pr[3072 + dir * 16 + rr]) * w[rr * 256];
        const float ls = fminf(xg, 0.f) - log1pf(__expf(-fabsf(xg)));
        dec = __expf(ls * (1.f / 16.f));
      } else {
        q = siluf(bf2f(pr[h * 128 + d])) * 0.08838834764831845f;
        const float lbv = LB[d];
        const float f = lbv + (1.f - lbv) * sigmoidf_(bf2f(pr[1024 + dir * 1024 + h * 128 + d]));
        k = 1.f - f; dec = f;
      }
      Qs[idx] = q; Ks[idx] = k; Ds[idx] = dec;
    }
    for (int idx = tid; idx < TC * DVS; idx += NTHR) {
      const int tt = idx / DVS, ee = idx % DVS;
      const int n = chunk * TC + tt;
      int row;
      if (n < TCX) row = ML + b * TCX + (dir ? (TCX - 1 - n) : n); else row = b * TL + (dir ? (TL - 1 - (n - TCX)) : (n - TCX));
      const bf16_t* pr = p.P + (size_t)row * LDP;
      Vs[idx] = bf2f(pr[(MODE ? 3072 : 2048) + h * 128 + sl * DVS + ee]);
    }
    __syncthreads();
    for (int tt = 0; tt < TC; ++tt) {
      const float v = Vs[tt * DVS + e];
      float part = 0.f;
#pragma unroll
      for (int i4 = 0; i4 < DPT / 4; ++i4) {
        const float4 q4 = *(const float4*)(Qs + tt * DK + dpart * DPT + i4 * 4);
        const float4 k4 = *(const float4*)(Ks + tt * DK + dpart * DPT + i4 * 4);
        const float4 d4 = *(const float4*)(Ds + tt * DK + dpart * DPT + i4 * 4);
        S[i4 * 4 + 0] = S[i4 * 4 + 0] * d4.x + k4.x * v; part += q4.x * S[i4 * 4 + 0];
        S[i4 * 4 + 1] = S[i4 * 4 + 1] * d4.y + k4.y * v; part += q4.y * S[i4 * 4 + 1];
        S[i4 * 4 + 2] = S[i4 * 4 + 2] * d4.z + k4.z * v; part += q4.z * S[i4 * 4 + 2];
        S[i4 * 4 + 3] = S[i4 * 4 + 3] * d4.w + k4.w * v; part += q4.w * S[i4 * 4 + 3];
      }
#pragma unroll
      for (int o = DP / 2; o >= 1; o >>= 1) part += __shfl_xor(part, o, 64);
      if (dpart == 0) Os[tt * DVS + e] = part;
    }
    __syncthreads();
    for (int idx = tid; idx < TC * DVS; idx += NTHR) {
      const int tt = idx / DVS, ee = idx % DVS;
      const int n = chunk * TC + tt;
      int row;
      if (n < TCX) row = ML + b * TCX + (dir ? (TCX - 1 - n) : n); else row = b * TL + (dir ? (TL - 1 - (n - TCX)) : (n - TCX));
      Ro[(size_t)row * ldo + ocol + ee] = f2bf(Os[idx]);
    }
  }
}

template <int MODE>
__device__ void scan2_item(const Params& p, int l, int item) {
  constexpr int DK = MODE ? 128 : 64, NH = MODE ? 8 : 4, LDP = MODE ? LDP_O : LDP_E, NDB = DK / 16, QS = DK + 8, TS = 72;
  const int dir = item & 1, h = (item >> 1) % NH, b = item / (2 * NH);
  bf16_t* Qh = (bf16_t*)smem_raw; bf16_t* Kh = Qh + 64 * QS; bf16_t* KbT = Kh + 64 * QS; bf16_t* VT = KbT + DK * TS; float* ET = (float*)(VT + 128 * TS);
  const int tid = TID(), wave = __builtin_amdgcn_readfirstlane(tid >> 6), lane = tid & 63, r15 = lane & 15, fq = lane >> 4;
  const int pd = tid % DK, pi = __builtin_amdgcn_readfirstlane(tid / DK);
  const bool pact = pi < 4;
  const int ve = tid & 127, vi = __builtin_amdgcn_readfirstlane(tid >> 7);
  float lbv = 0.f;
  if (MODE == 1) {
    const float* lr = p.lb_raw + (size_t)dir * 4 * 1024 + h * 128 + pd;
    const float r0 = lr[0], r1 = lr[1024], r2 = lr[2048], r3 = lr[3072];
    const float mx = fmaxf(fmaxf(r0, r1), fmaxf(r2, r3));
    const float e0 = __expf(r0 - mx), e1 = __expf(r1 - mx), e2 = __expf(r2 - mx), e3 = __expf(r3 - mx);
    float a = 0.f;
    if (l >= 1) a += e1;
    if (l >= 2) a += e2;
    if (l >= 3) a += e3;
    lbv = a / (e0 + e1 + e2 + e3);
  }
  const int qcol = MODE ? h * 128 + pd : 1536 + h * 64 + pd;
  const int kcol = MODE ? 1024 + dir * 1024 + h * 128 + pd : 1792 + h * 64 + pd;
  const int vcol = (MODE ? 3072 : 2048) + h * 128 + ve;
  const int gcol = dir * 256 + h * 64 + pd;
  bf16_t* Ro; int ldo;
  if (MODE == 0) { Ro = p.R2 + (size_t)dir * MT * 512; ldo = 512; } else { Ro = dir ? p.R2 : p.R1; ldo = 1024; }
  Ro += h * 128 + 16 * wave + r15;
  const int rowc = ML + b * TCX, rowl = b * TL;
  auto tokrow = [&](int n) -> int { return n < TCX ? rowc + (dir ? (TCX - 1 - n) : n) : rowl + (dir ? (TL - 1 - (n - TCX)) : (n - TCX)); };
  bf16_t rq[16], rk[16], rv[16]; float rg[16];
  auto load_raw = [&](int ck) {
#pragma unroll
    for (int tt = 0; tt < 16; ++tt) {
      if (pact) {
        const int row = tokrow(ck * 64 + 16 * pi + tt);
        const bf16_t* pr = p.P + (size_t)row * LDP;
        rq[tt] = pr[qcol]; rk[tt] = pr[kcol];
#if EXP2
        if (MODE == 0) {
          const int jx = l >> 1;
          const float* w = p.w_gate_up + ((size_t)(jx * 2 + dir) * 16) * 256 + h * 64 + pd;
          float xg = p.b_gate_up[(jx * 2 + dir) * 256 + h * 64 + pd];
#pragma unroll
          for (int rr = 0; rr < 16; ++rr) xg += bf2f(pr[3072 + dir * 16 + rr]) * w[rr * 256];
          const float ls = fminf(xg, 0.f) - log1pf(__expf(-fabsf(xg)));
          rg[tt] = ls * (1.f / 16.f);
        }
#else
        if (MODE == 0) rg[tt] = p.Gk[(size_t)row * 512 + gcol];
#endif
      }
      const int rowv = tokrow(ck * 64 + 16 * vi + tt);
      rv[tt] = p.P[(size_t)rowv * LDP + vcol];
    }
  };
  f32x4 S[NDB];
#pragma unroll
  for (int db = 0; db < NDB; ++db) S[db] = (f32x4){0.f, 0.f, 0.f, 0.f};
  constexpr int BUFE = 2 * 64 * QS + DK * TS + 128 * TS + 2 * 4 * DK;
  auto prep = [&](int bi) {
    bf16_t* Qh_ = Qh + bi * BUFE; bf16_t* Kh_ = Kh + bi * BUFE; bf16_t* KbT_ = KbT + bi * BUFE; bf16_t* VT_ = VT + bi * BUFE; float* ET_ = (float*)(VT_ + 128 * TS);
    if (pact) {
      float E = 1.f, kh[16];
#pragma unroll
      for (int tt = 0; tt < 16; ++tt) {
        float q, k, dec;
        if (MODE == 1) {
          q = siluf(bf2f(rq[tt])) * 0.08838834764831845f;
          dec = lbv + (1.f - lbv) * sigmoidf_(bf2f(rk[tt]));
          k = 1.f - dec;
        } else { q = bf2f(rq[tt]) * 0.125f; k = bf2f(rk[tt]); dec = rg[tt]; }
        E *= dec;
        const float kE = k * __builtin_amdgcn_rcpf(E);
        kh[tt] = kE;
        Qh_[(16 * pi + tt) * QS + pd] = f2bf(q * E);
        Kh_[(16 * pi + tt) * QS + pd] = f2bf(kE);
      }
      ET_[pi * DK + pd] = E;
      unsigned w[8];
#pragma unroll
      for (int u = 0; u < 8; ++u) w[u] = pack2(kh[2 * u] * E, kh[2 * u + 1] * E);
      *(uint4*)(KbT_ + pd * TS + 16 * pi) = make_uint4(w[0], w[1], w[2], w[3]);
      *(uint4*)(KbT_ + pd * TS + 16 * pi + 8) = make_uint4(w[4], w[5], w[6], w[7]);
    }
    {
      unsigned w[8];
#pragma unroll
      for (int u = 0; u < 8; ++u) w[u] = (unsigned)rv[2 * u] | ((unsigned)rv[2 * u + 1] << 16);
      *(uint4*)(VT_ + ve * TS + 16 * vi) = make_uint4(w[0], w[1], w[2], w[3]);
      *(uint4*)(VT_ + ve * TS + 16 * vi + 8) = make_uint4(w[4], w[5], w[6], w[7]);
    }
  };
  __syncthreads();
  load_raw(0);
  prep(0);
  load_raw(1);
  __syncthreads();
  for (int ck = 0; ck < NKK / 64; ++ck) {
    if (ck + 1 < NKK / 64) { prep((ck + 1) & 1); if (ck + 2 < NKK / 64) load_raw(ck + 2); }
    const int bo = (ck & 1) * BUFE;
    const bf16_t* Qb = Qh + bo; const bf16_t* Kb = Kh + bo; const bf16_t* KTb = KbT + bo; const bf16_t* Vb = VT + bo; const float* Eb = (const float*)(Vb + 128 * TS);
#pragma unroll
    for (int i = 0; i < 4; ++i) {
      f32x4 att = (f32x4){0.f, 0.f, 0.f, 0.f};
#pragma unroll
      for (int kb = 0; kb < DK / 32; ++kb) {
        const bf16x8 ka = *(const bf16x8*)(Kb + (16 * i + r15) * QS + 32 * kb + 8 * fq);
        const bf16x8 qb = *(const bf16x8*)(Qb + (16 * i + r15) * QS + 32 * kb + 8 * fq);
        att = __builtin_amdgcn_mfma_f32_16x16x32_bf16(ka, qb, att, 0, 0, 0);
      }
      const unsigned a01 = pack2((4 * fq + 0 <= r15) ? att[0] : 0.f, (4 * fq + 1 <= r15) ? att[1] : 0.f);
      const unsigned a23 = pack2((4 * fq + 2 <= r15) ? att[2] : 0.f, (4 * fq + 3 <= r15) ? att[3] : 0.f);
      const bf16x8 a8 = __builtin_bit_cast(bf16x8, make_uint4(a01, a23, 0u, 0u));
      f32x4 o = (f32x4){0.f, 0.f, 0.f, 0.f};
#pragma unroll
      for (int kb = 0; kb < DK / 32; ++kb) {
        const s16x4 qlo = *(const s16x4*)(Qb + (16 * i + r15) * QS + 32 * kb + 4 * fq);
        const s16x4 qhi = *(const s16x4*)(Qb + (16 * i + r15) * QS + 32 * kb + 16 + 4 * fq);
        const bf16x8 qa = __builtin_shufflevector(qlo, qhi, 0, 1, 2, 3, 4, 5, 6, 7);
        const bf16x8 sb = __builtin_bit_cast(bf16x8, make_uint4(pack2(S[2 * kb][0], S[2 * kb][1]), pack2(S[2 * kb][2], S[2 * kb][3]),
                                                                  pack2(S[2 * kb + 1][0], S[2 * kb + 1][1]), pack2(S[2 * kb + 1][2], S[2 * kb + 1][3])));
        o = __builtin_amdgcn_mfma_f32_16x16x32_bf16(qa, sb, o, 0, 0, 0);
      }
      const s16x4 vb = *(const s16x4*)(Vb + (16 * wave + r15) * TS + 16 * i + 4 * fq);
      const s16x4 z4 = (s16x4){0, 0, 0, 0};
      const bf16x8 vb8 = __builtin_shufflevector(vb, z4, 0, 1, 2, 3, 4, 5, 6, 7);
      o = __builtin_amdgcn_mfma_f32_16x16x32_bf16(a8, vb8, o, 0, 0, 0);
#pragma unroll
      for (int jj = 0; jj < 4; ++jj) {
        const int row = tokrow(ck * 64 + 16 * i + 4 * fq + jj);
        Ro[(size_t)row * ldo] = f2bf(o[jj]);
      }
#pragma unroll
      for (int db = 0; db < NDB; ++db) {
        const float4 et = *(const float4*)(Eb + i * DK + 16 * db + 4 * fq);
        f32x4 s = S[db];
        s[0] *= et.x; s[1] *= et.y; s[2] *= et.z; s[3] *= et.w;
        const s16x4 ka = *(const s16x4*)(KTb + (16 * db + r15) * TS + 16 * i + 4 * fq);
        S[db] = __builtin_amdgcn_mfma_f32_16x16x32_bf16(__builtin_shufflevector(ka, z4, 0, 1, 2, 3, 4, 5, 6, 7), vb8, s, 0, 0, 0);
      }
    }
    __syncthreads();
  }
}

__device__ void phase_post_even(const Params& p, int l) {
  const int j = l >> 1;
  const int wave = TID() >> 6, lane = TID() & 63;
  const float lambda_init = 0.8f - 0.6f * expf(-0.3f * (float)l);
  const float* la = p.lambda_a + j * 256;
  const float s1 = wave_sum(la[lane] * la[64 + lane]);
  const float s2 = wave_sum(la[128 + lane] * la[192 + lane]);
  const float lam = expf(s1) - expf(s2) + lambda_init;
  const float ga0 = p.subln[j * 128 + 2 * lane] * (1.f - lambda_init), ga1 = p.subln[j * 128 + 2 * lane + 1] * (1.f - lambda_init);
  const float gb0 = p.onorm_b[j * 128 + 2 * lane], gb1 = p.onorm_b[j * 128 + 2 * lane + 1];
  for (int row = blockIdx.x * 8 + wave; row < MT; row += gridDim.x * 8) {
    bf16_t* r1 = p.R1 + (size_t)row * D;
    const bf16_t* r2f = p.R2 + (size_t)row * 512;
    const bf16_t* r2b = p.R2 + (size_t)MT * 512 + (size_t)row * 512;
    const bf16_t* pg = p.P + (size_t)row * LDP_E + 2560;
    unsigned a1[4], a2[4], bf_[4], bb_[4], gg[4];
#pragma unroll
    for (int h = 0; h < 4; ++h) {
      a1[h] = *(const unsigned*)(r1 + h * 128 + 2 * lane);
      a2[h] = *(const unsigned*)(r1 + 512 + h * 128 + 2 * lane);
      bf_[h] = *(const unsigned*)(r2f + h * 128 + 2 * lane);
      bb_[h] = *(const unsigned*)(r2b + h * 128 + 2 * lane);
      gg[h] = *(const unsigned*)(pg + h * 128 + 2 * lane);
    }
    unsigned oa[4], ob[4];
#pragma unroll
    for (int h = 0; h < 4; ++h) {
      const float x0 = bf2f((bf16_t)(a1[h] & 0xffff)) - lam * bf2f((bf16_t)(a2[h] & 0xffff));
      const float x1 = bf2f((bf16_t)(a1[h] >> 16)) - lam * bf2f((bf16_t)(a2[h] >> 16));
      const float ra = rsqrtf(wave_sum(x0 * x0 + x1 * x1) * (1.f / 128.f) + EPSN);
      oa[h] = pack2(x0 * ra * ga0, x1 * ra * ga1);
      const float y0 = bf2f((bf16_t)(bf_[h] & 0xffff)) + bf2f((bf16_t)(bb_[h] & 0xffff));
      const float y1 = bf2f((bf16_t)(bf_[h] >> 16)) + bf2f((bf16_t)(bb_[h] >> 16));
      const float rb = rsqrtf(wave_sum(y0 * y0 + y1 * y1) * (1.f / 128.f) + EPSN);
      const float g0 = bf2f((bf16_t)(gg[h] & 0xffff)), g1 = bf2f((bf16_t)(gg[h] >> 16));
      ob[h] = pack2(y0 * rb * gb0 * siluf(g0), y1 * rb * gb1 * siluf(g1));
    }
#pragma unroll
    for (int h = 0; h < 4; ++h) {
      *(unsigned*)(r1 + h * 128 + 2 * lane) = oa[h];
      *(unsigned*)(r1 + 512 + h * 128 + 2 * lane) = ob[h];
    }
  }
}

__device__ void phase_post_odd(const Params& p, int l) {
  const int j = l >> 1;
  const int wave = TID() >> 6, lane = TID() & 63;
  const float g0 = p.onorm_c[j * 128 + 2 * lane], g1 = p.onorm_c[j * 128 + 2 * lane + 1];
  for (int row = blockIdx.x * 8 + wave; row < MT; row += gridDim.x * 8) {
    bf16_t* r1 = p.R1 + (size_t)row * D;
    const bf16_t* r2 = p.R2 + (size_t)row * D;
    const bf16_t* pg = p.P + (size_t)row * LDP_O + 4096;
    unsigned a[8], bq[8], gg[8];
#pragma unroll
    for (int h = 0; h < 8; ++h) {
      a[h] = *(const unsigned*)(r1 + h * 128 + 2 * lane);
      bq[h] = *(const unsigned*)(r2 + h * 128 + 2 * lane);
      gg[h] = *(const unsigned*)(pg + h * 128 + 2 * lane);
    }
    unsigned o[8];
#pragma unroll
    for (int h = 0; h < 8; ++h) {
      const float y0 = bf2f((bf16_t)(a[h] & 0xffff)) + bf2f((bf16_t)(bq[h] & 0xffff));
      const float y1 = bf2f((bf16_t)(a[h] >> 16)) + bf2f((bf16_t)(bq[h] >> 16));
      const float rb = rsqrtf(wave_sum(y0 * y0 + y1 * y1) * (1.f / 128.f) + EPSN);
      const float q0 = bf2f((bf16_t)(gg[h] & 0xffff)), q1 = bf2f((bf16_t)(gg[h] >> 16));
      o[h] = pack2(y0 * rb * g0 * siluf(q0), y1 * rb * g1 * siluf(q1));
    }
#pragma unroll
    for (int h = 0; h < 8; ++h) *(unsigned*)(r1 + h * 128 + 2 * lane) = o[h];
  }
}

constexpr int NPHASE = 1 + 4 * 9;
#ifndef GEMM_INL
#define GEMM_INL
#endif
__device__ GEMM_INL void gemm_call_p(const bf16_t* A, const bf16_t* Bt, int M, int N, int K, EpiArgs ea) { gemm_phase<EPI_P>(A, Bt, M, N, K, ea); }
__device__ GEMM_INL void gemm_call_res(const bf16_t* A, const bf16_t* Bt, int M, int N, int K, EpiArgs ea) { gemm_phase<EPI_RES>(A, Bt, M, N, K, ea); }
__device__ GEMM_INL void gemm_call_sw(const bf16_t* A, const bf16_t* Bt, int M, int N, int K, EpiArgs ea) { gemm_phase<EPI_SWIGLU>(A, Bt, M, N, K, ea); }

__device__ void run_phase(const Params& p, int ph) {
  if (ph == 0) { phase_init(p); return; }
  const int l = (ph - 1) / 9, s = (ph - 1) % 9, j = l >> 1;
  const bool even = (l & 1) == 0;
  const int mrows = l < 3 ? MT : ML;
  const float* modl = p.mod + (size_t)l * 9 * 6144;
  float* slab = (float*)(p.P + (size_t)56 * 1024 * 1024);
  if (s == 1 || s == 5 || s == 8) {
    if (s == 1) {
      EpiArgs ea{p.P, even ? LDP_E : LDP_O, nullptr, nullptr, nullptr, nullptr};
      const bf16_t* Bt = even ? p.wt_in_even + (size_t)j * LDP_E * 1024 : p.wt_in_odd + (size_t)j * LDP_O * 1024;
      gemm_call_p(p.R1, Bt, MT, even ? LDP_E : LDP_O, 1024, ea);
    } else {
      EpiArgs ea{nullptr, 0, p.out, p.Z, modl + (s == 5 ? 2 : 5) * 1024, slab};
      const bf16_t* A = s == 5 ? p.R1 : p.P;
      const bf16_t* Bt = s == 5 ? (even ? p.wt_out_even : p.wt_out_odd) + (size_t)j * 1024 * 1024 : p.wt_ffn_out + (size_t)l * 1024 * DFF;
      gemm_call_res(A, Bt, mrows, 1024, s == 5 ? 1024 : DFF, ea);
    }
    return;
  }
  switch (s) {
    case 0: phase_norm(p, l, 0, MT, p.R1, l > 0 ? p.mod + ((size_t)(l - 1) * 9 + 8) * 6144 + 5 * 1024 : nullptr, slab); break;
    case 2: if (even) phase_prep_even(p, j); break;
    case 3: {
      if (even) {
#if DYNQ
        int* qs = (int*)(smem_raw + LDS_BYTES - 16);
        for (;;) {
          __syncthreads();
          if (TID() == 0) *qs = (int)atomicAdd(p.ctr + l, 1u);
          __syncthreads();
          const int it = *qs;
          if (it >= 64 + 576) break;
          if (it < 64) scan2_item<0>(p, l, it); else attn_item(p, it - 64);
        }
#else
#if EXP1
        for (int it = blockIdx.x; it < 256 + 576; it += gridDim.x) { if (it < 256) scan_item<0>(p, l, it); else attn_item(p, it - 256); }
#else
        for (int it = blockIdx.x; it < 64 + 576; it += gridDim.x) { if (it < 64) scan2_item<0>(p, l, it); else attn_item(p, it - 64); }
#endif
#endif
      } else {
        for (int it = blockIdx.x; it < 128; it += gridDim.x) scan2_item<1>(p, l, it);
      }
    } break;
    case 4: if (even) phase_post_even(p, l); else phase_post_odd(p, l); break;
    case 6: phase_norm(p, l, 1, mrows, p.R2, l < 3 ? modl + (size_t)8 * 6144 + 2 * 1024 : nullptr, slab); break;
    case 7: {
      EpiArgs ea{p.P, DFF, nullptr, nullptr, nullptr, nullptr};
      gemm_call_sw(p.R2, p.wt_ffn_in + (size_t)l * 5632 * 1024, mrows, 5632, 1024, ea);
    } break;
  }
}

DI void grid_barrier(unsigned* ctr, unsigned target) {
  asm volatile("s_waitcnt vmcnt(0)" ::: "memory");
  __syncthreads();
  if (threadIdx.x == 0) {
    __builtin_amdgcn_fence(__ATOMIC_RELEASE, "agent");
    asm volatile("s_waitcnt vmcnt(0)" ::: "memory");
    __hip_atomic_fetch_add(ctr, 1u, __ATOMIC_RELAXED, __HIP_MEMORY_SCOPE_AGENT);
    unsigned spins = 0;
    while (__hip_atomic_load(ctr, __ATOMIC_RELAXED, __HIP_MEMORY_SCOPE_AGENT) < target) { __builtin_amdgcn_s_sleep(1); if (++spins > (1u << 24)) break; }
  }
  __syncthreads();
  __builtin_amdgcn_fence(__ATOMIC_ACQUIRE, "agent");
  asm volatile("s_waitcnt vmcnt(0)" ::: "memory");
}

__global__ void __launch_bounds__(NTHR, 2) mega_kernel(Params p, int ph0, int ph1) {
  cg::grid_group grid = cg::this_grid();
  unsigned nbar = 0;
  for (int ph = ph0; ph < ph1; ++ph) {
#if DBL_MASK
    { const int s_ = ph == 0 ? 9 : (ph - 1) % 9; const int nrep = ((DBL_MASK >> s_) & 1) ? 2 : 1; for (int rep = 0; rep < nrep; ++rep) run_phase(p, ph); }
#else
    run_phase(p, ph);
#endif
    if (ph + 1 < ph1) {
      if (ph > 0) { const int s_ = (ph - 1) % 9, l_ = (ph - 1) / 9; if (s_ == 2 && (l_ & 1)) continue; }
#if CUSTOM_BAR
      if (ph == 0) grid.sync(); else { ++nbar; grid_barrier(p.ctr + 32, nbar * gridDim.x); }
#else
      grid.sync();
#endif
    }
  }
}

extern "C" void kernel_launch(void* const* d_in, const int* in_sizes, int n_in, void* d_out, int out_size, void* d_ws, size_t ws_size, hipStream_t stream) {
  constexpr size_t kDynLds = LDS_BYTES;
  static int grid_blocks = 0;
  if (!grid_blocks) {
    hipFuncSetAttribute((const void*)mega_kernel, hipFuncAttributeMaxDynamicSharedMemorySize, (int)kDynLds);
    int dev = 0, cus = 0, per_cu = 0;
    hipGetDevice(&dev);
    hipDeviceGetAttribute(&cus, hipDeviceAttributeMultiprocessorCount, dev);
    hipOccupancyMaxActiveBlocksPerMultiprocessor(&per_cu, mega_kernel, NTHR, kDynLds);
    if (per_cu < 1) per_cu = 1;
    grid_blocks = cus * per_cu;
  }
  Params p{};
  const float* const* in = (const float* const*)d_in;
  p.x = in[0]; p.c = in[1]; p.ctx = in[2]; p.c_ctx = in[3]; p.w_ada = in[4]; p.b_ada = in[5]; p.n1g = in[6]; p.n2g = in[7];
  p.w_in_even = in[8]; p.qk_gain = in[9]; p.lambda_a = in[10]; p.subln = in[11]; p.w_gate_up = in[12]; p.b_gate_up = in[13];
  p.onorm_b = in[14]; p.w_out_even = in[15]; p.w_in_odd = in[16]; p.lb_raw = in[17]; p.onorm_c = in[18]; p.w_out_odd = in[19];
  p.w_ffn_in = in[20]; p.w_ffn_out = in[21];
  p.out = (float*)d_out;
  char* w = (char*)d_ws;
  size_t off = 0;
  auto take = [&](size_t bytes) { char* r = w + off; off += (bytes + 255) & ~(size_t)255; return r; };
  p.wt_in_even = (bf16_t*)take((size_t)2 * LDP_E * 1024 * 2);
  p.wt_in_odd = (bf16_t*)take((size_t)2 * LDP_O * 1024 * 2);
  p.wt_out_even = (bf16_t*)take((size_t)2 * 1024 * 1024 * 2);
  p.wt_out_odd = (bf16_t*)take((size_t)2 * 1024 * 1024 * 2);
  p.wt_ffn_in = (bf16_t*)take((size_t)4 * 5632 * 1024 * 2);
  p.wt_ffn_out = (bf16_t*)take((size_t)4 * 1024 * DFF * 2);
  p.Z = (float*)take((size_t)MC * D * 4);
  p.mod = (float*)take((size_t)4 * 9 * 6144 * 4);
  p.P = (bf16_t*)take((size_t)MT * LDP_O * 2);
  p.R1 = (bf16_t*)take((size_t)MT * D * 2);
  p.R2 = (bf16_t*)take((size_t)MT * D * 2);
  p.Vt = p.P + (size_t)MT * LDP_E;
  p.Gk = (float*)(p.Vt + (size_t)NB * 4 * 128 * NKK);
  p.ctr = (unsigned*)take(256);
  if (off > ws_size) { fprintf(stderr, "workspace too small: need %zu have %zu\n", off, ws_size); return; }
#if ONE_LAUNCH
  int ph0 = 0, ph1 = NPHASE;
  void* args[] = {&p, &ph0, &ph1};
  hipError_t e = hipLaunchCooperativeKernel((const void*)mega_kernel, dim3(grid_blocks), dim3(NTHR), args, kDynLds, stream);
  if (e != hipSuccess) fprintf(stderr, "cooperative launch failed: %s (grid %d)\n", hipGetErrorString(e), grid_blocks);
#else
  for (int ph = 0; ph < NPHASE; ++ph) {
    const int l = (ph - 1) / 9, s = (ph - 1) % 9;
    if (ph > 0 && s == 2 && (l & 1)) continue;
    mega_kernel<<<grid_blocks, NTHR, kDynLds, stream>>>(p, ph, ph + 1);
  }
#endif
}
```

```cpp
#include <hip/hip_runtime.h>
#include <hip/hip_cooperative_groups.h>
#include <cstdio>
namespace cg = cooperative_groups;

#ifndef DYNQ
#define DYNQ 1
#endif
#ifndef EXP1
#define EXP1 0
#endif
#ifndef EXP2
#define EXP2 0
#endif
#ifndef EXTRA_SYNC
#define EXTRA_SYNC 0
#endif
#ifndef CUSTOM_BAR
#define CUSTOM_BAR 2
#endif
#ifndef PROBE_SEL
#define PROBE_SEL 0
#define PROBE_LAYERS 15
#endif
#ifndef SCANPROBE
#define SCANPROBE 0
#endif
#ifndef STOREPROBE
#define STOREPROBE 0
#endif
#ifndef ITEMPROBE
#define ITEMPROBE 0
#define ITEMPROBE_BLOCK 0
#endif
#ifndef FUSE_NORM
#define FUSE_NORM 1
#endif
#ifndef DBL_MASK
#define DBL_MASK 0
#endif
#ifndef ONE_LAUNCH
#define ONE_LAUNCH 1
#endif

typedef unsigned short bf16_t;
typedef short bf16x8 __attribute__((ext_vector_type(8)));
typedef short s16x4 __attribute__((ext_vector_type(4)));
typedef float f32x4 __attribute__((ext_vector_type(4)));
typedef float f32x16 __attribute__((ext_vector_type(16)));
#define DI __device__ __forceinline__

__device__ const float ROPE_CS[64][16] = {
  {1.00000000e+00f,1.00000000e+00f,1.00000000e+00f,1.00000000e+00f,1.00000000e+00f,1.00000000e+00f,1.00000000e+00f,1.00000000e+00f,1.00000000e+00f,1.00000000e+00f,1.00000000e+00f,1.00000000e+00f,1.00000000e+00f,1.00000000e+00f,1.00000000e+00f,1.00000000e+00f},
  {5.40302277e-01f,8.46009135e-01f,9.50415254e-01f,9.84230220e-01f,9.95004177e-01f,9.98419285e-01f,9.99500036e-01f,9.99841869e-01f,9.99949992e-01f,9.99984205e-01f,9.99994993e-01f,9.99998391e-01f,9.99999523e-01f,9.99999821e-01f,9.99999940e-01f,1.00000000e+00f},
  {-4.16146845e-01f,4.31462824e-01f,8.06578398e-01f,9.37418282e-01f,9.80066597e-01f,9.93682086e-01f,9.98000681e-01f,9.99367595e-01f,9.99800026e-01f,9.99936759e-01f,9.99979973e-01f,9.99993682e-01f,9.99997973e-01f,9.99999344e-01f,9.99999821e-01f,9.99999940e-01f},
  {-9.89992499e-01f,-1.15966164e-01f,5.82753658e-01f,8.61040652e-01f,9.55336511e-01f,9.85803485e-01f,9.95503366e-01f,9.98577297e-01f,9.99550045e-01f,9.99857724e-01f,9.99954998e-01f,9.99985754e-01f,9.99995530e-01f,9.99998569e-01f,9.99999523e-01f,9.99999881e-01f},
  {-6.53643608e-01f,-6.27679706e-01f,3.01137477e-01f,7.57506192e-01f,9.21060979e-01f,9.74808276e-01f,9.92010653e-01f,9.97471273e-01f,9.99200106e-01f,9.99747038e-01f,9.99920011e-01f,9.99974728e-01f,9.99992013e-01f,9.99997497e-01f,9.99999225e-01f,9.99999762e-01f},
  {2.83662200e-01f,-9.46079254e-01f,-1.03423381e-02f,6.30080283e-01f,8.77582550e-01f,9.60731268e-01f,9.87526000e-01f,9.96049762e-01f,9.98750269e-01f,9.99604762e-01f,9.99875009e-01f,9.99960482e-01f,9.99987483e-01f,9.99996066e-01f,9.99998748e-01f,9.99999583e-01f},
  {9.60170269e-01f,-9.73103702e-01f,-3.20796400e-01f,4.82782036e-01f,8.25335622e-01f,9.43616986e-01f,9.82053936e-01f,9.94313300e-01f,9.98200536e-01f,9.99430835e-01f,9.99819994e-01f,9.99943078e-01f,9.99981999e-01f,9.99994338e-01f,9.99998212e-01f,9.99999404e-01f},
  {7.53902256e-01f,-7.00429797e-01f,-5.99437475e-01f,3.20257008e-01f,7.64842212e-01f,9.23519433e-01f,9.75599885e-01f,9.92262423e-01f,9.97551024e-01f,9.99225318e-01f,9.99755025e-01f,9.99922514e-01f,9.99975502e-01f,9.99992251e-01f,9.99997556e-01f,9.99999225e-01f},
  {-1.45500034e-01f,-2.12036446e-01f,-8.18632424e-01f,1.47631213e-01f,6.96706712e-01f,9.00502324e-01f,9.68170285e-01f,9.89897788e-01f,9.96801734e-01f,9.98988271e-01f,9.99680042e-01f,9.99898791e-01f,9.99967992e-01f,9.99989867e-01f,9.99996781e-01f,9.99998987e-01f},
  {-9.11130250e-01f,3.41660261e-01f,-9.56644177e-01f,-2.96507962e-02f,6.21609926e-01f,8.74638259e-01f,9.59772646e-01f,9.87220109e-01f,9.95952725e-01f,9.98719573e-01f,9.99595046e-01f,9.99871910e-01f,9.99959528e-01f,9.99987185e-01f,9.99995947e-01f,9.99998748e-01f},
  {-8.39071512e-01f,7.90131867e-01f,-9.99786079e-01f,-2.05997631e-01f,5.40302277e-01f,8.46009135e-01f,9.50415313e-01f,9.84230220e-01f,9.95004177e-01f,9.98419285e-01f,9.99500036e-01f,9.99841869e-01f,9.99949992e-01f,9.99984205e-01f,9.99994993e-01f,9.99998391e-01f},
  {4.42569796e-03f,9.95257378e-01f,-9.43779767e-01f,-3.75847399e-01f,4.53596085e-01f,8.14705312e-01f,9.40107584e-01f,9.80929136e-01f,9.93956089e-01f,9.98087406e-01f,9.99395072e-01f,9.99808669e-01f,9.99939501e-01f,9.99980867e-01f,9.99993920e-01f,9.99998093e-01f},
  {8.43853951e-01f,8.93861592e-01f,-7.94179380e-01f,-5.33843040e-01f,3.62357706e-01f,7.80825913e-01f,9.28859890e-01f,9.77317870e-01f,9.92808640e-01f,9.97723997e-01f,9.99280095e-01f,9.99772310e-01f,9.99927998e-01f,9.99977231e-01f,9.99992788e-01f,9.99997735e-01f},
  {9.07446802e-01f,5.17172873e-01f,-5.65820515e-01f,-6.75001681e-01f,2.67498761e-01f,7.44477987e-01f,9.16683376e-01f,9.73397553e-01f,9.91561890e-01f,9.97329056e-01f,9.99155104e-01f,9.99732792e-01f,9.99915481e-01f,9.99973297e-01f,9.99991536e-01f,9.99997318e-01f},
  {1.36737213e-01f,-1.87961515e-02f,-2.81349480e-01f,-7.94870913e-01f,1.69967160e-01f,7.05776393e-01f,9.03590262e-01f,9.69169438e-01f,9.90216017e-01f,9.96902585e-01f,9.99020159e-01f,9.99690115e-01f,9.99902010e-01f,9.99969006e-01f,9.99990225e-01f,9.99996901e-01f},
  {-7.59687901e-01f,-5.48975468e-01f,3.10223512e-02f,-8.89670432e-01f,7.07371980e-02f,6.64843500e-01f,8.89593601e-01f,9.64634836e-01f,9.88771081e-01f,9.96444523e-01f,9.98875201e-01f,9.99644279e-01f,9.99887526e-01f,9.99964416e-01f,9.99988735e-01f,9.99996424e-01f},
  {-9.57659483e-01f,-9.10081089e-01f,3.40318173e-01f,-9.56410050e-01f,-2.91995462e-02f,6.21808827e-01f,8.74707460e-01f,9.59795177e-01f,9.87227261e-01f,9.95954990e-01f,9.98720288e-01f,9.99595284e-01f,9.99872029e-01f,9.99959528e-01f,9.99987185e-01f,9.99995947e-01f},
  {-2.75163352e-01f,-9.90897954e-01f,6.15864813e-01f,-9.92985010e-01f,-1.28844544e-01f,5.76808274e-01f,8.58946681e-01f,9.54652011e-01f,9.85584795e-01f,9.95433986e-01f,9.98555362e-01f,9.99543071e-01f,9.99855518e-01f,9.99954283e-01f,9.99985576e-01f,9.99995410e-01f},
  {6.60316706e-01f,-7.66536534e-01f,8.30336154e-01f,-9.98241663e-01f,-2.27202162e-01f,5.29984176e-01f,8.42327058e-01f,9.49207008e-01f,9.83843684e-01f,9.94881511e-01f,9.98380423e-01f,9.99487758e-01f,9.99837995e-01f,9.99948800e-01f,9.99983788e-01f,9.99994874e-01f},
  {9.88704622e-01f,-3.06095392e-01f,9.62463796e-01f,-9.72014248e-01f,-3.23289543e-01f,4.81484592e-01f,8.24865162e-01f,9.43461835e-01f,9.82004225e-01f,9.94297504e-01f,9.98195529e-01f,9.99429286e-01f,9.99819517e-01f,9.99942899e-01f,9.99981940e-01f,9.99994278e-01f},
  {4.08082068e-01f,2.48616725e-01f,9.99144375e-01f,-9.15129960e-01f,-4.16146845e-01f,4.31462824e-01f,8.06578457e-01f,9.37418282e-01f,9.80066597e-01f,9.93682086e-01f,9.98000681e-01f,9.99367595e-01f,9.99800026e-01f,9.99936759e-01f,9.99979973e-01f,9.99993682e-01f},
  {-5.47729254e-01f,7.26760268e-01f,9.36740458e-01f,-8.29382956e-01f,-5.04846215e-01f,3.80077004e-01f,7.87485182e-01f,9.31078374e-01f,9.78030920e-01f,9.93035257e-01f,9.97795820e-01f,9.99302804e-01f,9.99779522e-01f,9.99930263e-01f,9.99977946e-01f,9.99993026e-01f},
  {-9.99960840e-01f,9.81074572e-01f,7.81440377e-01f,-7.17477441e-01f,-5.88501155e-01f,3.27489585e-01f,7.67604589e-01f,9.24443960e-01f,9.75897431e-01f,9.92357016e-01f,9.97581005e-01f,9.99234855e-01f,9.99758005e-01f,9.99923468e-01f,9.99975801e-01f,9.99992371e-01f},
  {-5.32833040e-01f,9.33235765e-01f,5.48645258e-01f,-5.82943261e-01f,-6.66275978e-01f,2.73866832e-01f,7.46956408e-01f,9.17517304e-01f,9.73666370e-01f,9.91647422e-01f,9.97356176e-01f,9.99163687e-01f,9.99735534e-01f,9.99916375e-01f,9.99973536e-01f,9.99991655e-01f},
  {4.24179018e-01f,5.97977161e-01f,2.61441678e-01f,-4.30023283e-01f,-7.37393796e-01f,2.19378278e-01f,7.25561321e-01f,9.10300434e-01f,9.71337974e-01f,9.90906477e-01f,9.97121394e-01f,9.99089420e-01f,9.99711990e-01f,9.99908924e-01f,9.99971211e-01f,9.99990880e-01f},
  {9.91202831e-01f,7.85522610e-02f,-5.16893305e-02f,-2.63540596e-01f,-8.01143587e-01f,1.64196163e-01f,7.03440726e-01f,9.02795732e-01f,9.68912423e-01f,9.90134120e-01f,9.96876657e-01f,9.99011934e-01f,9.99687493e-01f,9.99901175e-01f,9.99968767e-01f,9.99990106e-01f},
  {6.46919310e-01f,-4.65064496e-01f,-3.59694332e-01f,-8.87455046e-02f,-8.56888831e-01f,1.08494945e-01f,6.80616796e-01f,8.95005584e-01f,9.66389954e-01f,9.89330530e-01f,9.96621907e-01f,9.98931348e-01f,9.99662042e-01f,9.99893129e-01f,9.99966204e-01f,9.99989331e-01f},
  {-2.92138815e-01f,-8.65450621e-01f,-6.32028639e-01f,8.88481140e-02f,-9.04072165e-01f,5.24506159e-02f,6.57112300e-01f,8.86932373e-01f,9.63770926e-01f,9.88495648e-01f,9.96357203e-01f,9.98847544e-01f,9.99635518e-01f,9.99884725e-01f,9.99963522e-01f,9.99988496e-01f},
  {-9.62605894e-01f,-9.99293387e-01f,-8.41684937e-01f,2.63639510e-01f,-9.42222297e-01f,-3.75941908e-03f,6.32950664e-01f,8.78578722e-01f,9.61055458e-01f,9.87629473e-01f,9.96082544e-01f,9.98760641e-01f,9.99608040e-01f,9.99876022e-01f,9.99960780e-01f,9.99987602e-01f},
  {-7.48057544e-01f,-8.25371623e-01f,-9.67871487e-01f,4.30115849e-01f,-9.70958173e-01f,-5.99575676e-02f,6.08156204e-01f,8.69947195e-01f,9.58243906e-01f,9.86732066e-01f,9.95797932e-01f,9.98670578e-01f,9.99579549e-01f,9.99867022e-01f,9.99957979e-01f,9.99986708e-01f},
  {1.54251456e-01f,-3.97251874e-01f,-9.98075247e-01f,5.83026946e-01f,-9.89992499e-01f,-1.15966164e-01f,5.82753658e-01f,8.61040652e-01f,9.55336511e-01f,9.85803485e-01f,9.95503366e-01f,9.98577297e-01f,9.99550045e-01f,9.99857724e-01f,9.99954998e-01f,9.99985754e-01f},
  {9.14742351e-01f,1.53215483e-01f,-9.29300308e-01f,7.17549205e-01f,-9.99135137e-01f,-1.71608135e-01f,5.56768358e-01f,8.51861775e-01f,9.52333570e-01f,9.84843671e-01f,9.95198846e-01f,9.98480916e-01f,9.99519527e-01f,9.99848068e-01f,9.99951959e-01f,9.99984801e-01f},
  {8.34223390e-01f,6.56495154e-01f,-7.68367112e-01f,8.29440355e-01f,-9.98294771e-01f,-2.26707578e-01f,5.30226350e-01f,8.42413545e-01f,9.49235439e-01f,9.83852804e-01f,9.94884372e-01f,9.98381376e-01f,9.99488056e-01f,9.99838114e-01f,9.99948800e-01f,9.99983788e-01f},
  {-1.32767474e-02f,9.57586050e-01f,-5.31235278e-01f,9.15171385e-01f,-9.87479806e-01f,-2.81090319e-01f,5.03154159e-01f,8.32698941e-01f,9.46042359e-01f,9.82830763e-01f,9.94559944e-01f,9.98278618e-01f,9.99455571e-01f,9.99827802e-01f,9.99945521e-01f,9.99982774e-01f},
  {-8.48570287e-01f,9.63757515e-01f,-2.41421118e-01f,9.72038329e-01f,-9.66798186e-01f,-3.34584385e-01f,4.75578904e-01f,8.22721004e-01f,9.42754686e-01f,9.81777668e-01f,9.94225562e-01f,9.98172760e-01f,9.99422073e-01f,9.99817252e-01f,9.99942183e-01f,9.99981701e-01f},
  {-9.03692186e-01f,6.73110247e-01f,7.23346695e-02f,9.98247743e-01f,-9.36456680e-01f,-3.87020677e-01f,4.47528064e-01f,8.12482953e-01f,9.39372718e-01f,9.80693519e-01f,9.93881226e-01f,9.98063743e-01f,9.99387562e-01f,9.99806345e-01f,9.99938726e-01f,9.99980628e-01f},
  {-1.27963692e-01f,1.75156534e-01f,3.78916174e-01f,9.92972851e-01f,-8.96758378e-01f,-4.38233554e-01f,4.19029742e-01f,8.01987886e-01f,9.35896814e-01f,9.79578316e-01f,9.93526995e-01f,9.97951567e-01f,9.99352098e-01f,9.99795079e-01f,9.99935210e-01f,9.99979496e-01f},
  {7.65414059e-01f,-3.76742303e-01f,6.47921681e-01f,9.56380010e-01f,-8.48100007e-01f,-4.88060862e-01f,3.90112430e-01f,7.91239262e-01f,9.32327330e-01f,9.78432178e-01f,9.93162811e-01f,9.97836173e-01f,9.99315560e-01f,9.99783576e-01f,9.99931574e-01f,9.99978364e-01f},
  {9.55073655e-01f,-8.12611222e-01f,8.52673113e-01f,8.89623463e-01f,-7.90967762e-01f,-5.36345184e-01f,3.60805035e-01f,7.80240417e-01f,9.28664625e-01f,9.77255106e-01f,9.92788672e-01f,9.97717679e-01f,9.99278069e-01f,9.99771714e-01f,9.99927819e-01f,9.99977171e-01f},
  {2.66642928e-01f,-9.98210371e-01f,9.72865343e-01f,7.94808388e-01f,-7.25932240e-01f,-5.82933903e-01f,3.31136853e-01f,7.68994927e-01f,9.24909055e-01f,9.76047099e-01f,9.92404640e-01f,9.97596025e-01f,9.99239624e-01f,9.99759495e-01f,9.99923944e-01f,9.99975979e-01f},
  {-6.66938066e-01f,-8.76379430e-01f,9.96578991e-01f,6.74925625e-01f,-6.53643608e-01f,-6.27679706e-01f,3.01137596e-01f,7.57506192e-01f,9.21060979e-01f,9.74808276e-01f,9.92010653e-01f,9.97471273e-01f,9.99200106e-01f,9.99747038e-01f,9.99920011e-01f,9.99974728e-01f},
  {-9.87339258e-01f,-4.84639406e-01f,9.21462357e-01f,5.33756077e-01f,-5.74824035e-01f,-6.70441091e-01f,2.70837069e-01f,7.45777905e-01f,9.17120814e-01f,9.73538578e-01f,9.91606772e-01f,9.97343302e-01f,9.99159634e-01f,9.99734223e-01f,9.99915957e-01f,9.99973416e-01f},
  {-3.99985313e-01f,5.63609414e-02f,7.54965365e-01f,3.75752151e-01f,-4.90260571e-01f,-7.11082935e-01f,2.40265876e-01f,7.33813822e-01f,9.13088918e-01f,9.72238123e-01f,9.91192937e-01f,9.97212172e-01f,9.99118149e-01f,9.99721110e-01f,9.99911785e-01f,9.99972105e-01f},
  {5.55113316e-01f,5.80003142e-01f,5.13598442e-01f,2.05897167e-01f,-4.00799006e-01f,-7.49476731e-01f,2.09454417e-01f,7.21617639e-01f,9.08965766e-01f,9.70906913e-01f,9.90769207e-01f,9.97077882e-01f,9.99075651e-01f,9.99707639e-01f,9.99907553e-01f,9.99970794e-01f},
  {9.99843299e-01f,9.25014675e-01f,2.21298173e-01f,2.95478199e-02f,-3.07332784e-01f,-7.85501122e-01f,1.78433523e-01f,7.09193349e-01f,9.04751658e-01f,9.69545007e-01f,9.90335584e-01f,9.96940494e-01f,9.99032140e-01f,9.99693930e-01f,9.99903202e-01f,9.99969363e-01f},
  {5.25321960e-01f,9.85138178e-01f,-9.29481089e-02f,-1.47732988e-01f,-2.10795805e-01f,-8.19042206e-01f,1.47234216e-01f,6.96544766e-01f,9.00447130e-01f,9.68152404e-01f,9.89892066e-01f,9.96799886e-01f,9.98987675e-01f,9.99679863e-01f,9.99898732e-01f,9.99967992e-01f},
  {-4.32177931e-01f,7.41858006e-01f,-3.97976756e-01f,-3.20354372e-01f,-1.12152621e-01f,-8.49993885e-01f,1.15887694e-01f,6.83675885e-01f,8.96052480e-01f,9.66729224e-01f,9.89438653e-01f,9.96656179e-01f,9.98942196e-01f,9.99665439e-01f,9.99894202e-01f,9.99966562e-01f},
  {-9.92335498e-01f,2.70098448e-01f,-6.63538277e-01f,-4.82871950e-01f,-1.23883775e-02f,-8.78258407e-01f,8.44252855e-02f,6.70590878e-01f,8.91568303e-01f,9.65275466e-01f,9.88975346e-01f,9.96509314e-01f,9.98895705e-01f,9.99650776e-01f,9.99889553e-01f,9.99965072e-01f},
  {-6.40144348e-01f,-2.84846604e-01f,-8.63296509e-01f,-6.30159974e-01f,8.74991715e-02f,-9.03746367e-01f,5.28784581e-02f,6.57293737e-01f,8.86994898e-01f,9.63791192e-01f,9.88502085e-01f,9.96359289e-01f,9.98848200e-01f,9.99635756e-01f,9.99884784e-01f,9.99963582e-01f},
  {3.00592542e-01f,-7.52063990e-01f,-9.77442741e-01f,-7.57573068e-01f,1.86512470e-01f,-9.26377118e-01f,2.12787576e-02f,6.43788815e-01f,8.82332861e-01f,9.62276459e-01f,9.88018990e-01f,9.96206105e-01f,9.98799741e-01f,9.99620378e-01f,9.99879956e-01f,9.99962032e-01f},
  {9.64965999e-01f,-9.87659097e-01f,-9.94656444e-01f,-8.61092687e-01f,2.83662200e-01f,-9.46079254e-01f,-1.03422189e-02f,6.30080283e-01f,8.77582550e-01f,9.60731268e-01f,9.87526000e-01f,9.96049762e-01f,9.98750269e-01f,9.99604762e-01f,9.99875009e-01f,9.99960482e-01f},
  {7.42154181e-01f,-9.19073522e-01f,-9.13230121e-01f,-9.37454224e-01f,3.77977669e-01f,-9.62790370e-01f,-4.19528559e-02f,6.16172493e-01f,8.72744501e-01f,9.59155679e-01f,9.87023175e-01f,9.95890260e-01f,9.98699784e-01f,9.99588788e-01f,9.99869943e-01f,9.99958873e-01f},
  {-1.62990779e-01f,-5.67430019e-01f,-7.41239965e-01f,-9.84248459e-01f,4.68516916e-01f,-9.76457715e-01f,-7.35215396e-02f,6.02069914e-01f,8.67819190e-01f,9.57549810e-01f,9.86510456e-01f,9.95727658e-01f,9.98648286e-01f,9.99572515e-01f,9.99864817e-01f,9.99957263e-01f},
  {-9.18282807e-01f,-4.10281904e-02f,-4.95741814e-01f,-1.00000000e+00f,5.54374516e-01f,-9.87038016e-01f,-1.05016708e-01f,5.87776959e-01f,8.62807095e-01f,9.55913603e-01f,9.85987842e-01f,9.95561838e-01f,9.98595834e-01f,9.99555886e-01f,9.99859571e-01f,9.99955595e-01f},
  {-8.29309821e-01f,4.98009592e-01f,-2.01079622e-01f,-9.84212041e-01f,6.34692967e-01f,-9.94497895e-01f,-1.36406869e-01f,5.73298037e-01f,8.57708693e-01f,9.54247177e-01f,9.85455394e-01f,9.95392919e-01f,9.98542368e-01f,9.99538958e-01f,9.99854207e-01f,9.99953866e-01f},
  {2.21267566e-02f,8.83669317e-01f,1.13521777e-01f,-9.37382519e-01f,7.08669782e-01f,-9.98813629e-01f,-1.67660639e-01f,5.58637917e-01f,8.52524519e-01f,9.52550590e-01f,9.84913111e-01f,9.95220840e-01f,9.98487890e-01f,9.99521732e-01f,9.99848783e-01f,9.99952197e-01f},
  {8.53220105e-01f,9.97174621e-01f,4.16867077e-01f,-8.60988438e-01f,7.75565803e-01f,-9.99971747e-01f,-1.98746875e-01f,5.43801069e-01f,8.47255111e-01f,9.50823903e-01f,9.84360933e-01f,9.95045662e-01f,9.98432398e-01f,9.99504209e-01f,9.99843180e-01f,9.99950409e-01f},
  {8.99866819e-01f,8.03569078e-01f,6.78870201e-01f,-7.57439196e-01f,8.34712923e-01f,-9.97968495e-01f,-2.29634270e-01f,5.28792322e-01f,8.41901004e-01f,9.49067116e-01f,9.83798921e-01f,9.94867265e-01f,9.98375952e-01f,9.99486327e-01f,9.99837577e-01f,9.99948621e-01f},
  {1.19180135e-01f,3.62476677e-01f,8.73550534e-01f,-6.30000710e-01f,8.85519624e-01f,-9.92810190e-01f,-2.60292053e-01f,5.13616323e-01f,8.36462677e-01f,9.47280347e-01f,9.83227074e-01f,9.94685769e-01f,9.98318493e-01f,9.99468148e-01f,9.99831796e-01f,9.99946833e-01f},
  {-7.71080196e-01f,-1.90249100e-01f,9.81602073e-01f,-4.82692331e-01f,9.27478492e-01f,-9.84513164e-01f,-2.90689558e-01f,4.98277903e-01f,8.30940723e-01f,9.45463598e-01f,9.82645452e-01f,9.94501114e-01f,9.98260021e-01f,9.99449670e-01f,9.99825954e-01f,9.99944985e-01f},
  {-9.52412963e-01f,-6.84381902e-01f,9.92308319e-01f,-3.20159167e-01f,9.60170269e-01f,-9.73103702e-01f,-3.20796400e-01f,4.82782036e-01f,8.25335622e-01f,9.43616986e-01f,9.82053936e-01f,9.94313300e-01f,9.98200536e-01f,9.99430835e-01f,9.99819994e-01f,9.99943078e-01f},
  {-2.58101642e-01f,-9.67739642e-01f,9.04607594e-01f,-1.47529200e-01f,9.83268440e-01f,-9.58617806e-01f,-3.50582451e-01f,4.67133403e-01f,8.19648027e-01f,9.41740453e-01f,9.81452644e-01f,9.94122326e-01f,9.98140097e-01f,9.99411702e-01f,9.99813974e-01f,9.99941170e-01f},
  {6.73507154e-01f,-9.53050017e-01f,7.27198064e-01f,2.97537707e-02f,9.96542096e-01f,-9.41101313e-01f,-3.80017966e-01f,4.51337039e-01f,8.13878477e-01f,9.39834237e-01f,9.80841517e-01f,9.93928254e-01f,9.98078644e-01f,9.99392271e-01f,9.99807835e-01f,9.99939203e-01f},
  {9.85896587e-01f,-6.44837022e-01f,4.77671444e-01f,2.06098333e-01f,9.99858618e-01f,-9.20609534e-01f,-4.09073502e-01f,4.35397953e-01f,8.08027506e-01f,9.37898219e-01f,9.80220556e-01f,9.93731022e-01f,9.98016179e-01f,9.99372482e-01f,9.99801576e-01f,9.99937236e-01f}
};
__device__ const float ROPE_SN[64][16] = {
  {0.00000000e+00f,0.00000000e+00f,0.00000000e+00f,0.00000000e+00f,0.00000000e+00f,0.00000000e+00f,0.00000000e+00f,0.00000000e+00f,0.00000000e+00f,0.00000000e+00f,0.00000000e+00f,0.00000000e+00f,0.00000000e+00f,0.00000000e+00f,0.00000000e+00f,0.00000000e+00f},
  {8.41470957e-01f,5.33168435e-01f,3.10983598e-01f,1.76892191e-01f,9.98334214e-02f,5.62044978e-02f,3.16175036e-02f,1.77818574e-02f,9.99983307e-03f,5.62338345e-03f,3.16227227e-03f,1.77827850e-03f,9.99999931e-04f,5.62341243e-04f,3.16227757e-04f,1.77827940e-04f},
  {9.09297407e-01f,9.02130723e-01f,5.91127098e-01f,3.48205268e-01f,1.98669329e-01f,1.12231314e-01f,6.32033944e-02f,3.55580896e-02f,1.99986659e-02f,1.12465890e-02f,6.32451288e-03f,3.55655141e-03f,1.99999870e-03f,1.12468237e-03f,6.32455456e-04f,3.55655880e-04f},
  {1.41120002e-01f,9.93253171e-01f,8.12648892e-01f,5.08536100e-01f,2.95520216e-01f,1.67903304e-01f,9.47260857e-02f,5.33230826e-02f,2.99954992e-02f,1.68694388e-02f,9.48669016e-03f,5.33481315e-03f,2.99999560e-03f,1.68702309e-03f,9.48683126e-04f,5.33483806e-04f},
  {-7.56802499e-01f,7.78471708e-01f,9.53580737e-01f,6.52827978e-01f,3.89418334e-01f,2.23044485e-01f,1.26154065e-01f,7.10712075e-02f,3.99893336e-02f,2.24917568e-02f,1.26487734e-02f,7.11305765e-03f,3.99998948e-03f,2.24936334e-03f,1.26491068e-03f,7.11311703e-04f},
  {-9.58924294e-01f,3.23935270e-01f,9.99946535e-01f,7.76529968e-01f,4.79425550e-01f,2.77480543e-01f,1.57455876e-01f,8.87968615e-02f,4.99791652e-02f,2.81133614e-02f,1.58107281e-02f,8.89127981e-03f,4.99997940e-03f,2.81170290e-03f,1.58113812e-03f,8.89139599e-04f},
  {-2.79415488e-01f,-2.30367512e-01f,9.47148204e-01f,8.75740528e-01f,5.64642489e-01f,3.31039310e-01f,1.88600272e-01f,1.06494442e-01f,5.99640049e-02f,3.37340795e-02f,1.89725272e-02f,1.06694745e-02f,5.99996420e-03f,3.37404152e-03f,1.89736532e-03f,1.06696738e-03f},
  {6.56986594e-01f,-7.13721275e-01f,8.00421596e-01f,9.47330713e-01f,6.44217670e-01f,3.83551568e-01f,2.19556093e-01f,1.24158338e-01f,6.99428469e-02f,3.93537246e-02f,2.21341345e-02f,1.24476347e-02f,6.99994294e-03f,3.93637875e-03f,2.21359241e-03f,1.24479528e-03f},
  {9.89358246e-01f,-9.77261782e-01f,5.74317753e-01f,9.89042461e-01f,7.17356086e-01f,4.34851229e-01f,2.50292331e-01f,1.41782969e-01f,7.99146891e-02f,4.49721329e-02f,2.52955221e-02f,1.42257558e-02f,7.99991470e-03f,4.49871505e-03f,2.52981926e-03f,1.42262306e-03f},
  {4.12118495e-01f,-9.39823508e-01f,2.91259229e-01f,9.99560297e-01f,7.83326924e-01f,4.84776139e-01f,2.80778319e-01f,1.59362778e-01f,8.98785442e-02f,5.05891182e-02f,2.84566563e-02f,1.60038304e-02f,8.99987947e-03f,5.06105041e-03f,2.84604589e-03f,1.60045072e-03f},
  {-5.44021130e-01f,-6.12936914e-01f,-2.06835698e-02f,9.78552461e-01f,8.41470957e-01f,5.33168435e-01f,3.10983568e-01f,1.76892191e-01f,9.98334140e-02f,5.62044978e-02f,3.16175036e-02f,1.77818574e-02f,9.99983400e-03f,5.62338345e-03f,3.16227227e-03f,1.77827850e-03f},
  {-9.99990225e-01f,-9.72764567e-02f,-3.30574960e-01f,9.26681578e-01f,8.91207397e-01f,5.79875171e-01f,3.40877861e-01f,1.94365650e-01f,1.09778300e-01f,6.18181042e-02f,3.47780399e-02f,1.95598267e-02f,1.09997792e-02f,6.18571462e-03f,3.47849843e-03f,1.95610616e-03f},
  {-5.36572933e-01f,4.48342979e-01f,-6.07683420e-01f,8.45583618e-01f,9.32039082e-01f,6.24748647e-01f,3.70431304e-01f,2.11777672e-01f,1.19712204e-01f,6.74297586e-02f,3.79382223e-02f,2.13377345e-02f,1.19997123e-02f,6.74804440e-03f,3.79472389e-03f,2.13393359e-03f},
  {4.20167029e-01f,8.55880976e-01f,-8.24528456e-01f,7.37816215e-01f,9.63558197e-01f,6.67647004e-01f,3.99614304e-01f,2.29122713e-01f,1.29634142e-01f,7.30392784e-02f,4.10980321e-02f,2.31155735e-02f,1.29996343e-02f,7.31037185e-03f,4.11094911e-03f,2.31176103e-03f},
  {9.90607381e-01f,9.99823332e-01f,-9.59605396e-01f,6.06778562e-01f,9.85449731e-01f,7.08434701e-01f,4.28397775e-01f,2.46395305e-01f,1.39543116e-01f,7.86464810e-02f,4.42574248e-02f,2.48933397e-02f,1.39995432e-02f,7.87269697e-03f,4.42717411e-03f,2.48958869e-03f},
  {6.50287867e-01f,8.35838437e-01f,-9.99518692e-01f,4.56603259e-01f,9.97494996e-01f,7.46982634e-01f,4.56752867e-01f,2.63589978e-01f,1.49438128e-01f,8.42512026e-02f,4.74163815e-02f,2.66710296e-02f,1.49994381e-02f,8.43502022e-03f,4.74339863e-03f,2.66741589e-03f},
  {-2.87903309e-01f,4.14430231e-01f,-9.40310359e-01f,2.92027086e-01f,9.99573588e-01f,7.83169091e-01f,4.84651238e-01f,2.80701309e-01f,1.59318209e-01f,8.98532644e-02f,5.05748577e-02f,2.84486320e-02f,1.59993190e-02f,8.99733976e-03f,5.05962269e-03f,2.84524332e-03f},
  {-9.61397469e-01f,-1.34615138e-01f,-7.87851870e-01f,1.18240520e-01f,9.91664827e-01f,8.16879570e-01f,5.12064993e-01f,2.97723860e-01f,1.69182345e-01f,9.54524800e-02f,5.37328273e-02f,3.02261449e-02f,1.69991814e-02f,9.55965649e-03f,5.37584582e-03f,3.02307028e-03f},
  {-7.50987232e-01f,-6.42200708e-01f,-5.57262897e-01f,-5.92755191e-02f,9.73847628e-01f,8.48007560e-01f,5.38966715e-01f,3.14652264e-01f,1.79029569e-01f,1.01048686e-01f,5.68902642e-02f,3.20035629e-02f,1.79990288e-02f,1.01219704e-02f,5.69206895e-03f,3.20089748e-03f},
  {1.49877205e-01f,-9.52000856e-01f,-2.71410108e-01f,-2.34921798e-01f,9.46300089e-01f,8.76454532e-01f,5.65329552e-01f,3.31481189e-01f,1.88858896e-01f,1.06641680e-01f,6.00471310e-02f,3.37808803e-02f,1.89988576e-02f,1.06842816e-02f,6.00829115e-03f,3.37872445e-03f},
  {9.12945271e-01f,-9.68601942e-01f,4.13582884e-02f,-4.03158993e-01f,9.09297407e-01f,9.02130723e-01f,5.91127038e-01f,3.48205268e-01f,1.98669314e-01f,1.12231314e-01f,6.32033944e-02f,3.55580896e-02f,1.99986678e-02f,1.12465890e-02f,6.32451288e-03f,3.55655141e-03f},
  {8.36655617e-01f,-6.86891198e-01f,3.50024760e-01f,-5.58680534e-01f,8.63209307e-01f,9.24954832e-01f,6.16333544e-01f,3.64819258e-01f,2.08459899e-01f,1.17817394e-01f,6.63590282e-02f,3.73351872e-02f,2.09984574e-02f,1.18088927e-02f,6.64073415e-03f,3.73437814e-03f},
  {-8.85130931e-03f,-1.93630233e-01f,6.23979926e-01f,-6.96581721e-01f,8.08496356e-01f,9.44854796e-01f,6.40923738e-01f,3.81317884e-01f,2.18229622e-01f,1.23399742e-01f,6.95140064e-02f,3.91121693e-02f,2.19982266e-02f,1.23711927e-02f,6.95695449e-03f,3.91220488e-03f},
  {-8.46220434e-01f,3.59264523e-01f,8.36055279e-01f,-8.12512875e-01f,7.45705247e-01f,9.61767614e-01f,6.64873064e-01f,3.97695929e-01f,2.27977514e-01f,1.28978193e-01f,7.26682767e-02f,4.08890247e-02f,2.29979735e-02f,1.29334899e-02f,7.27317436e-03f,4.09003161e-03f},
  {-9.05578375e-01f,8.01513135e-01f,9.65219259e-01f,-9.02817786e-01f,6.75463140e-01f,9.75639880e-01f,6.88157499e-01f,4.13948208e-01f,2.37702623e-01f,1.34552568e-01f,7.58218244e-02f,4.26657498e-02f,2.39976961e-02f,1.34957815e-02f,7.58939330e-03f,4.26785741e-03f},
  {-1.32351756e-01f,9.96909976e-01f,9.98663187e-01f,-9.64648306e-01f,5.98472118e-01f,9.86427724e-01f,7.10753918e-01f,4.30069596e-01f,2.47403964e-01f,1.40122697e-01f,7.89746121e-02f,4.44423407e-02f,2.49973964e-02f,1.40580693e-02f,7.90561177e-03f,4.44568414e-03f},
  {7.62558460e-01f,8.85276794e-01f,9.33070183e-01f,-9.96054351e-01f,5.15501261e-01f,9.94096994e-01f,7.32639611e-01f,4.46054995e-01f,2.57080555e-01f,1.45688385e-01f,8.21266174e-02f,4.62187938e-02f,2.59970706e-02f,1.46203535e-02f,8.22182931e-03f,4.62350994e-03f},
  {9.56375957e-01f,5.00994205e-01f,7.74945021e-01f,-9.96045172e-01f,4.27379847e-01f,9.98623490e-01f,7.53792703e-01f,4.61899310e-01f,2.66731411e-01f,1.51249468e-01f,8.52777958e-02f,4.79951017e-02f,2.69967206e-02f,1.51826320e-02f,8.53804592e-03f,4.80133574e-03f},
  {2.70905793e-01f,-3.75856608e-02f,5.39968967e-01f,-9.64621305e-01f,3.34988207e-01f,9.99992907e-01f,7.74192095e-01f,4.77597594e-01f,2.76355654e-01f,1.56805754e-01f,8.84281173e-02f,4.97712530e-02f,2.79963426e-02f,1.57449059e-02f,8.85426160e-03f,4.97916201e-03f},
  {-6.63633883e-01f,-5.64589798e-01f,2.51445323e-01f,-9.02773678e-01f,2.39249229e-01f,9.98200953e-01f,7.93817401e-01f,4.93144840e-01f,2.85952210e-01f,1.62357092e-01f,9.15775672e-02f,5.15472479e-02f,2.89959367e-02f,1.63071752e-02f,9.17047635e-03f,5.15698735e-03f},
  {-9.88031626e-01f,-9.17709649e-01f,-6.20148405e-02f,-8.12452853e-01f,1.41120002e-01f,9.93253171e-01f,8.12648892e-01f,5.08536100e-01f,2.95520186e-01f,1.67903304e-01f,9.47260931e-02f,5.33230826e-02f,2.99955010e-02f,1.68694388e-02f,9.48669016e-03f,5.33481315e-03f},
  {-4.04037654e-01f,-9.88192797e-01f,-3.69325012e-01f,-6.96507812e-01f,4.15805206e-02f,9.85165298e-01f,8.30667794e-01f,5.23766637e-01f,3.05058628e-01f,1.73444211e-01f,9.78736654e-02f,5.50987460e-02f,3.09950355e-02f,1.74316969e-02f,9.80290305e-03f,5.51263802e-03f},
  {5.51426709e-01f,-7.54330218e-01f,-6.40009403e-01f,-5.58595300e-01f,-5.83741926e-02f,9.73962843e-01f,8.47856104e-01f,5.38831532e-01f,3.14566553e-01f,1.78979620e-01f,1.01020269e-01f,5.68742342e-02f,3.19945402e-02f,1.79939512e-02f,1.01191159e-02f,5.69046335e-03f},
  {9.99911845e-01f,-2.88147390e-01f,-8.47224355e-01f,-4.03064936e-01f,-1.57745644e-01f,9.59681332e-01f,8.64196658e-01f,5.53726017e-01f,3.24043006e-01f,1.84509367e-01f,1.04165860e-01f,5.86495437e-02f,3.29940096e-02f,1.85561981e-02f,1.04353270e-02f,5.86828869e-03f},
  {5.29082716e-01f,2.66779721e-01f,-9.70420420e-01f,-2.34822124e-01f,-2.55541205e-01f,9.42365825e-01f,8.79673064e-01f,5.68445385e-01f,3.33487093e-01f,1.90033287e-01f,1.07310407e-01f,6.04246669e-02f,3.39934528e-02f,1.91184394e-02f,1.07515370e-02f,6.04611309e-03f},
  {-4.28182662e-01f,7.39542127e-01f,-9.97380435e-01f,-5.91726787e-02f,-3.50783229e-01f,9.22071040e-01f,8.94269884e-01f,5.82984984e-01f,3.42897803e-01f,1.95551202e-01f,1.10453881e-01f,6.21996038e-02f,3.49928550e-02f,1.96806751e-02f,1.10677453e-02f,6.22393796e-03f},
  {-9.91778851e-01f,9.84540582e-01f,-9.25431013e-01f,1.18342586e-01f,-4.42520559e-01f,8.98861170e-01f,9.07972515e-01f,5.97340286e-01f,3.52274209e-01f,2.01062918e-01f,1.13596253e-01f,6.39743358e-02f,3.59922275e-02f,2.02429052e-02f,1.13839535e-02f,6.40176190e-03f},
  {-6.43538117e-01f,9.26318109e-01f,-7.61706948e-01f,2.92125374e-01f,-5.29836178e-01f,8.72809589e-01f,9.20767248e-01f,6.11506701e-01f,3.61615449e-01f,2.06568271e-01f,1.16737492e-01f,6.57488778e-02f,3.69915590e-02f,2.08051261e-02f,1.17001599e-02f,6.57958630e-03f},
  {2.96368569e-01f,5.82806170e-01f,-5.22444785e-01f,4.56694692e-01f,-6.11857831e-01f,8.43998730e-01f,9.32641268e-01f,6.25479698e-01f,3.70920479e-01f,2.12067112e-01f,1.19877554e-01f,6.75232038e-02f,3.79908569e-02f,2.13673431e-02f,1.20163653e-02f,6.75741071e-03f},
  {9.63795364e-01f,5.98003156e-02f,-2.31372014e-01f,6.06860459e-01f,-6.87766254e-01f,8.12519610e-01f,9.43582714e-01f,6.39254928e-01f,3.80188406e-01f,2.17559248e-01f,1.23016424e-01f,6.92973137e-02f,3.89901139e-02f,2.19295528e-02f,1.23325698e-02f,6.93523418e-03f},
  {7.45113134e-01f,-4.81621295e-01f,8.26458037e-02f,7.37885714e-01f,-7.56802499e-01f,7.78471708e-01f,9.53580678e-01f,6.52827978e-01f,3.89418334e-01f,2.23044485e-01f,1.26154065e-01f,7.10712075e-02f,3.99893373e-02f,2.24917568e-02f,1.26487734e-02f,7.11305765e-03f},
  {-1.58622667e-01f,-8.74714017e-01f,3.88467699e-01f,8.45638454e-01f,-8.18277061e-01f,7.41962790e-01f,9.62625206e-01f,6.66194677e-01f,3.98609310e-01f,2.28522688e-01f,1.29290432e-01f,7.28448778e-02f,4.09885161e-02f,2.30539497e-02f,1.29649751e-02f,7.29088066e-03f},
  {-9.16521549e-01f,-9.98410463e-01f,6.55764699e-01f,9.26720202e-01f,-8.71575892e-01f,7.03108132e-01f,9.70707119e-01f,6.79350674e-01f,4.07760441e-01f,2.33993664e-01f,1.32425532e-01f,7.46183172e-02f,4.19876575e-02f,2.36161388e-02f,1.32811759e-02f,7.46870413e-03f},
  {-8.31774771e-01f,-8.14614236e-01f,8.58030677e-01f,9.78573620e-01f,-9.16166008e-01f,6.62030637e-01f,9.77818429e-01f,6.92291796e-01f,4.16870773e-01f,2.39457220e-01f,1.35559291e-01f,7.63915181e-02f,4.29867506e-02f,2.41783205e-02f,1.35973748e-02f,7.64652714e-03f},
  {1.77019257e-02f,-3.79931390e-01f,9.75206196e-01f,9.99563396e-01f,-9.51602101e-01f,6.18860185e-01f,9.83951986e-01f,7.05014050e-01f,4.25939471e-01f,2.44913206e-01f,1.38691694e-01f,7.81644881e-02f,4.39858064e-02f,2.47404929e-02f,1.39135728e-02f,7.82434922e-03f},
  {8.50903511e-01f,1.71763569e-01f,9.95670974e-01f,9.89027262e-01f,-9.77530122e-01f,5.73733270e-01f,9.89101648e-01f,7.17513323e-01f,4.34965521e-01f,2.50361472e-01f,1.41822711e-01f,7.99371973e-02f,4.49848175e-02f,2.53026579e-02f,1.42297689e-02f,8.00217129e-03f},
  {9.01788354e-01f,6.70557022e-01f,9.17395473e-01f,9.47297752e-01f,-9.93690968e-01f,5.26792526e-01f,9.93262351e-01f,7.29785740e-01f,4.43948090e-01f,2.55801797e-01f,1.44952312e-01f,8.17096606e-02f,4.59837839e-02f,2.58648153e-02f,1.45459641e-02f,8.17999430e-03f},
  {1.23573124e-01f,9.62832689e-01f,7.48142362e-01f,8.75690997e-01f,-9.99923289e-01f,4.78186339e-01f,9.96429801e-01f,7.41827428e-01f,4.52886283e-01f,2.61234075e-01f,1.48080453e-01f,8.34818557e-02f,4.69827019e-02f,2.64269635e-02f,1.48621574e-02f,8.35781638e-03f},
  {-7.68254638e-01f,9.58573103e-01f,5.04697084e-01f,7.76465356e-01f,-9.96164620e-01f,4.28068399e-01f,9.98600960e-01f,7.53634512e-01f,4.61779177e-01f,2.66658038e-01f,1.51207119e-01f,8.52537975e-02f,4.79815714e-02f,2.69891042e-02f,1.51783489e-02f,8.53563752e-03f},
  {-9.53752637e-01f,6.59090102e-01f,2.11200655e-01f,6.52750373e-01f,-9.82452571e-01f,3.76597136e-01f,9.99773562e-01f,7.65203178e-01f,4.70625877e-01f,2.72073567e-01f,1.54332280e-01f,8.70254710e-02f,4.89803962e-02f,2.75512375e-02f,1.54945394e-02f,8.71345960e-03f},
  {-2.62374848e-01f,1.56619072e-01f,-1.03240460e-01f,5.08447945e-01f,-9.58924294e-01f,3.23935270e-01f,9.99946535e-01f,7.76529968e-01f,4.79425550e-01f,2.77480543e-01f,1.57455891e-01f,8.87968615e-02f,4.99791689e-02f,2.81133596e-02f,1.58107281e-02f,8.89127981e-03f},
  {6.70229197e-01f,-3.94086063e-01f,-4.07444149e-01f,3.48108500e-01f,-9.25814748e-01f,2.70249337e-01f,9.99119580e-01f,7.87611187e-01f,4.88177240e-01f,2.82878697e-01f,1.60577938e-01f,9.05679762e-02f,5.09778969e-02f,2.86754742e-02f,1.61269177e-02f,9.06910095e-03f},
  {9.86627579e-01f,-8.23421597e-01f,-6.71240151e-01f,1.76790684e-01f,-8.83454502e-01f,2.15709001e-01f,9.97293651e-01f,7.98443377e-01f,4.96880114e-01f,2.88267940e-01f,1.63698375e-01f,9.23388004e-02f,5.19765690e-02f,2.92375814e-02f,1.64431017e-02f,9.24692024e-03f},
  {3.95925164e-01f,-9.99157965e-01f,-8.68469954e-01f,-1.03020677e-04f,-8.32267344e-01f,1.60486728e-01f,9.94470477e-01f,8.09023023e-01f,5.05533338e-01f,2.93648034e-01f,1.66817173e-01f,9.41093415e-02f,5.29751927e-02f,2.97996756e-02f,1.67592876e-02f,9.42474138e-03f},
  {-5.58789074e-01f,-8.67171526e-01f,-9.79574919e-01f,-1.76993474e-01f,-7.72764444e-01f,1.04756832e-01f,9.90652919e-01f,8.19346905e-01f,5.14135957e-01f,2.99018890e-01f,1.69934288e-01f,9.58795771e-02f,5.39737605e-02f,3.03617641e-02f,1.70754679e-02f,9.60256159e-03f},
  {-9.99755144e-01f,-4.68111664e-01f,-9.93535519e-01f,-3.48301649e-01f,-7.05540299e-01f,4.86960001e-02f,9.85844791e-01f,8.29411685e-01f,5.22687256e-01f,3.04380238e-01f,1.73049718e-01f,9.76495072e-02f,5.49722798e-02f,3.09238415e-02f,1.73916500e-02f,9.78038087e-03f},
  {-5.21551013e-01f,7.51182064e-02f,-9.08967435e-01f,-5.08624554e-01f,-6.31266713e-01f,-7.51878507e-03f,9.80050862e-01f,8.39214146e-01f,5.31186223e-01f,3.09731960e-01f,1.76163420e-01f,9.94191393e-02f,5.59707358e-02f,3.14859077e-02f,1.77078284e-02f,9.95820016e-03f},
  {4.36164767e-01f,5.95211506e-01f,-7.34258294e-01f,-6.52905703e-01f,-5.50685287e-01f,-6.37097955e-02f,9.73276973e-01f,8.48751247e-01f,5.39632022e-01f,3.15073937e-01f,1.79275364e-01f,1.01188451e-01f,5.69691435e-02f,3.20479684e-02f,1.80240069e-02f,1.01360194e-02f},
  {9.92872655e-01f,9.31992829e-01f,-4.86733496e-01f,-7.76594579e-01f,-4.64602023e-01f,-1.19699396e-01f,9.65529919e-01f,8.58020008e-01f,5.48023939e-01f,3.20405900e-01f,1.82385504e-01f,1.02957435e-01f,5.79674877e-02f,3.26100141e-02f,1.83401816e-02f,1.03138378e-02f},
  {6.36738002e-01f,9.81735826e-01f,-1.90938011e-01f,-8.75790000e-01f,-3.73876572e-01f,-1.75310582e-01f,9.56817448e-01f,8.67017388e-01f,5.56361020e-01f,3.25727791e-01f,1.85493827e-01f,1.04726106e-01f,5.89657798e-02f,3.31720486e-02f,1.86563563e-02f,1.04916561e-02f},
  {-3.04810613e-01f,7.29123712e-01f,1.23790950e-01f,-9.47363734e-01f,-2.79415488e-01f,-2.30367512e-01f,9.47148204e-01f,8.75740528e-01f,5.64642429e-01f,3.31039310e-01f,1.88600287e-01f,1.06494442e-01f,5.99640086e-02f,3.37340795e-02f,1.89725272e-02f,1.06694745e-02f},
  {-9.66117799e-01f,2.51952261e-01f,4.26245421e-01f,-9.89057720e-01f,-1.82162598e-01f,-2.84696162e-01f,9.36531842e-01f,8.84186864e-01f,5.72867453e-01f,3.36340427e-01f,1.91704854e-01f,1.08262435e-01f,6.09621815e-02f,3.42960916e-02f,1.92886982e-02f,1.08472919e-02f},
  {-7.39180684e-01f,-3.02812874e-01f,6.86427653e-01f,-9.99557257e-01f,-8.30891207e-02f,-3.38124752e-01f,9.24979091e-01f,8.92353535e-01f,5.81035137e-01f,3.41630876e-01f,1.94807529e-01f,1.10030092e-01f,6.19602874e-02f,3.48580964e-02f,1.96048655e-02f,1.10251084e-02f},
  {1.67355701e-01f,-7.64320076e-01f,8.78538549e-01f,-9.78531301e-01f,1.68140903e-02f,-3.90484393e-01f,9.12501454e-01f,9.00238097e-01f,5.89144766e-01f,3.46910536e-01f,1.97908238e-01f,1.11797392e-01f,6.29583374e-02f,3.54200937e-02f,1.99210308e-02f,1.12029258e-02f}
};


constexpr int D = 1024, ML = 16384, MC = 2048, MT = ML + MC, TL = 2048, TCX = 256, NB = 8;
constexpr int LDP_E = 3328, LDP_O = 5120, DFF = 2816, NKK = 2304;
constexpr int NTHR = 512;
constexpr int LDS_BYTES = 152 * 1024;
constexpr float EPSN = 1e-6f;

struct Params {
  const float *x, *c, *ctx, *c_ctx, *w_ada, *b_ada, *n1g, *n2g, *w_in_even, *qk_gain, *lambda_a, *subln, *w_gate_up, *b_gate_up,
      *onorm_b, *w_out_even, *w_in_odd, *lb_raw, *onorm_c, *w_out_odd, *w_ffn_in, *w_ffn_out;
  float* out;
  bf16_t *wt_in_even, *wt_in_odd, *wt_out_even, *wt_out_odd, *wt_ffn_in, *wt_ffn_out;
  float* Z;
  float* mod;
  bf16_t *P, *R1, *R2, *Vt;
  float* Gk;
  unsigned* ctr;
  unsigned* xbar;
  float* rowss;
  unsigned* pcnt;
};

extern __shared__ __attribute__((aligned(16))) char smem_raw[];

typedef float f32x2 __attribute__((ext_vector_type(2)));
typedef __bf16 hbf16x2 __attribute__((ext_vector_type(2)));
DI unsigned pack2(float a, float b) { const f32x2 v = {a, b}; return __builtin_bit_cast(unsigned, __builtin_convertvector(v, hbf16x2)); }
DI bf16_t f2bf(float x) { return (bf16_t)(pack2(x, 0.f) & 0xffffu); }
DI float bf2f(bf16_t h) { return __uint_as_float(((unsigned)h) << 16); }
DI float wave_sum(float v) {
#pragma unroll
  for (int o = 32; o >= 1; o >>= 1) v += __shfl_xor(v, o, 64);
  return v;
}
#define LDS_BARRIER() do { asm volatile("s_waitcnt lgkmcnt(0)" ::: "memory"); __builtin_amdgcn_s_barrier(); asm volatile("" ::: "memory"); } while (0)
DI int TID() { int t = threadIdx.x; asm volatile("" : "+v"(t)); return t; }
DI float sigmoidf_(float x) { return __builtin_amdgcn_rcpf(1.f + __builtin_amdgcn_exp2f(x * -1.44269504088896f)); }
DI float siluf(float x) { return x * sigmoidf_(x); }

DI void convert_tile(const float* __restrict__ src, int K, int N, bf16_t* __restrict__ dst, int mode, int tile) {
  float* ts = (float*)smem_raw;
  const int tid = TID();
  const int nkt = K >> 6;
  const int kt = tile % nkt, nt = tile / nkt;
  const int k0 = kt << 6, n0 = nt << 6;
#pragma unroll
  for (int i = 0; i < 2; ++i) {
    const int idx = tid + i * NTHR;
    const int kr = idx >> 4, c4 = idx & 15;
    const int n = n0 + 4 * c4;
    float4 v = make_float4(0.f, 0.f, 0.f, 0.f);
    if (n < N) v = *(const float4*)(src + (size_t)(k0 + kr) * N + n);
    float* t = ts + kr * 65 + 4 * c4;
    t[0] = v.x; t[1] = v.y; t[2] = v.z; t[3] = v.w;
  }
  __syncthreads();
  {
    const int nrow = tid >> 3, kq = tid & 7;
    float f[8];
#pragma unroll
    for (int j = 0; j < 8; ++j) f[j] = ts[(kq * 8 + j) * 65 + nrow];
    int n = n0 + nrow;
    int orow = n;
    if (mode & 1) { const int up = n >= DFF ? 1 : 0; const int j = n - up * DFF; orow = (j >> 7) * 256 + up * 128 + (j & 127); }
    if (mode & 2) { const int c32 = orow & 31; orow = (orow & ~31) + 16 * ((c32 >> 2) & 1) + 4 * (c32 >> 3) + (c32 & 3); }
    uint4 o;
    o.x = pack2(f[0], f[1]); o.y = pack2(f[2], f[3]); o.z = pack2(f[4], f[5]); o.w = pack2(f[6], f[7]);
    *(uint4*)(dst + (size_t)orow * K + k0 + kq * 8) = o;
  }
  __syncthreads();
}

__device__ void mod_table(const Params& p, int l0, int nl, int first, int stride) {
  const int tid = TID();
    float* sc = (float*)smem_raw;
    float* part = sc + 9 * 1024;
    __syncthreads();
    for (int i = tid; i < 9 * 1024; i += NTHR) {
      const int m = i >> 10, k = i & 1023;
      const float v = m < 8 ? p.c[m * 1024 + k] : p.c_ctx[k];
      sc[i] = siluf(v);
    }
    __syncthreads();
    for (int it = first; it < nl * 96; it += stride) {
      const int l = l0 + it / 96, n0 = (it % 96) * 64;
      const int col4 = tid & 15, ks = tid >> 4;
      float acc[9][4];
#pragma unroll
      for (int m = 0; m < 9; ++m) { acc[m][0] = 0.f; acc[m][1] = 0.f; acc[m][2] = 0.f; acc[m][3] = 0.f; }
      const float* wp = p.w_ada + (size_t)l * 1024 * 6144 + n0 + 4 * col4;
      for (int k8 = 0; k8 < 32; k8 += 8) {
        float4 w[8];
#pragma unroll
        for (int u = 0; u < 8; ++u) w[u] = *(const float4*)(wp + (size_t)(ks * 32 + k8 + u) * 6144);
#pragma unroll
        for (int u = 0; u < 8; ++u) {
          const int k = ks * 32 + k8 + u;
#pragma unroll
          for (int m = 0; m < 9; ++m) { const float s = sc[m * 1024 + k]; acc[m][0] += s * w[u].x; acc[m][1] += s * w[u].y; acc[m][2] += s * w[u].z; acc[m][3] += s * w[u].w; }
        }
      }
#pragma unroll
      for (int m = 0; m < 9; ++m) {
        float* pp = part + (ks * 9 + m) * 64 + 4 * col4;
        pp[0] = acc[m][0]; pp[1] = acc[m][1]; pp[2] = acc[m][2]; pp[3] = acc[m][3];
      }
      __syncthreads();
      for (int i = tid; i < 9 * 64; i += NTHR) {
        const int m = i >> 6, cc = i & 63;
        float s = p.b_ada[l * 6144 + n0 + cc];
        for (int q = 0; q < 32; ++q) s += part[(q * 9 + m) * 64 + cc];
        p.mod[((size_t)l * 9 + m) * 6144 + n0 + cc] = s;
      }
      __syncthreads();
    }
}

__device__ void convert_weights(const Params& p, int half, int first, int stride) {
  const int U0 = 832, U1 = U0 + 1280, U2 = U1 + 256, U3 = U2 + 256, U4 = U3 + 2 * 1408, U5 = U4 + 2 * 704;
  for (int it = first; it < U5; it += stride) {
    if (it < U0) convert_tile(p.w_in_even + (size_t)half * 1024 * 3104, 1024, 3104, p.wt_in_even + (size_t)half * LDP_E * 1024, 2, it);
    else if (it < U1) convert_tile(p.w_in_odd + (size_t)half * 1024 * 5120, 1024, 5120, p.wt_in_odd + (size_t)half * 5120 * 1024, 2, it - U0);
    else if (it < U2) convert_tile(p.w_out_even + (size_t)half * 1024 * 1024, 1024, 1024, p.wt_out_even + (size_t)half * 1024 * 1024, 2, it - U1);
    else if (it < U3) convert_tile(p.w_out_odd + (size_t)half * 1024 * 1024, 1024, 1024, p.wt_out_odd + (size_t)half * 1024 * 1024, 2, it - U2);
    else if (it < U4) { const int q = it - U3; const int j = 2 * half + q / 1408, t = q % 1408; convert_tile(p.w_ffn_in + (size_t)j * 1024 * 5632, 1024, 5632, p.wt_ffn_in + (size_t)j * 5632 * 1024, 3, t); }
    else { const int q = it - U4; const int j = 2 * half + q / 704, t = q % 704; convert_tile(p.w_ffn_out + (size_t)j * DFF * 1024, DFF, 1024, p.wt_ffn_out + (size_t)j * 1024 * DFF, 2, t); }
  }
}

__device__ void phase_init(const Params& p) {
  const int tid = TID(), nb = gridDim.x, bid = blockIdx.x;
  convert_weights(p, 0, bid, nb);
  if (nb <= 128) convert_weights(p, 1, bid, nb);
  mod_table(p, 0, nb > 128 ? 2 : 4, bid, nb);
}

__device__ void phase_norm(const Params& p, int l, int which, int nrows, bf16_t* __restrict__ H, const float* fold_gate, const float* slab, const float* xlat, const float* xctx, bool skip_latent) {
  const int wave = TID() >> 6, lane = TID() & 63;
  const float* gain = (which == 0 ? p.n1g : p.n2g) + l * 1024;
  const int sh_idx = which == 0 ? 0 : 3, sc_idx = which == 0 ? 1 : 4;
  const int gw = blockIdx.x * 8 + wave, nw = gridDim.x * 8;
  for (int blk = gw; blk < (skip_latent ? 0 : ML / 8); blk += nw) {
    const int row0 = blk * 8;
    const float* md = p.mod + ((size_t)l * 9 + (row0 >> 11)) * 6144;
    float4 A[4], B[4];
#pragma unroll
    for (int i = 0; i < 4; ++i) {
      const int col = i * 256 + lane * 4;
      const float4 g = *(const float4*)(gain + col);
      const float4 sc = *(const float4*)(md + sc_idx * 1024 + col);
      B[i] = *(const float4*)(md + sh_idx * 1024 + col);
      A[i] = make_float4(g.x * (1.f + sc.x), g.y * (1.f + sc.y), g.z * (1.f + sc.z), g.w * (1.f + sc.w));
    }
#pragma unroll
    for (int half = 0; half < 2; ++half) {
      float4 v[4][4];
#pragma unroll
      for (int k = 0; k < 4; ++k)
#pragma unroll
        for (int i = 0; i < 4; ++i) v[k][i] = *(const float4*)(xlat + (size_t)(row0 + half * 4 + k) * D + i * 256 + lane * 4);
#pragma unroll
      for (int k = 0; k < 4; ++k) {
        float ss = 0.f;
#pragma unroll
        for (int i = 0; i < 4; ++i) ss += v[k][i].x * v[k][i].x + v[k][i].y * v[k][i].y + v[k][i].z * v[k][i].z + v[k][i].w * v[k][i].w;
        ss = wave_sum(ss);
        const float r = rsqrtf(ss * (1.f / 1024.f) + EPSN);
#pragma unroll
        for (int i = 0; i < 4; ++i) {
          uint2 o;
          o.x = pack2(v[k][i].x * r * A[i].x + B[i].x, v[k][i].y * r * A[i].y + B[i].y);
          o.y = pack2(v[k][i].z * r * A[i].z + B[i].z, v[k][i].w * r * A[i].w + B[i].w);
          *(uint2*)(H + (size_t)(row0 + half * 4 + k) * D + i * 256 + lane * 4) = o;
        }
      }
    }
  }
  for (int row = ML + gw; row < nrows; row += nw) {
    const float* xr = xctx + (size_t)(row - ML) * D;
    const float* md = p.mod + ((size_t)l * 9 + 8) * 6144;
    float4 v[4];
    float ss = 0.f;
#pragma unroll
    for (int i = 0; i < 4; ++i) v[i] = *(const float4*)(xr + i * 256 + lane * 4);
    if (fold_gate != nullptr) {
      float* zw = p.Z + (size_t)(row - ML) * D;
#pragma unroll
      for (int i = 0; i < 4; ++i) {
        const int col = i * 256 + lane * 4;
        float4 s = make_float4(0.f, 0.f, 0.f, 0.f);
#pragma unroll
        for (int pc = 0; pc < 8; ++pc) { const float4 t = *(const float4*)(slab + ((size_t)pc * MC + (row - ML)) * D + col); s.x += t.x; s.y += t.y; s.z += t.z; s.w += t.w; }
        const float4 g = *(const float4*)(fold_gate + col);
        v[i].x += g.x * s.x; v[i].y += g.y * s.y; v[i].z += g.z * s.z; v[i].w += g.w * s.w;
        *(float4*)(zw + col) = v[i];
      }
    }
#pragma unroll
    for (int i = 0; i < 4; ++i) ss += v[i].x * v[i].x + v[i].y * v[i].y + v[i].z * v[i].z + v[i].w * v[i].w;
    ss = wave_sum(ss);
    const float r = rsqrtf(ss * (1.f / 1024.f) + EPSN);
#pragma unroll
    for (int i = 0; i < 4; ++i) {
      const int col = i * 256 + lane * 4;
      const float4 g = *(const float4*)(gain + col);
      const float4 sh = *(const float4*)(md + sh_idx * 1024 + col);
      const float4 sc = *(const float4*)(md + sc_idx * 1024 + col);
      uint2 o;
      o.x = pack2(v[i].x * r * g.x * (1.f + sc.x) + sh.x, v[i].y * r * g.y * (1.f + sc.y) + sh.y);
      o.y = pack2(v[i].z * r * g.z * (1.f + sc.z) + sh.z, v[i].w * r * g.w * (1.f + sc.w) + sh.w);
      *(uint2*)(H + (size_t)row * D + col) = o;
    }
  }
}

#define LAS __attribute__((address_space(3)))
constexpr int BM = 256, BK = 64, HALF = 128, HTB = HALF * BK * 2, NXCD = 8, WGM = 8;
DI int lds_byte(int r, int c) { const int st = (r >> 4) * 2 + (c >> 5), rr = r & 15, cc = c & 31, ob = rr * 64 + cc * 2; return st * 1024 + (ob ^ (((ob >> 9) & 1) << 5)); }
DI void stage_rc(int b, int& R, int& C) { const int st = b / 1024, sb = b % 1024, swz = sb ^ (((sb >> 9) & 1) << 5); R = (st >> 1) * 16 + swz / 64; C = (st & 1) * 32 + (swz % 64) / 2; }

struct Unit { int pm, pn, k0, nk, part; };
struct TileOrder {
  int nM, nN, nwg, G, c, ntk, nwhole, nMw;
  DI void init(int M, int N, int K, bool split) {
    nM = M / BM; nN = N / BM; nwg = nM * nN; G = gridDim.x; c = blockIdx.x; ntk = K / BK;
    nMw = (split && M == MT) ? ML / BM : nM; nwhole = nMw * nN;
  }
  DI bool next(int i, Unit& u) const {
    long L = (long)i * G + c;
    if (nwg - nwhole == (G >> 3) && nwhole == G) L = i == 0 ? (long)nwhole + c : (i == 1 ? (long)c : (long)nwg * 8);
    if (L >= nwhole) {
      const long q = L - nwhole; const int tile = (int)(q >> 3); if (tile >= nwg - nwhole) return false;
      const int pc = (int)(q & 7);
      const int base = (ntk >> 4) << 1, extra = (ntk - 8 * base) >> 1;
      u.nk = base + (pc < extra ? 2 : 0); u.k0 = pc * base + 2 * (pc < extra ? pc : extra); u.part = 1 + pc;
      u.pm = nMw + tile / nN; u.pn = tile % nN; return true;
    }
    u.k0 = 0; u.nk = ntk; u.part = 0;
    int wgid = (int)L; { const int q = nwhole / NXCD, r = nwhole % NXCD, xcd = wgid % NXCD, off = wgid / NXCD; wgid = (xcd < r ? xcd * (q + 1) : r * (q + 1) + (xcd - r) * q) + off; }
    const int nig = WGM * nN, gid = wgid / nig, fm = gid * WGM, gsz = (nMw - fm) < WGM ? (nMw - fm) : WGM;
    u.pm = fm + ((wgid % nig) % gsz); u.pn = (wgid % nig) / gsz; return true;
  }
};

enum { EPI_P = 0, EPI_RES = 1, EPI_SWIGLU = 2 };
struct EpiArgs { bf16_t* outb; int ld; float* xl; float* xz; const float* gate; float* slab; const float* xin; const float* lbraw; int lyr;
                 float* rowss; unsigned* pcnt; bf16_t* hout; const float* ngain; const float* nmod; int nsh, nsc; };

template <int EPI, bool PART>
DI void gemm_epilogue(f32x4 (&acc)[2][2][4][2], const Unit& u, int wr, int wc, int fr, int fq, const EpiArgs& ea) {
  const int brow = u.pm * BM, bcol = u.pn * BM;
  int amode = 0;
  float4 onek[2][2];
  if (EPI == EPI_P && ea.lbraw != nullptr) {
    amode = bcol < 1024 ? 1 : (bcol < 3072 ? 2 : 0);
    if (amode == 2) {
      const int dirx = bcol >= 2048 ? 1 : 0;
#pragma unroll
      for (int bj = 0; bj < 2; ++bj)
#pragma unroll
        for (int n = 0; n < 2; ++n) {
          const int c = (bcol & 1023) + bj * HALF + wc * 32 + 8 * fq + 4 * n;
          const float* lr = ea.lbraw + (size_t)dirx * 4096 + c;
          const float4 r0 = *(const float4*)(lr), r1 = *(const float4*)(lr + 1024), r2 = *(const float4*)(lr + 2048), r3 = *(const float4*)(lr + 3072);
          float o4[4];
          const float q0[4] = {r0.x, r0.y, r0.z, r0.w}, q1[4] = {r1.x, r1.y, r1.z, r1.w}, q2[4] = {r2.x, r2.y, r2.z, r2.w}, q3[4] = {r3.x, r3.y, r3.z, r3.w};
#pragma unroll
          for (int t = 0; t < 4; ++t) {
            const float mx = fmaxf(fmaxf(q0[t], q1[t]), fmaxf(q2[t], q3[t]));
            const float e0 = __expf(q0[t] - mx), e1 = __expf(q1[t] - mx), e2 = __expf(q2[t] - mx), e3 = __expf(q3[t] - mx);
            float a = 0.f;
            if (ea.lyr >= 1) a += e1;
            if (ea.lyr >= 2) a += e2;
            if (ea.lyr >= 3) a += e3;
            o4[t] = 1.f - a / (e0 + e1 + e2 + e3);
          }
          onek[bj][n] = make_float4(o4[0], o4[1], o4[2], o4[3]);
        }
    }
  }
#pragma unroll
  for (int ai = 0; ai < 2; ++ai)
#pragma unroll
    for (int m = 0; m < 4; ++m) {
      const int row = brow + ai * HALF + wr * 64 + m * 16 + fr;
      if (EPI == EPI_P) {
#pragma unroll
        for (int bj = 0; bj < 2; ++bj) {
          unsigned w4[4];
#pragma unroll
          for (int n = 0; n < 2; ++n) {
            f32x4 a = acc[ai][bj][m][n];
            if (amode == 1) { a[0] = siluf(a[0]) * 0.08838834764831845f; a[1] = siluf(a[1]) * 0.08838834764831845f; a[2] = siluf(a[2]) * 0.08838834764831845f; a[3] = siluf(a[3]) * 0.08838834764831845f; }
            else if (amode == 2) { a[0] = onek[bj][n].x * sigmoidf_(-a[0]); a[1] = onek[bj][n].y * sigmoidf_(-a[1]); a[2] = onek[bj][n].z * sigmoidf_(-a[2]); a[3] = onek[bj][n].w * sigmoidf_(-a[3]); }
            w4[2 * n] = pack2(a[0], a[1]); w4[2 * n + 1] = pack2(a[2], a[3]);
          }
          const int col = bcol + bj * HALF + wc * 32 + 8 * fq;
          *(uint4*)(ea.outb + (size_t)row * ea.ld + col) = make_uint4(w4[0], w4[1], w4[2], w4[3]);
        }
      } else if (EPI == EPI_RES) {
        float* xr = row < ML ? ea.xl + (size_t)row * D : ea.xz + (size_t)(row - ML) * D;
        const int midx = row < ML ? (row >> 11) : 8;
        const float* g = ea.gate + (size_t)midx * 6144;
#pragma unroll
        for (int bj = 0; bj < 2; ++bj)
#pragma unroll
          for (int n = 0; n < 2; ++n) {
            const int col = bcol + bj * HALF + wc * 32 + 8 * fq + 4 * n;
            const f32x4 a = acc[ai][bj][m][n];
            if (PART) {
              *(float4*)(ea.slab + ((size_t)(u.part - 1) * MC + (row - ML)) * D + col) = make_float4(a[0], a[1], a[2], a[3]);
            } else {
              const float4 gv = *(const float4*)(g + col);
              float4 xv = *(const float4*)((row < ML ? ea.xin + (size_t)row * D : (const float*)xr) + col);
              xv.x += gv.x * a[0]; xv.y += gv.y * a[1]; xv.z += gv.z * a[2]; xv.w += gv.w * a[3];
              *(float4*)(xr + col) = xv;
              acc[ai][bj][m][n] = (f32x4){xv.x, xv.y, xv.z, xv.w};
            }
          }
      } else {
        unsigned w4[4];
#pragma unroll
        for (int n = 0; n < 2; ++n) {
          const f32x4 g = acc[ai][0][m][n], up = acc[ai][1][m][n];
          w4[2 * n] = pack2(siluf(g[0]) * up[0], siluf(g[1]) * up[1]); w4[2 * n + 1] = pack2(siluf(g[2]) * up[2], siluf(g[3]) * up[3]);
        }
        *(uint4*)(ea.outb + (size_t)row * ea.ld + u.pn * HALF + wc * 32 + 8 * fq) = make_uint4(w4[0], w4[1], w4[2], w4[3]);
      }
    }
  if (EPI == EPI_RES && !PART && ea.rowss != nullptr) {
    const int lane_ = fr + 16 * fq;
#pragma unroll
    for (int ai = 0; ai < 2; ++ai)
#pragma unroll
      for (int m = 0; m < 4; ++m) {
        float ss = 0.f;
#pragma unroll
        for (int bj = 0; bj < 2; ++bj)
#pragma unroll
          for (int n = 0; n < 2; ++n) { const f32x4 a = acc[ai][bj][m][n]; ss += a[0] * a[0] + a[1] * a[1] + a[2] * a[2] + a[3] * a[3]; }
        ss += __shfl_xor(ss, 16, 64); ss += __shfl_xor(ss, 32, 64);
        if (fq == 0) __hip_atomic_fetch_add(ea.rowss + brow + ai * HALF + wr * 64 + m * 16 + fr, ss, __ATOMIC_RELAXED, __HIP_MEMORY_SCOPE_AGENT);
      }
    asm volatile("s_waitcnt vmcnt(0)" ::: "memory");
    unsigned* pc = ea.pcnt + u.pm * 32;
    if (lane_ == 0) __hip_atomic_fetch_add(pc, 1u, __ATOMIC_RELAXED, __HIP_MEMORY_SCOPE_AGENT);
    const float* md = ea.nmod + (size_t)(brow >> 11) * 6144;
    float4 Aq[2][2], Bq[2][2];
#pragma unroll
    for (int bj = 0; bj < 2; ++bj)
#pragma unroll
      for (int n = 0; n < 2; ++n) {
        const int col = bcol + bj * HALF + wc * 32 + 8 * fq + 4 * n;
        const float4 g = *(const float4*)(ea.ngain + col);
        const float4 sc = *(const float4*)(md + ea.nsc * 1024 + col);
        Bq[bj][n] = *(const float4*)(md + ea.nsh * 1024 + col);
        Aq[bj][n] = make_float4(g.x * (1.f + sc.x), g.y * (1.f + sc.y), g.z * (1.f + sc.z), g.w * (1.f + sc.w));
      }
    if (lane_ == 0) {
      unsigned spins = 0;
      while (__hip_atomic_load(pc, __ATOMIC_RELAXED, __HIP_MEMORY_SCOPE_AGENT) < 32u) { __builtin_amdgcn_s_sleep(1); if (++spins > (1u << 18)) break; }
    }
    asm volatile("" ::: "memory");
#pragma unroll
    for (int ai = 0; ai < 2; ++ai)
#pragma unroll
      for (int m = 0; m < 4; ++m) {
        const int row = brow + ai * HALF + wr * 64 + m * 16 + fr;
        const float tot = __hip_atomic_load(ea.rowss + row, __ATOMIC_RELAXED, __HIP_MEMORY_SCOPE_AGENT);
        const float r = rsqrtf(tot * (1.f / 1024.f) + EPSN);
#pragma unroll
        for (int bj = 0; bj < 2; ++bj) {
          unsigned w4[4];
#pragma unroll
          for (int n = 0; n < 2; ++n) {
            const f32x4 a = acc[ai][bj][m][n];
            w4[2 * n] = pack2(a[0] * r * Aq[bj][n].x + Bq[bj][n].x, a[1] * r * Aq[bj][n].y + Bq[bj][n].y);
            w4[2 * n + 1] = pack2(a[2] * r * Aq[bj][n].z + Bq[bj][n].z, a[3] * r * Aq[bj][n].w + Bq[bj][n].w);
          }
          *(uint4*)(ea.hout + (size_t)row * D + bcol + bj * HALF + wc * 32 + 8 * fq) = make_uint4(w4[0], w4[1], w4[2], w4[3]);
        }
      }
  }
}

template <int EPI>
DI void gemm_phase(const bf16_t* __restrict__ Ag, const bf16_t* __restrict__ Btg, int M, int N, int K, const EpiArgs ea) {
  LAS unsigned char* lds = (LAS unsigned char*)smem_raw;
  TileOrder S; S.init(M, N, K, EPI == EPI_RES);
  const int tid = TID(), wid = __builtin_amdgcn_readfirstlane(tid >> 6), lane = tid & 63, wr = wid >> 2, wc = wid & 3, fr = lane & 15, fq = lane >> 4;
  unsigned voffA[2];
#pragma unroll
  for (int i = 0; i < 2; ++i) { int R, C; stage_rc(tid * 16 + i * 8192, R, C); voffA[i] = (unsigned)(R * K + C) * 2u; }
  const size_t kstep = (size_t)(BK * 2);
  const size_t hstep = (size_t)HALF * K * 2;
  const size_t tstep = 2 * hstep;
  const unsigned ldsw = (unsigned)wid * 1024u;
  const int aoff = lds_byte(wr * 64 + fr, fq * 8), boff = lds_byte(wc * 32 + fr, fq * 8);
#define G_SA(b, h) (((b) * 2 + (h)) * HTB)
#define G_SB(b, h) ((4 + (b) * 2 + (h)) * HTB)
#define G_STAGE(bufoff, gbase) do { _Pragma("unroll") for (int _i = 0; _i < 2; ++_i) \
    __builtin_amdgcn_global_load_lds((const unsigned*)((const char*)(gbase) + voffA[_i]), (LAS unsigned*)(lds + (bufoff) + ldsw + _i * 8192), 16, 0, 0); } while (0)
#define G_LDA(dst, b, h) do { _Pragma("unroll") for (int m = 0; m < 4; ++m) _Pragma("unroll") for (int k = 0; k < 2; ++k) dst[m][k] = *(const LAS bf16x8*)(lds + G_SA(b, h) + aoff + m * 2048 + k * 1024); } while (0)
#define G_LDB(dst, b, h) do { _Pragma("unroll") for (int n = 0; n < 2; ++n) _Pragma("unroll") for (int k = 0; k < 2; ++k) dst[n][k] = *(const LAS bf16x8*)(lds + G_SB(b, h) + boff + n * 2048 + k * 1024); } while (0)
#define G_MMA(ai, bj, At_, Bt_) do { __builtin_amdgcn_s_setprio(1); _Pragma("unroll") for (int m = 0; m < 4; ++m) _Pragma("unroll") for (int n = 0; n < 2; ++n) _Pragma("unroll") for (int k = 0; k < 2; ++k) \
    acc[ai][bj][m][n] = __builtin_amdgcn_mfma_f32_16x16x32_bf16(Bt_[n][k], At_[m][k], acc[ai][bj][m][n], 0, 0, 0); __builtin_amdgcn_s_setprio(0); } while (0)
#define G_WAIT_V(n) asm volatile("s_waitcnt vmcnt(" #n ")" ::: "memory")
#define G_WAIT_L(n) asm volatile("s_waitcnt lgkmcnt(" #n ")" ::: "memory")
#define G_BAR __builtin_amdgcn_s_barrier()
#define G_SCHED __builtin_amdgcn_sched_barrier(0)
  Unit cur, nxt; int ui = 0;
  if (S.next(0, cur)) {
    f32x4 acc[2][2][4][2];
#pragma unroll
    for (int a = 0; a < 2; ++a)
#pragma unroll
      for (int b = 0; b < 2; ++b)
#pragma unroll
        for (int m = 0; m < 4; ++m)
#pragma unroll
          for (int n = 0; n < 2; ++n) acc[a][b][m][n] = (f32x4){0.f, 0.f, 0.f, 0.f};
    bf16x8 At[4][2], B0[2][2], B1[2][2];
    const char* cA = (const char*)Ag + (size_t)cur.pm * tstep + (size_t)cur.k0 * kstep; const char* cB = (const char*)Btg + (size_t)cur.pn * tstep + (size_t)cur.k0 * kstep;
    G_STAGE(G_SB(0, 0), cB); G_STAGE(G_SA(0, 0), cA); G_STAGE(G_SB(0, 1), cB + hstep); G_STAGE(G_SA(0, 1), cA + hstep);
    if (wr == 1) G_BAR;
    G_WAIT_V(4); G_BAR;
    G_STAGE(G_SB(1, 0), cB + kstep); G_STAGE(G_SA(1, 0), cA + kstep); G_STAGE(G_SB(1, 1), cB + hstep + kstep);
    G_WAIT_V(6); G_BAR;
    for (;;) {
      const bool has_next = S.next(ui + 1, nxt);
      const char* nA = has_next ? (const char*)Ag + (size_t)nxt.pm * tstep + (size_t)nxt.k0 * kstep : cA; const char* nB = has_next ? (const char*)Btg + (size_t)nxt.pn * tstep + (size_t)nxt.k0 * kstep : cB;
      const int nt = cur.nk;
      for (int t = 0; t < nt; t += 2) {
        const bool last = (t == nt - 2);
        const char* a1 = cA + (size_t)(t + 1) * kstep;
        const char* a2 = last ? nA : cA + (size_t)(t + 2) * kstep; const char* b2 = last ? nB : cB + (size_t)(t + 2) * kstep;
        const char* a3 = a2 + kstep; const char* b3 = b2 + kstep;
        G_LDB(B0, 0, 0); G_SCHED; G_LDA(At, 0, 0); G_STAGE(G_SA(1, 1), a1 + hstep);
        G_WAIT_L(8); G_BAR; G_WAIT_L(0); G_MMA(0, 0, At, B0); G_BAR; G_SCHED;
        G_LDB(B1, 0, 1); G_STAGE(G_SB(0, 0), b2);
        G_BAR; G_WAIT_L(0); G_MMA(0, 1, At, B1); G_BAR;
        G_LDA(At, 0, 1); G_STAGE(G_SA(0, 0), a2);
        G_BAR; G_WAIT_L(0); G_MMA(1, 0, At, B0); G_BAR; G_SCHED;
        G_STAGE(G_SB(0, 1), b2 + hstep);
        G_WAIT_V(6); G_BAR; G_MMA(1, 1, At, B1); G_BAR;
        G_LDB(B0, 1, 0); G_SCHED; G_LDA(At, 1, 0); G_STAGE(G_SA(0, 1), a2 + hstep);
        G_WAIT_L(8); G_BAR; G_WAIT_L(0); G_MMA(0, 0, At, B0); G_BAR; G_SCHED;
        G_LDB(B1, 1, 1); G_STAGE(G_SB(1, 0), b3);
        G_BAR; G_WAIT_L(0); G_MMA(0, 1, At, B1); G_BAR;
        G_LDA(At, 1, 1); G_STAGE(G_SA(1, 0), a3);
        G_BAR; G_WAIT_L(0); G_MMA(1, 0, At, B0); G_BAR; G_SCHED;
        G_STAGE(G_SB(1, 1), b3 + hstep);
        G_WAIT_V(6); G_BAR; G_MMA(1, 1, At, B1); G_BAR;
      }
      const bool defer = EPI == EPI_RES && !has_next && ea.rowss != nullptr && !cur.part;
      if (!defer) { if (EPI == EPI_RES && cur.part) gemm_epilogue<EPI, true>(acc, cur, wr, wc, fr, fq, ea); else gemm_epilogue<EPI, false>(acc, cur, wr, wc, fr, fq, ea); }
      if (!has_next) break;
#pragma unroll
      for (int a = 0; a < 2; ++a)
#pragma unroll
        for (int b = 0; b < 2; ++b)
#pragma unroll
          for (int m = 0; m < 4; ++m)
#pragma unroll
            for (int n = 0; n < 2; ++n) acc[a][b][m][n] = (f32x4){0.f, 0.f, 0.f, 0.f};
      cur = nxt; cA = nA; cB = nB; ++ui;
    }
    G_WAIT_V(0);
    if (wr == 0) G_BAR;
    G_BAR;
    if (EPI == EPI_RES && ea.rowss != nullptr && !cur.part) gemm_epilogue<EPI, false>(acc, cur, wr, wc, fr, fq, ea);
  }
#undef G_SA
#undef G_SB
#undef G_STAGE
#undef G_LDA
#undef G_LDB
#undef G_MMA
}

__device__ void phase_prep_even(const Params& p, int j) {
  const int wave = TID() >> 6, lane = TID() & 63, tid = TID();
  const float qscale = 0.125f * 1.44269504088896f;
  const int gw = blockIdx.x * 8 + wave, nw = gridDim.x * 8;
  {
    const int li = lane & 7, d0 = 8 * li;
    float gq[8], gk[8];
#pragma unroll
    for (int u = 0; u < 8; ++u) { gq[u] = p.qk_gain[j * 128 + d0 + u] * qscale; gk[u] = p.qk_gain[j * 128 + 64 + d0 + u]; }
    const int aidx = 8 * (li & 1);
    const bool second = (li & 2) != 0;
    auto do_rows = [&](int row0, int nr, bool lat) {
      uint4 raw[4][2];
#pragma unroll
      for (int k = 0; k < 4; ++k)
        if (k < nr) {
          const bf16_t* pr = p.P + (size_t)(row0 + k) * LDP_E;
          raw[k][0] = *(const uint4*)(pr + lane * 8); raw[k][1] = *(const uint4*)(pr + 512 + lane * 8);
        }
#pragma unroll
      for (int k = 0; k < 4; ++k)
        if (k < nr) {
          const int t = (row0 + k) & 2047;
          const int pos = (li & 4) ? (t & 63) : (t >> 6);
          float cs[8], sn[8];
          if (lat) {
#pragma unroll
            for (int u = 0; u < 8; ++u) { cs[u] = ROPE_CS[pos][aidx + u]; sn[u] = ROPE_SN[pos][aidx + u]; }
          }
#pragma unroll
          for (int hf = 0; hf < 2; ++hf) {
            const unsigned w4[4] = {raw[k][hf].x, raw[k][hf].y, raw[k][hf].z, raw[k][hf].w};
            float v[8];
            float ss = 0.f;
#pragma unroll
            for (int u = 0; u < 4; ++u) { v[2 * u] = __uint_as_float(w4[u] << 16); v[2 * u + 1] = __uint_as_float(w4[u] & 0xffff0000u); }
#pragma unroll
            for (int u = 0; u < 8; ++u) ss += v[u] * v[u];
            ss += __shfl_xor(ss, 1, 64); ss += __shfl_xor(ss, 2, 64); ss += __shfl_xor(ss, 4, 64);
            const float r = rsqrtf(ss * (1.f / 64.f) + EPSN);
            float y[8];
#pragma unroll
            for (int u = 0; u < 8; ++u) y[u] = v[u] * r * (hf == 0 ? gq[u] : gk[u]);
            if (lat) {
#pragma unroll
              for (int u = 0; u < 8; ++u) {
                const float o = __shfl_xor(y[u], 2, 64);
                y[u] = second ? (y[u] * cs[u] + o * sn[u]) : (y[u] * cs[u] - o * sn[u]);
              }
            }
            uint4 ov; ov.x = pack2(y[0], y[1]); ov.y = pack2(y[2], y[3]); ov.z = pack2(y[4], y[5]); ov.w = pack2(y[6], y[7]);
            *(uint4*)(p.P + (size_t)(row0 + k) * LDP_E + hf * 512 + lane * 8) = ov;
          }
        }
    };
    for (int blk = gw; blk < ML / 8; blk += nw) { do_rows(blk * 8, 4, true); do_rows(blk * 8 + 4, 4, true); }
    for (int row = ML + gw; row < MT; row += nw) do_rows(row, 1, false);
  }
  bf16_t* ts = (bf16_t*)smem_raw;
  for (int it = blockIdx.x; it < NB * 4 * 36; it += gridDim.x) {
    const int kb = it % 36, h = (it / 36) & 3, b = it / 144;
    __syncthreads();
    {
      const int r = tid >> 3, ch = tid & 7;
      const int kk = kb * 64 + r;
      const int row = kk < TCX ? ML + b * TCX + kk : b * TL + (kk - TCX);
      const bf16_t* src = p.P + (size_t)row * LDP_E + 1024 + h * 128;
#pragma unroll
      for (int i = 0; i < 2; ++i) {
        const int c8 = (ch + i * 8) * 8;
        const uint4 v = *(const uint4*)(src + c8);
        unsigned* d = (unsigned*)(ts + r * 130 + c8);
        d[0] = v.x; d[1] = v.y; d[2] = v.z; d[3] = v.w;
      }
    }
    __syncthreads();
    {
      const int e = tid >> 2, kq = tid & 3;
      unsigned w[8];
#pragma unroll
      for (int i = 0; i < 8; ++i) {
        const unsigned lo = ts[(kq * 16 + 2 * i) * 130 + e], hi = ts[(kq * 16 + 2 * i + 1) * 130 + e];
        w[i] = lo | (hi << 16);
      }
      bf16_t* dst = p.Vt + ((size_t)(b * 4 + h) * 128 + e) * NKK + kb * 64 + kq * 16;
      *(uint4*)(dst) = make_uint4(w[0], w[1], w[4], w[5]);
      *(uint4*)(dst + 8) = make_uint4(w[2], w[3], w[6], w[7]);
    }
  }
  {
    float wreg[8][16], breg[8];
#pragma unroll
    for (int u = 0; u < 8; ++u) {
      const int col = u * 64 + lane, dr = col >> 8, cc = col & 255;
      breg[u] = p.b_gate_up[j * 512 + col];
#pragma unroll
      for (int rr = 0; rr < 16; ++rr) wreg[u][rr] = p.w_gate_up[(size_t)j * 8192 + (dr * 16 + rr) * 256 + cc];
    }
    auto gate_rows = [&](int row0, int nr) {
      uint4 lrw[2][4];
#pragma unroll
      for (int k = 0; k < 2; ++k)
        if (k < nr) {
          const uint4* pr = (const uint4*)(p.P + (size_t)(row0 + k) * LDP_E + 3072);
          lrw[k][0] = pr[0]; lrw[k][1] = pr[1]; lrw[k][2] = pr[2]; lrw[k][3] = pr[3];
        }
#pragma unroll
      for (int k = 0; k < 2; ++k)
        if (k < nr) {
          float lr[32];
#pragma unroll
          for (int q = 0; q < 4; ++q) {
            const unsigned w4[4] = {lrw[k][q].x, lrw[k][q].y, lrw[k][q].z, lrw[k][q].w};
#pragma unroll
            for (int u = 0; u < 4; ++u) { lr[8 * q + 2 * u] = __uint_as_float(w4[u] << 16); lr[8 * q + 2 * u + 1] = __uint_as_float(w4[u] & 0xffff0000u); }
          }
#pragma unroll
          for (int u = 0; u < 8; ++u) {
            const int dr = u >> 2;
            float xg = breg[u];
#pragma unroll
            for (int rr = 0; rr < 16; ++rr) xg += lr[dr * 16 + rr] * wreg[u][rr];
            const float ls = fminf(xg, 0.f) - __logf(1.f + __expf(-fabsf(xg)));
            p.Gk[(size_t)(row0 + k) * 512 + u * 64 + lane] = __expf(ls * (1.f / 16.f));
          }
        }
    };
    for (int blk = gw; blk < MT / 8; blk += nw) { gate_rows(blk * 8, 2); gate_rows(blk * 8 + 2, 2); gate_rows(blk * 8 + 4, 2); gate_rows(blk * 8 + 6, 2); }
  }
}

__device__ void attn_item(const Params& p, int item) {
  const int tid = TID(), wave = tid >> 6, lane = tid & 63, r = lane & 31, hh = lane >> 5;
  int b, hc, qrow0, krow_ctx, krow_lat, ntile;
  if (item < 512) { b = item >> 6; hc = (item >> 3) & 7; qrow0 = b * TL + (item & 7) * 256; ntile = 36; }
  else { const int i2 = item - 512; b = i2 >> 3; hc = i2 & 7; qrow0 = ML + b * TCX; ntile = 4; }
  krow_ctx = ML + b * TCX; krow_lat = b * TL;
  const int h = hc >> 1, c = hc & 1;
  bf16_t* Ksm = (bf16_t*)smem_raw;
  bf16_t* Vsm = (bf16_t*)(smem_raw + 2 * 9216);
  const int qrow = qrow0 + wave * 32 + r;
  bf16x8 qf[4];
#pragma unroll
  for (int s = 0; s < 4; ++s) qf[s] = *(const bf16x8*)(p.P + (size_t)qrow * LDP_E + hc * 64 + 16 * s + 8 * hh);
  f32x16 oacc[4];
#pragma unroll
  for (int eb = 0; eb < 4; ++eb)
#pragma unroll
    for (int i = 0; i < 16; ++i) oacc[eb][i] = 0.f;
  float mrun = -1e30f, lsum = 0.f;
  const int kkey = tid >> 3, kch = tid & 7;
  const int ve = tid >> 2, vch = tid & 3;
  const bf16_t* vbase = p.Vt + ((size_t)(b * 4 + h) * 128 + ve) * NKK + vch * 16;
  uint4 kreg, vreg0, vreg1;
  auto gload = [&](int t) {
    const int kk = t * 64 + kkey;
    const int row = kk < TCX ? krow_ctx + kk : krow_lat + (kk - TCX);
    kreg = *(const uint4*)(p.P + (size_t)row * LDP_E + 512 + hc * 64 + kch * 8);
    vreg0 = *(const uint4*)(vbase + t * 64);
    vreg1 = *(const uint4*)(vbase + t * 64 + 8);
  };
  auto sstore = [&](int buf) {
    *(uint4*)(Ksm + buf * 4608 + kkey * 72 + kch * 8) = kreg;
    uint4* d = (uint4*)(Vsm + buf * 9216 + ve * 72 + vch * 16);
    d[0] = vreg0; d[1] = vreg1;
  };
  __syncthreads();
  gload(0); sstore(0);
  __syncthreads();
  for (int t = 0; t < ntile; ++t) {
    const int buf = t & 1;
    if (t + 1 < ntile) gload(t + 1);
    const bf16_t* Kb = Ksm + buf * 4608;
    const bf16_t* Vb = Vsm + buf * 9216;
    f32x16 sacc[2];
#pragma unroll
    for (int kb = 0; kb < 2; ++kb) {
#pragma unroll
      for (int i = 0; i < 16; ++i) sacc[kb][i] = 0.f;
#pragma unroll
      for (int s = 0; s < 4; ++s) {
        const bf16x8 kf = *(const bf16x8*)(Kb + (32 * kb + r) * 72 + 16 * s + 8 * hh);
        sacc[kb] = __builtin_amdgcn_mfma_f32_32x32x16_bf16(kf, qf[s], sacc[kb], 0, 0, 0);
      }
    }
    float mx = sacc[0][0];
#pragma unroll
    for (int kb = 0; kb < 2; ++kb)
#pragma unroll
      for (int i = 0; i < 16; ++i) mx = fmaxf(mx, sacc[kb][i]);
    mx = fmaxf(mx, __shfl_xor(mx, 32, 64));
    if (__builtin_amdgcn_ballot_w64(mx > mrun + 8.f)) {
      const float mnew = fmaxf(mrun, mx);
      const float alpha = __builtin_amdgcn_exp2f(mrun - mnew);
      mrun = mnew;
      lsum *= alpha;
#pragma unroll
      for (int eb = 0; eb < 4; ++eb)
#pragma unroll
        for (int i = 0; i < 16; ++i) oacc[eb][i] *= alpha;
    }
    float ps = 0.f;
#pragma unroll
    for (int kb = 0; kb < 2; ++kb)
#pragma unroll
      for (int i = 0; i < 16; ++i) { const float pv = __builtin_amdgcn_exp2f(sacc[kb][i] - mrun); sacc[kb][i] = pv; ps += pv; }
    lsum += ps;
#pragma unroll
    for (int ks = 0; ks < 4; ++ks) {
      const int kb = ks >> 1, s2 = ks & 1;
      uint4 pu;
      pu.x = pack2(sacc[kb][8 * s2 + 0], sacc[kb][8 * s2 + 1]); pu.y = pack2(sacc[kb][8 * s2 + 2], sacc[kb][8 * s2 + 3]);
      pu.z = pack2(sacc[kb][8 * s2 + 4], sacc[kb][8 * s2 + 5]); pu.w = pack2(sacc[kb][8 * s2 + 6], sacc[kb][8 * s2 + 7]);
      const bf16x8 pf = __builtin_bit_cast(bf16x8, pu);
#pragma unroll
      for (int eb = 0; eb < 4; ++eb) {
        const bf16x8 vf = *(const bf16x8*)(Vb + (32 * eb + r) * 72 + 16 * ks + 8 * hh);
        oacc[eb] = __builtin_amdgcn_mfma_f32_32x32x16_bf16(vf, pf, oacc[eb], 0, 0, 0);
      }
    }
    if (t + 1 < ntile) sstore(buf ^ 1);
    __syncthreads();
  }
  lsum += __shfl_xor(lsum, 32, 64);
  const float inv = 1.f / lsum;
  bf16_t* orow = p.R1 + (size_t)qrow * D + c * 512 + h * 128;
#pragma unroll
  for (int eb = 0; eb < 4; ++eb)
#pragma unroll
    for (int g = 0; g < 4; ++g) {
      const int e = 32 * eb + 8 * g + 4 * hh;
      uint2 o; o.x = pack2(oacc[eb][4 * g] * inv, oacc[eb][4 * g + 1] * inv); o.y = pack2(oacc[eb][4 * g + 2] * inv, oacc[eb][4 * g + 3] * inv);
      *(uint2*)(orow + e) = o;
    }
}

template <int MODE>
__device__ void scan_item(const Params& p, int l, int item) {
  constexpr int DK = MODE ? 128 : 64, DVS = MODE ? 64 : 32, DP = NTHR / DVS, DPT = DK / DP, TC = 32;
  constexpr int NH = MODE ? 8 : 4, NSL = 128 / DVS, LDP = MODE ? LDP_O : LDP_E;
  const int j = l >> 1;
  const int sl = item % NSL, dir = (item / NSL) & 1, h = (item / (NSL * 2)) % NH, b = item / (NSL * 2 * NH);
  float* Qs = (float*)smem_raw; float* Ks = Qs + TC * DK; float* Ds = Ks + TC * DK; float* Vs = Ds + TC * DK; float* Os = Vs + TC * DVS; float* LB = Os + TC * DVS;
  const int tid = TID(), dpart = tid % DP, e = tid / DP;
  float S[DPT];
#pragma unroll
  for (int i = 0; i < DPT; ++i) S[i] = 0.f;
  __syncthreads();
  if (MODE == 1) {
    if (tid < 128) {
      const float* lr = p.lb_raw + (size_t)dir * 4 * 1024 + h * 128 + tid;
      const float r0 = lr[0], r1 = lr[1024], r2 = lr[2048], r3 = lr[3072];
      const float mx = fmaxf(fmaxf(r0, r1), fmaxf(r2, r3));
      const float e0 = __expf(r0 - mx), e1 = __expf(r1 - mx), e2 = __expf(r2 - mx), e3 = __expf(r3 - mx);
      const float inv = 1.f / (e0 + e1 + e2 + e3);
      float acc = 0.f;
      if (l >= 1) acc += e1;
      if (l >= 2) acc += e2;
      if (l >= 3) acc += e3;
      LB[tid] = acc * inv;
    }
  }
  bf16_t* Ro;
  int ldo, ocol;
  if (MODE == 0) { Ro = p.R2 + (size_t)dir * MT * 512; ldo = 512; ocol = h * 128 + sl * DVS; }
  else { Ro = dir ? p.R2 : p.R1; ldo = 1024; ocol = h * 128 + sl * DVS; }
  for (int chunk = 0; chunk < NKK / TC; ++chunk) {
    __syncthreads();
    for (int idx = tid; idx < TC * DK; idx += NTHR) {
      const int tt = idx / DK, d = idx % DK;
      const int n = chunk * TC + tt;
      int row;
      if (n < TCX) row = ML + b * TCX + (dir ? (TCX - 1 - n) : n); else row = b * TL + (dir ? (TL - 1 - (n - TCX)) : (n - TCX));
      const bf16_t* pr = p.P + (size_t)row * LDP;
      float q, k, dec;
      if (MODE == 0) {
        q = bf2f(pr[1536 + h * 64 + d]) * 0.125f;
        k = bf2f(pr[1792 + h * 64 + d]);
        const float* w = p.w_gate_up + ((size_t)(j * 2 + dir) * 16) * 256 + h * 64 + d;
        float xg = p.b_gate_up[(j * 2 + dir) * 256 + h * 64 + d];
#pragma unroll
        for (int rr = 0; rr < 16; ++rr) xg += bf2f(pr[3072 + dir * 16 + rr]) * w[rr * 256];
        const float ls = fminf(xg, 0.f) - log1pf(__expf(-fabsf(xg)));
        dec = __expf(ls * (1.f / 16.f));
      } else {
        q = siluf(bf2f(pr[h * 128 + d])) * 0.08838834764831845f;
        const float lbv = LB[d];
        const float f = lbv + (1.f - lbv) * sigmoidf_(bf2f(pr[1024 + dir * 1024 + h * 128 + d]));
        k = 1.f - f; dec = f;
      }
      Qs[idx] = q; Ks[idx] = k; Ds[idx] = dec;
    }
    for (int idx = tid; idx < TC * DVS; idx += NTHR) {
      const int tt = idx / DVS, ee = idx % DVS;
      const int n = chunk * TC + tt;
      int row;
      if (n < TCX) row = ML + b * TCX + (dir ? (TCX - 1 - n) : n); else row = b * TL + (dir ? (TL - 1 - (n - TCX)) : (n - TCX));
      const bf16_t* pr = p.P + (size_t)row * LDP;
      Vs[idx] = bf2f(pr[(MODE ? 3072 : 2048) + h * 128 + sl * DVS + ee]);
    }
    __syncthreads();
    for (int tt = 0; tt < TC; ++tt) {
      const float v = Vs[tt * DVS + e];
      float part = 0.f;
#pragma unroll
      for (int i4 = 0; i4 < DPT / 4; ++i4) {
        const float4 q4 = *(const float4*)(Qs + tt * DK + dpart * DPT + i4 * 4);
        const float4 k4 = *(const float4*)(Ks + tt * DK + dpart * DPT + i4 * 4);
        const float4 d4 = *(const float4*)(Ds + tt * DK + dpart * DPT + i4 * 4);
        S[i4 * 4 + 0] = S[i4 * 4 + 0] * d4.x + k4.x * v; part += q4.x * S[i4 * 4 + 0];
        S[i4 * 4 + 1] = S[i4 * 4 + 1] * d4.y + k4.y * v; part += q4.y * S[i4 * 4 + 1];
        S[i4 * 4 + 2] = S[i4 * 4 + 2] * d4.z + k4.z * v; part += q4.z * S[i4 * 4 + 2];
        S[i4 * 4 + 3] = S[i4 * 4 + 3] * d4.w + k4.w * v; part += q4.w * S[i4 * 4 + 3];
      }
#pragma unroll
      for (int o = DP / 2; o >= 1; o >>= 1) part += __shfl_xor(part, o, 64);
      if (dpart == 0) Os[tt * DVS + e] = part;
    }
    __syncthreads();
    for (int idx = tid; idx < TC * DVS; idx += NTHR) {
      const int tt = idx / DVS, ee = idx % DVS;
      const int n = chunk * TC + tt;
      int row;
      if (n < TCX) row = ML + b * TCX + (dir ? (TCX - 1 - n) : n); else row = b * TL + (dir ? (TL - 1 - (n - TCX)) : (n - TCX));
      Ro[(size_t)row * ldo + ocol + ee] = f2bf(Os[idx]);
    }
  }
}

template <int MODE>
__device__ void scan2_item(const Params& p, int l, int item) {
  constexpr int DK = MODE ? 128 : 64, NH = MODE ? 8 : 4, LDP = MODE ? LDP_O : LDP_E, NDB = DK / 16, QS = DK + 8, TS = 72;
  const int dir = item & 1, h = (item >> 1) % NH, b = item / (2 * NH);
  bf16_t* Qh = (bf16_t*)smem_raw; bf16_t* Kh = Qh + 64 * QS; bf16_t* KbT = Kh + 64 * QS; bf16_t* VT = KbT + DK * TS; float* ET = (float*)(VT + 128 * TS);
  const int tid = TID(), wave = __builtin_amdgcn_readfirstlane(tid >> 6), lane = tid & 63, r15 = lane & 15, fq = lane >> 4;
  const int pd = tid % DK, pi = __builtin_amdgcn_readfirstlane(tid / DK);
  const bool pact = pi < 4;
  const int ve = tid & 127, vi = __builtin_amdgcn_readfirstlane(tid >> 7);
  float lbv = 0.f;
  if (MODE == 1) {
    const float* lr = p.lb_raw + (size_t)dir * 4 * 1024 + h * 128 + pd;
    const float r0 = lr[0], r1 = lr[1024], r2 = lr[2048], r3 = lr[3072];
    const float mx = fmaxf(fmaxf(r0, r1), fmaxf(r2, r3));
    const float e0 = __expf(r0 - mx), e1 = __expf(r1 - mx), e2 = __expf(r2 - mx), e3 = __expf(r3 - mx);
    float a = 0.f;
    if (l >= 1) a += e1;
    if (l >= 2) a += e2;
    if (l >= 3) a += e3;
    lbv = a / (e0 + e1 + e2 + e3);
  }
  const int qcol = MODE ? h * 128 + pd : 1536 + h * 64 + pd;
  const int kcol = MODE ? 1024 + dir * 1024 + h * 128 + pd : 1792 + h * 64 + pd;
  const int vcol = (MODE ? 3072 : 2048) + h * 128 + ve;
  const int gcol = dir * 256 + h * 64 + pd;
  bf16_t* Ro; int ldo;
  if (MODE == 0) { Ro = p.R2 + (size_t)dir * MT * 512; ldo = 512; } else { Ro = dir ? p.R2 : p.R1; ldo = 1024; }
  Ro += h * 128 + 16 * wave + r15;
  const int rowc = ML + b * TCX, rowl = b * TL;
  auto tokrow = [&](int n) -> int { return n < TCX ? rowc + (dir ? (TCX - 1 - n) : n) : rowl + (dir ? (TL - 1 - (n - TCX)) : (n - TCX)); };
  bf16_t rq[16], rk[16], rv[16]; float rg[16];
  auto load_raw = [&](int ck) {
#pragma unroll
    for (int tt = 0; tt < 16; ++tt) {
      if (pact) {
        const int row = tokrow(ck * 64 + 16 * pi + tt);
        const bf16_t* pr = p.P + (size_t)row * LDP;
        rq[tt] = pr[qcol]; rk[tt] = pr[kcol];
#if EXP2
        if (MODE == 0) {
          const int jx = l >> 1;
          const float* w = p.w_gate_up + ((size_t)(jx * 2 + dir) * 16) * 256 + h * 64 + pd;
          float xg = p.b_gate_up[(jx * 2 + dir) * 256 + h * 64 + pd];
#pragma unroll
          for (int rr = 0; rr < 16; ++rr) xg += bf2f(pr[3072 + dir * 16 + rr]) * w[rr * 256];
          const float ls = fminf(xg, 0.f) - log1pf(__expf(-fabsf(xg)));
          rg[tt] = ls * (1.f / 16.f);
        }
#else
        if (MODE == 0) rg[tt] = p.Gk[(size_t)row * 512 + gcol];
#endif
      }
      const int rowv = tokrow(ck * 64 + 16 * vi + tt);
      rv[tt] = p.P[(size_t)rowv * LDP + vcol];
    }
  };
  f32x4 S[NDB];
#pragma unroll
  for (int db = 0; db < NDB; ++db) S[db] = (f32x4){0.f, 0.f, 0.f, 0.f};
  constexpr int BUFE = 2 * 64 * QS + DK * TS + 128 * TS + 2 * 4 * DK;
  auto prep = [&](int bi) {
    bf16_t* Qh_ = Qh + bi * BUFE; bf16_t* Kh_ = Kh + bi * BUFE; bf16_t* KbT_ = KbT + bi * BUFE; bf16_t* VT_ = VT + bi * BUFE; float* ET_ = (float*)(VT_ + 128 * TS);
    if (pact) {
      float E = 1.f, kh[16];
#pragma unroll
      for (int tt = 0; tt < 16; ++tt) {
        float q, k, dec;
        if (MODE == 1) {
          q = siluf(bf2f(rq[tt])) * 0.08838834764831845f;
          dec = lbv + (1.f - lbv) * sigmoidf_(bf2f(rk[tt]));
          k = 1.f - dec;
        } else { q = bf2f(rq[tt]) * 0.125f; k = bf2f(rk[tt]); dec = rg[tt]; }
        E *= dec;
        const float kE = k * __builtin_amdgcn_rcpf(E);
        kh[tt] = kE;
        Qh_[(16 * pi + tt) * QS + pd] = f2bf(q * E);
        Kh_[(16 * pi + tt) * QS + pd] = f2bf(kE);
      }
      ET_[pi * DK + pd] = E;
      unsigned w[8];
#pragma unroll
      for (int u = 0; u < 8; ++u) w[u] = pack2(kh[2 * u] * E, kh[2 * u + 1] * E);
      *(uint4*)(KbT_ + pd * TS + 16 * pi) = make_uint4(w[0], w[1], w[2], w[3]);
      *(uint4*)(KbT_ + pd * TS + 16 * pi + 8) = make_uint4(w[4], w[5], w[6], w[7]);
    }
    {
      unsigned w[8];
#pragma unroll
      for (int u = 0; u < 8; ++u) w[u] = (unsigned)rv[2 * u] | ((unsigned)rv[2 * u + 1] << 16);
      *(uint4*)(VT_ + ve * TS + 16 * vi) = make_uint4(w[0], w[1], w[2], w[3]);
      *(uint4*)(VT_ + ve * TS + 16 * vi + 8) = make_uint4(w[4], w[5], w[6], w[7]);
    }
  };
  __syncthreads();
  load_raw(0);
  prep(0);
  load_raw(1);
  __syncthreads();
  for (int ck = 0; ck < NKK / 64; ++ck) {
    if (ck + 1 < NKK / 64) { prep((ck + 1) & 1); if (ck + 2 < NKK / 64) load_raw(ck + 2); }
    const int bo = (ck & 1) * BUFE;
    const bf16_t* Qb = Qh + bo; const bf16_t* Kb = Kh + bo; const bf16_t* KTb = KbT + bo; const bf16_t* Vb = VT + bo; const float* Eb = (const float*)(Vb + 128 * TS);
#pragma unroll
    for (int i = 0; i < 4; ++i) {
      f32x4 att = (f32x4){0.f, 0.f, 0.f, 0.f};
#pragma unroll
      for (int kb = 0; kb < DK / 32; ++kb) {
        const bf16x8 ka = *(const bf16x8*)(Kb + (16 * i + r15) * QS + 32 * kb + 8 * fq);
        const bf16x8 qb = *(const bf16x8*)(Qb + (16 * i + r15) * QS + 32 * kb + 8 * fq);
        att = __builtin_amdgcn_mfma_f32_16x16x32_bf16(ka, qb, att, 0, 0, 0);
      }
      const unsigned a01 = pack2((4 * fq + 0 <= r15) ? att[0] : 0.f, (4 * fq + 1 <= r15) ? att[1] : 0.f);
      const unsigned a23 = pack2((4 * fq + 2 <= r15) ? att[2] : 0.f, (4 * fq + 3 <= r15) ? att[3] : 0.f);
      const bf16x8 a8 = __builtin_bit_cast(bf16x8, make_uint4(a01, a23, 0u, 0u));
      f32x4 o = (f32x4){0.f, 0.f, 0.f, 0.f};
#pragma unroll
      for (int kb = 0; kb < DK / 32; ++kb) {
        const s16x4 qlo = *(const s16x4*)(Qb + (16 * i + r15) * QS + 32 * kb + 4 * fq);
        const s16x4 qhi = *(const s16x4*)(Qb + (16 * i + r15) * QS + 32 * kb + 16 + 4 * fq);
        const bf16x8 qa = __builtin_shufflevector(qlo, qhi, 0, 1, 2, 3, 4, 5, 6, 7);
        const bf16x8 sb = __builtin_bit_cast(bf16x8, make_uint4(pack2(S[2 * kb][0], S[2 * kb][1]), pack2(S[2 * kb][2], S[2 * kb][3]),
                                                                  pack2(S[2 * kb + 1][0], S[2 * kb + 1][1]), pack2(S[2 * kb + 1][2], S[2 * kb + 1][3])));
        o = __builtin_amdgcn_mfma_f32_16x16x32_bf16(qa, sb, o, 0, 0, 0);
      }
      const s16x4 vb = *(const s16x4*)(Vb + (16 * wave + r15) * TS + 16 * i + 4 * fq);
      const s16x4 z4 = (s16x4){0, 0, 0, 0};
      const bf16x8 vb8 = __builtin_shufflevector(vb, z4, 0, 1, 2, 3, 4, 5, 6, 7);
      o = __builtin_amdgcn_mfma_f32_16x16x32_bf16(a8, vb8, o, 0, 0, 0);
#pragma unroll
      for (int jj = 0; jj < 4; ++jj) {
        const int row = tokrow(ck * 64 + 16 * i + 4 * fq + jj);
        Ro[(size_t)row * ldo] = f2bf(o[jj]);
      }
#pragma unroll
      for (int db = 0; db < NDB; ++db) {
        const float4 et = *(const float4*)(Eb + i * DK + 16 * db + 4 * fq);
        f32x4 s = S[db];
        s[0] *= et.x; s[1] *= et.y; s[2] *= et.z; s[3] *= et.w;
        const s16x4 ka = *(const s16x4*)(KTb + (16 * db + r15) * TS + 16 * i + 4 * fq);
        S[db] = __builtin_amdgcn_mfma_f32_16x16x32_bf16(__builtin_shufflevector(ka, z4, 0, 1, 2, 3, 4, 5, 6, 7), vb8, s, 0, 0, 0);
      }
    }
    __syncthreads();
  }
}

template <int MODE>
__device__ void scan3_item(const Params& p, int l, int item) {
  constexpr int DK = MODE ? 128 : 64, NH = MODE ? 8 : 4, LDP = MODE ? LDP_O : LDP_E, NDB = DK / 16, QS = DK + 8, TS = 72;
  constexpr int NSB = MODE ? 2 : 1;
  constexpr int NCK = NKK / 64;
  const int dir = item & 1, h = (item >> 1) % NH, b = item / (2 * NH);
  bf16_t* Qh = (bf16_t*)smem_raw; bf16_t* Kh = Qh + 64 * QS; bf16_t* KbT = Kh + 64 * QS; bf16_t* VT = KbT + DK * TS;
  constexpr int BUFE = 2 * 64 * QS + DK * TS + 128 * TS + 2 * 4 * DK;
  const int tid = TID(), wave = __builtin_amdgcn_readfirstlane(tid >> 6), lane = tid & 63, r15 = lane & 15, fq = lane >> 4;
  const int rowc = ML + b * TCX, rowl = b * TL;
  auto tokrow = [&](int n) -> int { return n < TCX ? rowc + (dir ? (TCX - 1 - n) : n) : rowl + (dir ? (TL - 1 - (n - TCX)) : (n - TCX)); };
  __syncthreads();
  if (wave >= 4) {
    const int pt = tid - 256;
    const int pd = pt % DK, pi0 = __builtin_amdgcn_readfirstlane(pt / DK);
    const int ve = pt & 127, vi0 = __builtin_amdgcn_readfirstlane(pt >> 7);
    float lbv = 0.f;
    if (MODE == 1) {
      const float* lr = p.lb_raw + (size_t)dir * 4 * 1024 + h * 128 + pd;
      const float r0 = lr[0], r1 = lr[1024], r2 = lr[2048], r3 = lr[3072];
      const float mx = fmaxf(fmaxf(r0, r1), fmaxf(r2, r3));
      const float e0 = __expf(r0 - mx), e1 = __expf(r1 - mx), e2 = __expf(r2 - mx), e3 = __expf(r3 - mx);
      float a = 0.f;
      if (l >= 1) a += e1;
      if (l >= 2) a += e2;
      if (l >= 3) a += e3;
      lbv = a / (e0 + e1 + e2 + e3);
    }
    const int qcol = MODE ? h * 128 + pd : 1536 + h * 64 + pd;
    const int kcol = MODE ? 1024 + dir * 1024 + h * 128 + pd : 1792 + h * 64 + pd;
    const int vcol = (MODE ? 3072 : 2048) + h * 128 + ve;
    const int gcol = dir * 256 + h * 64 + pd;
    unsigned rqkA[NSB][16], rv2A[2][8], rqkB[NSB][16], rv2B[2][8]; float rgA[NSB][16], rgB[NSB][16];
    const long rstep = dir ? -1 : 1;
    auto load_raw = [&](int ck, auto& rqk, auto& rv2, auto& rg) {
#pragma unroll
      for (int sb = 0; sb < NSB; ++sb) {
        const int pi = MODE ? pi0 + 2 * sb : pi0;
        const int row0 = tokrow(ck * 64 + 16 * pi);
        const bf16_t* pr = p.P + (size_t)row0 * LDP;
        const float* gr = p.Gk + (size_t)row0 * 512 + gcol;
#pragma unroll
        for (int tt = 0; tt < 16; ++tt) {
          rqk[sb][tt] = (unsigned)pr[qcol] | ((unsigned)pr[kcol] << 16);
          if (MODE == 0) { rg[sb][tt] = *gr; gr += rstep * 512; }
          pr += rstep * LDP;
        }
      }
#pragma unroll
      for (int sv = 0; sv < 2; ++sv) {
        const int row0 = tokrow(ck * 64 + 16 * (vi0 + 2 * sv));
        const bf16_t* pv = p.P + (size_t)row0 * LDP + vcol;
#pragma unroll
        for (int tt = 0; tt < 16; ++tt) {
          const unsigned vv = *pv; pv += rstep * LDP;
          if (tt & 1) rv2[sv][tt >> 1] |= vv << 16; else rv2[sv][tt >> 1] = vv;
        }
      }
    };
    auto prep = [&](int bi, auto& rqk, auto& rv2, auto& rg) {
      bf16_t* Qh_ = Qh + bi * BUFE; bf16_t* Kh_ = Kh + bi * BUFE; bf16_t* KbT_ = KbT + bi * BUFE; bf16_t* VT_ = VT + bi * BUFE; float* ET_ = (float*)(VT_ + 128 * TS);
#pragma unroll
      for (int sb = 0; sb < NSB; ++sb) {
        const int pi = MODE ? pi0 + 2 * sb : pi0;
        float E = 1.f, kh[16];
#pragma unroll
        for (int tt = 0; tt < 16; ++tt) {
          float q, k, dec;
          if (MODE == 1) {
            q = __uint_as_float(rqk[sb][tt] << 16);
            k = __uint_as_float(rqk[sb][tt] & 0xffff0000u);
            dec = 1.f - k;
          } else { q = __uint_as_float(rqk[sb][tt] << 16) * 0.125f; k = __uint_as_float(rqk[sb][tt] & 0xffff0000u); dec = rg[sb][tt]; }
          E *= dec;
          const float kE = k * __builtin_amdgcn_rcpf(E);
          kh[tt] = kE;
          Qh_[(16 * pi + tt) * QS + pd] = f2bf(q * E);
          Kh_[(16 * pi + tt) * QS + pd] = f2bf(kE);
        }
        ET_[pi * DK + pd] = E;
        unsigned w[8];
#pragma unroll
        for (int u = 0; u < 8; ++u) w[u] = pack2(kh[2 * u] * E, kh[2 * u + 1] * E);
        *(uint4*)(KbT_ + pd * TS + 16 * pi) = make_uint4(w[0], w[1], w[2], w[3]);
        *(uint4*)(KbT_ + pd * TS + 16 * pi + 8) = make_uint4(w[4], w[5], w[6], w[7]);
      }
#pragma unroll
      for (int sv = 0; sv < 2; ++sv) {
        const int vi = vi0 + 2 * sv;
        *(uint4*)(VT_ + ve * TS + 16 * vi) = make_uint4(rv2[sv][0], rv2[sv][1], rv2[sv][2], rv2[sv][3]);
        *(uint4*)(VT_ + ve * TS + 16 * vi + 8) = make_uint4(rv2[sv][4], rv2[sv][5], rv2[sv][6], rv2[sv][7]);
      }
    };
    load_raw(0, rqkA, rv2A, rgA);
    load_raw(1, rqkB, rv2B, rgB);
    prep(0, rqkA, rv2A, rgA);
    load_raw(2, rqkA, rv2A, rgA);
    LDS_BARRIER();
    for (int ck = 0; ck < NCK; ck += 2) {
      if (ck + 1 < NCK) { prep((ck + 1) & 1, rqkB, rv2B, rgB); if (ck + 3 < NCK) load_raw(ck + 3, rqkB, rv2B, rgB); }
      LDS_BARRIER();
      if (ck + 2 < NCK) { prep((ck + 2) & 1, rqkA, rv2A, rgA); if (ck + 4 < NCK) load_raw(ck + 4, rqkA, rv2A, rgA); }
      LDS_BARRIER();
    }
  } else {
    bf16_t* Ro; int ldo;
    if (MODE == 0) { Ro = p.R2 + (size_t)dir * MT * 512; ldo = 512; } else { Ro = dir ? p.R2 : p.R1; ldo = 1024; }
    Ro += h * 128 + 32 * wave + r15;
    f32x4 S[2][NDB];
#pragma unroll
    for (int eb = 0; eb < 2; ++eb)
#pragma unroll
      for (int db = 0; db < NDB; ++db) S[eb][db] = (f32x4){0.f, 0.f, 0.f, 0.f};
    const s16x4 z4 = (s16x4){0, 0, 0, 0};
#if SCANPROBE
    unsigned long long twait = 0;
#endif
    LDS_BARRIER();
    for (int ck = 0; ck < NCK; ++ck) {
      const int bo = (ck & 1) * BUFE;
      const bf16_t* Qb = Qh + bo; const bf16_t* Kb = Kh + bo; const bf16_t* KTb = KbT + bo; const bf16_t* Vb = VT + bo; const float* Eb = (const float*)(Vb + 128 * TS);
#pragma unroll
      for (int i = 0; i < 4; ++i) {
        bf16x8 ka_[DK / 32], qb_[DK / 32], qa_[DK / 32], ka8_[NDB], vb8[2];
        float4 et_[NDB];
#pragma unroll
        for (int kb = 0; kb < DK / 32; ++kb) {
          ka_[kb] = *(const bf16x8*)(Kb + (16 * i + r15) * QS + 32 * kb + 8 * fq);
          qb_[kb] = *(const bf16x8*)(Qb + (16 * i + r15) * QS + 32 * kb + 8 * fq);
        }
#pragma unroll
        for (int kb = 0; kb < DK / 32; ++kb) {
          const s16x4 qlo = *(const s16x4*)(Qb + (16 * i + r15) * QS + 32 * kb + 4 * fq);
          const s16x4 qhi = *(const s16x4*)(Qb + (16 * i + r15) * QS + 32 * kb + 16 + 4 * fq);
          qa_[kb] = __builtin_shufflevector(qlo, qhi, 0, 1, 2, 3, 4, 5, 6, 7);
        }
#pragma unroll
        for (int eb = 0; eb < 2; ++eb) {
          const s16x4 vb = *(const s16x4*)(Vb + (32 * wave + 16 * eb + r15) * TS + 16 * i + 4 * fq);
          vb8[eb] = __builtin_shufflevector(vb, z4, 0, 1, 2, 3, 4, 5, 6, 7);
        }
#pragma unroll
        for (int db = 0; db < NDB; ++db) {
          et_[db] = *(const float4*)(Eb + i * DK + 16 * db + 4 * fq);
          const s16x4 ka = *(const s16x4*)(KTb + (16 * db + r15) * TS + 16 * i + 4 * fq);
          ka8_[db] = __builtin_shufflevector(ka, z4, 0, 1, 2, 3, 4, 5, 6, 7);
        }
        __builtin_amdgcn_sched_barrier(0);
        f32x4 att = (f32x4){0.f, 0.f, 0.f, 0.f};
#pragma unroll
        for (int kb = 0; kb < DK / 32; ++kb) att = __builtin_amdgcn_mfma_f32_16x16x32_bf16(ka_[kb], qb_[kb], att, 0, 0, 0);
        f32x4 o[2];
        o[0] = (f32x4){0.f, 0.f, 0.f, 0.f}; o[1] = (f32x4){0.f, 0.f, 0.f, 0.f};
#pragma unroll
        for (int kb = 0; kb < DK / 32; ++kb) {
#pragma unroll
          for (int eb = 0; eb < 2; ++eb) {
            const bf16x8 sb = __builtin_bit_cast(bf16x8, make_uint4(pack2(S[eb][2 * kb][0], S[eb][2 * kb][1]), pack2(S[eb][2 * kb][2], S[eb][2 * kb][3]),
                                                                      pack2(S[eb][2 * kb + 1][0], S[eb][2 * kb + 1][1]), pack2(S[eb][2 * kb + 1][2], S[eb][2 * kb + 1][3])));
            o[eb] = __builtin_amdgcn_mfma_f32_16x16x32_bf16(qa_[kb], sb, o[eb], 0, 0, 0);
          }
        }
#pragma unroll
        for (int db = 0; db < NDB; ++db) {
#pragma unroll
          for (int eb = 0; eb < 2; ++eb) {
            f32x4 s = S[eb][db];
            s[0] *= et_[db].x; s[1] *= et_[db].y; s[2] *= et_[db].z; s[3] *= et_[db].w;
            S[eb][db] = __builtin_amdgcn_mfma_f32_16x16x32_bf16(ka8_[db], vb8[eb], s, 0, 0, 0);
          }
        }
        const unsigned a01 = pack2((4 * fq + 0 <= r15) ? att[0] : 0.f, (4 * fq + 1 <= r15) ? att[1] : 0.f);
        const unsigned a23 = pack2((4 * fq + 2 <= r15) ? att[2] : 0.f, (4 * fq + 3 <= r15) ? att[3] : 0.f);
        const bf16x8 a8 = __builtin_bit_cast(bf16x8, make_uint4(a01, a23, 0u, 0u));
#pragma unroll
        for (int eb = 0; eb < 2; ++eb) o[eb] = __builtin_amdgcn_mfma_f32_16x16x32_bf16(a8, vb8[eb], o[eb], 0, 0, 0);
#if STOREPROBE
        for (int rep = 0; rep < 2; ++rep) {
        asm volatile("" ::: "memory");
#endif
#pragma unroll
        for (int jj = 0; jj < 4; ++jj) {
          const int row = tokrow(ck * 64 + 16 * i + 4 * fq + jj);
          Ro[(size_t)row * ldo] = f2bf(o[0][jj]);
          Ro[(size_t)row * ldo + 16] = f2bf(o[1][jj]);
        }
#if STOREPROBE
        }
#endif
      }
#if SCANPROBE
      const unsigned long long tb0 = __builtin_amdgcn_s_memrealtime();
      LDS_BARRIER();
      twait += __builtin_amdgcn_s_memrealtime() - tb0;
#else
      LDS_BARRIER();
#endif
    }
#if SCANPROBE
    if (MODE == 1 && blockIdx.x == 0 && tid == 0) { p.ctr[48] += (unsigned)twait; }
#endif
  }
}

DI void unpack8(const uint4& r, float (&v)[8]) {
  v[0] = __uint_as_float(r.x << 16); v[1] = __uint_as_float(r.x & 0xffff0000u); v[2] = __uint_as_float(r.y << 16); v[3] = __uint_as_float(r.y & 0xffff0000u);
  v[4] = __uint_as_float(r.z << 16); v[5] = __uint_as_float(r.z & 0xffff0000u); v[6] = __uint_as_float(r.w << 16); v[7] = __uint_as_float(r.w & 0xffff0000u);
}
DI float sum16(float s) { s += __shfl_xor(s, 1, 64); s += __shfl_xor(s, 2, 64); s += __shfl_xor(s, 4, 64); s += __shfl_xor(s, 8, 64); return s; }

__device__ void phase_post_even(const Params& p, int l) {
  const int j = l >> 1;
  const int wave = TID() >> 6, lane = TID() & 63;
  const float lambda_init = 0.8f - 0.6f * expf(-0.3f * (float)l);
  const float* la = p.lambda_a + j * 256;
  const float s1 = wave_sum(la[lane] * la[64 + lane]);
  const float s2 = wave_sum(la[128 + lane] * la[192 + lane]);
  const float lam = expf(s1) - expf(s2) + lambda_init;
  const int e0 = 8 * (lane & 15);
  float ga[8], gb[8];
#pragma unroll
  for (int u = 0; u < 8; ++u) { ga[u] = p.subln[j * 128 + e0 + u] * (1.f - lambda_init); gb[u] = p.onorm_b[j * 128 + e0 + u]; }
  const int gw = blockIdx.x * 8 + wave, nw = gridDim.x * 8;
  for (int blk = gw; blk < MT / 4; blk += nw) {
    uint4 A1[4], A2[4], Bf[4], Bb[4], G[4];
#pragma unroll
    for (int k = 0; k < 4; ++k) {
      const int row = blk * 4 + k;
      const bf16_t* r1 = p.R1 + (size_t)row * D;
      A1[k] = *(const uint4*)(r1 + lane * 8); A2[k] = *(const uint4*)(r1 + 512 + lane * 8);
      Bf[k] = *(const uint4*)(p.R2 + (size_t)row * 512 + lane * 8);
      Bb[k] = *(const uint4*)(p.R2 + (size_t)MT * 512 + (size_t)row * 512 + lane * 8);
      G[k] = *(const uint4*)(p.P + (size_t)row * LDP_E + 2560 + lane * 8);
    }
#pragma unroll
    for (int k = 0; k < 4; ++k) {
      const int row = blk * 4 + k;
      float a1[8], a2[8], bf_[8], bb_[8], g[8], x[8], y[8];
      unpack8(A1[k], a1); unpack8(A2[k], a2); unpack8(Bf[k], bf_); unpack8(Bb[k], bb_); unpack8(G[k], g);
      float sx = 0.f, sy = 0.f;
#pragma unroll
      for (int u = 0; u < 8; ++u) { x[u] = a1[u] - lam * a2[u]; y[u] = bf_[u] + bb_[u]; sx += x[u] * x[u]; sy += y[u] * y[u]; }
      const float ra = rsqrtf(sum16(sx) * (1.f / 128.f) + EPSN), rb = rsqrtf(sum16(sy) * (1.f / 128.f) + EPSN);
#pragma unroll
      for (int u = 0; u < 8; ++u) { x[u] = x[u] * ra * ga[u]; y[u] = y[u] * rb * gb[u] * siluf(g[u]); }
      bf16_t* r1 = p.R1 + (size_t)row * D;
      *(uint4*)(r1 + lane * 8) = make_uint4(pack2(x[0], x[1]), pack2(x[2], x[3]), pack2(x[4], x[5]), pack2(x[6], x[7]));
      *(uint4*)(r1 + 512 + lane * 8) = make_uint4(pack2(y[0], y[1]), pack2(y[2], y[3]), pack2(y[4], y[5]), pack2(y[6], y[7]));
    }
  }
}

__device__ void phase_post_odd(const Params& p, int l, int nrows) {
  const int j = l >> 1;
  const int wave = TID() >> 6, lane = TID() & 63;
  const int e0 = 8 * (lane & 15);
  float gc[8];
#pragma unroll
  for (int u = 0; u < 8; ++u) gc[u] = p.onorm_c[j * 128 + e0 + u];
  const int gw = blockIdx.x * 8 + wave, nw = gridDim.x * 8;
  for (int blk = gw; blk < nrows / 2; blk += nw) {
    uint4 A[2][2], B[2][2], G[2][2];
#pragma unroll
    for (int k = 0; k < 2; ++k)
#pragma unroll
      for (int hf = 0; hf < 2; ++hf) {
        const int row = blk * 2 + k;
        A[k][hf] = *(const uint4*)(p.R1 + (size_t)row * D + hf * 512 + lane * 8);
        B[k][hf] = *(const uint4*)(p.R2 + (size_t)row * D + hf * 512 + lane * 8);
        G[k][hf] = *(const uint4*)(p.P + (size_t)row * LDP_O + 4096 + hf * 512 + lane * 8);
      }
#pragma unroll
    for (int k = 0; k < 2; ++k)
#pragma unroll
      for (int hf = 0; hf < 2; ++hf) {
        const int row = blk * 2 + k;
        float a[8], bq[8], g[8], y[8];
        unpack8(A[k][hf], a); unpack8(B[k][hf], bq); unpack8(G[k][hf], g);
        float sy = 0.f;
#pragma unroll
        for (int u = 0; u < 8; ++u) { y[u] = a[u] + bq[u]; sy += y[u] * y[u]; }
        const float rb = rsqrtf(sum16(sy) * (1.f / 128.f) + EPSN);
#pragma unroll
        for (int u = 0; u < 8; ++u) y[u] = y[u] * rb * gc[u] * siluf(g[u]);
        *(uint4*)(p.R1 + (size_t)row * D + hf * 512 + lane * 8) = make_uint4(pack2(y[0], y[1]), pack2(y[2], y[3]), pack2(y[4], y[5]), pack2(y[6], y[7]));
      }
  }
}

constexpr int NPHASE = 1 + 4 * 9;
#ifndef GEMM_INL
#define GEMM_INL
#endif
__device__ GEMM_INL void gemm_call_p(const bf16_t* A, const bf16_t* Bt, int M, int N, int K, EpiArgs ea) { gemm_phase<EPI_P>(A, Bt, M, N, K, ea); }
__device__ GEMM_INL void gemm_call_res(const bf16_t* A, const bf16_t* Bt, int M, int N, int K, EpiArgs ea) { gemm_phase<EPI_RES>(A, Bt, M, N, K, ea); }
__device__ GEMM_INL void gemm_call_sw(const bf16_t* A, const bf16_t* Bt, int M, int N, int K, EpiArgs ea) { gemm_phase<EPI_SWIGLU>(A, Bt, M, N, K, ea); }

__device__ void run_phase(const Params& p, int ph) {
  if (ph == 0) { phase_init(p); return; }
  const int l = (ph - 1) / 9, s = (ph - 1) % 9, j = l >> 1;
  const bool even = (l & 1) == 0;
  const int mrows = l < 3 ? MT : ML;
  const float* modl = p.mod + (size_t)l * 9 * 6144;
  float* slab = (float*)(p.P + (size_t)56 * 1024 * 1024);
  if (s == 1 || s == 5 || s == 8) {
    if (s == 1) {
      EpiArgs ea{p.P, even ? LDP_E : LDP_O, nullptr, nullptr, nullptr, nullptr, nullptr, even ? nullptr : p.lb_raw, l, nullptr, nullptr, nullptr, nullptr, nullptr, 0, 0};
      const bf16_t* Bt = even ? p.wt_in_even + (size_t)j * LDP_E * 1024 : p.wt_in_odd + (size_t)j * LDP_O * 1024;
      gemm_call_p(p.R1, Bt, MT, even ? LDP_E : LDP_O, 1024, ea);
    } else {
      const bool fuse = FUSE_NORM && gridDim.x == 256 && (s == 5 || l < 3);
      const int inst = l * 2 + (s == 8 ? 1 : 0), ln = s == 5 ? l : l + 1;
      EpiArgs ea{nullptr, 0, p.out, p.Z, modl + (s == 5 ? 2 : 5) * 1024, slab, (l == 0 && s == 5) ? p.x : p.out, nullptr, 0,
                 fuse ? p.rowss + (size_t)inst * ML : nullptr, p.pcnt + (size_t)inst * 64 * 32, s == 5 ? p.R2 : p.R1,
                 (s == 5 ? p.n2g : p.n1g) + (fuse ? ln : 0) * 1024, p.mod + (size_t)(fuse ? ln : 0) * 9 * 6144, s == 5 ? 3 : 0, s == 5 ? 4 : 1};
      const bf16_t* A = s == 5 ? p.R1 : p.P;
      const bf16_t* Bt = s == 5 ? (even ? p.wt_out_even : p.wt_out_odd) + (size_t)j * 1024 * 1024 : p.wt_ffn_out + (size_t)l * 1024 * DFF;
      gemm_call_res(A, Bt, mrows, 1024, s == 5 ? 1024 : DFF, ea);
    }
    return;
  }
  switch (s) {
    case 0: phase_norm(p, l, 0, MT, p.R1, l > 0 ? p.mod + ((size_t)(l - 1) * 9 + 8) * 6144 + 5 * 1024 : nullptr, slab, l == 0 ? p.x : p.out, l == 0 ? p.ctx : p.Z, FUSE_NORM && gridDim.x == 256 && l > 0); break;
    case 2: if (even) phase_prep_even(p, j); break;
    case 3: {
      if (even) {
#if DYNQ
        int* qs = (int*)(smem_raw + LDS_BYTES - 16);
        for (;;) {
          __syncthreads();
          if (TID() == 0) *qs = (int)atomicAdd(p.ctr + l, 1u);
          __syncthreads();
          const int it = *qs;
          if (it >= 64 + 576) break;
#if ITEMPROBE
          const unsigned long long ti0 = __builtin_amdgcn_s_memrealtime();
#endif
          if (it < 64) scan3_item<0>(p, l, it); else attn_item(p, it - 64);
#if ITEMPROBE
          __syncthreads();
          if (blockIdx.x == ITEMPROBE_BLOCK && TID() == 0 && ((it < 64) == (ITEMPROBE == 1))) p.ctr[48] += (unsigned)(__builtin_amdgcn_s_memrealtime() - ti0);
#endif
        }
#else
#if EXP1
        for (int it = blockIdx.x; it < 256 + 576; it += gridDim.x) { if (it < 256) scan_item<0>(p, l, it); else attn_item(p, it - 256); }
#else
        for (int it = blockIdx.x; it < 64 + 576; it += gridDim.x) { if (it < 64) scan3_item<0>(p, l, it); else attn_item(p, it - 64); }
#endif
#endif
      } else {
        for (int it = blockIdx.x; it < 128; it += gridDim.x) scan3_item<1>(p, l, it);
        if (l == 1 && gridDim.x > 128 && blockIdx.x >= 128) { convert_weights(p, 1, blockIdx.x - 128, gridDim.x - 128); mod_table(p, 2, 2, blockIdx.x - 128, gridDim.x - 128); }
      }
    } break;
    case 4: if (even) phase_post_even(p, l); else phase_post_odd(p, l, mrows); break;
    case 6: phase_norm(p, l, 1, mrows, p.R2, l < 3 ? modl + (size_t)8 * 6144 + 2 * 1024 : nullptr, slab, p.out, l == 0 ? p.ctx : p.Z, FUSE_NORM && gridDim.x == 256); break;
    case 7: {
      EpiArgs ea{p.P, DFF, nullptr, nullptr, nullptr, nullptr, nullptr, nullptr, 0, nullptr, nullptr, nullptr, nullptr, nullptr, 0, 0};
      gemm_call_sw(p.R2, p.wt_ffn_in + (size_t)l * 5632 * 1024, mrows, 5632, 1024, ea);
    } break;
  }
}

#define XB_TMO      128
#define XB_XCNT(j)  (256  + 64 * (j))
#define XB_XSUB(j)  (1280 + 64 * (j))
#define XB_XGEN(j)  (2304 + 64 * (j))
#define XB_TOP      3328
#define XB_TOPGEN   3392
#define XCD_BAR_WORDS 3456
#define XB_SPIN_CAP (1u << 20)
DI unsigned xb_ld(unsigned* p)              { return __hip_atomic_load(p, __ATOMIC_RELAXED, __HIP_MEMORY_SCOPE_AGENT); }
DI unsigned xb_add(unsigned* p, unsigned v) { return __hip_atomic_fetch_add(p, v, __ATOMIC_RELAXED, __HIP_MEMORY_SCOPE_AGENT); }
DI unsigned xb_xcc_id() { return (unsigned)__builtin_amdgcn_s_getreg((3 << 11) | 20) & 0xFu; }
#define XB_SPIN(cond, bar) do { unsigned _sp = 0; while (cond) { __builtin_amdgcn_s_sleep(1); \
    if ((++_sp & 255u) == 0u) { if (xb_ld(&(bar)[XB_TMO])) break; if (_sp > XB_SPIN_CAP) { atomicAdd(&(bar)[XB_TMO], 1u); break; } } } } while (0)
struct XcdBarrier { unsigned* bar; unsigned x; volatile LAS unsigned* st; };
DI XcdBarrier xcd_barrier_post(unsigned* bar, volatile LAS unsigned* st) {
  XcdBarrier b; b.bar = bar; b.x = xb_xcc_id(); b.st = st;
  if (threadIdx.x == 0) (void)xb_add(&bar[XB_XCNT(b.x)], 1u);
  return b;
}
DI void xcd_barrier_complete(unsigned* bar, unsigned x, unsigned& nloc, unsigned& nx) {
  const unsigned G = gridDim.x * gridDim.y * gridDim.z;
  unsigned sum, cnt, mine, sp = 0u;
  for (;;) {
    sum = 0u; cnt = 0u; mine = 0u;
#pragma unroll
    for (unsigned j = 0; j < 16; ++j) { const unsigned c = xb_ld(&bar[XB_XCNT(j)]); sum += c; cnt += (c > 0u) ? 1u : 0u; mine = (j == x) ? c : mine; }
    if (sum == G) break;
    __builtin_amdgcn_s_sleep(1);
    if ((++sp & 255u) == 0u) { if (xb_ld(&bar[XB_TMO])) break; if (sp > XB_SPIN_CAP) { atomicAdd(&bar[XB_TMO], 1u); break; } }
  }
  nloc = mine > 0u ? mine : 1u; nx = cnt > 0u ? cnt : 1u;
}
DI void xcd_barrier(const XcdBarrier& b) {
  asm volatile("s_waitcnt vmcnt(0)" ::: "memory");
  __syncthreads();
  if (threadIdx.x == 0) {
    unsigned* bar = b.bar;
    __builtin_amdgcn_s_waitcnt(0);
    unsigned nloc = b.st[0], nx = b.st[1];
    if (nloc == 0u) { xcd_barrier_complete(bar, b.x, nloc, nx); b.st[0] = nloc; b.st[1] = nx; }
    const unsigned old = xb_add(&bar[XB_XSUB(b.x)], 1u);
    const unsigned gen = old / nloc;
    if (old + 1u == (gen + 1u) * nloc) {
      __builtin_amdgcn_fence(__ATOMIC_RELEASE, "agent");
      asm volatile("s_waitcnt vmcnt(0)" ::: "memory");
      const unsigned og = xb_add(&bar[XB_TOP], 1u);
      const unsigned tg = og / nx;
      if (og + 1u == (tg + 1u) * nx) xb_add(&bar[XB_TOPGEN], 1u);
      else XB_SPIN(xb_ld(&bar[XB_TOPGEN]) == tg, bar);
      __builtin_amdgcn_fence(__ATOMIC_ACQUIRE, "agent");
      xb_add(&bar[XB_XGEN(b.x)], 1u);
      asm volatile("s_waitcnt vmcnt(0)" ::: "memory");
    } else {
      XB_SPIN(xb_ld(&bar[XB_XGEN(b.x)]) == gen, bar);
      __builtin_amdgcn_fence(__ATOMIC_ACQUIRE, "agent");
      asm volatile("s_waitcnt vmcnt(0)" ::: "memory");
    }
  }
  __syncthreads();
}

DI void grid_barrier(unsigned* ctr, unsigned target) {
  asm volatile("s_waitcnt vmcnt(0)" ::: "memory");
  __syncthreads();
  if (threadIdx.x == 0) {
    __builtin_amdgcn_fence(__ATOMIC_RELEASE, "agent");
    asm volatile("s_waitcnt vmcnt(0)" ::: "memory");
    __hip_atomic_fetch_add(ctr, 1u, __ATOMIC_RELAXED, __HIP_MEMORY_SCOPE_AGENT);
    unsigned spins = 0;
    while (__hip_atomic_load(ctr, __ATOMIC_RELAXED, __HIP_MEMORY_SCOPE_AGENT) < target) { __builtin_amdgcn_s_sleep(1); if (++spins > (1u << 24)) break; }
  }
  __syncthreads();
  __builtin_amdgcn_fence(__ATOMIC_ACQUIRE, "agent");
  asm volatile("s_waitcnt vmcnt(0)" ::: "memory");
}

__global__ void __launch_bounds__(NTHR, 2) mega_kernel(Params p, int ph0, int ph1) {
  cg::grid_group grid = cg::this_grid();
  unsigned nbar = 0;
#if CUSTOM_BAR == 2
  volatile LAS unsigned* xst = (volatile LAS unsigned*)(LAS unsigned*)(smem_raw + LDS_BYTES - 32);
  if (threadIdx.x == 0) { xst[0] = 0u; xst[1] = 0u; }
  __syncthreads();
  XcdBarrier xbar = xcd_barrier_post(p.xbar, xst);
#endif
#if PROBE_SEL
  unsigned long long t_acc = 0;
#endif
  for (int ph = ph0; ph < ph1; ++ph) {
#if PROBE_SEL
    const unsigned long long t_beg = __builtin_amdgcn_s_memrealtime();
#endif
#if DBL_MASK
    { const int s_ = ph == 0 ? 9 : (ph - 1) % 9; const int nrep = ((DBL_MASK >> s_) & 1) ? 2 : 1; for (int rep = 0; rep < nrep; ++rep) run_phase(p, ph); }
#else
    run_phase(p, ph);
#endif
    if (ph + 1 < ph1) {
      if (ph > 0) { const int s_ = (ph - 1) % 9, l_ = (ph - 1) / 9; if (s_ == 2 && (l_ & 1)) continue; }
#if CUSTOM_BAR == 2
      if (ph1 > 4096) grid.sync();
      xcd_barrier(xbar);
#elif CUSTOM_BAR
      if (ph == 0) grid.sync(); else { ++nbar; grid_barrier(p.ctr + 32, nbar * gridDim.x); }
#if EXTRA_SYNC
      if (ph > 0) { ++nbar; grid_barrier(p.ctr + 32, nbar * gridDim.x); ++nbar; grid_barrier(p.ctr + 32, nbar * gridDim.x); }
#endif
#else
      grid.sync();
#endif
#if PROBE_SEL
      { const int s_ = ph == 0 ? 9 : (ph - 1) % 9, l_ = ph == 0 ? 0 : (ph - 1) / 9;
        if (((PROBE_SEL >> s_) & 1) && ((PROBE_LAYERS >> l_) & 1)) t_acc += __builtin_amdgcn_s_memrealtime() - t_beg; }
#endif
    }
  }
#if PROBE_SEL
  { const unsigned long long t0 = __builtin_amdgcn_s_memrealtime(); while (__builtin_amdgcn_s_memrealtime() - t0 < t_acc) __builtin_amdgcn_s_sleep(8); }
#endif
#if SCANPROBE || ITEMPROBE
  if (blockIdx.x == ITEMPROBE_BLOCK) { const unsigned long long tw = p.ctr[48]; const unsigned long long t0 = __builtin_amdgcn_s_memrealtime(); while (__builtin_amdgcn_s_memrealtime() - t0 < tw) __builtin_amdgcn_s_sleep(8); }
#endif
}

extern "C" void kernel_launch(void* const* d_in, const int* in_sizes, int n_in, void* d_out, int out_size, void* d_ws, size_t ws_size, hipStream_t stream) {
  constexpr size_t kDynLds = LDS_BYTES;
  static int grid_blocks = 0;
  if (!grid_blocks) {
    hipFuncSetAttribute((const void*)mega_kernel, hipFuncAttributeMaxDynamicSharedMemorySize, (int)kDynLds);
    int dev = 0, cus = 0, per_cu = 0;
    hipGetDevice(&dev);
    hipDeviceGetAttribute(&cus, hipDeviceAttributeMultiprocessorCount, dev);
    hipOccupancyMaxActiveBlocksPerMultiprocessor(&per_cu, mega_kernel, NTHR, kDynLds);
    if (per_cu < 1) per_cu = 1;
    grid_blocks = cus * per_cu;
  }
  Params p{};
  const float* const* in = (const float* const*)d_in;
  p.x = in[0]; p.c = in[1]; p.ctx = in[2]; p.c_ctx = in[3]; p.w_ada = in[4]; p.b_ada = in[5]; p.n1g = in[6]; p.n2g = in[7];
  p.w_in_even = in[8]; p.qk_gain = in[9]; p.lambda_a = in[10]; p.subln = in[11]; p.w_gate_up = in[12]; p.b_gate_up = in[13];
  p.onorm_b = in[14]; p.w_out_even = in[15]; p.w_in_odd = in[16]; p.lb_raw = in[17]; p.onorm_c = in[18]; p.w_out_odd = in[19];
  p.w_ffn_in = in[20]; p.w_ffn_out = in[21];
  p.out = (float*)d_out;
  char* w = (char*)d_ws;
  size_t off = 0;
  auto take = [&](size_t bytes) { char* r = w + off; off += (bytes + 255) & ~(size_t)255; return r; };
  p.wt_in_even = (bf16_t*)take((size_t)2 * LDP_E * 1024 * 2);
  p.wt_in_odd = (bf16_t*)take((size_t)2 * LDP_O * 1024 * 2);
  p.wt_out_even = (bf16_t*)take((size_t)2 * 1024 * 1024 * 2);
  p.wt_out_odd = (bf16_t*)take((size_t)2 * 1024 * 1024 * 2);
  p.wt_ffn_in = (bf16_t*)take((size_t)4 * 5632 * 1024 * 2);
  p.wt_ffn_out = (bf16_t*)take((size_t)4 * 1024 * DFF * 2);
  p.Z = (float*)take((size_t)MC * D * 4);
  p.mod = (float*)take((size_t)4 * 9 * 6144 * 4);
  p.P = (bf16_t*)take((size_t)MT * LDP_O * 2);
  p.R1 = (bf16_t*)take((size_t)MT * D * 2);
  p.R2 = (bf16_t*)take((size_t)MT * D * 2);
  p.Vt = p.P + (size_t)MT * LDP_E;
  p.Gk = (float*)(p.Vt + (size_t)NB * 4 * 128 * NKK);
  p.ctr = (unsigned*)take(256);
  p.xbar = (unsigned*)take(16384);
  p.rowss = (float*)take((size_t)8 * ML * 4);
  p.pcnt = (unsigned*)take((size_t)8 * 64 * 32 * 4);
  if (off > ws_size) { fprintf(stderr, "workspace too small: need %zu have %zu\n", off, ws_size); return; }
  hipMemsetAsync(p.ctr, 0, 256 + 16384 + (size_t)8 * ML * 4 + (size_t)8 * 64 * 32 * 4, stream);
#if ONE_LAUNCH
  int ph0 = 0, ph1 = NPHASE;
  void* args[] = {&p, &ph0, &ph1};
  hipError_t e = hipLaunchCooperativeKernel((const void*)mega_kernel, dim3(grid_blocks), dim3(NTHR), args, kDynLds, stream);
  if (e != hipSuccess) fprintf(stderr, "cooperative launch failed: %s (grid %d)\n", hipGetErrorString(e), grid_blocks);
#else
  for (int ph = 0; ph < NPHASE; ++ph) {
    const int l = (ph - 1) / 9, s = (ph - 1) % 9;
    if (ph > 0 && s == 2 && (l & 1)) continue;
    mega_kernel<<<grid_blocks, NTHR, kDynLds, stream>>>(p, ph, ph + 1);
  }
#endif
}
```

```cpp
#include <hip/hip_runtime.h>
#include <hip/hip_cooperative_groups.h>
#include <cstdio>
namespace cg = cooperative_groups;

#ifndef DYNQ
#define DYNQ 1
#endif
#ifndef EXP1
#define EXP1 0
#endif
#ifndef EXP2
#define EXP2 0
#endif
#ifndef EXTRA_SYNC
#define EXTRA_SYNC 0
#endif
#ifndef CUSTOM_BAR
#define CUSTOM_BAR 2
#endif
#ifndef PROBE_SEL
#define PROBE_SEL 0
#define PROBE_LAYERS 15
#endif
#ifndef SCANPROBE
#define SCANPROBE 0
#endif
#ifndef STOREPROBE
#define STOREPROBE 0
#endif
#ifndef ITEMPROBE
#define ITEMPROBE 0
#define ITEMPROBE_BLOCK 0
#endif
#ifndef FUSE_NORM
#define FUSE_NORM 1
#endif
#ifndef DBL_MASK
#define DBL_MASK 0
#endif
#ifndef ONE_LAUNCH
#define ONE_LAUNCH 1
#endif

typedef unsigned short bf16_t;
typedef short bf16x8 __attribute__((ext_vector_type(8)));
typedef short s16x4 __attribute__((ext_vector_type(4)));
typedef float f32x4 __attribute__((ext_vector_type(4)));
typedef float f32x16 __attribute__((ext_vector_type(16)));
#define DI __device__ __forceinline__

__device__ const float ROPE_CS[64][16] = {
  {1.00000000e+00f,1.00000000e+00f,1.00000000e+00f,1.00000000e+00f,1.00000000e+00f,1.00000000e+00f,1.00000000e+00f,1.00000000e+00f,1.00000000e+00f,1.00000000e+00f,1.00000000e+00f,1.00000000e+00f,1.00000000e+00f,1.00000000e+00f,1.00000000e+00f,1.00000000e+00f},
  {5.40302277e-01f,8.46009135e-01f,9.50415254e-01f,9.84230220e-01f,9.95004177e-01f,9.98419285e-01f,9.99500036e-01f,9.99841869e-01f,9.99949992e-01f,9.99984205e-01f,9.99994993e-01f,9.99998391e-01f,9.99999523e-01f,9.99999821e-01f,9.99999940e-01f,1.00000000e+00f},
  {-4.16146845e-01f,4.31462824e-01f,8.06578398e-01f,9.37418282e-01f,9.80066597e-01f,9.93682086e-01f,9.98000681e-01f,9.99367595e-01f,9.99800026e-01f,9.99936759e-01f,9.99979973e-01f,9.99993682e-01f,9.99997973e-01f,9.99999344e-01f,9.99999821e-01f,9.99999940e-01f},
  {-9.89992499e-01f,-1.15966164e-01f,5.82753658e-01f,8.61040652e-01f,9.55336511e-01f,9.85803485e-01f,9.95503366e-01f,9.98577297e-01f,9.99550045e-01f,9.99857724e-01f,9.99954998e-01f,9.99985754e-01f,9.99995530e-01f,9.99998569e-01f,9.99999523e-01f,9.99999881e-01f},
  {-6.53643608e-01f,-6.27679706e-01f,3.01137477e-01f,7.57506192e-01f,9.21060979e-01f,9.74808276e-01f,9.92010653e-01f,9.97471273e-01f,9.99200106e-01f,9.99747038e-01f,9.99920011e-01f,9.99974728e-01f,9.99992013e-01f,9.99997497e-01f,9.99999225e-01f,9.99999762e-01f},
  {2.83662200e-01f,-9.46079254e-01f,-1.03423381e-02f,6.30080283e-01f,8.77582550e-01f,9.60731268e-01f,9.87526000e-01f,9.96049762e-01f,9.98750269e-01f,9.99604762e-01f,9.99875009e-01f,9.99960482e-01f,9.99987483e-01f,9.99996066e-01f,9.99998748e-01f,9.99999583e-01f},
  {9.60170269e-01f,-9.73103702e-01f,-3.20796400e-01f,4.82782036e-01f,8.25335622e-01f,9.43616986e-01f,9.82053936e-01f,9.94313300e-01f,9.98200536e-01f,9.99430835e-01f,9.99819994e-01f,9.99943078e-01f,9.99981999e-01f,9.99994338e-01f,9.99998212e-01f,9.99999404e-01f},
  {7.53902256e-01f,-7.00429797e-01f,-5.99437475e-01f,3.20257008e-01f,7.64842212e-01f,9.23519433e-01f,9.75599885e-01f,9.92262423e-01f,9.97551024e-01f,9.99225318e-01f,9.99755025e-01f,9.99922514e-01f,9.99975502e-01f,9.99992251e-01f,9.99997556e-01f,9.99999225e-01f},
  {-1.45500034e-01f,-2.12036446e-01f,-8.18632424e-01f,1.47631213e-01f,6.96706712e-01f,9.00502324e-01f,9.68170285e-01f,9.89897788e-01f,9.96801734e-01f,9.98988271e-01f,9.99680042e-01f,9.99898791e-01f,9.99967992e-01f,9.99989867e-01f,9.99996781e-01f,9.99998987e-01f},
  {-9.11130250e-01f,3.41660261e-01f,-9.56644177e-01f,-2.96507962e-02f,6.21609926e-01f,8.74638259e-01f,9.59772646e-01f,9.87220109e-01f,9.95952725e-01f,9.98719573e-01f,9.99595046e-01f,9.99871910e-01f,9.99959528e-01f,9.99987185e-01f,9.99995947e-01f,9.99998748e-01f},
  {-8.39071512e-01f,7.90131867e-01f,-9.99786079e-01f,-2.05997631e-01f,5.40302277e-01f,8.46009135e-01f,9.50415313e-01f,9.84230220e-01f,9.95004177e-01f,9.98419285e-01f,9.99500036e-01f,9.99841869e-01f,9.99949992e-01f,9.99984205e-01f,9.99994993e-01f,9.99998391e-01f},
  {4.42569796e-03f,9.95257378e-01f,-9.43779767e-01f,-3.75847399e-01f,4.53596085e-01f,8.14705312e-01f,9.40107584e-01f,9.80929136e-01f,9.93956089e-01f,9.98087406e-01f,9.99395072e-01f,9.99808669e-01f,9.99939501e-01f,9.99980867e-01f,9.99993920e-01f,9.99998093e-01f},
  {8.43853951e-01f,8.93861592e-01f,-7.94179380e-01f,-5.33843040e-01f,3.62357706e-01f,7.80825913e-01f,9.28859890e-01f,9.77317870e-01f,9.92808640e-01f,9.97723997e-01f,9.99280095e-01f,9.99772310e-01f,9.99927998e-01f,9.99977231e-01f,9.99992788e-01f,9.99997735e-01f},
  {9.07446802e-01f,5.17172873e-01f,-5.65820515e-01f,-6.75001681e-01f,2.67498761e-01f,7.44477987e-01f,9.16683376e-01f,9.73397553e-01f,9.91561890e-01f,9.97329056e-01f,9.99155104e-01f,9.99732792e-01f,9.99915481e-01f,9.99973297e-01f,9.99991536e-01f,9.99997318e-01f},
  {1.36737213e-01f,-1.87961515e-02f,-2.81349480e-01f,-7.94870913e-01f,1.69967160e-01f,7.05776393e-01f,9.03590262e-01f,9.69169438e-01f,9.90216017e-01f,9.96902585e-01f,9.99020159e-01f,9.99690115e-01f,9.99902010e-01f,9.99969006e-01f,9.99990225e-01f,9.99996901e-01f},
  {-7.59687901e-01f,-5.48975468e-01f,3.10223512e-02f,-8.89670432e-01f,7.07371980e-02f,6.64843500e-01f,8.89593601e-01f,9.64634836e-01f,9.88771081e-01f,9.96444523e-01f,9.98875201e-01f,9.99644279e-01f,9.99887526e-01f,9.99964416e-01f,9.99988735e-01f,9.99996424e-01f},
  {-9.57659483e-01f,-9.10081089e-01f,3.40318173e-01f,-9.56410050e-01f,-2.91995462e-02f,6.21808827e-01f,8.74707460e-01f,9.59795177e-01f,9.87227261e-01f,9.95954990e-01f,9.98720288e-01f,9.99595284e-01f,9.99872029e-01f,9.99959528e-01f,9.99987185e-01f,9.99995947e-01f},
  {-2.75163352e-01f,-9.90897954e-01f,6.15864813e-01f,-9.92985010e-01f,-1.28844544e-01f,5.76808274e-01f,8.58946681e-01f,9.54652011e-01f,9.85584795e-01f,9.95433986e-01f,9.98555362e-01f,9.99543071e-01f,9.99855518e-01f,9.99954283e-01f,9.99985576e-01f,9.99995410e-01f},
  {6.60316706e-01f,-7.66536534e-01f,8.30336154e-01f,-9.98241663e-01f,-2.27202162e-01f,5.29984176e-01f,8.42327058e-01f,9.49207008e-01f,9.83843684e-01f,9.94881511e-01f,9.98380423e-01f,9.99487758e-01f,9.99837995e-01f,9.99948800e-01f,9.99983788e-01f,9.99994874e-01f},
  {9.88704622e-01f,-3.06095392e-01f,9.62463796e-01f,-9.72014248e-01f,-3.23289543e-01f,4.81484592e-01f,8.24865162e-01f,9.43461835e-01f,9.82004225e-01f,9.94297504e-01f,9.98195529e-01f,9.99429286e-01f,9.99819517e-01f,9.99942899e-01f,9.99981940e-01f,9.99994278e-01f},
  {4.08082068e-01f,2.48616725e-01f,9.99144375e-01f,-9.15129960e-01f,-4.16146845e-01f,4.31462824e-01f,8.06578457e-01f,9.37418282e-01f,9.80066597e-01f,9.93682086e-01f,9.98000681e-01f,9.99367595e-01f,9.99800026e-01f,9.99936759e-01f,9.99979973e-01f,9.99993682e-01f},
  {-5.47729254e-01f,7.26760268e-01f,9.36740458e-01f,-8.29382956e-01f,-5.04846215e-01f,3.80077004e-01f,7.87485182e-01f,9.31078374e-01f,9.78030920e-01f,9.93035257e-01f,9.97795820e-01f,9.99302804e-01f,9.99779522e-01f,9.99930263e-01f,9.99977946e-01f,9.99993026e-01f},
  {-9.99960840e-01f,9.81074572e-01f,7.81440377e-01f,-7.17477441e-01f,-5.88501155e-01f,3.27489585e-01f,7.67604589e-01f,9.24443960e-01f,9.75897431e-01f,9.92357016e-01f,9.97581005e-01f,9.99234855e-01f,9.99758005e-01f,9.99923468e-01f,9.99975801e-01f,9.99992371e-01f},
  {-5.32833040e-01f,9.33235765e-01f,5.48645258e-01f,-5.82943261e-01f,-6.66275978e-01f,2.73866832e-01f,7.46956408e-01f,9.17517304e-01f,9.73666370e-01f,9.91647422e-01f,9.97356176e-01f,9.99163687e-01f,9.99735534e-01f,9.99916375e-01f,9.99973536e-01f,9.99991655e-01f},
  {4.24179018e-01f,5.97977161e-01f,2.61441678e-01f,-4.30023283e-01f,-7.37393796e-01f,2.19378278e-01f,7.25561321e-01f,9.10300434e-01f,9.71337974e-01f,9.90906477e-01f,9.97121394e-01f,9.99089420e-01f,9.99711990e-01f,9.99908924e-01f,9.99971211e-01f,9.99990880e-01f},
  {9.91202831e-01f,7.85522610e-02f,-5.16893305e-02f,-2.63540596e-01f,-8.01143587e-01f,1.64196163e-01f,7.03440726e-01f,9.02795732e-01f,9.68912423e-01f,9.90134120e-01f,9.96876657e-01f,9.99011934e-01f,9.99687493e-01f,9.99901175e-01f,9.99968767e-01f,9.99990106e-01f},
  {6.46919310e-01f,-4.65064496e-01f,-3.59694332e-01f,-8.87455046e-02f,-8.56888831e-01f,1.08494945e-01f,6.80616796e-01f,8.95005584e-01f,9.66389954e-01f,9.89330530e-01f,9.96621907e-01f,9.98931348e-01f,9.99662042e-01f,9.99893129e-01f,9.99966204e-01f,9.99989331e-01f},
  {-2.92138815e-01f,-8.65450621e-01f,-6.32028639e-01f,8.88481140e-02f,-9.04072165e-01f,5.24506159e-02f,6.57112300e-01f,8.86932373e-01f,9.63770926e-01f,9.88495648e-01f,9.96357203e-01f,9.98847544e-01f,9.99635518e-01f,9.99884725e-01f,9.99963522e-01f,9.99988496e-01f},
  {-9.62605894e-01f,-9.99293387e-01f,-8.41684937e-01f,2.63639510e-01f,-9.42222297e-01f,-3.75941908e-03f,6.32950664e-01f,8.78578722e-01f,9.61055458e-01f,9.87629473e-01f,9.96082544e-01f,9.98760641e-01f,9.99608040e-01f,9.99876022e-01f,9.99960780e-01f,9.99987602e-01f},
  {-7.48057544e-01f,-8.25371623e-01f,-9.67871487e-01f,4.30115849e-01f,-9.70958173e-01f,-5.99575676e-02f,6.08156204e-01f,8.69947195e-01f,9.58243906e-01f,9.86732066e-01f,9.95797932e-01f,9.98670578e-01f,9.99579549e-01f,9.99867022e-01f,9.99957979e-01f,9.99986708e-01f},
  {1.54251456e-01f,-3.97251874e-01f,-9.98075247e-01f,5.83026946e-01f,-9.89992499e-01f,-1.15966164e-01f,5.82753658e-01f,8.61040652e-01f,9.55336511e-01f,9.85803485e-01f,9.95503366e-01f,9.98577297e-01f,9.99550045e-01f,9.99857724e-01f,9.99954998e-01f,9.99985754e-01f},
  {9.14742351e-01f,1.53215483e-01f,-9.29300308e-01f,7.17549205e-01f,-9.99135137e-01f,-1.71608135e-01f,5.56768358e-01f,8.51861775e-01f,9.52333570e-01f,9.84843671e-01f,9.95198846e-01f,9.98480916e-01f,9.99519527e-01f,9.99848068e-01f,9.99951959e-01f,9.99984801e-01f},
  {8.34223390e-01f,6.56495154e-01f,-7.68367112e-01f,8.29440355e-01f,-9.98294771e-01f,-2.26707578e-01f,5.30226350e-01f,8.42413545e-01f,9.49235439e-01f,9.83852804e-01f,9.94884372e-01f,9.98381376e-01f,9.99488056e-01f,9.99838114e-01f,9.99948800e-01f,9.99983788e-01f},
  {-1.32767474e-02f,9.57586050e-01f,-5.31235278e-01f,9.15171385e-01f,-9.87479806e-01f,-2.81090319e-01f,5.03154159e-01f,8.32698941e-01f,9.46042359e-01f,9.82830763e-01f,9.94559944e-01f,9.98278618e-01f,9.99455571e-01f,9.99827802e-01f,9.99945521e-01f,9.99982774e-01f},
  {-8.48570287e-01f,9.63757515e-01f,-2.41421118e-01f,9.72038329e-01f,-9.66798186e-01f,-3.34584385e-01f,4.75578904e-01f,8.22721004e-01f,9.42754686e-01f,9.81777668e-01f,9.94225562e-01f,9.98172760e-01f,9.99422073e-01f,9.99817252e-01f,9.99942183e-01f,9.99981701e-01f},
  {-9.03692186e-01f,6.73110247e-01f,7.23346695e-02f,9.98247743e-01f,-9.36456680e-01f,-3.87020677e-01f,4.47528064e-01f,8.12482953e-01f,9.39372718e-01f,9.80693519e-01f,9.93881226e-01f,9.98063743e-01f,9.99387562e-01f,9.99806345e-01f,9.99938726e-01f,9.99980628e-01f},
  {-1.27963692e-01f,1.75156534e-01f,3.78916174e-01f,9.92972851e-01f,-8.96758378e-01f,-4.38233554e-01f,4.19029742e-01f,8.01987886e-01f,9.35896814e-01f,9.79578316e-01f,9.93526995e-01f,9.97951567e-01f,9.99352098e-01f,9.99795079e-01f,9.99935210e-01f,9.99979496e-01f},
  {7.65414059e-01f,-3.76742303e-01f,6.47921681e-01f,9.56380010e-01f,-8.48100007e-01f,-4.88060862e-01f,3.90112430e-01f,7.91239262e-01f,9.32327330e-01f,9.78432178e-01f,9.93162811e-01f,9.97836173e-01f,9.99315560e-01f,9.99783576e-01f,9.99931574e-01f,9.99978364e-01f},
  {9.55073655e-01f,-8.12611222e-01f,8.52673113e-01f,8.89623463e-01f,-7.90967762e-01f,-5.36345184e-01f,3.60805035e-01f,7.80240417e-01f,9.28664625e-01f,9.77255106e-01f,9.92788672e-01f,9.97717679e-01f,9.99278069e-01f,9.99771714e-01f,9.99927819e-01f,9.99977171e-01f},
  {2.66642928e-01f,-9.98210371e-01f,9.72865343e-01f,7.94808388e-01f,-7.25932240e-01f,-5.82933903e-01f,3.31136853e-01f,7.68994927e-01f,9.24909055e-01f,9.76047099e-01f,9.92404640e-01f,9.97596025e-01f,9.99239624e-01f,9.99759495e-01f,9.99923944e-01f,9.99975979e-01f},
  {-6.66938066e-01f,-8.76379430e-01f,9.96578991e-01f,6.74925625e-01f,-6.53643608e-01f,-6.27679706e-01f,3.01137596e-01f,7.57506192e-01f,9.21060979e-01f,9.74808276e-01f,9.92010653e-01f,9.97471273e-01f,9.99200106e-01f,9.99747038e-01f,9.99920011e-01f,9.99974728e-01f},
  {-9.87339258e-01f,-4.84639406e-01f,9.21462357e-01f,5.33756077e-01f,-5.74824035e-01f,-6.70441091e-01f,2.70837069e-01f,7.45777905e-01f,9.17120814e-01f,9.73538578e-01f,9.91606772e-01f,9.97343302e-01f,9.99159634e-01f,9.99734223e-01f,9.99915957e-01f,9.99973416e-01f},
  {-3.99985313e-01f,5.63609414e-02f,7.54965365e-01f,3.75752151e-01f,-4.90260571e-01f,-7.11082935e-01f,2.40265876e-01f,7.33813822e-01f,9.13088918e-01f,9.72238123e-01f,9.91192937e-01f,9.97212172e-01f,9.99118149e-01f,9.99721110e-01f,9.99911785e-01f,9.99972105e-01f},
  {5.55113316e-01f,5.80003142e-01f,5.13598442e-01f,2.05897167e-01f,-4.00799006e-01f,-7.49476731e-01f,2.09454417e-01f,7.21617639e-01f,9.08965766e-01f,9.70906913e-01f,9.90769207e-01f,9.97077882e-01f,9.99075651e-01f,9.99707639e-01f,9.99907553e-01f,9.99970794e-01f},
  {9.99843299e-01f,9.25014675e-01f,2.21298173e-01f,2.95478199e-02f,-3.07332784e-01f,-7.85501122e-01f,1.78433523e-01f,7.09193349e-01f,9.04751658e-01f,9.69545007e-01f,9.90335584e-01f,9.96940494e-01f,9.99032140e-01f,9.99693930e-01f,9.99903202e-01f,9.99969363e-01f},
  {5.25321960e-01f,9.85138178e-01f,-9.29481089e-02f,-1.47732988e-01f,-2.10795805e-01f,-8.19042206e-01f,1.47234216e-01f,6.96544766e-01f,9.00447130e-01f,9.68152404e-01f,9.89892066e-01f,9.96799886e-01f,9.98987675e-01f,9.99679863e-01f,9.99898732e-01f,9.99967992e-01f},
  {-4.32177931e-01f,7.41858006e-01f,-3.97976756e-01f,-3.20354372e-01f,-1.12152621e-01f,-8.49993885e-01f,1.15887694e-01f,6.83675885e-01f,8.96052480e-01f,9.66729224e-01f,9.89438653e-01f,9.96656179e-01f,9.98942196e-01f,9.99665439e-01f,9.99894202e-01f,9.99966562e-01f},
  {-9.92335498e-01f,2.70098448e-01f,-6.63538277e-01f,-4.82871950e-01f,-1.23883775e-02f,-8.78258407e-01f,8.44252855e-02f,6.70590878e-01f,8.91568303e-01f,9.65275466e-01f,9.88975346e-01f,9.96509314e-01f,9.98895705e-01f,9.99650776e-01f,9.99889553e-01f,9.99965072e-01f},
  {-6.40144348e-01f,-2.84846604e-01f,-8.63296509e-01f,-6.30159974e-01f,8.74991715e-02f,-9.03746367e-01f,5.28784581e-02f,6.57293737e-01f,8.86994898e-01f,9.63791192e-01f,9.88502085e-01f,9.96359289e-01f,9.98848200e-01f,9.99635756e-01f,9.99884784e-01f,9.99963582e-01f},
  {3.00592542e-01f,-7.52063990e-01f,-9.77442741e-01f,-7.57573068e-01f,1.86512470e-01f,-9.26377118e-01f,2.12787576e-02f,6.43788815e-01f,8.82332861e-01f,9.62276459e-01f,9.88018990e-01f,9.96206105e-01f,9.98799741e-01f,9.99620378e-01f,9.99879956e-01f,9.99962032e-01f},
  {9.64965999e-01f,-9.87659097e-01f,-9.94656444e-01f,-8.61092687e-01f,2.83662200e-01f,-9.46079254e-01f,-1.03422189e-02f,6.30080283e-01f,8.77582550e-01f,9.60731268e-01f,9.87526000e-01f,9.96049762e-01f,9.98750269e-01f,9.99604762e-01f,9.99875009e-01f,9.99960482e-01f},
  {7.42154181e-01f,-9.19073522e-01f,-9.13230121e-01f,-9.37454224e-01f,3.77977669e-01f,-9.62790370e-01f,-4.19528559e-02f,6.16172493e-01f,8.72744501e-01f,9.59155679e-01f,9.87023175e-01f,9.95890260e-01f,9.98699784e-01f,9.99588788e-01f,9.99869943e-01f,9.99958873e-01f},
  {-1.62990779e-01f,-5.67430019e-01f,-7.41239965e-01f,-9.84248459e-01f,4.68516916e-01f,-9.76457715e-01f,-7.35215396e-02f,6.02069914e-01f,8.67819190e-01f,9.57549810e-01f,9.86510456e-01f,9.95727658e-01f,9.98648286e-01f,9.99572515e-01f,9.99864817e-01f,9.99957263e-01f},
  {-9.18282807e-01f,-4.10281904e-02f,-4.95741814e-01f,-1.00000000e+00f,5.54374516e-01f,-9.87038016e-01f,-1.05016708e-01f,5.87776959e-01f,8.62807095e-01f,9.55913603e-01f,9.85987842e-01f,9.95561838e-01f,9.98595834e-01f,9.99555886e-01f,9.99859571e-01f,9.99955595e-01f},
  {-8.29309821e-01f,4.98009592e-01f,-2.01079622e-01f,-9.84212041e-01f,6.34692967e-01f,-9.94497895e-01f,-1.36406869e-01f,5.73298037e-01f,8.57708693e-01f,9.54247177e-01f,9.85455394e-01f,9.95392919e-01f,9.98542368e-01f,9.99538958e-01f,9.99854207e-01f,9.99953866e-01f},
  {2.21267566e-02f,8.83669317e-01f,1.13521777e-01f,-9.37382519e-01f,7.08669782e-01f,-9.98813629e-01f,-1.67660639e-01f,5.58637917e-01f,8.52524519e-01f,9.52550590e-01f,9.84913111e-01f,9.95220840e-01f,9.98487890e-01f,9.99521732e-01f,9.99848783e-01f,9.99952197e-01f},
  {8.53220105e-01f,9.97174621e-01f,4.16867077e-01f,-8.60988438e-01f,7.75565803e-01f,-9.99971747e-01f,-1.98746875e-01f,5.43801069e-01f,8.47255111e-01f,9.50823903e-01f,9.84360933e-01f,9.95045662e-01f,9.98432398e-01f,9.99504209e-01f,9.99843180e-01f,9.99950409e-01f},
  {8.99866819e-01f,8.03569078e-01f,6.78870201e-01f,-7.57439196e-01f,8.34712923e-01f,-9.97968495e-01f,-2.29634270e-01f,5.28792322e-01f,8.41901004e-01f,9.49067116e-01f,9.83798921e-01f,9.94867265e-01f,9.98375952e-01f,9.99486327e-01f,9.99837577e-01f,9.99948621e-01f},
  {1.19180135e-01f,3.62476677e-01f,8.73550534e-01f,-6.30000710e-01f,8.85519624e-01f,-9.92810190e-01f,-2.60292053e-01f,5.13616323e-01f,8.36462677e-01f,9.47280347e-01f,9.83227074e-01f,9.94685769e-01f,9.98318493e-01f,9.99468148e-01f,9.99831796e-01f,9.99946833e-01f},
  {-7.71080196e-01f,-1.90249100e-01f,9.81602073e-01f,-4.82692331e-01f,9.27478492e-01f,-9.84513164e-01f,-2.90689558e-01f,4.98277903e-01f,8.30940723e-01f,9.45463598e-01f,9.82645452e-01f,9.94501114e-01f,9.98260021e-01f,9.99449670e-01f,9.99825954e-01f,9.99944985e-01f},
  {-9.52412963e-01f,-6.84381902e-01f,9.92308319e-01f,-3.20159167e-01f,9.60170269e-01f,-9.73103702e-01f,-3.20796400e-01f,4.82782036e-01f,8.25335622e-01f,9.43616986e-01f,9.82053936e-01f,9.94313300e-01f,9.98200536e-01f,9.99430835e-01f,9.99819994e-01f,9.99943078e-01f},
  {-2.58101642e-01f,-9.67739642e-01f,9.04607594e-01f,-1.47529200e-01f,9.83268440e-01f,-9.58617806e-01f,-3.50582451e-01f,4.67133403e-01f,8.19648027e-01f,9.41740453e-01f,9.81452644e-01f,9.94122326e-01f,9.98140097e-01f,9.99411702e-01f,9.99813974e-01f,9.99941170e-01f},
  {6.73507154e-01f,-9.53050017e-01f,7.27198064e-01f,2.97537707e-02f,9.96542096e-01f,-9.41101313e-01f,-3.80017966e-01f,4.51337039e-01f,8.13878477e-01f,9.39834237e-01f,9.80841517e-01f,9.93928254e-01f,9.98078644e-01f,9.99392271e-01f,9.99807835e-01f,9.99939203e-01f},
  {9.85896587e-01f,-6.44837022e-01f,4.77671444e-01f,2.06098333e-01f,9.99858618e-01f,-9.20609534e-01f,-4.09073502e-01f,4.35397953e-01f,8.08027506e-01f,9.37898219e-01f,9.80220556e-01f,9.93731022e-01f,9.98016179e-01f,9.99372482e-01f,9.99801576e-01f,9.99937236e-01f}
};
__device__ const float ROPE_SN[64][16] = {
  {0.00000000e+00f,0.00000000e+00f,0.00000000e+00f,0.00000000e+00f,0.00000000e+00f,0.00000000e+00f,0.00000000e+00f,0.00000000e+00f,0.00000000e+00f,0.00000000e+00f,0.00000000e+00f,0.00000000e+00f,0.00000000e+00f,0.00000000e+00f,0.00000000e+00f,0.00000000e+00f},
  {8.41470957e-01f,5.33168435e-01f,3.10983598e-01f,1.76892191e-01f,9.98334214e-02f,5.62044978e-02f,3.16175036e-02f,1.77818574e-02f,9.99983307e-03f,5.62338345e-03f,3.16227227e-03f,1.77827850e-03f,9.99999931e-04f,5.62341243e-04f,3.16227757e-04f,1.77827940e-04f},
  {9.09297407e-01f,9.02130723e-01f,5.91127098e-01f,3.48205268e-01f,1.98669329e-01f,1.12231314e-01f,6.32033944e-02f,3.55580896e-02f,1.99986659e-02f,1.12465890e-02f,6.32451288e-03f,3.55655141e-03f,1.99999870e-03f,1.12468237e-03f,6.32455456e-04f,3.55655880e-04f},
  {1.41120002e-01f,9.93253171e-01f,8.12648892e-01f,5.08536100e-01f,2.95520216e-01f,1.67903304e-01f,9.47260857e-02f,5.33230826e-02f,2.99954992e-02f,1.68694388e-02f,9.48669016e-03f,5.33481315e-03f,2.99999560e-03f,1.68702309e-03f,9.48683126e-04f,5.33483806e-04f},
  {-7.56802499e-01f,7.78471708e-01f,9.53580737e-01f,6.52827978e-01f,3.89418334e-01f,2.23044485e-01f,1.26154065e-01f,7.10712075e-02f,3.99893336e-02f,2.24917568e-02f,1.26487734e-02f,7.11305765e-03f,3.99998948e-03f,2.24936334e-03f,1.26491068e-03f,7.11311703e-04f},
  {-9.58924294e-01f,3.23935270e-01f,9.99946535e-01f,7.76529968e-01f,4.79425550e-01f,2.77480543e-01f,1.57455876e-01f,8.87968615e-02f,4.99791652e-02f,2.81133614e-02f,1.58107281e-02f,8.89127981e-03f,4.99997940e-03f,2.81170290e-03f,1.58113812e-03f,8.89139599e-04f},
  {-2.79415488e-01f,-2.30367512e-01f,9.47148204e-01f,8.75740528e-01f,5.64642489e-01f,3.31039310e-01f,1.88600272e-01f,1.06494442e-01f,5.99640049e-02f,3.37340795e-02f,1.89725272e-02f,1.06694745e-02f,5.99996420e-03f,3.37404152e-03f,1.89736532e-03f,1.06696738e-03f},
  {6.56986594e-01f,-7.13721275e-01f,8.00421596e-01f,9.47330713e-01f,6.44217670e-01f,3.83551568e-01f,2.19556093e-01f,1.24158338e-01f,6.99428469e-02f,3.93537246e-02f,2.21341345e-02f,1.24476347e-02f,6.99994294e-03f,3.93637875e-03f,2.21359241e-03f,1.24479528e-03f},
  {9.89358246e-01f,-9.77261782e-01f,5.74317753e-01f,9.89042461e-01f,7.17356086e-01f,4.34851229e-01f,2.50292331e-01f,1.41782969e-01f,7.99146891e-02f,4.49721329e-02f,2.52955221e-02f,1.42257558e-02f,7.99991470e-03f,4.49871505e-03f,2.52981926e-03f,1.42262306e-03f},
  {4.12118495e-01f,-9.39823508e-01f,2.91259229e-01f,9.99560297e-01f,7.83326924e-01f,4.84776139e-01f,2.80778319e-01f,1.59362778e-01f,8.98785442e-02f,5.05891182e-02f,2.84566563e-02f,1.60038304e-02f,8.99987947e-03f,5.06105041e-03f,2.84604589e-03f,1.60045072e-03f},
  {-5.44021130e-01f,-6.12936914e-01f,-2.06835698e-02f,9.78552461e-01f,8.41470957e-01f,5.33168435e-01f,3.10983568e-01f,1.76892191e-01f,9.98334140e-02f,5.62044978e-02f,3.16175036e-02f,1.77818574e-02f,9.99983400e-03f,5.62338345e-03f,3.16227227e-03f,1.77827850e-03f},
  {-9.99990225e-01f,-9.72764567e-02f,-3.30574960e-01f,9.26681578e-01f,8.91207397e-01f,5.79875171e-01f,3.40877861e-01f,1.94365650e-01f,1.09778300e-01f,6.18181042e-02f,3.47780399e-02f,1.95598267e-02f,1.09997792e-02f,6.18571462e-03f,3.47849843e-03f,1.95610616e-03f},
  {-5.36572933e-01f,4.48342979e-01f,-6.07683420e-01f,8.45583618e-01f,9.32039082e-01f,6.24748647e-01f,3.70431304e-01f,2.11777672e-01f,1.19712204e-01f,6.74297586e-02f,3.79382223e-02f,2.13377345e-02f,1.19997123e-02f,6.74804440e-03f,3.79472389e-03f,2.13393359e-03f},
  {4.20167029e-01f,8.55880976e-01f,-8.24528456e-01f,7.37816215e-01f,9.63558197e-01f,6.67647004e-01f,3.99614304e-01f,2.29122713e-01f,1.29634142e-01f,7.30392784e-02f,4.10980321e-02f,2.31155735e-02f,1.29996343e-02f,7.31037185e-03f,4.11094911e-03f,2.31176103e-03f},
  {9.90607381e-01f,9.99823332e-01f,-9.59605396e-01f,6.06778562e-01f,9.85449731e-01f,7.08434701e-01f,4.28397775e-01f,2.46395305e-01f,1.39543116e-01f,7.86464810e-02f,4.42574248e-02f,2.48933397e-02f,1.39995432e-02f,7.87269697e-03f,4.42717411e-03f,2.48958869e-03f},
  {6.50287867e-01f,8.35838437e-01f,-9.99518692e-01f,4.56603259e-01f,9.97494996e-01f,7.46982634e-01f,4.56752867e-01f,2.63589978e-01f,1.49438128e-01f,8.42512026e-02f,4.74163815e-02f,2.66710296e-02f,1.49994381e-02f,8.43502022e-03f,4.74339863e-03f,2.66741589e-03f},
  {-2.87903309e-01f,4.14430231e-01f,-9.40310359e-01f,2.92027086e-01f,9.99573588e-01f,7.83169091e-01f,4.84651238e-01f,2.80701309e-01f,1.59318209e-01f,8.98532644e-02f,5.05748577e-02f,2.84486320e-02f,1.59993190e-02f,8.99733976e-03f,5.05962269e-03f,2.84524332e-03f},
  {-9.61397469e-01f,-1.34615138e-01f,-7.87851870e-01f,1.18240520e-01f,9.91664827e-01f,8.16879570e-01f,5.12064993e-01f,2.97723860e-01f,1.69182345e-01f,9.54524800e-02f,5.37328273e-02f,3.02261449e-02f,1.69991814e-02f,9.55965649e-03f,5.37584582e-03f,3.02307028e-03f},
  {-7.50987232e-01f,-6.42200708e-01f,-5.57262897e-01f,-5.92755191e-02f,9.73847628e-01f,8.48007560e-01f,5.38966715e-01f,3.14652264e-01f,1.79029569e-01f,1.01048686e-01f,5.68902642e-02f,3.20035629e-02f,1.79990288e-02f,1.01219704e-02f,5.69206895e-03f,3.20089748e-03f},
  {1.49877205e-01f,-9.52000856e-01f,-2.71410108e-01f,-2.34921798e-01f,9.46300089e-01f,8.76454532e-01f,5.65329552e-01f,3.31481189e-01f,1.88858896e-01f,1.06641680e-01f,6.00471310e-02f,3.37808803e-02f,1.89988576e-02f,1.06842816e-02f,6.00829115e-03f,3.37872445e-03f},
  {9.12945271e-01f,-9.68601942e-01f,4.13582884e-02f,-4.03158993e-01f,9.09297407e-01f,9.02130723e-01f,5.91127038e-01f,3.48205268e-01f,1.98669314e-01f,1.12231314e-01f,6.32033944e-02f,3.55580896e-02f,1.99986678e-02f,1.12465890e-02f,6.32451288e-03f,3.55655141e-03f},
  {8.36655617e-01f,-6.86891198e-01f,3.50024760e-01f,-5.58680534e-01f,8.63209307e-01f,9.24954832e-01f,6.16333544e-01f,3.64819258e-01f,2.08459899e-01f,1.17817394e-01f,6.63590282e-02f,3.73351872e-02f,2.09984574e-02f,1.18088927e-02f,6.64073415e-03f,3.73437814e-03f},
  {-8.85130931e-03f,-1.93630233e-01f,6.23979926e-01f,-6.96581721e-01f,8.08496356e-01f,9.44854796e-01f,6.40923738e-01f,3.81317884e-01f,2.18229622e-01f,1.23399742e-01f,6.95140064e-02f,3.91121693e-02f,2.19982266e-02f,1.23711927e-02f,6.95695449e-03f,3.91220488e-03f},
  {-8.46220434e-01f,3.59264523e-01f,8.36055279e-01f,-8.12512875e-01f,7.45705247e-01f,9.61767614e-01f,6.64873064e-01f,3.97695929e-01f,2.27977514e-01f,1.28978193e-01f,7.26682767e-02f,4.08890247e-02f,2.29979735e-02f,1.29334899e-02f,7.27317436e-03f,4.09003161e-03f},
  {-9.05578375e-01f,8.01513135e-01f,9.65219259e-01f,-9.02817786e-01f,6.75463140e-01f,9.75639880e-01f,6.88157499e-01f,4.13948208e-01f,2.37702623e-01f,1.34552568e-01f,7.58218244e-02f,4.26657498e-02f,2.39976961e-02f,1.34957815e-02f,7.58939330e-03f,4.26785741e-03f},
  {-1.32351756e-01f,9.96909976e-01f,9.98663187e-01f,-9.64648306e-01f,5.98472118e-01f,9.86427724e-01f,7.10753918e-01f,4.30069596e-01f,2.47403964e-01f,1.40122697e-01f,7.89746121e-02f,4.44423407e-02f,2.49973964e-02f,1.40580693e-02f,7.90561177e-03f,4.44568414e-03f},
  {7.62558460e-01f,8.85276794e-01f,9.33070183e-01f,-9.96054351e-01f,5.15501261e-01f,9.94096994e-01f,7.32639611e-01f,4.46054995e-01f,2.57080555e-01f,1.45688385e-01f,8.21266174e-02f,4.62187938e-02f,2.59970706e-02f,1.46203535e-02f,8.22182931e-03f,4.62350994e-03f},
  {9.56375957e-01f,5.00994205e-01f,7.74945021e-01f,-9.96045172e-01f,4.27379847e-01f,9.98623490e-01f,7.53792703e-01f,4.61899310e-01f,2.66731411e-01f,1.51249468e-01f,8.52777958e-02f,4.79951017e-02f,2.69967206e-02f,1.51826320e-02f,8.53804592e-03f,4.80133574e-03f},
  {2.70905793e-01f,-3.75856608e-02f,5.39968967e-01f,-9.64621305e-01f,3.34988207e-01f,9.99992907e-01f,7.74192095e-01f,4.77597594e-01f,2.76355654e-01f,1.56805754e-01f,8.84281173e-02f,4.97712530e-02f,2.79963426e-02f,1.57449059e-02f,8.85426160e-03f,4.97916201e-03f},
  {-6.63633883e-01f,-5.64589798e-01f,2.51445323e-01f,-9.02773678e-01f,2.39249229e-01f,9.98200953e-01f,7.93817401e-01f,4.93144840e-01f,2.85952210e-01f,1.62357092e-01f,9.15775672e-02f,5.15472479e-02f,2.89959367e-02f,1.63071752e-02f,9.17047635e-03f,5.15698735e-03f},
  {-9.88031626e-01f,-9.17709649e-01f,-6.20148405e-02f,-8.12452853e-01f,1.41120002e-01f,9.93253171e-01f,8.12648892e-01f,5.08536100e-01f,2.95520186e-01f,1.67903304e-01f,9.47260931e-02f,5.33230826e-02f,2.99955010e-02f,1.68694388e-02f,9.48669016e-03f,5.33481315e-03f},
  {-4.04037654e-01f,-9.88192797e-01f,-3.69325012e-01f,-6.96507812e-01f,4.15805206e-02f,9.85165298e-01f,8.30667794e-01f,5.23766637e-01f,3.05058628e-01f,1.73444211e-01f,9.78736654e-02f,5.50987460e-02f,3.09950355e-02f,1.74316969e-02f,9.80290305e-03f,5.51263802e-03f},
  {5.51426709e-01f,-7.54330218e-01f,-6.40009403e-01f,-5.58595300e-01f,-5.83741926e-02f,9.73962843e-01f,8.47856104e-01f,5.38831532e-01f,3.14566553e-01f,1.78979620e-01f,1.01020269e-01f,5.68742342e-02f,3.19945402e-02f,1.79939512e-02f,1.01191159e-02f,5.69046335e-03f},
  {9.99911845e-01f,-2.88147390e-01f,-8.47224355e-01f,-4.03064936e-01f,-1.57745644e-01f,9.59681332e-01f,8.64196658e-01f,5.53726017e-01f,3.24043006e-01f,1.84509367e-01f,1.04165860e-01f,5.86495437e-02f,3.29940096e-02f,1.85561981e-02f,1.04353270e-02f,5.86828869e-03f},
  {5.29082716e-01f,2.66779721e-01f,-9.70420420e-01f,-2.34822124e-01f,-2.55541205e-01f,9.42365825e-01f,8.79673064e-01f,5.68445385e-01f,3.33487093e-01f,1.90033287e-01f,1.07310407e-01f,6.04246669e-02f,3.39934528e-02f,1.91184394e-02f,1.07515370e-02f,6.04611309e-03f},
  {-4.28182662e-01f,7.39542127e-01f,-9.97380435e-01f,-5.91726787e-02f,-3.50783229e-01f,9.22071040e-01f,8.94269884e-01f,5.82984984e-01f,3.42897803e-01f,1.95551202e-01f,1.10453881e-01f,6.21996038e-02f,3.49928550e-02f,1.96806751e-02f,1.10677453e-02f,6.22393796e-03f},
  {-9.91778851e-01f,9.84540582e-01f,-9.25431013e-01f,1.18342586e-01f,-4.42520559e-01f,8.98861170e-01f,9.07972515e-01f,5.97340286e-01f,3.52274209e-01f,2.01062918e-01f,1.13596253e-01f,6.39743358e-02f,3.59922275e-02f,2.02429052e-02f,1.13839535e-02f,6.40176190e-03f},
  {-6.43538117e-01f,9.26318109e-01f,-7.61706948e-01f,2.92125374e-01f,-5.29836178e-01f,8.72809589e-01f,9.20767248e-01f,6.11506701e-01f,3.61615449e-01f,2.06568271e-01f,1.16737492e-01f,6.57488778e-02f,3.69915590e-02f,2.08051261e-02f,1.17001599e-02f,6.57958630e-03f},
  {2.96368569e-01f,5.82806170e-01f,-5.22444785e-01f,4.56694692e-01f,-6.11857831e-01f,8.43998730e-01f,9.32641268e-01f,6.25479698e-01f,3.70920479e-01f,2.12067112e-01f,1.19877554e-01f,6.75232038e-02f,3.79908569e-02f,2.13673431e-02f,1.20163653e-02f,6.75741071e-03f},
  {9.63795364e-01f,5.98003156e-02f,-2.31372014e-01f,6.06860459e-01f,-6.87766254e-01f,8.12519610e-01f,9.43582714e-01f,6.39254928e-01f,3.80188406e-01f,2.17559248e-01f,1.23016424e-01f,6.92973137e-02f,3.89901139e-02f,2.19295528e-02f,1.23325698e-02f,6.93523418e-03f},
  {7.45113134e-01f,-4.81621295e-01f,8.26458037e-02f,7.37885714e-01f,-7.56802499e-01f,7.78471708e-01f,9.53580678e-01f,6.52827978e-01f,3.89418334e-01f,2.23044485e-01f,1.26154065e-01f,7.10712075e-02f,3.99893373e-02f,2.24917568e-02f,1.26487734e-02f,7.11305765e-03f},
  {-1.58622667e-01f,-8.74714017e-01f,3.88467699e-01f,8.45638454e-01f,-8.18277061e-01f,7.41962790e-01f,9.62625206e-01f,6.66194677e-01f,3.98609310e-01f,2.28522688e-01f,1.29290432e-01f,7.28448778e-02f,4.09885161e-02f,2.30539497e-02f,1.29649751e-02f,7.29088066e-03f},
  {-9.16521549e-01f,-9.98410463e-01f,6.55764699e-01f,9.26720202e-01f,-8.71575892e-01f,7.03108132e-01f,9.70707119e-01f,6.79350674e-01f,4.07760441e-01f,2.33993664e-01f,1.32425532e-01f,7.46183172e-02f,4.19876575e-02f,2.36161388e-02f,1.32811759e-02f,7.46870413e-03f},
  {-8.31774771e-01f,-8.14614236e-01f,8.58030677e-01f,9.78573620e-01f,-9.16166008e-01f,6.62030637e-01f,9.77818429e-01f,6.92291796e-01f,4.16870773e-01f,2.39457220e-01f,1.35559291e-01f,7.63915181e-02f,4.29867506e-02f,2.41783205e-02f,1.35973748e-02f,7.64652714e-03f},
  {1.77019257e-02f,-3.79931390e-01f,9.75206196e-01f,9.99563396e-01f,-9.51602101e-01f,6.18860185e-01f,9.83951986e-01f,7.05014050e-01f,4.25939471e-01f,2.44913206e-01f,1.38691694e-01f,7.81644881e-02f,4.39858064e-02f,2.47404929e-02f,1.39135728e-02f,7.82434922e-03f},
  {8.50903511e-01f,1.71763569e-01f,9.95670974e-01f,9.89027262e-01f,-9.77530122e-01f,5.73733270e-01f,9.89101648e-01f,7.17513323e-01f,4.34965521e-01f,2.50361472e-01f,1.41822711e-01f,7.99371973e-02f,4.49848175e-02f,2.53026579e-02f,1.42297689e-02f,8.00217129e-03f},
  {9.01788354e-01f,6.70557022e-01f,9.17395473e-01f,9.47297752e-01f,-9.93690968e-01f,5.26792526e-01f,9.93262351e-01f,7.29785740e-01f,4.43948090e-01f,2.55801797e-01f,1.44952312e-01f,8.17096606e-02f,4.59837839e-02f,2.58648153e-02f,1.45459641e-02f,8.17999430e-03f},
  {1.23573124e-01f,9.62832689e-01f,7.48142362e-01f,8.75690997e-01f,-9.99923289e-01f,4.78186339e-01f,9.96429801e-01f,7.41827428e-01f,4.52886283e-01f,2.61234075e-01f,1.48080453e-01f,8.34818557e-02f,4.69827019e-02f,2.64269635e-02f,1.48621574e-02f,8.35781638e-03f},
  {-7.68254638e-01f,9.58573103e-01f,5.04697084e-01f,7.76465356e-01f,-9.96164620e-01f,4.28068399e-01f,9.98600960e-01f,7.53634512e-01f,4.61779177e-01f,2.66658038e-01f,1.51207119e-01f,8.52537975e-02f,4.79815714e-02f,2.69891042e-02f,1.51783489e-02f,8.53563752e-03f},
  {-9.53752637e-01f,6.59090102e-01f,2.11200655e-01f,6.52750373e-01f,-9.82452571e-01f,3.76597136e-01f,9.99773562e-01f,7.65203178e-01f,4.70625877e-01f,2.72073567e-01f,1.54332280e-01f,8.70254710e-02f,4.89803962e-02f,2.75512375e-02f,1.54945394e-02f,8.71345960e-03f},
  {-2.62374848e-01f,1.56619072e-01f,-1.03240460e-01f,5.08447945e-01f,-9.58924294e-01f,3.23935270e-01f,9.99946535e-01f,7.76529968e-01f,4.79425550e-01f,2.77480543e-01f,1.57455891e-01f,8.87968615e-02f,4.99791689e-02f,2.81133596e-02f,1.58107281e-02f,8.89127981e-03f},
  {6.70229197e-01f,-3.94086063e-01f,-4.07444149e-01f,3.48108500e-01f,-9.25814748e-01f,2.70249337e-01f,9.99119580e-01f,7.87611187e-01f,4.88177240e-01f,2.82878697e-01f,1.60577938e-01f,9.05679762e-02f,5.09778969e-02f,2.86754742e-02f,1.61269177e-02f,9.06910095e-03f},
  {9.86627579e-01f,-8.23421597e-01f,-6.71240151e-01f,1.76790684e-01f,-8.83454502e-01f,2.15709001e-01f,9.97293651e-01f,7.98443377e-01f,4.96880114e-01f,2.88267940e-01f,1.63698375e-01f,9.23388004e-02f,5.19765690e-02f,2.92375814e-02f,1.64431017e-02f,9.24692024e-03f},
  {3.95925164e-01f,-9.99157965e-01f,-8.68469954e-01f,-1.03020677e-04f,-8.32267344e-01f,1.60486728e-01f,9.94470477e-01f,8.09023023e-01f,5.05533338e-01f,2.93648034e-01f,1.66817173e-01f,9.41093415e-02f,5.29751927e-02f,2.97996756e-02f,1.67592876e-02f,9.42474138e-03f},
  {-5.58789074e-01f,-8.67171526e-01f,-9.79574919e-01f,-1.76993474e-01f,-7.72764444e-01f,1.04756832e-01f,9.90652919e-01f,8.19346905e-01f,5.14135957e-01f,2.99018890e-01f,1.69934288e-01f,9.58795771e-02f,5.39737605e-02f,3.03617641e-02f,1.70754679e-02f,9.60256159e-03f},
  {-9.99755144e-01f,-4.68111664e-01f,-9.93535519e-01f,-3.48301649e-01f,-7.05540299e-01f,4.86960001e-02f,9.85844791e-01f,8.29411685e-01f,5.22687256e-01f,3.04380238e-01f,1.73049718e-01f,9.76495072e-02f,5.49722798e-02f,3.09238415e-02f,1.73916500e-02f,9.78038087e-03f},
  {-5.21551013e-01f,7.51182064e-02f,-9.08967435e-01f,-5.08624554e-01f,-6.31266713e-01f,-7.51878507e-03f,9.80050862e-01f,8.39214146e-01f,5.31186223e-01f,3.09731960e-01f,1.76163420e-01f,9.94191393e-02f,5.59707358e-02f,3.14859077e-02f,1.77078284e-02f,9.95820016e-03f},
  {4.36164767e-01f,5.95211506e-01f,-7.34258294e-01f,-6.52905703e-01f,-5.50685287e-01f,-6.37097955e-02f,9.73276973e-01f,8.48751247e-01f,5.39632022e-01f,3.15073937e-01f,1.79275364e-01f,1.01188451e-01f,5.69691435e-02f,3.20479684e-02f,1.80240069e-02f,1.01360194e-02f},
  {9.92872655e-01f,9.31992829e-01f,-4.86733496e-01f,-7.76594579e-01f,-4.64602023e-01f,-1.19699396e-01f,9.65529919e-01f,8.58020008e-01f,5.48023939e-01f,3.20405900e-01f,1.82385504e-01f,1.02957435e-01f,5.79674877e-02f,3.26100141e-02f,1.83401816e-02f,1.03138378e-02f},
  {6.36738002e-01f,9.81735826e-01f,-1.90938011e-01f,-8.75790000e-01f,-3.73876572e-01f,-1.75310582e-01f,9.56817448e-01f,8.67017388e-01f,5.56361020e-01f,3.25727791e-01f,1.85493827e-01f,1.04726106e-01f,5.89657798e-02f,3.31720486e-02f,1.86563563e-02f,1.04916561e-02f},
  {-3.04810613e-01f,7.29123712e-01f,1.23790950e-01f,-9.47363734e-01f,-2.79415488e-01f,-2.30367512e-01f,9.47148204e-01f,8.75740528e-01f,5.64642429e-01f,3.31039310e-01f,1.88600287e-01f,1.06494442e-01f,5.99640086e-02f,3.37340795e-02f,1.89725272e-02f,1.06694745e-02f},
  {-9.66117799e-01f,2.51952261e-01f,4.26245421e-01f,-9.89057720e-01f,-1.82162598e-01f,-2.84696162e-01f,9.36531842e-01f,8.84186864e-01f,5.72867453e-01f,3.36340427e-01f,1.91704854e-01f,1.08262435e-01f,6.09621815e-02f,3.42960916e-02f,1.92886982e-02f,1.08472919e-02f},
  {-7.39180684e-01f,-3.02812874e-01f,6.86427653e-01f,-9.99557257e-01f,-8.30891207e-02f,-3.38124752e-01f,9.24979091e-01f,8.92353535e-01f,5.81035137e-01f,3.41630876e-01f,1.94807529e-01f,1.10030092e-01f,6.19602874e-02f,3.48580964e-02f,1.96048655e-02f,1.10251084e-02f},
  {1.67355701e-01f,-7.64320076e-01f,8.78538549e-01f,-9.78531301e-01f,1.68140903e-02f,-3.90484393e-01f,9.12501454e-01f,9.00238097e-01f,5.89144766e-01f,3.46910536e-01f,1.97908238e-01f,1.11797392e-01f,6.29583374e-02f,3.54200937e-02f,1.99210308e-02f,1.12029258e-02f}
};


constexpr int D = 1024, ML = 16384, MC = 2048, MT = ML + MC, TL = 2048, TCX = 256, NB = 8;
constexpr int LDP_E = 3328, LDP_O = 5120, DFF = 2816, NKK = 2304;
constexpr int NTHR = 512;
constexpr int LDS_BYTES = 152 * 1024;
constexpr float EPSN = 1e-6f;

struct Params {
  const float *x, *c, *ctx, *c_ctx, *w_ada, *b_ada, *n1g, *n2g, *w_in_even, *qk_gain, *lambda_a, *subln, *w_gate_up, *b_gate_up,
      *onorm_b, *w_out_even, *w_in_odd, *lb_raw, *onorm_c, *w_out_odd, *w_ffn_in, *w_ffn_out;
  float* out;
  bf16_t *wt_in_even, *wt_in_odd, *wt_out_even, *wt_out_odd, *wt_ffn_in, *wt_ffn_out;
  float* Z;
  float* mod;
  bf16_t *P, *R1, *R2, *Vt;
  float* Gk;
  unsigned* ctr;
  unsigned* xbar;
  float* rowss;
  unsigned* pcnt;
};

extern __shared__ __attribute__((aligned(16))) char smem_raw[];

typedef float f32x2 __attribute__((ext_vector_type(2)));
typedef __bf16 hbf16x2 __attribute__((ext_vector_type(2)));
DI unsigned pack2(float a, float b) { const f32x2 v = {a, b}; return __builtin_bit_cast(unsigned, __builtin_convertvector(v, hbf16x2)); }
DI bf16_t f2bf(float x) { return (bf16_t)(pack2(x, 0.f) & 0xffffu); }
DI float bf2f(bf16_t h) { return __uint_as_float(((unsigned)h) << 16); }
DI float wave_sum(float v) {
#pragma unroll
  for (int o = 32; o >= 1; o >>= 1) v += __shfl_xor(v, o, 64);
  return v;
}
#define LDS_BARRIER() do { asm volatile("s_waitcnt lgkmcnt(0)" ::: "memory"); __builtin_amdgcn_s_barrier(); asm volatile("" ::: "memory"); } while (0)
DI int TID() { int t = threadIdx.x; asm volatile("" : "+v"(t)); return t; }
DI float sigmoidf_(float x) { return __builtin_amdgcn_rcpf(1.f + __builtin_amdgcn_exp2f(x * -1.44269504088896f)); }
DI float siluf(float x) { return x * sigmoidf_(x); }

DI void convert_tile(const float* __restrict__ src, int K, int N, bf16_t* __restrict__ dst, int mode, int tile) {
  float* ts = (float*)smem_raw;
  const int tid = TID();
  const int nkt = K >> 6;
  const int kt = tile % nkt, nt = tile / nkt;
  const int k0 = kt << 6, n0 = nt << 6;
#pragma unroll
  for (int i = 0; i < 2; ++i) {
    const int idx = tid + i * NTHR;
    const int kr = idx >> 4, c4 = idx & 15;
    const int n = n0 + 4 * c4;
    float4 v = make_float4(0.f, 0.f, 0.f, 0.f);
    if (n < N) v = *(const float4*)(src + (size_t)(k0 + kr) * N + n);
    float* t = ts + kr * 65 + 4 * c4;
    t[0] = v.x; t[1] = v.y; t[2] = v.z; t[3] = v.w;
  }
  __syncthreads();
  {
    const int nrow = tid >> 3, kq = tid & 7;
    float f[8];
#pragma unroll
    for (int j = 0; j < 8; ++j) f[j] = ts[(kq * 8 + j) * 65 + nrow];
    int n = n0 + nrow;
    int orow = n;
    if (mode & 1) { const int up = n >= DFF ? 1 : 0; const int j = n - up * DFF; orow = (j >> 7) * 256 + up * 128 + (j & 127); }
    if (mode & 2) { const int c32 = orow & 31; orow = (orow & ~31) + 16 * ((c32 >> 2) & 1) + 4 * (c32 >> 3) + (c32 & 3); }
    uint4 o;
    o.x = pack2(f[0], f[1]); o.y = pack2(f[2], f[3]); o.z = pack2(f[4], f[5]); o.w = pack2(f[6], f[7]);
    *(uint4*)(dst + (size_t)orow * K + k0 + kq * 8) = o;
  }
  __syncthreads();
}

__device__ void mod_table(const Params& p, int l0, int nl, int first, int stride) {
  const int tid = TID();
    float* sc = (float*)smem_raw;
    float* part = sc + 9 * 1024;
    __syncthreads();
    for (int i = tid; i < 9 * 1024; i += NTHR) {
      const int m = i >> 10, k = i & 1023;
      const float v = m < 8 ? p.c[m * 1024 + k] : p.c_ctx[k];
      sc[i] = siluf(v);
    }
    __syncthreads();
    for (int it = first; it < nl * 96; it += stride) {
      const int l = l0 + it / 96, n0 = (it % 96) * 64;
      const int col4 = tid & 15, ks = tid >> 4;
      float acc[9][4];
#pragma unroll
      for (int m = 0; m < 9; ++m) { acc[m][0] = 0.f; acc[m][1] = 0.f; acc[m][2] = 0.f; acc[m][3] = 0.f; }
      const float* wp = p.w_ada + (size_t)l * 1024 * 6144 + n0 + 4 * col4;
      for (int k8 = 0; k8 < 32; k8 += 8) {
        float4 w[8];
#pragma unroll
        for (int u = 0; u < 8; ++u) w[u] = *(const float4*)(wp + (size_t)(ks * 32 + k8 + u) * 6144);
#pragma unroll
        for (int u = 0; u < 8; ++u) {
          const int k = ks * 32 + k8 + u;
#pragma unroll
          for (int m = 0; m < 9; ++m) { const float s = sc[m * 1024 + k]; acc[m][0] += s * w[u].x; acc[m][1] += s * w[u].y; acc[m][2] += s * w[u].z; acc[m][3] += s * w[u].w; }
        }
      }
#pragma unroll
      for (int m = 0; m < 9; ++m) {
        float* pp = part + (ks * 9 + m) * 64 + 4 * col4;
        pp[0] = acc[m][0]; pp[1] = acc[m][1]; pp[2] = acc[m][2]; pp[3] = acc[m][3];
      }
      __syncthreads();
      for (int i = tid; i < 9 * 64; i += NTHR) {
        const int m = i >> 6, cc = i & 63;
        float s = p.b_ada[l * 6144 + n0 + cc];
        for (int q = 0; q < 32; ++q) s += part[(q * 9 + m) * 64 + cc];
        p.mod[((size_t)l * 9 + m) * 6144 + n0 + cc] = s;
      }
      __syncthreads();
    }
}

__device__ void convert_weights(const Params& p, int half, int first, int stride) {
  const int U0 = 832, U1 = U0 + 1280, U2 = U1 + 256, U3 = U2 + 256, U4 = U3 + 2 * 1408, U5 = U4 + 2 * 704;
  for (int it = first; it < U5; it += stride) {
    if (it < U0) convert_tile(p.w_in_even + (size_t)half * 1024 * 3104, 1024, 3104, p.wt_in_even + (size_t)half * LDP_E * 1024, 2, it);
    else if (it < U1) convert_tile(p.w_in_odd + (size_t)half * 1024 * 5120, 1024, 5120, p.wt_in_odd + (size_t)half * 5120 * 1024, 2, it - U0);
    else if (it < U2) convert_tile(p.w_out_even + (size_t)half * 1024 * 1024, 1024, 1024, p.wt_out_even + (size_t)half * 1024 * 1024, 0, it - U1);
    else if (it < U3) convert_tile(p.w_out_odd + (size_t)half * 1024 * 1024, 1024, 1024, p.wt_out_odd + (size_t)half * 1024 * 1024, 0, it - U2);
    else if (it < U4) { const int q = it - U3; const int j = 2 * half + q / 1408, t = q % 1408; convert_tile(p.w_ffn_in + (size_t)j * 1024 * 5632, 1024, 5632, p.wt_ffn_in + (size_t)j * 5632 * 1024, 3, t); }
    else { const int q = it - U4; const int j = 2 * half + q / 704, t = q % 704; convert_tile(p.w_ffn_out + (size_t)j * DFF * 1024, DFF, 1024, p.wt_ffn_out + (size_t)j * 1024 * DFF, 0, t); }
  }
}

__device__ void phase_init(const Params& p) {
  const int tid = TID(), nb = gridDim.x, bid = blockIdx.x;
  convert_weights(p, 0, bid, nb);
  if (nb <= 128) convert_weights(p, 1, bid, nb);
  mod_table(p, 0, nb > 128 ? 2 : 4, bid, nb);
}

__device__ void phase_norm(const Params& p, int l, int which, int nrows, bf16_t* __restrict__ H, const float* fold_gate, const float* slab, const float* xlat, const float* xctx, bool skip_latent) {
  const int wave = TID() >> 6, lane = TID() & 63;
  const float* gain = (which == 0 ? p.n1g : p.n2g) + l * 1024;
  const int sh_idx = which == 0 ? 0 : 3, sc_idx = which == 0 ? 1 : 4;
  const int gw = blockIdx.x * 8 + wave, nw = gridDim.x * 8;
  for (int blk = gw; blk < (skip_latent ? 0 : ML / 8); blk += nw) {
    const int row0 = blk * 8;
    const float* md = p.mod + ((size_t)l * 9 + (row0 >> 11)) * 6144;
    float4 A[4], B[4];
#pragma unroll
    for (int i = 0; i < 4; ++i) {
      const int col = i * 256 + lane * 4;
      const float4 g = *(const float4*)(gain + col);
      const float4 sc = *(const float4*)(md + sc_idx * 1024 + col);
      B[i] = *(const float4*)(md + sh_idx * 1024 + col);
      A[i] = make_float4(g.x * (1.f + sc.x), g.y * (1.f + sc.y), g.z * (1.f + sc.z), g.w * (1.f + sc.w));
    }
#pragma unroll
    for (int half = 0; half < 2; ++half) {
      float4 v[4][4];
#pragma unroll
      for (int k = 0; k < 4; ++k)
#pragma unroll
        for (int i = 0; i < 4; ++i) v[k][i] = *(const float4*)(xlat + (size_t)(row0 + half * 4 + k) * D + i * 256 + lane * 4);
#pragma unroll
      for (int k = 0; k < 4; ++k) {
        float ss = 0.f;
#pragma unroll
        for (int i = 0; i < 4; ++i) ss += v[k][i].x * v[k][i].x + v[k][i].y * v[k][i].y + v[k][i].z * v[k][i].z + v[k][i].w * v[k][i].w;
        ss = wave_sum(ss);
        const float r = rsqrtf(ss * (1.f / 1024.f) + EPSN);
#pragma unroll
        for (int i = 0; i < 4; ++i) {
          uint2 o;
          o.x = pack2(v[k][i].x * r * A[i].x + B[i].x, v[k][i].y * r * A[i].y + B[i].y);
          o.y = pack2(v[k][i].z * r * A[i].z + B[i].z, v[k][i].w * r * A[i].w + B[i].w);
          *(uint2*)(H + (size_t)(row0 + half * 4 + k) * D + i * 256 + lane * 4) = o;
        }
      }
    }
  }
  for (int row = ML + gw; row < nrows; row += nw) {
    const float* xr = xctx + (size_t)(row - ML) * D;
    const float* md = p.mod + ((size_t)l * 9 + 8) * 6144;
    float4 v[4];
    float ss = 0.f;
#pragma unroll
    for (int i = 0; i < 4; ++i) v[i] = *(const float4*)(xr + i * 256 + lane * 4);
    if (fold_gate != nullptr) {
      float* zw = p.Z + (size_t)(row - ML) * D;
#pragma unroll
      for (int i = 0; i < 4; ++i) {
        const int col = i * 256 + lane * 4;
        float4 s = make_float4(0.f, 0.f, 0.f, 0.f);
#pragma unroll
        for (int pc = 0; pc < 8; ++pc) { const float4 t = *(const float4*)(slab + ((size_t)pc * MC + (row - ML)) * D + col); s.x += t.x; s.y += t.y; s.z += t.z; s.w += t.w; }
        const float4 g = *(const float4*)(fold_gate + col);
        v[i].x += g.x * s.x; v[i].y += g.y * s.y; v[i].z += g.z * s.z; v[i].w += g.w * s.w;
        *(float4*)(zw + col) = v[i];
      }
    }
#pragma unroll
    for (int i = 0; i < 4; ++i) ss += v[i].x * v[i].x + v[i].y * v[i].y + v[i].z * v[i].z + v[i].w * v[i].w;
    ss = wave_sum(ss);
    const float r = rsqrtf(ss * (1.f / 1024.f) + EPSN);
#pragma unroll
    for (int i = 0; i < 4; ++i) {
      const int col = i * 256 + lane * 4;
      const float4 g = *(const float4*)(gain + col);
      const float4 sh = *(const float4*)(md + sh_idx * 1024 + col);
      const float4 sc = *(const float4*)(md + sc_idx * 1024 + col);
      uint2 o;
      o.x = pack2(v[i].x * r * g.x * (1.f + sc.x) + sh.x, v[i].y * r * g.y * (1.f + sc.y) + sh.y);
      o.y = pack2(v[i].z * r * g.z * (1.f + sc.z) + sh.z, v[i].w * r * g.w * (1.f + sc.w) + sh.w);
      *(uint2*)(H + (size_t)row * D + col) = o;
    }
  }
}

#define LAS __attribute__((address_space(3)))
constexpr int BM = 256, BK = 64, HALF = 128, HTB = HALF * BK * 2, NXCD = 8, WGM = 8;
DI int lds_byte(int r, int c) { const int st = (r >> 4) * 2 + (c >> 5), rr = r & 15, cc = c & 31, ob = rr * 64 + cc * 2; return st * 1024 + (ob ^ (((ob >> 9) & 1) << 5)); }
DI void stage_rc(int b, int& R, int& C) { const int st = b / 1024, sb = b % 1024, swz = sb ^ (((sb >> 9) & 1) << 5); R = (st >> 1) * 16 + swz / 64; C = (st & 1) * 32 + (swz % 64) / 2; }

struct Unit { int pm, pn, k0, nk, part; };
struct TileOrder {
  int nM, nN, nwg, G, c, ntk, nwhole, nMw;
  DI void init(int M, int N, int K, bool split) {
    nM = M / BM; nN = N / BM; nwg = nM * nN; G = gridDim.x; c = blockIdx.x; ntk = K / BK;
    nMw = (split && M == MT) ? ML / BM : nM; nwhole = nMw * nN;
  }
  DI bool next(int i, Unit& u) const {
    long L = (long)i * G + c;
    if (nwg - nwhole == (G >> 3) && nwhole == G) L = i == 0 ? (long)nwhole + c : (i == 1 ? (long)c : (long)nwg * 8);
    if (L >= nwhole) {
      const long q = L - nwhole; const int tile = (int)(q >> 3); if (tile >= nwg - nwhole) return false;
      const int pc = (int)(q & 7);
      const int base = (ntk >> 4) << 1, extra = (ntk - 8 * base) >> 1;
      u.nk = base + (pc < extra ? 2 : 0); u.k0 = pc * base + 2 * (pc < extra ? pc : extra); u.part = 1 + pc;
      u.pm = nMw + tile / nN; u.pn = tile % nN; return true;
    }
    u.k0 = 0; u.nk = ntk; u.part = 0;
    int wgid = (int)L; { const int q = nwhole / NXCD, r = nwhole % NXCD, xcd = wgid % NXCD, off = wgid / NXCD; wgid = (xcd < r ? xcd * (q + 1) : r * (q + 1) + (xcd - r) * q) + off; }
    const int nig = WGM * nN, gid = wgid / nig, fm = gid * WGM, gsz = (nMw - fm) < WGM ? (nMw - fm) : WGM;
    u.pm = fm + ((wgid % nig) % gsz); u.pn = (wgid % nig) / gsz; return true;
  }
};

enum { EPI_P = 0, EPI_RES = 1, EPI_SWIGLU = 2 };
struct EpiArgs { bf16_t* outb; int ld; float* xl; float* xz; const float* gate; float* slab; const float* xin; const float* lbraw; int lyr;
                 float* rowss; unsigned* pcnt; bf16_t* hout; const float* ngain; const float* nmod; int nsh, nsc; };

template <int EPI, bool PART>
DI void gemm_epilogue(f32x4 (&acc)[2][2][4][2], const Unit& u, int wr, int wc, int fr, int fq, const EpiArgs& ea) {
  const int brow = u.pm * BM, bcol = u.pn * BM;
  int amode = 0;
  float4 onek[2][2];
  if (EPI == EPI_P && ea.lbraw != nullptr) {
    amode = bcol < 1024 ? 1 : (bcol < 3072 ? 2 : 0);
    if (amode == 2) {
      const int dirx = bcol >= 2048 ? 1 : 0;
#pragma unroll
      for (int bj = 0; bj < 2; ++bj)
#pragma unroll
        for (int n = 0; n < 2; ++n) {
          const int c = (bcol & 1023) + bj * HALF + wc * 32 + 8 * fq + 4 * n;
          const float* lr = ea.lbraw + (size_t)dirx * 4096 + c;
          const float4 r0 = *(const float4*)(lr), r1 = *(const float4*)(lr + 1024), r2 = *(const float4*)(lr + 2048), r3 = *(const float4*)(lr + 3072);
          float o4[4];
          const float q0[4] = {r0.x, r0.y, r0.z, r0.w}, q1[4] = {r1.x, r1.y, r1.z, r1.w}, q2[4] = {r2.x, r2.y, r2.z, r2.w}, q3[4] = {r3.x, r3.y, r3.z, r3.w};
#pragma unroll
          for (int t = 0; t < 4; ++t) {
            const float mx = fmaxf(fmaxf(q0[t], q1[t]), fmaxf(q2[t], q3[t]));
            const float e0 = __expf(q0[t] - mx), e1 = __expf(q1[t] - mx), e2 = __expf(q2[t] - mx), e3 = __expf(q3[t] - mx);
            float a = 0.f;
            if (ea.lyr >= 1) a += e1;
            if (ea.lyr >= 2) a += e2;
            if (ea.lyr >= 3) a += e3;
            o4[t] = 1.f - a / (e0 + e1 + e2 + e3);
          }
          onek[bj][n] = make_float4(o4[0], o4[1], o4[2], o4[3]);
        }
    }
  }
#pragma unroll
  for (int ai = 0; ai < 2; ++ai)
#pragma unroll
    for (int m = 0; m < 4; ++m) {
      const int row = brow + ai * HALF + wr * 64 + m * 16 + fr;
      if (EPI == EPI_P) {
#pragma unroll
        for (int bj = 0; bj < 2; ++bj) {
          unsigned w4[4];
#pragma unroll
          for (int n = 0; n < 2; ++n) {
            f32x4 a = acc[ai][bj][m][n];
            if (amode == 1) { a[0] = siluf(a[0]) * 0.08838834764831845f; a[1] = siluf(a[1]) * 0.08838834764831845f; a[2] = siluf(a[2]) * 0.08838834764831845f; a[3] = siluf(a[3]) * 0.08838834764831845f; }
            else if (amode == 2) { a[0] = onek[bj][n].x * sigmoidf_(-a[0]); a[1] = onek[bj][n].y * sigmoidf_(-a[1]); a[2] = onek[bj][n].z * sigmoidf_(-a[2]); a[3] = onek[bj][n].w * sigmoidf_(-a[3]); }
            w4[2 * n] = pack2(a[0], a[1]); w4[2 * n + 1] = pack2(a[2], a[3]);
          }
          const int col = bcol + bj * HALF + wc * 32 + 8 * fq;
          *(uint4*)(ea.outb + (size_t)row * ea.ld + col) = make_uint4(w4[0], w4[1], w4[2], w4[3]);
        }
      } else if (EPI == EPI_RES) {
        float* xr = row < ML ? ea.xl + (size_t)row * D : ea.xz + (size_t)(row - ML) * D;
        const int midx = row < ML ? (row >> 11) : 8;
        const float* g = ea.gate + (size_t)midx * 6144;
#pragma unroll
        for (int bj = 0; bj < 2; ++bj)
#pragma unroll
          for (int n = 0; n < 2; ++n) {
            const int col = bcol + bj * HALF + wc * 32 + n * 16 + 4 * fq;
            const f32x4 a = acc[ai][bj][m][n];
            if (PART) {
              *(float4*)(ea.slab + ((size_t)(u.part - 1) * MC + (row - ML)) * D + col) = make_float4(a[0], a[1], a[2], a[3]);
            } else {
              const float4 gv = *(const float4*)(g + col);
              float4 xv = *(const float4*)((row < ML ? ea.xin + (size_t)row * D : (const float*)xr) + col);
              xv.x += gv.x * a[0]; xv.y += gv.y * a[1]; xv.z += gv.z * a[2]; xv.w += gv.w * a[3];
              *(float4*)(xr + col) = xv;
              acc[ai][bj][m][n] = (f32x4){xv.x, xv.y, xv.z, xv.w};
            }
          }
      } else {
        unsigned w4[4];
#pragma unroll
        for (int n = 0; n < 2; ++n) {
          const f32x4 g = acc[ai][0][m][n], up = acc[ai][1][m][n];
          w4[2 * n] = pack2(siluf(g[0]) * up[0], siluf(g[1]) * up[1]); w4[2 * n + 1] = pack2(siluf(g[2]) * up[2], siluf(g[3]) * up[3]);
        }
        *(uint4*)(ea.outb + (size_t)row * ea.ld + u.pn * HALF + wc * 32 + 8 * fq) = make_uint4(w4[0], w4[1], w4[2], w4[3]);
      }
    }
  if (EPI == EPI_RES && !PART && ea.rowss != nullptr) {
    const int lane_ = fr + 16 * fq;
#pragma unroll
    for (int ai = 0; ai < 2; ++ai)
#pragma unroll
      for (int m = 0; m < 4; ++m) {
        float ss = 0.f;
#pragma unroll
        for (int bj = 0; bj < 2; ++bj)
#pragma unroll
          for (int n = 0; n < 2; ++n) { const f32x4 a = acc[ai][bj][m][n]; ss += a[0] * a[0] + a[1] * a[1] + a[2] * a[2] + a[3] * a[3]; }
        ss += __shfl_xor(ss, 16, 64); ss += __shfl_xor(ss, 32, 64);
        if (fq == 0) __hip_atomic_fetch_add(ea.rowss + brow + ai * HALF + wr * 64 + m * 16 + fr, ss, __ATOMIC_RELAXED, __HIP_MEMORY_SCOPE_AGENT);
      }
    asm volatile("s_waitcnt vmcnt(0)" ::: "memory");
    unsigned* pc = ea.pcnt + u.pm * 32;
    if (lane_ == 0) __hip_atomic_fetch_add(pc, 1u, __ATOMIC_RELAXED, __HIP_MEMORY_SCOPE_AGENT);
    const float* md = ea.nmod + (size_t)(brow >> 11) * 6144;
    float4 Aq[2][2], Bq[2][2];
#pragma unroll
    for (int bj = 0; bj < 2; ++bj)
#pragma unroll
      for (int n = 0; n < 2; ++n) {
        const int col = bcol + bj * HALF + wc * 32 + n * 16 + 4 * fq;
        const float4 g = *(const float4*)(ea.ngain + col);
        const float4 sc = *(const float4*)(md + ea.nsc * 1024 + col);
        Bq[bj][n] = *(const float4*)(md + ea.nsh * 1024 + col);
        Aq[bj][n] = make_float4(g.x * (1.f + sc.x), g.y * (1.f + sc.y), g.z * (1.f + sc.z), g.w * (1.f + sc.w));
      }
    if (lane_ == 0) {
      unsigned spins = 0;
      while (__hip_atomic_load(pc, __ATOMIC_RELAXED, __HIP_MEMORY_SCOPE_AGENT) < 32u) { __builtin_amdgcn_s_sleep(1); if (++spins > (1u << 18)) break; }
    }
    asm volatile("" ::: "memory");
#pragma unroll
    for (int ai = 0; ai < 2; ++ai)
#pragma unroll
      for (int m = 0; m < 4; ++m) {
        const int row = brow + ai * HALF + wr * 64 + m * 16 + fr;
        const float tot = __hip_atomic_load(ea.rowss + row, __ATOMIC_RELAXED, __HIP_MEMORY_SCOPE_AGENT);
        const float r = rsqrtf(tot * (1.f / 1024.f) + EPSN);
#pragma unroll
        for (int bj = 0; bj < 2; ++bj)
#pragma unroll
          for (int n = 0; n < 2; ++n) {
            const int col = bcol + bj * HALF + wc * 32 + n * 16 + 4 * fq;
            const f32x4 a = acc[ai][bj][m][n];
            uint2 o;
            o.x = pack2(a[0] * r * Aq[bj][n].x + Bq[bj][n].x, a[1] * r * Aq[bj][n].y + Bq[bj][n].y);
            o.y = pack2(a[2] * r * Aq[bj][n].z + Bq[bj][n].z, a[3] * r * Aq[bj][n].w + Bq[bj][n].w);
            *(uint2*)(ea.hout + (size_t)row * D + col) = o;
          }
      }
  }
}

template <int EPI>
DI void gemm_phase(const bf16_t* __restrict__ Ag, const bf16_t* __restrict__ Btg, int M, int N, int K, const EpiArgs ea) {
  LAS unsigned char* lds = (LAS unsigned char*)smem_raw;
  TileOrder S; S.init(M, N, K, EPI == EPI_RES);
  const int tid = TID(), wid = __builtin_amdgcn_readfirstlane(tid >> 6), lane = tid & 63, wr = wid >> 2, wc = wid & 3, fr = lane & 15, fq = lane >> 4;
  unsigned voffA[2];
#pragma unroll
  for (int i = 0; i < 2; ++i) { int R, C; stage_rc(tid * 16 + i * 8192, R, C); voffA[i] = (unsigned)(R * K + C) * 2u; }
  const size_t kstep = (size_t)(BK * 2);
  const size_t hstep = (size_t)HALF * K * 2;
  const size_t tstep = 2 * hstep;
  const unsigned ldsw = (unsigned)wid * 1024u;
  const int aoff = lds_byte(wr * 64 + fr, fq * 8), boff = lds_byte(wc * 32 + fr, fq * 8);
#define G_SA(b, h) (((b) * 2 + (h)) * HTB)
#define G_SB(b, h) ((4 + (b) * 2 + (h)) * HTB)
#define G_STAGE(bufoff, gbase) do { _Pragma("unroll") for (int _i = 0; _i < 2; ++_i) \
    __builtin_amdgcn_global_load_lds((const unsigned*)((const char*)(gbase) + voffA[_i]), (LAS unsigned*)(lds + (bufoff) + ldsw + _i * 8192), 16, 0, 0); } while (0)
#define G_LDA(dst, b, h) do { _Pragma("unroll") for (int m = 0; m < 4; ++m) _Pragma("unroll") for (int k = 0; k < 2; ++k) dst[m][k] = *(const LAS bf16x8*)(lds + G_SA(b, h) + aoff + m * 2048 + k * 1024); } while (0)
#define G_LDB(dst, b, h) do { _Pragma("unroll") for (int n = 0; n < 2; ++n) _Pragma("unroll") for (int k = 0; k < 2; ++k) dst[n][k] = *(const LAS bf16x8*)(lds + G_SB(b, h) + boff + n * 2048 + k * 1024); } while (0)
#define G_MMA(ai, bj, At_, Bt_) do { __builtin_amdgcn_s_setprio(1); _Pragma("unroll") for (int m = 0; m < 4; ++m) _Pragma("unroll") for (int n = 0; n < 2; ++n) _Pragma("unroll") for (int k = 0; k < 2; ++k) \
    acc[ai][bj][m][n] = __builtin_amdgcn_mfma_f32_16x16x32_bf16(Bt_[n][k], At_[m][k], acc[ai][bj][m][n], 0, 0, 0); __builtin_amdgcn_s_setprio(0); } while (0)
#define G_WAIT_V(n) asm volatile("s_waitcnt vmcnt(" #n ")" ::: "memory")
#define G_WAIT_L(n) asm volatile("s_waitcnt lgkmcnt(" #n ")" ::: "memory")
#define G_BAR __builtin_amdgcn_s_barrier()
#define G_SCHED __builtin_amdgcn_sched_barrier(0)
  Unit cur, nxt; int ui = 0;
  if (S.next(0, cur)) {
    f32x4 acc[2][2][4][2];
#pragma unroll
    for (int a = 0; a < 2; ++a)
#pragma unroll
      for (int b = 0; b < 2; ++b)
#pragma unroll
        for (int m = 0; m < 4; ++m)
#pragma unroll
          for (int n = 0; n < 2; ++n) acc[a][b][m][n] = (f32x4){0.f, 0.f, 0.f, 0.f};
    bf16x8 At[4][2], B0[2][2], B1[2][2];
    const char* cA = (const char*)Ag + (size_t)cur.pm * tstep + (size_t)cur.k0 * kstep; const char* cB = (const char*)Btg + (size_t)cur.pn * tstep + (size_t)cur.k0 * kstep;
    G_STAGE(G_SB(0, 0), cB); G_STAGE(G_SA(0, 0), cA); G_STAGE(G_SB(0, 1), cB + hstep); G_STAGE(G_SA(0, 1), cA + hstep);
    if (wr == 1) G_BAR;
    G_WAIT_V(4); G_BAR;
    G_STAGE(G_SB(1, 0), cB + kstep); G_STAGE(G_SA(1, 0), cA + kstep); G_STAGE(G_SB(1, 1), cB + hstep + kstep);
    G_WAIT_V(6); G_BAR;
    for (;;) {
      const bool has_next = S.next(ui + 1, nxt);
      const char* nA = has_next ? (const char*)Ag + (size_t)nxt.pm * tstep + (size_t)nxt.k0 * kstep : cA; const char* nB = has_next ? (const char*)Btg + (size_t)nxt.pn * tstep + (size_t)nxt.k0 * kstep : cB;
      const int nt = cur.nk;
      for (int t = 0; t < nt; t += 2) {
        const bool last = (t == nt - 2);
        const char* a1 = cA + (size_t)(t + 1) * kstep;
        const char* a2 = last ? nA : cA + (size_t)(t + 2) * kstep; const char* b2 = last ? nB : cB + (size_t)(t + 2) * kstep;
        const char* a3 = a2 + kstep; const char* b3 = b2 + kstep;
        G_LDB(B0, 0, 0); G_SCHED; G_LDA(At, 0, 0); G_STAGE(G_SA(1, 1), a1 + hstep);
        G_WAIT_L(8); G_BAR; G_WAIT_L(0); G_MMA(0, 0, At, B0); G_BAR; G_SCHED;
        G_LDB(B1, 0, 1); G_STAGE(G_SB(0, 0), b2);
        G_BAR; G_WAIT_L(0); G_MMA(0, 1, At, B1); G_BAR;
        G_LDA(At, 0, 1); G_STAGE(G_SA(0, 0), a2);
        G_BAR; G_WAIT_L(0); G_MMA(1, 0, At, B0); G_BAR; G_SCHED;
        G_STAGE(G_SB(0, 1), b2 + hstep);
        G_WAIT_V(6); G_BAR; G_MMA(1, 1, At, B1); G_BAR;
        G_LDB(B0, 1, 0); G_SCHED; G_LDA(At, 1, 0); G_STAGE(G_SA(0, 1), a2 + hstep);
        G_WAIT_L(8); G_BAR; G_WAIT_L(0); G_MMA(0, 0, At, B0); G_BAR; G_SCHED;
        G_LDB(B1, 1, 1); G_STAGE(G_SB(1, 0), b3);
        G_BAR; G_WAIT_L(0); G_MMA(0, 1, At, B1); G_BAR;
        G_LDA(At, 1, 1); G_STAGE(G_SA(1, 0), a3);
        G_BAR; G_WAIT_L(0); G_MMA(1, 0, At, B0); G_BAR; G_SCHED;
        G_STAGE(G_SB(1, 1), b3 + hstep);
        G_WAIT_V(6); G_BAR; G_MMA(1, 1, At, B1); G_BAR;
      }
      const bool defer = EPI == EPI_RES && !has_next && ea.rowss != nullptr && !cur.part;
      if (!defer) { if (EPI == EPI_RES && cur.part) gemm_epilogue<EPI, true>(acc, cur, wr, wc, fr, fq, ea); else gemm_epilogue<EPI, false>(acc, cur, wr, wc, fr, fq, ea); }
      if (!has_next) break;
#pragma unroll
      for (int a = 0; a < 2; ++a)
#pragma unroll
        for (int b = 0; b < 2; ++b)
#pragma unroll
          for (int m = 0; m < 4; ++m)
#pragma unroll
            for (int n = 0; n < 2; ++n) acc[a][b][m][n] = (f32x4){0.f, 0.f, 0.f, 0.f};
      cur = nxt; cA = nA; cB = nB; ++ui;
    }
    G_WAIT_V(0);
    if (wr == 0) G_BAR;
    G_BAR;
    if (EPI == EPI_RES && ea.rowss != nullptr && !cur.part) gemm_epilogue<EPI, false>(acc, cur, wr, wc, fr, fq, ea);
  }
#undef G_SA
#undef G_SB
#undef G_STAGE
#undef G_LDA
#undef G_LDB
#undef G_MMA
}

__device__ void phase_prep_even(const Params& p, int j) {
  const int wave = TID() >> 6, lane = TID() & 63, tid = TID();
  const float qscale = 0.125f * 1.44269504088896f;
  const int gw = blockIdx.x * 8 + wave, nw = gridDim.x * 8;
  {
    const int li = lane & 7, d0 = 8 * li;
    float gq[8], gk[8];
#pragma unroll
    for (int u = 0; u < 8; ++u) { gq[u] = p.qk_gain[j * 128 + d0 + u] * qscale; gk[u] = p.qk_gain[j * 128 + 64 + d0 + u]; }
    const int aidx = 8 * (li & 1);
    const bool second = (li & 2) != 0;
    auto do_rows = [&](int row0, int nr, bool lat) {
      uint4 raw[4][2];
#pragma unroll
      for (int k = 0; k < 4; ++k)
        if (k < nr) {
          const bf16_t* pr = p.P + (size_t)(row0 + k) * LDP_E;
          raw[k][0] = *(const uint4*)(pr + lane * 8); raw[k][1] = *(const uint4*)(pr + 512 + lane * 8);
        }
#pragma unroll
      for (int k = 0; k < 4; ++k)
        if (k < nr) {
          const int t = (row0 + k) & 2047;
          const int pos = (li & 4) ? (t & 63) : (t >> 6);
          float cs[8], sn[8];
          if (lat) {
#pragma unroll
            for (int u = 0; u < 8; ++u) { cs[u] = ROPE_CS[pos][aidx + u]; sn[u] = ROPE_SN[pos][aidx + u]; }
          }
#pragma unroll
          for (int hf = 0; hf < 2; ++hf) {
            const unsigned w4[4] = {raw[k][hf].x, raw[k][hf].y, raw[k][hf].z, raw[k][hf].w};
            float v[8];
            float ss = 0.f;
#pragma unroll
            for (int u = 0; u < 4; ++u) { v[2 * u] = __uint_as_float(w4[u] << 16); v[2 * u + 1] = __uint_as_float(w4[u] & 0xffff0000u); }
#pragma unroll
            for (int u = 0; u < 8; ++u) ss += v[u] * v[u];
            ss += __shfl_xor(ss, 1, 64); ss += __shfl_xor(ss, 2, 64); ss += __shfl_xor(ss, 4, 64);
            const float r = rsqrtf(ss * (1.f / 64.f) + EPSN);
            float y[8];
#pragma unroll
            for (int u = 0; u < 8; ++u) y[u] = v[u] * r * (hf == 0 ? gq[u] : gk[u]);
            if (lat) {
#pragma unroll
              for (int u = 0; u < 8; ++u) {
                const float o = __shfl_xor(y[u], 2, 64);
                y[u] = second ? (y[u] * cs[u] + o * sn[u]) : (y[u] * cs[u] - o * sn[u]);
              }
            }
            uint4 ov; ov.x = pack2(y[0], y[1]); ov.y = pack2(y[2], y[3]); ov.z = pack2(y[4], y[5]); ov.w = pack2(y[6], y[7]);
            *(uint4*)(p.P + (size_t)(row0 + k) * LDP_E + hf * 512 + lane * 8) = ov;
          }
        }
    };
    for (int blk = gw; blk < ML / 8; blk += nw) { do_rows(blk * 8, 4, true); do_rows(blk * 8 + 4, 4, true); }
    for (int row = ML + gw; row < MT; row += nw) do_rows(row, 1, false);
  }
  bf16_t* ts = (bf16_t*)smem_raw;
  for (int it = blockIdx.x; it < NB * 4 * 36; it += gridDim.x) {
    const int kb = it % 36, h = (it / 36) & 3, b = it / 144;
    __syncthreads();
    {
      const int r = tid >> 3, ch = tid & 7;
      const int kk = kb * 64 + r;
      const int row = kk < TCX ? ML + b * TCX + kk : b * TL + (kk - TCX);
      const bf16_t* src = p.P + (size_t)row * LDP_E + 1024 + h * 128;
#pragma unroll
      for (int i = 0; i < 2; ++i) {
        const int c8 = (ch + i * 8) * 8;
        const uint4 v = *(const uint4*)(src + c8);
        unsigned* d = (unsigned*)(ts + r * 130 + c8);
        d[0] = v.x; d[1] = v.y; d[2] = v.z; d[3] = v.w;
      }
    }
    __syncthreads();
    {
      const int e = tid >> 2, kq = tid & 3;
      unsigned w[8];
#pragma unroll
      for (int i = 0; i < 8; ++i) {
        const unsigned lo = ts[(kq * 16 + 2 * i) * 130 + e], hi = ts[(kq * 16 + 2 * i + 1) * 130 + e];
        w[i] = lo | (hi << 16);
      }
      bf16_t* dst = p.Vt + ((size_t)(b * 4 + h) * 128 + e) * NKK + kb * 64 + kq * 16;
      *(uint4*)(dst) = make_uint4(w[0], w[1], w[4], w[5]);
      *(uint4*)(dst + 8) = make_uint4(w[2], w[3], w[6], w[7]);
    }
  }
  {
    float wreg[8][16], breg[8];
#pragma unroll
    for (int u = 0; u < 8; ++u) {
      const int col = u * 64 + lane, dr = col >> 8, cc = col & 255;
      breg[u] = p.b_gate_up[j * 512 + col];
#pragma unroll
      for (int rr = 0; rr < 16; ++rr) wreg[u][rr] = p.w_gate_up[(size_t)j * 8192 + (dr * 16 + rr) * 256 + cc];
    }
    auto gate_rows = [&](int row0, int nr) {
      uint4 lrw[2][4];
#pragma unroll
      for (int k = 0; k < 2; ++k)
        if (k < nr) {
          const uint4* pr = (const uint4*)(p.P + (size_t)(row0 + k) * LDP_E + 3072);
          lrw[k][0] = pr[0]; lrw[k][1] = pr[1]; lrw[k][2] = pr[2]; lrw[k][3] = pr[3];
        }
#pragma unroll
      for (int k = 0; k < 2; ++k)
        if (k < nr) {
          float lr[32];
#pragma unroll
          for (int q = 0; q < 4; ++q) {
            const unsigned w4[4] = {lrw[k][q].x, lrw[k][q].y, lrw[k][q].z, lrw[k][q].w};
#pragma unroll
            for (int u = 0; u < 4; ++u) { lr[8 * q + 2 * u] = __uint_as_float(w4[u] << 16); lr[8 * q + 2 * u + 1] = __uint_as_float(w4[u] & 0xffff0000u); }
          }
#pragma unroll
          for (int u = 0; u < 8; ++u) {
            const int dr = u >> 2;
            float xg = breg[u];
#pragma unroll
            for (int rr = 0; rr < 16; ++rr) xg += lr[dr * 16 + rr] * wreg[u][rr];
            const float ls = fminf(xg, 0.f) - __logf(1.f + __expf(-fabsf(xg)));
            p.Gk[(size_t)(row0 + k) * 512 + u * 64 + lane] = __expf(ls * (1.f / 16.f));
          }
        }
    };
    for (int blk = gw; blk < MT / 8; blk += nw) { gate_rows(blk * 8, 2); gate_rows(blk * 8 + 2, 2); gate_rows(blk * 8 + 4, 2); gate_rows(blk * 8 + 6, 2); }
  }
}

__device__ void attn_item(const Params& p, int item) {
  const int tid = TID(), wave = tid >> 6, lane = tid & 63, r = lane & 31, hh = lane >> 5;
  int b, hc, qrow0, krow_ctx, krow_lat, ntile;
  if (item < 512) { b = item >> 6; hc = (item >> 3) & 7; qrow0 = b * TL + (item & 7) * 256; ntile = 36; }
  else { const int i2 = item - 512; b = i2 >> 3; hc = i2 & 7; qrow0 = ML + b * TCX; ntile = 4; }
  krow_ctx = ML + b * TCX; krow_lat = b * TL;
  const int h = hc >> 1, c = hc & 1;
  bf16_t* Ksm = (bf16_t*)smem_raw;
  bf16_t* Vsm = (bf16_t*)(smem_raw + 2 * 9216);
  const int qrow = qrow0 + wave * 32 + r;
  bf16x8 qf[4];
#pragma unroll
  for (int s = 0; s < 4; ++s) qf[s] = *(const bf16x8*)(p.P + (size_t)qrow * LDP_E + hc * 64 + 16 * s + 8 * hh);
  f32x16 oacc[4];
#pragma unroll
  for (int eb = 0; eb < 4; ++eb)
#pragma unroll
    for (int i = 0; i < 16; ++i) oacc[eb][i] = 0.f;
  float mrun = -1e30f, lsum = 0.f;
  const int kkey = tid >> 3, kch = tid & 7;
  const int ve = tid >> 2, vch = tid & 3;
  const bf16_t* vbase = p.Vt + ((size_t)(b * 4 + h) * 128 + ve) * NKK + vch * 16;
  uint4 kreg, vreg0, vreg1;
  auto gload = [&](int t) {
    const int kk = t * 64 + kkey;
    const int row = kk < TCX ? krow_ctx + kk : krow_lat + (kk - TCX);
    kreg = *(const uint4*)(p.P + (size_t)row * LDP_E + 512 + hc * 64 + kch * 8);
    vreg0 = *(const uint4*)(vbase + t * 64);
    vreg1 = *(const uint4*)(vbase + t * 64 + 8);
  };
  auto sstore = [&](int buf) {
    *(uint4*)(Ksm + buf * 4608 + kkey * 72 + kch * 8) = kreg;
    uint4* d = (uint4*)(Vsm + buf * 9216 + ve * 72 + vch * 16);
    d[0] = vreg0; d[1] = vreg1;
  };
  __syncthreads();
  gload(0); sstore(0);
  __syncthreads();
  for (int t = 0; t < ntile; ++t) {
    const int buf = t & 1;
    if (t + 1 < ntile) gload(t + 1);
    const bf16_t* Kb = Ksm + buf * 4608;
    const bf16_t* Vb = Vsm + buf * 9216;
    f32x16 sacc[2];
#pragma unroll
    for (int kb = 0; kb < 2; ++kb) {
#pragma unroll
      for (int i = 0; i < 16; ++i) sacc[kb][i] = 0.f;
#pragma unroll
      for (int s = 0; s < 4; ++s) {
        const bf16x8 kf = *(const bf16x8*)(Kb + (32 * kb + r) * 72 + 16 * s + 8 * hh);
        sacc[kb] = __builtin_amdgcn_mfma_f32_32x32x16_bf16(kf, qf[s], sacc[kb], 0, 0, 0);
      }
    }
    float mx = sacc[0][0];
#pragma unroll
    for (int kb = 0; kb < 2; ++kb)
#pragma unroll
      for (int i = 0; i < 16; ++i) mx = fmaxf(mx, sacc[kb][i]);
    mx = fmaxf(mx, __shfl_xor(mx, 32, 64));
    if (__builtin_amdgcn_ballot_w64(mx > mrun + 8.f)) {
      const float mnew = fmaxf(mrun, mx);
      const float alpha = __builtin_amdgcn_exp2f(mrun - mnew);
      mrun = mnew;
      lsum *= alpha;
#pragma unroll
      for (int eb = 0; eb < 4; ++eb)
#pragma unroll
        for (int i = 0; i < 16; ++i) oacc[eb][i] *= alpha;
    }
    float ps = 0.f;
#pragma unroll
    for (int kb = 0; kb < 2; ++kb)
#pragma unroll
      for (int i = 0; i < 16; ++i) { const float pv = __builtin_amdgcn_exp2f(sacc[kb][i] - mrun); sacc[kb][i] = pv; ps += pv; }
    lsum += ps;
#pragma unroll
    for (int ks = 0; ks < 4; ++ks) {
      const int kb = ks >> 1, s2 = ks & 1;
      uint4 pu;
      pu.x = pack2(sacc[kb][8 * s2 + 0], sacc[kb][8 * s2 + 1]); pu.y = pack2(sacc[kb][8 * s2 + 2], sacc[kb][8 * s2 + 3]);
      pu.z = pack2(sacc[kb][8 * s2 + 4], sacc[kb][8 * s2 + 5]); pu.w = pack2(sacc[kb][8 * s2 + 6], sacc[kb][8 * s2 + 7]);
      const bf16x8 pf = __builtin_bit_cast(bf16x8, pu);
#pragma unroll
      for (int eb = 0; eb < 4; ++eb) {
        const bf16x8 vf = *(const bf16x8*)(Vb + (32 * eb + r) * 72 + 16 * ks + 8 * hh);
        oacc[eb] = __builtin_amdgcn_mfma_f32_32x32x16_bf16(vf, pf, oacc[eb], 0, 0, 0);
      }
    }
    if (t + 1 < ntile) sstore(buf ^ 1);
    __syncthreads();
  }
  lsum += __shfl_xor(lsum, 32, 64);
  const float inv = 1.f / lsum;
  bf16_t* orow = p.R1 + (size_t)qrow * D + c * 512 + h * 128;
#pragma unroll
  for (int eb = 0; eb < 4; ++eb)
#pragma unroll
    for (int g = 0; g < 4; ++g) {
      const int e = 32 * eb + 8 * g + 4 * hh;
      uint2 o; o.x = pack2(oacc[eb][4 * g] * inv, oacc[eb][4 * g + 1] * inv); o.y = pack2(oacc[eb][4 * g + 2] * inv, oacc[eb][4 * g + 3] * inv);
      *(uint2*)(orow + e) = o;
    }
}

template <int MODE>
__device__ void scan_item(const Params& p, int l, int item) {
  constexpr int DK = MODE ? 128 : 64, DVS = MODE ? 64 : 32, DP = NTHR / DVS, DPT = DK / DP, TC = 32;
  constexpr int NH = MODE ? 8 : 4, NSL = 128 / DVS, LDP = MODE ? LDP_O : LDP_E;
  const int j = l >> 1;
  const int sl = item % NSL, dir = (item / NSL) & 1, h = (item / (NSL * 2)) % NH, b = item / (NSL * 2 * NH);
  float* Qs = (float*)smem_raw; float* Ks = Qs + TC * DK; float* Ds = Ks + TC * DK; float* Vs = Ds + TC * DK; float* Os = Vs + TC * DVS; float* LB = Os + TC * DVS;
  const int tid = TID(), dpart = tid % DP, e = tid / DP;
  float S[DPT];
#pragma unroll
  for (int i = 0; i < DPT; ++i) S[i] = 0.f;
  __syncthreads();
  if (MODE == 1) {
    if (tid < 128) {
      const float* lr = p.lb_raw + (size_t)dir * 4 * 1024 + h * 128 + tid;
      const float r0 = lr[0], r1 = lr[1024], r2 = lr[2048], r3 = lr[3072];
      const float mx = fmaxf(fmaxf(r0, r1), fmaxf(r2, r3));
      const float e0 = __expf(r0 - mx), e1 = __expf(r1 - mx), e2 = __expf(r2 - mx), e3 = __expf(r3 - mx);
      const float inv = 1.f / (e0 + e1 + e2 + e3);
      float acc = 0.f;
      if (l >= 1) acc += e1;
      if (l >= 2) acc += e2;
      if (l >= 3) acc += e3;
      LB[tid] = acc * inv;
    }
  }
  bf16_t* Ro;
  int ldo, ocol;
  if (MODE == 0) { Ro = p.R2 + (size_t)dir * MT * 512; ldo = 512; ocol = h * 128 + sl * DVS; }
  else { Ro = dir ? p.R2 : p.R1; ldo = 1024; ocol = h * 128 + sl * DVS; }
  for (int chunk = 0; chunk < NKK / TC; ++chunk) {
    __syncthreads();
    for (int idx = tid; idx < TC * DK; idx += NTHR) {
      const int tt = idx / DK, d = idx % DK;
      const int n = chunk * TC + tt;
      int row;
      if (n < TCX) row = ML + b * TCX + (dir ? (TCX - 1 - n) : n); else row = b * TL + (dir ? (TL - 1 - (n - TCX)) : (n - TCX));
      const bf16_t* pr = p.P + (size_t)row * LDP;
      float q, k, dec;
      if (MODE == 0) {
        q = bf2f(pr[1536 + h * 64 + d]) * 0.125f;
        k = bf2f(pr[1792 + h * 64 + d]);
        const float* w = p.w_gate_up + ((size_t)(j * 2 + dir) * 16) * 256 + h * 64 + d;
        float xg = p.b_gate_up[(j * 2 + dir) * 256 + h * 64 + d];
#pragma unroll
        for (int rr = 0; rr < 16; ++rr) xg += bf2f(pr[3072 + dir * 16 + rr]) * w[rr * 256];
        const float ls = fminf(xg, 0.f) - log1pf(__expf(-fabsf(xg)));
        dec = __expf(ls * (1.f / 16.f));
      } else {
        q = siluf(bf2f(pr[h * 128 + d])) * 0.08838834764831845f;
        const float lbv = LB[d];
        const float f = lbv + (1.f - lbv) * sigmoidf_(bf2f(pr[1024 + dir * 1024 + h * 128 + d]));
        k = 1.f - f; dec = f;
      }
      Qs[idx] = q; Ks[idx] = k; Ds[idx] = dec;
    }
    for (int idx = tid; idx < TC * DVS; idx += NTHR) {
      const int tt = idx / DVS, ee = idx % DVS;
      const int n = chunk * TC + tt;
      int row;
      if (n < TCX) row = ML + b * TCX + (dir ? (TCX - 1 - n) : n); else row = b * TL + (dir ? (TL - 1 - (n - TCX)) : (n - TCX));
      const bf16_t* pr = p.P + (size_t)row * LDP;
      Vs[idx] = bf2f(pr[(MODE ? 3072 : 2048) + h * 128 + sl * DVS + ee]);
    }
    __syncthreads();
    for (int tt = 0; tt < TC; ++tt) {
      const float v = Vs[tt * DVS + e];
      float part = 0.f;
#pragma unroll
      for (int i4 = 0; i4 < DPT / 4; ++i4) {
        const float4 q4 = *(const float4*)(Qs + tt * DK + dpart * DPT + i4 * 4);
        const float4 k4 = *(const float4*)(Ks + tt * DK + dpart * DPT + i4 * 4);
        const float4 d4 = *(const float4*)(Ds + tt * DK + dpart * DPT + i4 * 4);
        S[i4 * 4 + 0] = S[i4 * 4 + 0] * d4.x + k4.x * v; part += q4.x * S[i4 * 4 + 0];
        S[i4 * 4 + 1] = S[i4 * 4 + 1] * d4.y + k4.y * v; part += q4.y * S[i4 * 4 + 1];
        S[i4 * 4 + 2] = S[i4 * 4 + 2] * d4.z + k4.z * v; part += q4.z * S[i4 * 4 + 2];
        S[i4 * 4 + 3] = S[i4 * 4 + 3] * d4.w + k4.w * v; part += q4.w * S[i4 * 4 + 3];
      }
#pragma unroll
      for (int o = DP / 2; o >= 1; o >>= 1) part += __shfl_xor(part, o, 64);
      if (dpart == 0) Os[tt * DVS + e] = part;
    }
    __syncthreads();
    for (int idx = tid; idx < TC * DVS; idx += NTHR) {
      const int tt = idx / DVS, ee = idx % DVS;
      const int n = chunk * TC + tt;
      int row;
      if (n < TCX) row = ML + b * TCX + (dir ? (TCX - 1 - n) : n); else row = b * TL + (dir ? (TL - 1 - (n - TCX)) : (n - TCX));
      Ro[(size_t)row * ldo + ocol + ee] = f2bf(Os[idx]);
    }
  }
}

template <int MODE>
__device__ void scan2_item(const Params& p, int l, int item) {
  constexpr int DK = MODE ? 128 : 64, NH = MODE ? 8 : 4, LDP = MODE ? LDP_O : LDP_E, NDB = DK / 16, QS = DK + 8, TS = 72;
  const int dir = item & 1, h = (item >> 1) % NH, b = item / (2 * NH);
  bf16_t* Qh = (bf16_t*)smem_raw; bf16_t* Kh = Qh + 64 * QS; bf16_t* KbT = Kh + 64 * QS; bf16_t* VT = KbT + DK * TS; float* ET = (float*)(VT + 128 * TS);
  const int tid = TID(), wave = __builtin_amdgcn_readfirstlane(tid >> 6), lane = tid & 63, r15 = lane & 15, fq = lane >> 4;
  const int pd = tid % DK, pi = __builtin_amdgcn_readfirstlane(tid / DK);
  const bool pact = pi < 4;
  const int ve = tid & 127, vi = __builtin_amdgcn_readfirstlane(tid >> 7);
  float lbv = 0.f;
  if (MODE == 1) {
    const float* lr = p.lb_raw + (size_t)dir * 4 * 1024 + h * 128 + pd;
    const float r0 = lr[0], r1 = lr[1024], r2 = lr[2048], r3 = lr[3072];
    const float mx = fmaxf(fmaxf(r0, r1), fmaxf(r2, r3));
    const float e0 = __expf(r0 - mx), e1 = __expf(r1 - mx), e2 = __expf(r2 - mx), e3 = __expf(r3 - mx);
    float a = 0.f;
    if (l >= 1) a += e1;
    if (l >= 2) a += e2;
    if (l >= 3) a += e3;
    lbv = a / (e0 + e1 + e2 + e3);
  }
  const int qcol = MODE ? h * 128 + pd : 1536 + h * 64 + pd;
  const int kcol = MODE ? 1024 + dir * 1024 + h * 128 + pd : 1792 + h * 64 + pd;
  const int vcol = (MODE ? 3072 : 2048) + h * 128 + ve;
  const int gcol = dir * 256 + h * 64 + pd;
  bf16_t* Ro; int ldo;
  if (MODE == 0) { Ro = p.R2 + (size_t)dir * MT * 512; ldo = 512; } else { Ro = dir ? p.R2 : p.R1; ldo = 1024; }
  Ro += h * 128 + 16 * wave + r15;
  const int rowc = ML + b * TCX, rowl = b * TL;
  auto tokrow = [&](int n) -> int { return n < TCX ? rowc + (dir ? (TCX - 1 - n) : n) : rowl + (dir ? (TL - 1 - (n - TCX)) : (n - TCX)); };
  bf16_t rq[16], rk[16], rv[16]; float rg[16];
  auto load_raw = [&](int ck) {
#pragma unroll
    for (int tt = 0; tt < 16; ++tt) {
      if (pact) {
        const int row = tokrow(ck * 64 + 16 * pi + tt);
        const bf16_t* pr = p.P + (size_t)row * LDP;
        rq[tt] = pr[qcol]; rk[tt] = pr[kcol];
#if EXP2
        if (MODE == 0) {
          const int jx = l >> 1;
          const float* w = p.w_gate_up + ((size_t)(jx * 2 + dir) * 16) * 256 + h * 64 + pd;
          float xg = p.b_gate_up[(jx * 2 + dir) * 256 + h * 64 + pd];
#pragma unroll
          for (int rr = 0; rr < 16; ++rr) xg += bf2f(pr[3072 + dir * 16 + rr]) * w[rr * 256];
          const float ls = fminf(xg, 0.f) - log1pf(__expf(-fabsf(xg)));
          rg[tt] = ls * (1.f / 16.f);
        }
#else
        if (MODE == 0) rg[tt] = p.Gk[(size_t)row * 512 + gcol];
#endif
      }
      const int rowv = tokrow(ck * 64 + 16 * vi + tt);
      rv[tt] = p.P[(size_t)rowv * LDP + vcol];
    }
  };
  f32x4 S[NDB];
#pragma unroll
  for (int db = 0; db < NDB; ++db) S[db] = (f32x4){0.f, 0.f, 0.f, 0.f};
  constexpr int BUFE = 2 * 64 * QS + DK * TS + 128 * TS + 2 * 4 * DK;
  auto prep = [&](int bi) {
    bf16_t* Qh_ = Qh + bi * BUFE; bf16_t* Kh_ = Kh + bi * BUFE; bf16_t* KbT_ = KbT + bi * BUFE; bf16_t* VT_ = VT + bi * BUFE; float* ET_ = (float*)(VT_ + 128 * TS);
    if (pact) {
      float E = 1.f, kh[16];
#pragma unroll
      for (int tt = 0; tt < 16; ++tt) {
        float q, k, dec;
        if (MODE == 1) {
          q = siluf(bf2f(rq[tt])) * 0.08838834764831845f;
          dec = lbv + (1.f - lbv) * sigmoidf_(bf2f(rk[tt]));
          k = 1.f - dec;
        } else { q = bf2f(rq[tt]) * 0.125f; k = bf2f(rk[tt]); dec = rg[tt]; }
        E *= dec;
        const float kE = k * __builtin_amdgcn_rcpf(E);
        kh[tt] = kE;
        Qh_[(16 * pi + tt) * QS + pd] = f2bf(q * E);
        Kh_[(16 * pi + tt) * QS + pd] = f2bf(kE);
      }
      ET_[pi * DK + pd] = E;
      unsigned w[8];
#pragma unroll
      for (int u = 0; u < 8; ++u) w[u] = pack2(kh[2 * u] * E, kh[2 * u + 1] * E);
      *(uint4*)(KbT_ + pd * TS + 16 * pi) = make_uint4(w[0], w[1], w[2], w[3]);
      *(uint4*)(KbT_ + pd * TS + 16 * pi + 8) = make_uint4(w[4], w[5], w[6], w[7]);
    }
    {
      unsigned w[8];
#pragma unroll
      for (int u = 0; u < 8; ++u) w[u] = (unsigned)rv[2 * u] | ((unsigned)rv[2 * u + 1] << 16);
      *(uint4*)(VT_ + ve * TS + 16 * vi) = make_uint4(w[0], w[1], w[2], w[3]);
      *(uint4*)(VT_ + ve * TS + 16 * vi + 8) = make_uint4(w[4], w[5], w[6], w[7]);
    }
  };
  __syncthreads();
  load_raw(0);
  prep(0);
  load_raw(1);
  __syncthreads();
  for (int ck = 0; ck < NKK / 64; ++ck) {
    if (ck + 1 < NKK / 64) { prep((ck + 1) & 1); if (ck + 2 < NKK / 64) load_raw(ck + 2); }
    const int bo = (ck & 1) * BUFE;
    const bf16_t* Qb = Qh + bo; const bf16_t* Kb = Kh + bo; const bf16_t* KTb = KbT + bo; const bf16_t* Vb = VT + bo; const float* Eb = (const float*)(Vb + 128 * TS);
#pragma unroll
    for (int i = 0; i < 4; ++i) {
      f32x4 att = (f32x4){0.f, 0.f, 0.f, 0.f};
#pragma unroll
      for (int kb = 0; kb < DK / 32; ++kb) {
        const bf16x8 ka = *(const bf16x8*)(Kb + (16 * i + r15) * QS + 32 * kb + 8 * fq);
        const bf16x8 qb = *(const bf16x8*)(Qb + (16 * i + r15) * QS + 32 * kb + 8 * fq);
        att = __builtin_amdgcn_mfma_f32_16x16x32_bf16(ka, qb, att, 0, 0, 0);
      }
      const unsigned a01 = pack2((4 * fq + 0 <= r15) ? att[0] : 0.f, (4 * fq + 1 <= r15) ? att[1] : 0.f);
      const unsigned a23 = pack2((4 * fq + 2 <= r15) ? att[2] : 0.f, (4 * fq + 3 <= r15) ? att[3] : 0.f);
      const bf16x8 a8 = __builtin_bit_cast(bf16x8, make_uint4(a01, a23, 0u, 0u));
      f32x4 o = (f32x4){0.f, 0.f, 0.f, 0.f};
#pragma unroll
      for (int kb = 0; kb < DK / 32; ++kb) {
        const s16x4 qlo = *(const s16x4*)(Qb + (16 * i + r15) * QS + 32 * kb + 4 * fq);
        const s16x4 qhi = *(const s16x4*)(Qb + (16 * i + r15) * QS + 32 * kb + 16 + 4 * fq);
        const bf16x8 qa = __builtin_shufflevector(qlo, qhi, 0, 1, 2, 3, 4, 5, 6, 7);
        const bf16x8 sb = __builtin_bit_cast(bf16x8, make_uint4(pack2(S[2 * kb][0], S[2 * kb][1]), pack2(S[2 * kb][2], S[2 * kb][3]),
                                                                  pack2(S[2 * kb + 1][0], S[2 * kb + 1][1]), pack2(S[2 * kb + 1][2], S[2 * kb + 1][3])));
        o = __builtin_amdgcn_mfma_f32_16x16x32_bf16(qa, sb, o, 0, 0, 0);
      }
      const s16x4 vb = *(const s16x4*)(Vb + (16 * wave + r15) * TS + 16 * i + 4 * fq);
      const s16x4 z4 = (s16x4){0, 0, 0, 0};
      const bf16x8 vb8 = __builtin_shufflevector(vb, z4, 0, 1, 2, 3, 4, 5, 6, 7);
      o = __builtin_amdgcn_mfma_f32_16x16x32_bf16(a8, vb8, o, 0, 0, 0);
#pragma unroll
      for (int jj = 0; jj < 4; ++jj) {
        const int row = tokrow(ck * 64 + 16 * i + 4 * fq + jj);
        Ro[(size_t)row * ldo] = f2bf(o[jj]);
      }
#pragma unroll
      for (int db = 0; db < NDB; ++db) {
        const float4 et = *(const float4*)(Eb + i * DK + 16 * db + 4 * fq);
        f32x4 s = S[db];
        s[0] *= et.x; s[1] *= et.y; s[2] *= et.z; s[3] *= et.w;
        const s16x4 ka = *(const s16x4*)(KTb + (16 * db + r15) * TS + 16 * i + 4 * fq);
        S[db] = __builtin_amdgcn_mfma_f32_16x16x32_bf16(__builtin_shufflevector(ka, z4, 0, 1, 2, 3, 4, 5, 6, 7), vb8, s, 0, 0, 0);
      }
    }
    __syncthreads();
  }
}

template <int MODE>
__device__ void scan3_item(const Params& p, int l, int item) {
  constexpr int DK = MODE ? 128 : 64, NH = MODE ? 8 : 4, LDP = MODE ? LDP_O : LDP_E, NDB = DK / 16, QS = DK + 8, TS = 72;
  constexpr int NSB = MODE ? 2 : 1;
  constexpr int NCK = NKK / 64;
  const int dir = item & 1, h = (item >> 1) % NH, b = item / (2 * NH);
  bf16_t* Qh = (bf16_t*)smem_raw; bf16_t* Kh = Qh + 64 * QS; bf16_t* KbT = Kh + 64 * QS; bf16_t* VT = KbT + DK * TS;
  constexpr int BUFE = 2 * 64 * QS + DK * TS + 128 * TS + 2 * 4 * DK;
  const int tid = TID(), wave = __builtin_amdgcn_readfirstlane(tid >> 6), lane = tid & 63, r15 = lane & 15, fq = lane >> 4;
  const int rowc = ML + b * TCX, rowl = b * TL;
  auto tokrow = [&](int n) -> int { return n < TCX ? rowc + (dir ? (TCX - 1 - n) : n) : rowl + (dir ? (TL - 1 - (n - TCX)) : (n - TCX)); };
  __syncthreads();
  if (wave >= 4) {
    const int pt = tid - 256;
    const int pd = pt % DK, pi0 = __builtin_amdgcn_readfirstlane(pt / DK);
    const int ve = pt & 127, vi0 = __builtin_amdgcn_readfirstlane(pt >> 7);
    float lbv = 0.f;
    if (MODE == 1) {
      const float* lr = p.lb_raw + (size_t)dir * 4 * 1024 + h * 128 + pd;
      const float r0 = lr[0], r1 = lr[1024], r2 = lr[2048], r3 = lr[3072];
      const float mx = fmaxf(fmaxf(r0, r1), fmaxf(r2, r3));
      const float e0 = __expf(r0 - mx), e1 = __expf(r1 - mx), e2 = __expf(r2 - mx), e3 = __expf(r3 - mx);
      float a = 0.f;
      if (l >= 1) a += e1;
      if (l >= 2) a += e2;
      if (l >= 3) a += e3;
      lbv = a / (e0 + e1 + e2 + e3);
    }
    const int qcol = MODE ? h * 128 + pd : 1536 + h * 64 + pd;
    const int kcol = MODE ? 1024 + dir * 1024 + h * 128 + pd : 1792 + h * 64 + pd;
    const int vcol = (MODE ? 3072 : 2048) + h * 128 + ve;
    const int gcol = dir * 256 + h * 64 + pd;
    unsigned rqkA[NSB][16], rv2A[2][8], rqkB[NSB][16], rv2B[2][8]; float rgA[NSB][16], rgB[NSB][16];
    const long rstep = dir ? -1 : 1;
    auto load_raw = [&](int ck, auto& rqk, auto& rv2, auto& rg) {
#pragma unroll
      for (int sb = 0; sb < NSB; ++sb) {
        const int pi = MODE ? pi0 + 2 * sb : pi0;
        const int row0 = tokrow(ck * 64 + 16 * pi);
        const bf16_t* pr = p.P + (size_t)row0 * LDP;
        const float* gr = p.Gk + (size_t)row0 * 512 + gcol;
#pragma unroll
        for (int tt = 0; tt < 16; ++tt) {
          rqk[sb][tt] = (unsigned)pr[qcol] | ((unsigned)pr[kcol] << 16);
          if (MODE == 0) { rg[sb][tt] = *gr; gr += rstep * 512; }
          pr += rstep * LDP;
        }
      }
#pragma unroll
      for (int sv = 0; sv < 2; ++sv) {
        const int row0 = tokrow(ck * 64 + 16 * (vi0 + 2 * sv));
        const bf16_t* pv = p.P + (size_t)row0 * LDP + vcol;
#pragma unroll
        for (int tt = 0; tt < 16; ++tt) {
          const unsigned vv = *pv; pv += rstep * LDP;
          if (tt & 1) rv2[sv][tt >> 1] |= vv << 16; else rv2[sv][tt >> 1] = vv;
        }
      }
    };
    auto prep = [&](int bi, auto& rqk, auto& rv2, auto& rg) {
      bf16_t* Qh_ = Qh + bi * BUFE; bf16_t* Kh_ = Kh + bi * BUFE; bf16_t* KbT_ = KbT + bi * BUFE; bf16_t* VT_ = VT + bi * BUFE; float* ET_ = (float*)(VT_ + 128 * TS);
#pragma unroll
      for (int sb = 0; sb < NSB; ++sb) {
        const int pi = MODE ? pi0 + 2 * sb : pi0;
        float E = 1.f, kh[16];
#pragma unroll
        for (int tt = 0; tt < 16; ++tt) {
          float q, k, dec;
          if (MODE == 1) {
            q = __uint_as_float(rqk[sb][tt] << 16);
            k = __uint_as_float(rqk[sb][tt] & 0xffff0000u);
            dec = 1.f - k;
          } else { q = __uint_as_float(rqk[sb][tt] << 16) * 0.125f; k = __uint_as_float(rqk[sb][tt] & 0xffff0000u); dec = rg[sb][tt]; }
          E *= dec;
          const float kE = k * __builtin_amdgcn_rcpf(E);
          kh[tt] = kE;
          Qh_[(16 * pi + tt) * QS + pd] = f2bf(q * E);
          Kh_[(16 * pi + tt) * QS + pd] = f2bf(kE);
        }
        ET_[pi * DK + pd] = E;
        unsigned w[8];
#pragma unroll
        for (int u = 0; u < 8; ++u) w[u] = pack2(kh[2 * u] * E, kh[2 * u + 1] * E);
        *(uint4*)(KbT_ + pd * TS + 16 * pi) = make_uint4(w[0], w[1], w[2], w[3]);
        *(uint4*)(KbT_ + pd * TS + 16 * pi + 8) = make_uint4(w[4], w[5], w[6], w[7]);
      }
#pragma unroll
      for (int sv = 0; sv < 2; ++sv) {
        const int vi = vi0 + 2 * sv;
        *(uint4*)(VT_ + ve * TS + 16 * vi) = make_uint4(rv2[sv][0], rv2[sv][1], rv2[sv][2], rv2[sv][3]);
        *(uint4*)(VT_ + ve * TS + 16 * vi + 8) = make_uint4(rv2[sv][4], rv2[sv][5], rv2[sv][6], rv2[sv][7]);
      }
    };
    load_raw(0, rqkA, rv2A, rgA);
    load_raw(1, rqkB, rv2B, rgB);
    prep(0, rqkA, rv2A, rgA);
    load_raw(2, rqkA, rv2A, rgA);
    LDS_BARRIER();
    for (int ck = 0; ck < NCK; ck += 2) {
      if (ck + 1 < NCK) { prep((ck + 1) & 1, rqkB, rv2B, rgB); if (ck + 3 < NCK) load_raw(ck + 3, rqkB, rv2B, rgB); }
      LDS_BARRIER();
      if (ck + 2 < NCK) { prep((ck + 2) & 1, rqkA, rv2A, rgA); if (ck + 4 < NCK) load_raw(ck + 4, rqkA, rv2A, rgA); }
      LDS_BARRIER();
    }
  } else {
    bf16_t* Ro; int ldo;
    if (MODE == 0) { Ro = p.R2 + (size_t)dir * MT * 512; ldo = 512; } else { Ro = dir ? p.R2 : p.R1; ldo = 1024; }
    Ro += h * 128 + 32 * wave + 4 * fq;
    f32x4 S[2][NDB];
#pragma unroll
    for (int eb = 0; eb < 2; ++eb)
#pragma unroll
      for (int db = 0; db < NDB; ++db) S[eb][db] = (f32x4){0.f, 0.f, 0.f, 0.f};
    const s16x4 z4 = (s16x4){0, 0, 0, 0};
#if SCANPROBE
    unsigned long long twait = 0;
#endif
    LDS_BARRIER();
    for (int ck = 0; ck < NCK; ++ck) {
      const int bo = (ck & 1) * BUFE;
      const bf16_t* Qb = Qh + bo; const bf16_t* Kb = Kh + bo; const bf16_t* KTb = KbT + bo; const bf16_t* Vb = VT + bo; const float* Eb = (const float*)(Vb + 128 * TS);
#pragma unroll
      for (int i = 0; i < 4; ++i) {
        bf16x8 ka_[DK / 32], qb_[DK / 32], qa_[DK / 32], ka8_[NDB], vb8[2];
        float4 et_[NDB];
#pragma unroll
        for (int kb = 0; kb < DK / 32; ++kb) {
          ka_[kb] = *(const bf16x8*)(Kb + (16 * i + r15) * QS + 32 * kb + 8 * fq);
          qb_[kb] = *(const bf16x8*)(Qb + (16 * i + r15) * QS + 32 * kb + 8 * fq);
        }
#pragma unroll
        for (int kb = 0; kb < DK / 32; ++kb) {
          const s16x4 qlo = *(const s16x4*)(Qb + (16 * i + r15) * QS + 32 * kb + 4 * fq);
          const s16x4 qhi = *(const s16x4*)(Qb + (16 * i + r15) * QS + 32 * kb + 16 + 4 * fq);
          qa_[kb] = __builtin_shufflevector(qlo, qhi, 0, 1, 2, 3, 4, 5, 6, 7);
        }
#pragma unroll
        for (int eb = 0; eb < 2; ++eb) {
          const s16x4 vb = *(const s16x4*)(Vb + (32 * wave + 16 * eb + r15) * TS + 16 * i + 4 * fq);
          vb8[eb] = __builtin_shufflevector(vb, z4, 0, 1, 2, 3, 4, 5, 6, 7);
        }
#pragma unroll
        for (int db = 0; db < NDB; ++db) {
          et_[db] = *(const float4*)(Eb + i * DK + 16 * db + 4 * fq);
          const s16x4 ka = *(const s16x4*)(KTb + (16 * db + r15) * TS + 16 * i + 4 * fq);
          ka8_[db] = __builtin_shufflevector(ka, z4, 0, 1, 2, 3, 4, 5, 6, 7);
        }
        __builtin_amdgcn_sched_barrier(0);
        f32x4 att = (f32x4){0.f, 0.f, 0.f, 0.f};
#pragma unroll
        for (int kb = 0; kb < DK / 32; ++kb) att = __builtin_amdgcn_mfma_f32_16x16x32_bf16(ka_[kb], qb_[kb], att, 0, 0, 0);
        f32x4 o[2];
        o[0] = (f32x4){0.f, 0.f, 0.f, 0.f}; o[1] = (f32x4){0.f, 0.f, 0.f, 0.f};
#pragma unroll
        for (int kb = 0; kb < DK / 32; ++kb) {
#pragma unroll
          for (int eb = 0; eb < 2; ++eb) {
            const bf16x8 sb = __builtin_bit_cast(bf16x8, make_uint4(pack2(S[eb][2 * kb][0], S[eb][2 * kb][1]), pack2(S[eb][2 * kb][2], S[eb][2 * kb][3]),
                                                                      pack2(S[eb][2 * kb + 1][0], S[eb][2 * kb + 1][1]), pack2(S[eb][2 * kb + 1][2], S[eb][2 * kb + 1][3])));
            o[eb] = __builtin_amdgcn_mfma_f32_16x16x32_bf16(sb, qa_[kb], o[eb], 0, 0, 0);
          }
        }
#pragma unroll
        for (int db = 0; db < NDB; ++db) {
#pragma unroll
          for (int eb = 0; eb < 2; ++eb) {
            f32x4 s = S[eb][db];
            s[0] *= et_[db].x; s[1] *= et_[db].y; s[2] *= et_[db].z; s[3] *= et_[db].w;
            S[eb][db] = __builtin_amdgcn_mfma_f32_16x16x32_bf16(ka8_[db], vb8[eb], s, 0, 0, 0);
          }
        }
        const unsigned a01 = pack2((4 * fq + 0 <= r15) ? att[0] : 0.f, (4 * fq + 1 <= r15) ? att[1] : 0.f);
        const unsigned a23 = pack2((4 * fq + 2 <= r15) ? att[2] : 0.f, (4 * fq + 3 <= r15) ? att[3] : 0.f);
        const bf16x8 a8 = __builtin_bit_cast(bf16x8, make_uint4(a01, a23, 0u, 0u));
#pragma unroll
        for (int eb = 0; eb < 2; ++eb) o[eb] = __builtin_amdgcn_mfma_f32_16x16x32_bf16(vb8[eb], a8, o[eb], 0, 0, 0);
#if STOREPROBE
        for (int rep = 0; rep < 2; ++rep) {
        asm volatile("" ::: "memory");
#endif
        {
          const int row = tokrow(ck * 64 + 16 * i + r15);
#pragma unroll
          for (int eb = 0; eb < 2; ++eb) *(uint2*)(Ro + (size_t)row * ldo + 16 * eb) = make_uint2(pack2(o[eb][0], o[eb][1]), pack2(o[eb][2], o[eb][3]));
        }
#if STOREPROBE
        }
#endif
      }
#if SCANPROBE
      const unsigned long long tb0 = __builtin_amdgcn_s_memrealtime();
      LDS_BARRIER();
      twait += __builtin_amdgcn_s_memrealtime() - tb0;
#else
      LDS_BARRIER();
#endif
    }
#if SCANPROBE
    if (MODE == 1 && blockIdx.x == 0 && tid == 0) { p.ctr[48] += (unsigned)twait; }
#endif
  }
}

DI void unpack8(const uint4& r, float (&v)[8]) {
  v[0] = __uint_as_float(r.x << 16); v[1] = __uint_as_float(r.x & 0xffff0000u); v[2] = __uint_as_float(r.y << 16); v[3] = __uint_as_float(r.y & 0xffff0000u);
  v[4] = __uint_as_float(r.z << 16); v[5] = __uint_as_float(r.z & 0xffff0000u); v[6] = __uint_as_float(r.w << 16); v[7] = __uint_as_float(r.w & 0xffff0000u);
}
DI float sum16(float s) { s += __shfl_xor(s, 1, 64); s += __shfl_xor(s, 2, 64); s += __shfl_xor(s, 4, 64); s += __shfl_xor(s, 8, 64); return s; }

__device__ void phase_post_even(const Params& p, int l) {
  const int j = l >> 1;
  const int wave = TID() >> 6, lane = TID() & 63;
  const float lambda_init = 0.8f - 0.6f * expf(-0.3f * (float)l);
  const float* la = p.lambda_a + j * 256;
  const float s1 = wave_sum(la[lane] * la[64 + lane]);
  const float s2 = wave_sum(la[128 + lane] * la[192 + lane]);
  const float lam = expf(s1) - expf(s2) + lambda_init;
  const int e0 = 8 * (lane & 15);
  float ga[8], gb[8];
#pragma unroll
  for (int u = 0; u < 8; ++u) { ga[u] = p.subln[j * 128 + e0 + u] * (1.f - lambda_init); gb[u] = p.onorm_b[j * 128 + e0 + u]; }
  const int gw = blockIdx.x * 8 + wave, nw = gridDim.x * 8;
  for (int blk = gw; blk < MT / 4; blk += nw) {
    uint4 A1[4], A2[4], Bf[4], Bb[4], G[4];
#pragma unroll
    for (int k = 0; k < 4; ++k) {
      const int row = blk * 4 + k;
      const bf16_t* r1 = p.R1 + (size_t)row * D;
      A1[k] = *(const uint4*)(r1 + lane * 8); A2[k] = *(const uint4*)(r1 + 512 + lane * 8);
      Bf[k] = *(const uint4*)(p.R2 + (size_t)row * 512 + lane * 8);
      Bb[k] = *(const uint4*)(p.R2 + (size_t)MT * 512 + (size_t)row * 512 + lane * 8);
      G[k] = *(const uint4*)(p.P + (size_t)row * LDP_E + 2560 + lane * 8);
    }
#pragma unroll
    for (int k = 0; k < 4; ++k) {
      const int row = blk * 4 + k;
      float a1[8], a2[8], bf_[8], bb_[8], g[8], x[8], y[8];
      unpack8(A1[k], a1); unpack8(A2[k], a2); unpack8(Bf[k], bf_); unpack8(Bb[k], bb_); unpack8(G[k], g);
      float sx = 0.f, sy = 0.f;
#pragma unroll
      for (int u = 0; u < 8; ++u) { x[u] = a1[u] - lam * a2[u]; y[u] = bf_[u] + bb_[u]; sx += x[u] * x[u]; sy += y[u] * y[u]; }
      const float ra = rsqrtf(sum16(sx) * (1.f / 128.f) + EPSN), rb = rsqrtf(sum16(sy) * (1.f / 128.f) + EPSN);
#pragma unroll
      for (int u = 0; u < 8; ++u) { x[u] = x[u] * ra * ga[u]; y[u] = y[u] * rb * gb[u] * siluf(g[u]); }
      bf16_t* r1 = p.R1 + (size_t)row * D;
      *(uint4*)(r1 + lane * 8) = make_uint4(pack2(x[0], x[1]), pack2(x[2], x[3]), pack2(x[4], x[5]), pack2(x[6], x[7]));
      *(uint4*)(r1 + 512 + lane * 8) = make_uint4(pack2(y[0], y[1]), pack2(y[2], y[3]), pack2(y[4], y[5]), pack2(y[6], y[7]));
    }
  }
}

__device__ void phase_post_odd(const Params& p, int l, int nrows) {
  const int j = l >> 1;
  const int wave = TID() >> 6, lane = TID() & 63;
  const int e0 = 8 * (lane & 15);
  float gc[8];
#pragma unroll
  for (int u = 0; u < 8; ++u) gc[u] = p.onorm_c[j * 128 + e0 + u];
  const int gw = blockIdx.x * 8 + wave, nw = gridDim.x * 8;
  for (int blk = gw; blk < nrows / 2; blk += nw) {
    uint4 A[2][2], B[2][2], G[2][2];
#pragma unroll
    for (int k = 0; k < 2; ++k)
#pragma unroll
      for (int hf = 0; hf < 2; ++hf) {
        const int row = blk * 2 + k;
        A[k][hf] = *(const uint4*)(p.R1 + (size_t)row * D + hf * 512 + lane * 8);
        B[k][hf] = *(const uint4*)(p.R2 + (size_t)row * D + hf * 512 + lane * 8);
        G[k][hf] = *(const uint4*)(p.P + (size_t)row * LDP_O + 4096 + hf * 512 + lane * 8);
      }
#pragma unroll
    for (int k = 0; k < 2; ++k)
#pragma unroll
      for (int hf = 0; hf < 2; ++hf) {
        const int row = blk * 2 + k;
        float a[8], bq[8], g[8], y[8];
        unpack8(A[k][hf], a); unpack8(B[k][hf], bq); unpack8(G[k][hf], g);
        float sy = 0.f;
#pragma unroll
        for (int u = 0; u < 8; ++u) { y[u] = a[u] + bq[u]; sy += y[u] * y[u]; }
        const float rb = rsqrtf(sum16(sy) * (1.f / 128.f) + EPSN);
#pragma unroll
        for (int u = 0; u < 8; ++u) y[u] = y[u] * rb * gc[u] * siluf(g[u]);
        *(uint4*)(p.R1 + (size_t)row * D + hf * 512 + lane * 8) = make_uint4(pack2(y[0], y[1]), pack2(y[2], y[3]), pack2(y[4], y[5]), pack2(y[6], y[7]));
      }
  }
}

constexpr int NPHASE = 1 + 4 * 9;
#ifndef GEMM_INL
#define GEMM_INL
#endif
__device__ GEMM_INL void gemm_call_p(const bf16_t* A, const bf16_t* Bt, int M, int N, int K, EpiArgs ea) { gemm_phase<EPI_P>(A, Bt, M, N, K, ea); }
__device__ GEMM_INL void gemm_call_res(const bf16_t* A, const bf16_t* Bt, int M, int N, int K, EpiArgs ea) { gemm_phase<EPI_RES>(A, Bt, M, N, K, ea); }
__device__ GEMM_INL void gemm_call_sw(const bf16_t* A, const bf16_t* Bt, int M, int N, int K, EpiArgs ea) { gemm_phase<EPI_SWIGLU>(A, Bt, M, N, K, ea); }

__device__ void run_phase(const Params& p, int ph) {
  if (ph == 0) { phase_init(p); return; }
  const int l = (ph - 1) / 9, s = (ph - 1) % 9, j = l >> 1;
  const bool even = (l & 1) == 0;
  const int mrows = l < 3 ? MT : ML;
  const float* modl = p.mod + (size_t)l * 9 * 6144;
  float* slab = (float*)(p.P + (size_t)56 * 1024 * 1024);
  if (s == 1 || s == 5 || s == 8) {
    if (s == 1) {
      EpiArgs ea{p.P, even ? LDP_E : LDP_O, nullptr, nullptr, nullptr, nullptr, nullptr, even ? nullptr : p.lb_raw, l, nullptr, nullptr, nullptr, nullptr, nullptr, 0, 0};
      const bf16_t* Bt = even ? p.wt_in_even + (size_t)j * LDP_E * 1024 : p.wt_in_odd + (size_t)j * LDP_O * 1024;
      gemm_call_p(p.R1, Bt, MT, even ? LDP_E : LDP_O, 1024, ea);
    } else {
      const bool fuse = FUSE_NORM && gridDim.x == 256 && (s == 5 || l < 3);
      const int inst = l * 2 + (s == 8 ? 1 : 0), ln = s == 5 ? l : l + 1;
      EpiArgs ea{nullptr, 0, p.out, p.Z, modl + (s == 5 ? 2 : 5) * 1024, slab, (l == 0 && s == 5) ? p.x : p.out, nullptr, 0,
                 fuse ? p.rowss + (size_t)inst * ML : nullptr, p.pcnt + (size_t)inst * 64 * 32, s == 5 ? p.R2 : p.R1,
                 (s == 5 ? p.n2g : p.n1g) + (fuse ? ln : 0) * 1024, p.mod + (size_t)(fuse ? ln : 0) * 9 * 6144, s == 5 ? 3 : 0, s == 5 ? 4 : 1};
      const bf16_t* A = s == 5 ? p.R1 : p.P;
      const bf16_t* Bt = s == 5 ? (even ? p.wt_out_even : p.wt_out_odd) + (size_t)j * 1024 * 1024 : p.wt_ffn_out + (size_t)l * 1024 * DFF;
      gemm_call_res(A, Bt, mrows, 1024, s == 5 ? 1024 : DFF, ea);
    }
    return;
  }
  switch (s) {
    case 0: phase_norm(p, l, 0, MT, p.R1, l > 0 ? p.mod + ((size_t)(l - 1) * 9 + 8) * 6144 + 5 * 1024 : nullptr, slab, l == 0 ? p.x : p.out, l == 0 ? p.ctx : p.Z, FUSE_NORM && gridDim.x == 256 && l > 0); break;
    case 2: if (even) phase_prep_even(p, j); break;
    case 3: {
      if (even) {
#if DYNQ
        int* qs = (int*)(smem_raw + LDS_BYTES - 16);
        for (;;) {
          __syncthreads();
          if (TID() == 0) *qs = (int)atomicAdd(p.ctr + l, 1u);
          __syncthreads();
          const int it = *qs;
          if (it >= 64 + 576) break;
#if ITEMPROBE
          const unsigned long long ti0 = __builtin_amdgcn_s_memrealtime();
#endif
          if (it < 64) scan3_item<0>(p, l, it); else attn_item(p, it - 64);
#if ITEMPROBE
          __syncthreads();
          if (blockIdx.x == ITEMPROBE_BLOCK && TID() == 0 && ((it < 64) == (ITEMPROBE == 1))) p.ctr[48] += (unsigned)(__builtin_amdgcn_s_memrealtime() - ti0);
#endif
        }
#else
#if EXP1
        for (int it = blockIdx.x; it < 256 + 576; it += gridDim.x) { if (it < 256) scan_item<0>(p, l, it); else attn_item(p, it - 256); }
#else
        for (int it = blockIdx.x; it < 64 + 576; it += gridDim.x) { if (it < 64) scan3_item<0>(p, l, it); else attn_item(p, it - 64); }
#endif
#endif
      } else {
        for (int it = blockIdx.x; it < 128; it += gridDim.x) scan3_item<1>(p, l, it);
        if (l == 1 && gridDim.x > 128 && blockIdx.x >= 128) { convert_weights(p, 1, blockIdx.x - 128, gridDim.x - 128); mod_table(p, 2, 2, blockIdx.x - 128, gridDim.x - 128); }
      }
    } break;
    case 4: if (even) phase_post_even(p, l); else phase_post_odd(p, l, mrows); break;
    case 6: phase_norm(p, l, 1, mrows, p.R2, l < 3 ? modl + (size_t)8 * 6144 + 2 * 1024 : nullptr, slab, p.out, l == 0 ? p.ctx : p.Z, FUSE_NORM && gridDim.x == 256); break;
    case 7: {
      EpiArgs ea{p.P, DFF, nullptr, nullptr, nullptr, nullptr, nullptr, nullptr, 0, nullptr, nullptr, nullptr, nullptr, nullptr, 0, 0};
      gemm_call_sw(p.R2, p.wt_ffn_in + (size_t)l * 5632 * 1024, mrows, 5632, 1024, ea);
    } break;
  }
}

#define XB_TMO      128
#define XB_XCNT(j)  (256  + 64 * (j))
#define XB_XSUB(j)  (1280 + 64 * (j))
#define XB_XGEN(j)  (2304 + 64 * (j))
#define XB_TOP      3328
#define XB_TOPGEN   3392
#define XCD_BAR_WORDS 3456
#define XB_SPIN_CAP (1u << 20)
DI unsigned xb_ld(unsigned* p)              { return __hip_atomic_load(p, __ATOMIC_RELAXED, __HIP_MEMORY_SCOPE_AGENT); }
DI unsigned xb_add(unsigned* p, unsigned v) { return __hip_atomic_fetch_add(p, v, __ATOMIC_RELAXED, __HIP_MEMORY_SCOPE_AGENT); }
DI unsigned xb_xcc_id() { return (unsigned)__builtin_amdgcn_s_getreg((3 << 11) | 20) & 0xFu; }
#define XB_SPIN(cond, bar) do { unsigned _sp = 0; while (cond) { __builtin_amdgcn_s_sleep(1); \
    if ((++_sp & 255u) == 0u) { if (xb_ld(&(bar)[XB_TMO])) break; if (_sp > XB_SPIN_CAP) { atomicAdd(&(bar)[XB_TMO], 1u); break; } } } } while (0)
struct XcdBarrier { unsigned* bar; unsigned x; volatile LAS unsigned* st; };
DI XcdBarrier xcd_barrier_post(unsigned* bar, volatile LAS unsigned* st) {
  XcdBarrier b; b.bar = bar; b.x = xb_xcc_id(); b.st = st;
  if (threadIdx.x == 0) (void)xb_add(&bar[XB_XCNT(b.x)], 1u);
  return b;
}
DI void xcd_barrier_complete(unsigned* bar, unsigned x, unsigned& nloc, unsigned& nx) {
  const unsigned G = gridDim.x * gridDim.y * gridDim.z;
  unsigned sum, cnt, mine, sp = 0u;
  for (;;) {
    sum = 0u; cnt = 0u; mine = 0u;
#pragma unroll
    for (unsigned j = 0; j < 16; ++j) { const unsigned c = xb_ld(&bar[XB_XCNT(j)]); sum += c; cnt += (c > 0u) ? 1u : 0u; mine = (j == x) ? c : mine; }
    if (sum == G) break;
    __builtin_amdgcn_s_sleep(1);
    if ((++sp & 255u) == 0u) { if (xb_ld(&bar[XB_TMO])) break; if (sp > XB_SPIN_CAP) { atomicAdd(&bar[XB_TMO], 1u); break; } }
  }
  nloc = mine > 0u ? mine : 1u; nx = cnt > 0u ? cnt : 1u;
}
DI void xcd_barrier(const XcdBarrier& b) {
  asm volatile("s_waitcnt vmcnt(0)" ::: "memory");
  __syncthreads();
  if (threadIdx.x == 0) {
    unsigned* bar = b.bar;
    __builtin_amdgcn_s_waitcnt(0);
    unsigned nloc = b.st[0], nx = b.st[1];
    if (nloc == 0u) { xcd_barrier_complete(bar, b.x, nloc, nx); b.st[0] = nloc; b.st[1] = nx; }
    const unsigned old = xb_add(&bar[XB_XSUB(b.x)], 1u);
    const unsigned gen = old / nloc;
    if (old + 1u == (gen + 1u) * nloc) {
      __builtin_amdgcn_fence(__ATOMIC_RELEASE, "agent");
      asm volatile("s_waitcnt vmcnt(0)" ::: "memory");
      const unsigned og = xb_add(&bar[XB_TOP], 1u);
      const unsigned tg = og / nx;
      if (og + 1u == (tg + 1u) * nx) xb_add(&bar[XB_TOPGEN], 1u);
      else XB_SPIN(xb_ld(&bar[XB_TOPGEN]) == tg, bar);
      __builtin_amdgcn_fence(__ATOMIC_ACQUIRE, "agent");
      xb_add(&bar[XB_XGEN(b.x)], 1u);
      asm volatile("s_waitcnt vmcnt(0)" ::: "memory");
    } else {
      XB_SPIN(xb_ld(&bar[XB_XGEN(b.x)]) == gen, bar);
      __builtin_amdgcn_fence(__ATOMIC_ACQUIRE, "agent");
      asm volatile("s_waitcnt vmcnt(0)" ::: "memory");
    }
  }
  __syncthreads();
}

DI void grid_barrier(unsigned* ctr, unsigned target) {
  asm volatile("s_waitcnt vmcnt(0)" ::: "memory");
  __syncthreads();
  if (threadIdx.x == 0) {
    __builtin_amdgcn_fence(__ATOMIC_RELEASE, "agent");
    asm volatile("s_waitcnt vmcnt(0)" ::: "memory");
    __hip_atomic_fetch_add(ctr, 1u, __ATOMIC_RELAXED, __HIP_MEMORY_SCOPE_AGENT);
    unsigned spins = 0;
    while (__hip_atomic_load(ctr, __ATOMIC_RELAXED, __HIP_MEMORY_SCOPE_AGENT) < target) { __builtin_amdgcn_s_sleep(1); if (++spins > (1u << 24)) break; }
  }
  __syncthreads();
  __builtin_amdgcn_fence(__ATOMIC_ACQUIRE, "agent");
  asm volatile("s_waitcnt vmcnt(0)" ::: "memory");
}

__global__ void __launch_bounds__(NTHR, 2) mega_kernel(Params p, int ph0, int ph1) {
  cg::grid_group grid = cg::this_grid();
  unsigned nbar = 0;
#if CUSTOM_BAR == 2
  volatile LAS unsigned* xst = (volatile LAS unsigned*)(LAS unsigned*)(smem_raw + LDS_BYTES - 32);
  if (threadIdx.x == 0) { xst[0] = 0u; xst[1] = 0u; }
  __syncthreads();
  XcdBarrier xbar = xcd_barrier_post(p.xbar, xst);
#endif
#if PROBE_SEL
  unsigned long long t_acc = 0;
#endif
  for (int ph = ph0; ph < ph1; ++ph) {
#if PROBE_SEL
    const unsigned long long t_beg = __builtin_amdgcn_s_memrealtime();
#endif
#if DBL_MASK
    { const int s_ = ph == 0 ? 9 : (ph - 1) % 9; const int nrep = ((DBL_MASK >> s_) & 1) ? 2 : 1; for (int rep = 0; rep < nrep; ++rep) run_phase(p, ph); }
#else
    run_phase(p, ph);
#endif
    if (ph + 1 < ph1) {
      if (ph > 0) { const int s_ = (ph - 1) % 9, l_ = (ph - 1) / 9; if (s_ == 2 && (l_ & 1)) continue; }
#if CUSTOM_BAR == 2
      if (ph1 > 4096) grid.sync();
      xcd_barrier(xbar);
#elif CUSTOM_BAR
      if (ph == 0) grid.sync(); else { ++nbar; grid_barrier(p.ctr + 32, nbar * gridDim.x); }
#if EXTRA_SYNC
      if (ph > 0) { ++nbar; grid_barrier(p.ctr + 32, nbar * gridDim.x); ++nbar; grid_barrier(p.ctr + 32, nbar * gridDim.x); }
#endif
#else
      grid.sync();
#endif
#if PROBE_SEL
      { const int s_ = ph == 0 ? 9 : (ph - 1) % 9, l_ = ph == 0 ? 0 : (ph - 1) / 9;
        if (((PROBE_SEL >> s_) & 1) && ((PROBE_LAYERS >> l_) & 1)) t_acc += __builtin_amdgcn_s_memrealtime() - t_beg; }
#endif
    }
  }
#if PROBE_SEL
  { const unsigned long long t0 = __builtin_amdgcn_s_memrealtime(); while (__builtin_amdgcn_s_memrealtime() - t0 < t_acc) __builtin_amdgcn_s_sleep(8); }
#endif
#if SCANPROBE || ITEMPROBE
  if (blockIdx.x == ITEMPROBE_BLOCK) { const unsigned long long tw = p.ctr[48]; const unsigned long long t0 = __builtin_amdgcn_s_memrealtime(); while (__builtin_amdgcn_s_memrealtime() - t0 < tw) __builtin_amdgcn_s_sleep(8); }
#endif
}

extern "C" void kernel_launch(void* const* d_in, const int* in_sizes, int n_in, void* d_out, int out_size, void* d_ws, size_t ws_size, hipStream_t stream) {
  constexpr size_t kDynLds = LDS_BYTES;
  static int grid_blocks = 0;
  if (!grid_blocks) {
    hipFuncSetAttribute((const void*)mega_kernel, hipFuncAttributeMaxDynamicSharedMemorySize, (int)kDynLds);
    int dev = 0, cus = 0, per_cu = 0;
    hipGetDevice(&dev);
    hipDeviceGetAttribute(&cus, hipDeviceAttributeMultiprocessorCount, dev);
    hipOccupancyMaxActiveBlocksPerMultiprocessor(&per_cu, mega_kernel, NTHR, kDynLds);
    if (per_cu < 1) per_cu = 1;
    grid_blocks = cus * per_cu;
  }
  Params p{};
  const float* const* in = (const float* const*)d_in;
  p.x = in[0]; p.c = in[1]; p.ctx = in[2]; p.c_ctx = in[3]; p.w_ada = in[4]; p.b_ada = in[5]; p.n1g = in[6]; p.n2g = in[7];
  p.w_in_even = in[8]; p.qk_gain = in[9]; p.lambda_a = in[10]; p.subln = in[11]; p.w_gate_up = in[12]; p.b_gate_up = in[13];
  p.onorm_b = in[14]; p.w_out_even = in[15]; p.w_in_odd = in[16]; p.lb_raw = in[17]; p.onorm_c = in[18]; p.w_out_odd = in[19];
  p.w_ffn_in = in[20]; p.w_ffn_out = in[21];
  p.out = (float*)d_out;
  char* w = (char*)d_ws;
  size_t off = 0;
  auto take = [&](size_t bytes) { char* r = w + off; off += (bytes + 255) & ~(size_t)255; return r; };
  p.wt_in_even = (bf16_t*)take((size_t)2 * LDP_E * 1024 * 2);
  p.wt_in_odd = (bf16_t*)take((size_t)2 * LDP_O * 1024 * 2);
  p.wt_out_even = (bf16_t*)take((size_t)2 * 1024 * 1024 * 2);
  p.wt_out_odd = (bf16_t*)take((size_t)2 * 1024 * 1024 * 2);
  p.wt_ffn_in = (bf16_t*)take((size_t)4 * 5632 * 1024 * 2);
  p.wt_ffn_out = (bf16_t*)take((size_t)4 * 1024 * DFF * 2);
  p.Z = (float*)take((size_t)MC * D * 4);
  p.mod = (float*)take((size_t)4 * 9 * 6144 * 4);
  p.P = (bf16_t*)take((size_t)MT * LDP_O * 2);
  p.R1 = (bf16_t*)take((size_t)MT * D * 2);
  p.R2 = (bf16_t*)take((size_t)MT * D * 2);
  p.Vt = p.P + (size_t)MT * LDP_E;
  p.Gk = (float*)(p.Vt + (size_t)NB * 4 * 128 * NKK);
  p.ctr = (unsigned*)take(256);
  p.xbar = (unsigned*)take(16384);
  p.rowss = (float*)take((size_t)8 * ML * 4);
  p.pcnt = (unsigned*)take((size_t)8 * 64 * 32 * 4);
  if (off > ws_size) { fprintf(stderr, "workspace too small: need %zu have %zu\n", off, ws_size); return; }
  hipMemsetAsync(p.ctr, 0, 256 + 16384 + (size_t)8 * ML * 4 + (size_t)8 * 64 * 32 * 4, stream);
#if ONE_LAUNCH
  int ph0 = 0, ph1 = NPHASE;
  void* args[] = {&p, &ph0, &ph1};
  hipError_t e = hipLaunchCooperativeKernel((const void*)mega_kernel, dim3(grid_blocks), dim3(NTHR), args, kDynLds, stream);
  if (e != hipSuccess) fprintf(stderr, "cooperative launch failed: %s (grid %d)\n", hipGetErrorString(e), grid_blocks);
#else
  for (int ph = 0; ph < NPHASE; ++ph) {
    const int l = (ph - 1) / 9, s = (ph - 1) % 9;
    if (ph > 0 && s == 2 && (l & 1)) continue;
    mega_kernel<<<grid_blocks, NTHR, kDynLds, stream>>>(p, ph, ph + 1);
  }
#endif
}
```
